# Optimizing an MI355X kernel written in HIP

```python
import jax
import jax.numpy as jnp
from jax import lax
import numpy as np

D_MODEL = 1024
BATCH = 32
SEQ = 2048
DEPTH = 1

GRID_W = 64
CTX_LEN = 256
HEAD_DIM = 64
RWKV_HEADS = 8
RWKV_DIM = RWKV_HEADS * HEAD_DIM
ATT_Q_HEADS = 8
ATT_KV_HEADS = 2
ATT_GROUP = ATT_Q_HEADS // ATT_KV_HEADS
ATT_DIM = ATT_Q_HEADS * HEAD_DIM
ATT_KV_DIM = ATT_KV_HEADS * HEAD_DIM
WINDOW = 128
BLOCK = 128
N_DIR = 2
DECAY_LORA = 64
AAA_LORA = 64
GATE_LORA = 128
N_BRANCH = 2
N_EXPERTS = 16
EC_FACTOR = 2
D_FF_EXPERT = 1536
CONV_W = 3
ROPE_BASE = 10000.0
NORM_EPS = 1e-6
LNX_EPS = 64e-5
MASK_VALUE = -1e30
SPLIT_REST = (N_DIR * DECAY_LORA, N_DIR * AAA_LORA, GATE_LORA, ATT_DIM, ATT_KV_DIM, ATT_KV_DIM, N_BRANCH * D_MODEL)
D_IN = 3 * RWKV_DIM + N_DIR * DECAY_LORA + N_DIR * AAA_LORA + GATE_LORA + ATT_DIM + 2 * ATT_KV_DIM + N_BRANCH * D_MODEL

kernel_name = "hybrid_rwkv7_swa_ec_moe_dit_layer"


def rmsnorm(x, g):
    xf = x.astype(jnp.float32)
    y = xf * lax.rsqrt(jnp.mean(xf * xf, axis=-1, keepdims=True) + NORM_EPS)
    return (y * g.astype(jnp.float32)).astype(x.dtype)


def modulate(h, shift, scale):
    return h * (1 + scale) + shift


def centred_short_conv(x, w):
    xp = jnp.pad(x, ((0, 0), (1, 1), (0, 0)))
    return w[0] * xp[:, :-2] + w[1] * xp[:, 1:-1] + w[2] * xp[:, 2:]


def project(h, w_in, conv_w):
    z = h @ w_in
    rkv = centred_short_conv(z[..., :3 * RWKV_DIM], conv_w)
    r, k, v = jnp.split(rkv, 3, axis=-1)
    rest = z[..., 3 * RWKV_DIM:]
    points = []
    acc = 0
    for size in SPLIT_REST[:-1]:
        acc += size
        points.append(acc)
    wd, ad, gd, q, kq, vq, gates = jnp.split(rest, points, axis=-1)
    return (r, k, v, wd, ad, gd, q, kq, vq, gates)


def rope_1d(x, pos):
    half = x.shape[-1] // 2
    inv_freq = ROPE_BASE ** (-jnp.arange(half, dtype=jnp.float32) / half)
    ang = pos.astype(jnp.float32)[:, None] * inv_freq[None, :]
    cos = jnp.cos(ang)[None, :, None, :]
    sin = jnp.sin(ang)[None, :, None, :]
    xf = x.astype(jnp.float32)
    x1, x2 = xf[..., :half], xf[..., half:]
    return jnp.concatenate([x1 * cos - x2 * sin, x1 * sin + x2 * cos], axis=-1).astype(x.dtype)


def rope_2d(x, row_pos, col_pos):
    d = x.shape[-1] // 2
    return jnp.concatenate([rope_1d(x[..., :d], row_pos), rope_1d(x[..., d:], col_pos)], axis=-1)


def to_heads(t):
    return t.reshape(t.shape[0], t.shape[1], RWKV_HEADS, HEAD_DIM)


def rwkv_direction_inputs(parts, d, p):
    r, k, v, wd, ad = (t.astype(jnp.float32) for t in parts[:5])
    wd_d = wd[..., d * DECAY_LORA:(d + 1) * DECAY_LORA]
    ad_d = ad[..., d * AAA_LORA:(d + 1) * AAA_LORA]
    w_log = -jax.nn.softplus(-(p["rwkv_w0"][d] + jnp.tanh(wd_d) @ p["rwkv_w2"][d])) - 0.5
    decay = jnp.exp(-jnp.exp(w_log))
    a = jax.nn.sigmoid(p["rwkv_a0"][d] + ad_d @ p["rwkv_a2"][d])
    kk = to_heads(k * p["rwkv_kk"][d])
    kk = kk * lax.rsqrt(jnp.maximum(jnp.sum(kk * kk, axis=-1, keepdims=True), 1e-24))
    k_mod = k * (1.0 + (a - 1.0) * p["rwkv_ka"][d])
    return (to_heads(r), to_heads(decay), to_heads(k_mod), to_heads(v), -kk, kk * to_heads(a))


def wkv7_scan(inputs, state0, reverse):
    xs = tuple(jnp.moveaxis(t, 1, 0) for t in inputs)

    def step(S, inp):
        r_t, w_t, k_t, v_t, a_t, b_t = inp
        Sa = jnp.einsum("bhvk,bhk->bhv", S, a_t)
        S = S * w_t[:, :, None, :] + Sa[..., :, None] * b_t[..., None, :] + v_t[..., :, None] * k_t[..., None, :]
        return S, jnp.einsum("bhvk,bhk->bhv", S, r_t)

    S_final, ys = lax.scan(step, state0, xs, reverse=reverse)
    return jnp.moveaxis(ys, 0, 1), S_final


def rwkv_bonus(inputs, r_k):
    r, _, k_mod, v = inputs[:4]
    return jnp.sum(r * k_mod * r_k.astype(jnp.float32), axis=-1, keepdims=True) * v


def rwkv_output(ys, bonus, gd, p):
    B, L = ys.shape[:2]
    mean = jnp.mean(ys, axis=-1, keepdims=True)
    var = jnp.mean(jnp.square(ys - mean), axis=-1, keepdims=True)
    y = ((ys - mean) * lax.rsqrt(var + LNX_EPS)).reshape(B, L, RWKV_DIM)
    y = y * p["lnx_w"] + p["lnx_b"] + bonus.reshape(B, L, RWKV_DIM)
    g = jax.nn.sigmoid(gd.astype(jnp.float32)) @ p["rwkv_g2"]
    return y * g


def rwkv_branch(lat, ctx, p, update_ctx):
    B = lat[0].shape[0]
    state0 = jnp.zeros((B, RWKV_HEADS, HEAD_DIM, HEAD_DIM), jnp.float32)
    y_lat, b_lat, y_ctx, b_ctx = [], [], [], []
    for d in range(N_DIR):
        reverse = d == 1
        inp_ctx = rwkv_direction_inputs(ctx, d, p)
        inp_lat = rwkv_direction_inputs(lat, d, p)
        ys_c, state_ctx = wkv7_scan(inp_ctx, state0, reverse)
        ys_l, _ = wkv7_scan(inp_lat, state_ctx, reverse)
        y_lat.append(ys_l)
        b_lat.append(rwkv_bonus(inp_lat, p["rwkv_rk"][d]))
        if update_ctx:
            y_ctx.append(ys_c)
            b_ctx.append(rwkv_bonus(inp_ctx, p["rwkv_rk"][d]))
    out_lat = rwkv_output(y_lat[0] + y_lat[1], b_lat[0] + b_lat[1], lat[5], p).astype(lat[0].dtype)
    out_ctx = None
    if update_ctx:
        out_ctx = rwkv_output(y_ctx[0] + y_ctx[1], b_ctx[0] + b_ctx[1], ctx[5], p).astype(ctx[0].dtype)
    return out_lat, out_ctx


def attention_branch(lat, ctx, p, update_ctx):
    q, k, v = lat
    q_c, k_c, v_c = ctx
    B, L, _ = q.shape
    Lc = k_c.shape[1]
    rows = L // GRID_W
    row_pos = jnp.repeat(jnp.arange(rows, dtype=jnp.int32), GRID_W)
    col_pos = jnp.tile(jnp.arange(GRID_W, dtype=jnp.int32), rows)
    q = rope_2d(rmsnorm(q.reshape(B, L, ATT_Q_HEADS, HEAD_DIM), p["q_norm_g"]), row_pos, col_pos)
    k = rope_2d(rmsnorm(k.reshape(B, L, ATT_KV_HEADS, HEAD_DIM), p["k_norm_g"]), row_pos, col_pos)
    v = v.reshape(B, L, ATT_KV_HEADS, HEAD_DIM)
    kc = rmsnorm(k_c.reshape(B, Lc, ATT_KV_HEADS, HEAD_DIM), p["k_norm_g"])
    vc = v_c.reshape(B, Lc, ATT_KV_HEADS, HEAD_DIM)
    sink = p["attn_sink"].astype(jnp.float32).reshape(1, ATT_KV_HEADS, ATT_GROUP, 1, 1)
    scale = HEAD_DIM ** -0.5

    n_blocks = L // BLOCK
    pad = ((0, 0), (BLOCK, BLOCK), (0, 0), (0, 0))
    kp = jnp.pad(k, pad)
    vp = jnp.pad(v, pad)
    q_blocks = jnp.moveaxis(q.reshape(B, n_blocks, BLOCK, ATT_KV_HEADS, ATT_GROUP, HEAD_DIM), 1, 0)
    band = 3 * BLOCK

    def block_attend(args):
        i, q_i = args
        start = i * BLOCK
        k_i = lax.dynamic_slice_in_dim(kp, start, band, axis=1)
        v_i = lax.dynamic_slice_in_dim(vp, start, band, axis=1)
        q_pos = start + jnp.arange(BLOCK)
        k_pos = start - BLOCK + jnp.arange(band)
        allowed = ((jnp.abs(q_pos[:, None] - k_pos[None, :]) <= WINDOW)
                   & (k_pos[None, :] >= 0) & (k_pos[None, :] < L))
        s_win = jnp.einsum("bqhgd,bkhd->bhgqk", q_i, k_i).astype(jnp.float32) * scale
        s_win = jnp.where(allowed, s_win, MASK_VALUE)
        s_ctx = jnp.einsum("bqhgd,bkhd->bhgqk", q_i, kc).astype(jnp.float32) * scale
        s_sink = jnp.broadcast_to(sink, s_win.shape[:-1] + (1,))
        probs = jax.nn.softmax(jnp.concatenate([s_win, s_ctx, s_sink], axis=-1), axis=-1).astype(v.dtype)
        o = jnp.einsum("bhgqk,bkhd->bqhgd", probs[..., :band], v_i)
        return o + jnp.einsum("bhgqk,bkhd->bqhgd", probs[..., band:band + Lc], vc)

    out_lat = lax.map(block_attend, (jnp.arange(n_blocks, dtype=jnp.int32), q_blocks))
    out_lat = jnp.moveaxis(out_lat, 0, 1).reshape(B, L, ATT_DIM)

    out_ctx = None
    if update_ctx:
        qc = rmsnorm(q_c.reshape(B, Lc, ATT_Q_HEADS, HEAD_DIM), p["q_norm_g"])
        qc = qc.reshape(B, Lc, ATT_KV_HEADS, ATT_GROUP, HEAD_DIM)
        s = jnp.einsum("bqhgd,bkhd->bhgqk", qc, kc).astype(jnp.float32) * scale
        s_sink = jnp.broadcast_to(sink, s.shape[:-1] + (1,))
        probs = jax.nn.softmax(jnp.concatenate([s, s_sink], axis=-1), axis=-1)[..., :Lc].astype(vc.dtype)
        out_ctx = jnp.einsum("bhgqk,bkhd->bqhgd", probs, vc).reshape(B, Lc, ATT_DIM)
    return out_lat, out_ctx


def merge_branches(o_rwkv, o_attn, gate_logits, p):
    gate_rwkv, gate_attn = jnp.split(jax.nn.sigmoid(gate_logits), N_BRANCH, axis=-1)
    merged = gate_rwkv * (o_rwkv @ p["w_br_rwkv"]) + gate_attn * (o_attn @ p["w_br_attn"])
    return merged @ p["w_out"]


def ec_moe(h, p):
    B, L, D = h.shape
    cap = EC_FACTOR * L // N_EXPERTS
    aff = jax.nn.softmax((h @ p["router_w"]).astype(jnp.float32), axis=-1)
    vals, idx = lax.top_k(jnp.swapaxes(aff, 1, 2), cap)
    idx_e = jnp.swapaxes(idx, 0, 1)
    vals_e = jnp.swapaxes(vals, 0, 1)

    def expert(args):
        w_gate, w_up, w_down, idx_b, val_b = args
        xe = jax.vmap(lambda hb, ib: hb[ib])(h, idx_b)
        ye = (jax.nn.silu(xe @ w_gate) * (xe @ w_up)) @ w_down
        return (ye * val_b[..., None]).astype(h.dtype)

    ys = lax.map(expert, (p["exp_w_gate"], p["exp_w_up"], p["exp_w_down"], idx_e, vals_e))
    flat_idx = (jnp.arange(B, dtype=jnp.int32)[None, :, None] * L + idx_e).reshape(-1)
    out = jnp.zeros((B * L, D), h.dtype).at[flat_idx].add(ys.reshape(-1, D))
    return out.reshape(B, L, D)


def trunk_layer(x, ctx, c_silu, c_ctx_silu, p, update_ctx):
    mod_lat = (c_silu @ p["ada_w"] + p["ada_b"])[:, None, :]
    mod_ctx = (c_ctx_silu @ p["ada_w"] + p["ada_b"])[None, None, :]
    sh1, sc1, gt1, sh2, sc2, gt2 = jnp.split(mod_lat, 6, axis=-1)
    csh1, csc1, cgt1, csh2, csc2, cgt2 = jnp.split(mod_ctx, 6, axis=-1)

    pl = project(modulate(rmsnorm(x, p["norm1_g"]), sh1, sc1), p["w_in"], p["rwkv_conv"])
    pc = project(modulate(rmsnorm(ctx, p["norm1_g"]), csh1, csc1), p["w_in"], p["rwkv_conv"])
    rw_lat, rw_ctx = rwkv_branch(pl[:6], pc[:6], p, update_ctx)
    at_lat, at_ctx = attention_branch(pl[6:9], pc[6:9], p, update_ctx)
    x = x + gt1 * merge_branches(rw_lat, at_lat, pl[9], p)
    x = x + gt2 * ec_moe(modulate(rmsnorm(x, p["norm2_g"]), sh2, sc2), p)
    if update_ctx:
        ctx = ctx + cgt1 * merge_branches(rw_ctx, at_ctx, pc[9], p)
        ctx = ctx + cgt2 * ec_moe(modulate(rmsnorm(ctx, p["norm2_g"]), csh2, csc2), p)
    return x, ctx


def setup_inputs(seed: int = 0) -> dict:
    key = jax.random.key(seed)
    ks = jax.random.split(key, 32)

    def nrm(k, shape, scale):
        return jax.random.normal(k, shape, jnp.float32) * scale

    centre = jnp.array([0.0, 1.0, 0.0], jnp.float32)[None, :, None]
    return {
        "x": nrm(ks[0], (BATCH, SEQ, D_MODEL), 1.0),
        "c": nrm(ks[1], (BATCH, D_MODEL), 1.0),
        "ctx": nrm(ks[2], (BATCH, CTX_LEN, D_MODEL), 1.0),
        "c_ctx": nrm(ks[3], (D_MODEL,), 1.0),
        "ada_w": nrm(ks[4], (DEPTH, D_MODEL, 6 * D_MODEL), 0.5 * D_MODEL ** -0.5),
        "ada_b": nrm(ks[5], (DEPTH, 6 * D_MODEL), 0.02),
        "norm1_g": 1.0 + nrm(ks[6], (DEPTH, D_MODEL), 0.02),
        "norm2_g": 1.0 + nrm(ks[7], (DEPTH, D_MODEL), 0.02),
        "w_in": nrm(ks[8], (DEPTH, D_MODEL, D_IN), D_MODEL ** -0.5),
        "rwkv_conv": centre + nrm(ks[9], (DEPTH, CONV_W, 3 * RWKV_DIM), 0.2),
        "rwkv_w0": jax.random.uniform(ks[10], (DEPTH, N_DIR, RWKV_DIM), jnp.float32, -3.0, 1.0),
        "rwkv_w2": nrm(ks[11], (DEPTH, N_DIR, DECAY_LORA, RWKV_DIM), 0.1),
        "rwkv_a0": nrm(ks[12], (DEPTH, N_DIR, RWKV_DIM), 0.5),
        "rwkv_a2": nrm(ks[13], (DEPTH, N_DIR, AAA_LORA, RWKV_DIM), AAA_LORA ** -0.5),
        "rwkv_kk": 0.85 + nrm(ks[14], (DEPTH, N_DIR, RWKV_DIM), 0.05),
        "rwkv_ka": 1.0 + nrm(ks[15], (DEPTH, N_DIR, RWKV_DIM), 0.05),
        "rwkv_rk": nrm(ks[16], (DEPTH, N_DIR, RWKV_HEADS, HEAD_DIM), 0.1),
        "rwkv_g2": nrm(ks[17], (DEPTH, GATE_LORA, RWKV_DIM), GATE_LORA ** -0.5),
        "lnx_w": 1.0 + nrm(ks[18], (DEPTH, RWKV_DIM), 0.02),
        "lnx_b": nrm(ks[19], (DEPTH, RWKV_DIM), 0.02),
        "q_norm_g": 1.0 + nrm(ks[20], (DEPTH, HEAD_DIM), 0.02),
        "k_norm_g": 1.0 + nrm(ks[21], (DEPTH, HEAD_DIM), 0.02),
        "attn_sink": nrm(ks[22], (DEPTH, ATT_Q_HEADS), 1.0),
        "w_br_rwkv": nrm(ks[23], (DEPTH, RWKV_DIM, D_MODEL), RWKV_DIM ** -0.5),
        "w_br_attn": nrm(ks[24], (DEPTH, ATT_DIM, D_MODEL), ATT_DIM ** -0.5),
        "w_out": nrm(ks[25], (DEPTH, D_MODEL, D_MODEL), D_MODEL ** -0.5),
        "router_w": nrm(ks[26], (DEPTH, D_MODEL, N_EXPERTS), D_MODEL ** -0.5),
        "exp_w_gate": nrm(ks[27], (DEPTH, N_EXPERTS, D_MODEL, D_FF_EXPERT), D_MODEL ** -0.5),
        "exp_w_up": nrm(ks[28], (DEPTH, N_EXPERTS, D_MODEL, D_FF_EXPERT), D_MODEL ** -0.5),
        "exp_w_down": nrm(ks[29], (DEPTH, N_EXPERTS, D_FF_EXPERT, D_MODEL), D_FF_EXPERT ** -0.5),
    }


def reference(x, c, ctx, c_ctx, ada_w, ada_b, norm1_g, norm2_g, w_in, rwkv_conv, rwkv_w0, rwkv_w2,
              rwkv_a0, rwkv_a2, rwkv_kk, rwkv_ka, rwkv_rk, rwkv_g2, lnx_w, lnx_b, q_norm_g, k_norm_g,
              attn_sink, w_br_rwkv, w_br_attn, w_out, router_w, exp_w_gate, exp_w_up, exp_w_down):
    c_silu = jax.nn.silu(c)
    c_ctx_silu = jax.nn.silu(c_ctx)
    for layer in range(DEPTH):
        p = {
            "ada_w": ada_w[layer], "ada_b": ada_b[layer],
            "norm1_g": norm1_g[layer], "norm2_g": norm2_g[layer],
            "w_in": w_in[layer], "rwkv_conv": rwkv_conv[layer],
            "rwkv_w0": rwkv_w0[layer], "rwkv_w2": rwkv_w2[layer],
            "rwkv_a0": rwkv_a0[layer], "rwkv_a2": rwkv_a2[layer],
            "rwkv_kk": rwkv_kk[layer], "rwkv_ka": rwkv_ka[layer], "rwkv_rk": rwkv_rk[layer],
            "rwkv_g2": rwkv_g2[layer], "lnx_w": lnx_w[layer], "lnx_b": lnx_b[layer],
            "q_norm_g": q_norm_g[layer], "k_norm_g": k_norm_g[layer], "attn_sink": attn_sink[layer],
            "w_br_rwkv": w_br_rwkv[layer], "w_br_attn": w_br_attn[layer], "w_out": w_out[layer],
            "router_w": router_w[layer], "exp_w_gate": exp_w_gate[layer],
            "exp_w_up": exp_w_up[layer], "exp_w_down": exp_w_down[layer],
        }
        x, ctx = trunk_layer(x, ctx, c_silu, c_ctx_silu, p, layer < DEPTH - 1)
    return x
```

```cpp
#include <hip/hip_runtime.h>
#include <cstdio>
#include <cstdint>
#define MK_N_LAUNCHES 12
namespace pg8 {
#define PG8_LAS __attribute__((address_space(3)))
typedef unsigned short bf16_t;
typedef short bf16x8 __attribute__((ext_vector_type(8)));
typedef float f32x4 __attribute__((ext_vector_type(4)));
typedef unsigned u32x4 __attribute__((ext_vector_type(4)));
constexpr int BM = 256, BK = 64, HALF = 128, HTB = HALF * BK * 2  , STAGE_BYTES = 8 * HTB, NXCD = 8, WGM = 8;

__host__ __device__ __forceinline__ int lds_byte(int r, int c) { const int st = (r >> 4) * 2 + (c >> 5), rr = r & 15, cc = c & 31, ob = rr * 64 + cc * 2; return st * 1024 + (ob ^ (((ob >> 9) & 1) << 5)); }
__host__ __device__ __forceinline__ void stage_rc(int b, int& R, int& C) { const int st = b / 1024, sb = b % 1024, swz = sb ^ (((sb >> 9) & 1) << 5); R = (st >> 1) * 16 + swz / 64; C = (st & 1) * 32 + (swz % 64) / 2; }
__host__ __device__ __forceinline__ int perm32(int rho) { const int n = rho >> 4, i = rho & 15; return 8 * (i >> 2) + 4 * n + (i & 3); }

struct Unit { int pm, pn; };
struct Gemm { const bf16_t* A; const bf16_t* Bt; int M, N, K; };

struct StaticOrder {
    int nM, nN, nwg, G, c;
    __host__ __device__ void init(int M, int N, int G_, int c_) { nM = M / BM; nN = N / BM; nwg = nM * nN; G = G_; c = c_; }
    __host__ __device__ bool next(int i, Unit& u) const {
        const long L = (long)i * G + c; if (L >= nwg) return false;
        int wgid = (int)L; { const int q = nwg / NXCD, r = nwg % NXCD, xcd = wgid % NXCD, off = wgid / NXCD; wgid = (xcd < r ? xcd * (q + 1) : r * (q + 1) + (xcd - r) * q) + off; }
        const int nig = WGM * nN, gid = wgid / nig, fm = gid * WGM, gsz = (nM - fm) < WGM ? (nM - fm) : WGM;
        u.pm = fm + ((wgid % nig) % gsz); u.pn = (wgid % nig) / gsz; return true;
    }
    __device__ __forceinline__ void a_ready(const Unit&) const {}
    __device__ __forceinline__ void done(const Unit&) const {}
};

template <class Epi, class Sched, bool ALIGN_EPI = false, bool SP2 = false>
__device__ __forceinline__ void gemm_phase(PG8_LAS unsigned char* lds, const Gemm g, const Sched& S, const Epi& E) {
    const int tid = threadIdx.x, wid = __builtin_amdgcn_readfirstlane(tid >> 6), lane = tid & 63, wr = wid >> 2, wc = wid & 3, fr = lane & 15, fq = lane >> 4;
    const int K = g.K, nt = K / BK;
    unsigned voffA[2], voffB[2];
#pragma unroll
    for (int i = 0; i < 2; ++i) { int R, C; stage_rc(tid * 16 + i * 8192, R, C); const int Rb = Epi::PERM ? ((R & ~31) + perm32(R & 31)) : R;
        voffA[i] = (unsigned)(R * K + C) * 2u; voffB[i] = (unsigned)(Rb * K + C) * 2u; }
    const size_t kstep = (size_t)(BK * 2);
    const size_t hstep = (size_t)HALF * K * 2;
    const size_t tstep = 2 * hstep;
    const unsigned ldsw = (unsigned)wid * 1024u;
    const int aoff = lds_byte(wr * 64 + fr, fq * 8), boff = lds_byte(wc * 32 + fr, fq * 8);
#define PG8_SA(b, h) (((b) * 2 + (h)) * HTB)
#define PG8_SB(b, h) ((4 + (b) * 2 + (h)) * HTB)
#define PG8_STAGE(bufoff, gbase, voff) do { _Pragma("unroll") for (int _i = 0; _i < 2; ++_i) \
        __builtin_amdgcn_global_load_lds((const unsigned*)((const char*)(gbase) + (voff)[_i]), (PG8_LAS unsigned*)(lds + (bufoff) + ldsw + _i * 8192), 16, 0, 0); } while (0)
#define PG8_LDA(dst, b, h) do { _Pragma("unroll") for (int m = 0; m < 4; ++m) _Pragma("unroll") for (int k = 0; k < 2; ++k) dst[m][k] = *(const PG8_LAS bf16x8*)(lds + PG8_SA(b, h) + aoff + m * 2048 + k * 1024); } while (0)
#define PG8_LDB(dst, b, h) do { _Pragma("unroll") for (int n = 0; n < 2; ++n) _Pragma("unroll") for (int k = 0; k < 2; ++k) dst[n][k] = *(const PG8_LAS bf16x8*)(lds + PG8_SB(b, h) + boff + n * 2048 + k * 1024); } while (0)
#define PG8_MMA(ai, bj, At, Bt) do { __builtin_amdgcn_s_setprio(1); _Pragma("unroll") for (int m = 0; m < 4; ++m) _Pragma("unroll") for (int n = 0; n < 2; ++n) _Pragma("unroll") for (int k = 0; k < 2; ++k) \
        acc[ai][bj][m][n] = __builtin_amdgcn_mfma_f32_16x16x32_bf16(Bt[n][k], At[m][k], acc[ai][bj][m][n], 0, 0, 0); __builtin_amdgcn_s_setprio(0); } while (0)
#define PG8_WAIT_V(n) asm volatile("s_waitcnt vmcnt(" #n ")" ::: "memory")
#define PG8_WAIT_L(n) asm volatile("s_waitcnt lgkmcnt(" #n ")" ::: "memory")
#define PG8_BAR __builtin_amdgcn_s_barrier()
#define PG8_SCHED __builtin_amdgcn_sched_barrier(0)
    Unit cur, nxt; int ui = 0;
    if (!S.next(0, cur)) return;
    f32x4 acc[2][2][4][2];
#pragma unroll
    for (int a = 0; a < 2; ++a)
#pragma unroll
        for (int b = 0; b < 2; ++b)
#pragma unroll
            for (int m = 0; m < 4; ++m)
#pragma unroll
                for (int n = 0; n < 2; ++n) acc[a][b][m][n] = (f32x4){0.f, 0.f, 0.f, 0.f};
    bf16x8 At[4][2], B0[2][2], B1[2][2];
    const char* cA = (const char*)g.A + (size_t)cur.pm * tstep; const char* cB = (const char*)g.Bt + (size_t)cur.pn * tstep;
    S.a_ready(cur);
    if constexpr (SP2) {
        PG8_STAGE(PG8_SB(0, 0), cB, voffB); PG8_STAGE(PG8_SB(0, 1), cB + hstep, voffB); PG8_STAGE(PG8_SA(0, 0), cA, voffA); PG8_STAGE(PG8_SA(0, 1), cA + hstep, voffA);
        if (wr == 1) PG8_BAR;
        PG8_WAIT_V(2); PG8_BAR;
        PG8_STAGE(PG8_SB(1, 0), cB + kstep, voffB); PG8_STAGE(PG8_SA(1, 0), cA + kstep, voffA); PG8_STAGE(PG8_SB(1, 1), cB + hstep + kstep, voffB);
        PG8_WAIT_V(6); PG8_BAR;
    } else {
        PG8_STAGE(PG8_SB(0, 0), cB, voffB); PG8_STAGE(PG8_SA(0, 0), cA, voffA); PG8_STAGE(PG8_SB(0, 1), cB + hstep, voffB); PG8_STAGE(PG8_SA(0, 1), cA + hstep, voffA);
        if (wr == 1) PG8_BAR;
        PG8_WAIT_V(4); PG8_BAR;
        PG8_STAGE(PG8_SB(1, 0), cB + kstep, voffB); PG8_STAGE(PG8_SA(1, 0), cA + kstep, voffA); PG8_STAGE(PG8_SB(1, 1), cB + hstep + kstep, voffB);
        PG8_WAIT_V(6); PG8_BAR;
    }
    for (;;) {
        const bool has_next = S.next(ui + 1, nxt);
        const char* nA = has_next ? (const char*)g.A + (size_t)nxt.pm * tstep : cA; const char* nB = has_next ? (const char*)g.Bt + (size_t)nxt.pn * tstep : cB;
        for (int t = 0; t < nt; t += 2) {
            const bool last = (t == nt - 2);
            const char* a1 = cA + (size_t)(t + 1) * kstep;
            const char* a2 = last ? nA : cA + (size_t)(t + 2) * kstep; const char* b2 = last ? nB : cB + (size_t)(t + 2) * kstep;
            const char* a3 = a2 + kstep; const char* b3 = b2 + kstep;
            if (last && has_next) S.a_ready(nxt);
            if constexpr (SP2) {
            PG8_LDB(B0, 0, 0); PG8_LDB(B1, 0, 1); PG8_SCHED; PG8_LDA(At, 0, 0); PG8_STAGE(PG8_SA(1, 1), a1 + hstep, voffA);
            PG8_WAIT_V(8); PG8_WAIT_L(0); PG8_BAR; PG8_MMA(0, 0, At, B0); PG8_MMA(0, 1, At, B1); PG8_BAR; PG8_SCHED;
            PG8_LDA(At, 0, 1); PG8_STAGE(PG8_SB(0, 0), b2, voffB); PG8_STAGE(PG8_SB(0, 1), b2 + hstep, voffB); PG8_STAGE(PG8_SA(0, 0), a2, voffA);
            PG8_WAIT_V(8); PG8_WAIT_L(0); PG8_BAR; PG8_MMA(1, 0, At, B0); PG8_MMA(1, 1, At, B1); PG8_BAR; PG8_SCHED;
            PG8_LDB(B0, 1, 0); PG8_LDB(B1, 1, 1); PG8_SCHED; PG8_LDA(At, 1, 0); PG8_STAGE(PG8_SA(0, 1), a2 + hstep, voffA);
            PG8_WAIT_V(8); PG8_WAIT_L(0); PG8_BAR; PG8_MMA(0, 0, At, B0); PG8_MMA(0, 1, At, B1); PG8_BAR; PG8_SCHED;
            PG8_LDA(At, 1, 1); PG8_STAGE(PG8_SB(1, 0), b3, voffB); PG8_STAGE(PG8_SB(1, 1), b3 + hstep, voffB); PG8_STAGE(PG8_SA(1, 0), a3, voffA);
            PG8_WAIT_V(8); PG8_WAIT_L(0); PG8_BAR; PG8_MMA(1, 0, At, B0); PG8_MMA(1, 1, At, B1); PG8_BAR; PG8_SCHED;
            } else {
            PG8_LDB(B0, 0, 0); PG8_SCHED; PG8_LDA(At, 0, 0); PG8_STAGE(PG8_SA(1, 1), a1 + hstep, voffA);
            PG8_WAIT_L(8); PG8_BAR; PG8_WAIT_L(0); PG8_MMA(0, 0, At, B0); PG8_BAR; PG8_SCHED;
            PG8_LDB(B1, 0, 1); PG8_STAGE(PG8_SB(0, 0), b2, voffB);
            PG8_BAR; PG8_WAIT_L(0); PG8_MMA(0, 1, At, B1); PG8_BAR;
            PG8_LDA(At, 0, 1); PG8_STAGE(PG8_SA(0, 0), a2, voffA);
            PG8_BAR; PG8_WAIT_L(0); PG8_MMA(1, 0, At, B0); PG8_BAR; PG8_SCHED;
            PG8_STAGE(PG8_SB(0, 1), b2 + hstep, voffB);
            PG8_WAIT_V(6); PG8_BAR; PG8_MMA(1, 1, At, B1); PG8_BAR;
            PG8_LDB(B0, 1, 0); PG8_SCHED; PG8_LDA(At, 1, 0); PG8_STAGE(PG8_SA(0, 1), a2 + hstep, voffA);
            PG8_WAIT_L(8); PG8_BAR; PG8_WAIT_L(0); PG8_MMA(0, 0, At, B0); PG8_BAR; PG8_SCHED;
            PG8_LDB(B1, 1, 1); PG8_STAGE(PG8_SB(1, 0), b3, voffB);
            PG8_BAR; PG8_WAIT_L(0); PG8_MMA(0, 1, At, B1); PG8_BAR;
            PG8_LDA(At, 1, 1); PG8_STAGE(PG8_SA(1, 0), a3, voffA);
            PG8_BAR; PG8_WAIT_L(0); PG8_MMA(1, 0, At, B0); PG8_BAR; PG8_SCHED;
            PG8_STAGE(PG8_SB(1, 1), b3 + hstep, voffB);
            PG8_WAIT_V(6); PG8_BAR; PG8_MMA(1, 1, At, B1); PG8_BAR;
            }
        }
        if constexpr (ALIGN_EPI) { if (wr == 0) PG8_BAR; }
        if constexpr (!Epi::AFTER_DRAIN) { E(acc, cur, wr, wc, fr, fq); S.done(cur); }
        if (!has_next) break;
#pragma unroll
        for (int a = 0; a < 2; ++a)
#pragma unroll
            for (int b = 0; b < 2; ++b)
#pragma unroll
                for (int m = 0; m < 4; ++m)
#pragma unroll
                    for (int n = 0; n < 2; ++n) acc[a][b][m][n] = (f32x4){0.f, 0.f, 0.f, 0.f};
        cur = nxt; cA = nA; cB = nB; ++ui;
        if constexpr (ALIGN_EPI) { if (wr == 1) PG8_BAR; }
    }
    PG8_WAIT_V(0);
    if constexpr (!ALIGN_EPI) { if (wr == 0) PG8_BAR; }
    PG8_BAR;
    if constexpr (Epi::AFTER_DRAIN) { E.fused(acc, cur, wr, wc, fr, fq, lds, wid, lane); S.done(cur); }
#undef PG8_SA
#undef PG8_SB
#undef PG8_STAGE
#undef PG8_LDA
#undef PG8_LDB
#undef PG8_MMA
#undef PG8_WAIT_V
#undef PG8_WAIT_L
#undef PG8_BAR
#undef PG8_SCHED
}
}
#define GAS __attribute__((address_space(1)))
#define LAS __attribute__((address_space(3)))
typedef unsigned short bf16;
typedef unsigned v4u __attribute__((ext_vector_type(4)));
typedef float f32x4 __attribute__((ext_vector_type(4)));
typedef short bf16x8 __attribute__((ext_vector_type(8)));
typedef GAS unsigned gu32;
typedef GAS unsigned long long gu64;
#define RLX_AGENT __ATOMIC_RELAXED, __HIP_MEMORY_SCOPE_AGENT
#define LDS_WAIT() asm volatile("s_waitcnt lgkmcnt(0)" ::: "memory")
#define VM_WAIT() asm volatile("s_waitcnt vmcnt(0)" ::: "memory")
__device__ __forceinline__ unsigned long long rt() { return __builtin_amdgcn_s_memrealtime(); }
__device__ __forceinline__ unsigned f2bf(float f) { unsigned u = __builtin_bit_cast(unsigned, f); return (u + 0x7fffu + ((u >> 16) & 1u)) >> 16; }
__device__ __forceinline__ unsigned pk2(float lo, float hi) { return f2bf(lo) | (f2bf(hi) << 16); }

#define XB_TMO      128
#define XB_XCNT(j)  (256  + 64 * (j))
#define XB_XSUB(j)  (1280 + 64 * (j))
#define XB_XGEN(j)  (2304 + 64 * (j))
#define XB_TOP      3328
#define XB_TOPGEN   3392
#define XCD_BAR_WORDS 3456
#define XB_SPIN_CAP (1u << 18)

__device__ __forceinline__ unsigned xb_ld(unsigned* p)              { return __hip_atomic_load(p, __ATOMIC_RELAXED, __HIP_MEMORY_SCOPE_AGENT); }
__device__ __forceinline__ unsigned xb_add(unsigned* p, unsigned v) { return __hip_atomic_fetch_add(p, v, __ATOMIC_RELAXED, __HIP_MEMORY_SCOPE_AGENT); }
__device__ __forceinline__ unsigned xb_xcc_id() { return (unsigned)__builtin_amdgcn_s_getreg((3 << 11) | 20) & 0xFu; }
#define XB_SPIN(cond, bar) do { unsigned _sp = 0; while (cond) { __builtin_amdgcn_s_sleep(1); \
    if ((++_sp & 255u) == 0u) { if (xb_ld(&(bar)[XB_TMO])) break; if (_sp > XB_SPIN_CAP) { atomicAdd(&(bar)[XB_TMO], 1u); break; } } } } while (0)

struct XcdBarrier {
    unsigned* bar; unsigned x;
    volatile LAS unsigned* st;
};

__device__ __forceinline__ XcdBarrier xcd_barrier_post(unsigned* bar, volatile LAS unsigned* st) {
    XcdBarrier b; b.bar = bar; b.x = xb_xcc_id(); b.st = st;
    if (threadIdx.x == 0) (void)xb_add(&bar[XB_XCNT(b.x)], 1u);
    return b;
}
__device__ __forceinline__ void xcd_barrier_complete(unsigned* bar, unsigned x, unsigned& nloc, unsigned& nx) {
    const unsigned G = gridDim.x * gridDim.y * gridDim.z;
    unsigned sum, cnt, mine, sp = 0u;
    for (;;) {
        sum = 0u; cnt = 0u; mine = 0u;
#pragma unroll
        for (unsigned j = 0; j < 16; ++j) { const unsigned c = xb_ld(&bar[XB_XCNT(j)]); sum += c; cnt += (c > 0u) ? 1u : 0u; mine = (j == x) ? c : mine; }
        if (sum == G) break;
        __builtin_amdgcn_s_sleep(1);
        if ((++sp & 255u) == 0u) { if (xb_ld(&bar[XB_TMO])) break; if (sp > XB_SPIN_CAP) { atomicAdd(&bar[XB_TMO], 1u); break; } }
    }
    nloc = mine > 0u ? mine : 1u; nx = cnt > 0u ? cnt : 1u;
}

__device__ __forceinline__ void xcd_barrier(const XcdBarrier& b) {
    asm volatile("s_waitcnt vmcnt(0)" ::: "memory");
    __syncthreads();
    if (threadIdx.x == 0) {
        unsigned* bar = b.bar;
        __builtin_amdgcn_s_waitcnt(0);
        unsigned nloc = b.st[0], nx = b.st[1];
        if (nloc == 0u) { xcd_barrier_complete(bar, b.x, nloc, nx); b.st[0] = nloc; b.st[1] = nx; }
        const unsigned old = xb_add(&bar[XB_XSUB(b.x)], 1u);
        const unsigned gen = old / nloc;
        if (old + 1u == (gen + 1u) * nloc) {
            __builtin_amdgcn_fence(__ATOMIC_RELEASE, "agent");
            asm volatile("s_waitcnt vmcnt(0)" ::: "memory");
            const unsigned og = xb_add(&bar[XB_TOP], 1u);
            const unsigned tg = og / nx;
            if (og + 1u == (tg + 1u) * nx) xb_add(&bar[XB_TOPGEN], 1u);
            else XB_SPIN(xb_ld(&bar[XB_TOPGEN]) == tg, bar);
            __builtin_amdgcn_fence(__ATOMIC_ACQUIRE, "agent");
            xb_add(&bar[XB_XGEN(b.x)], 1u);
            asm volatile("s_waitcnt vmcnt(0)" ::: "memory");
        } else {
            XB_SPIN(xb_ld(&bar[XB_XGEN(b.x)]) == gen, bar);
            __builtin_amdgcn_fence(__ATOMIC_ACQUIRE, "agent");
            asm volatile("s_waitcnt vmcnt(0)" ::: "memory");
        }
    }
    __syncthreads();
}

typedef float f32x2 __attribute__((ext_vector_type(2)));
typedef float f32x16 __attribute__((ext_vector_type(16)));
typedef unsigned v2u __attribute__((ext_vector_type(2)));
typedef __bf16 bf16x2_t __attribute__((ext_vector_type(2)));
using pg8::Unit;

constexpr int NWAVES = 8;
#ifndef MK_N_LAUNCHES
#define MK_N_LAUNCHES 1
#endif
constexpr int N_PHASES = 12;
constexpr int N_LAUNCHES = MK_N_LAUNCHES;

constexpr int NB = 32, SEQ = 2048, LC = 256, DM = 1024, NLAT = NB * SEQ, NCTX = NB * LC, NTOK = NLAT + NCTX;
constexpr int NE = 16, CAP = 256, DFF = 1536, NSLOT = NE * NB * CAP;
constexpr int WIN_ROWS = 4864, LORA_N = 2560, LORA_K = 384;
constexpr int KEYS = SEQ + LC;

constexpr size_t MiB = 1u << 20, KiB = 1u << 10;
constexpr size_t WS_CTL = 0, CTL_ZERO_BYTES = 1 * MiB;
constexpr size_t WS_MOD = 1 * MiB;
constexpr size_t WS_WIN = 2 * MiB;
constexpr size_t WS_WLORA = 11 * MiB + 512 * KiB;
constexpr size_t WS_WBRR = 13 * MiB + 512 * KiB;
constexpr size_t WS_WBRA = 14 * MiB + 512 * KiB;
constexpr size_t WS_WOUT = 15 * MiB + 512 * KiB;
constexpr size_t WS_WGU = 17 * MiB + 512 * KiB;
constexpr size_t WS_WD = 113 * MiB + 512 * KiB;
constexpr size_t WS_IDX = 161 * MiB + 512 * KiB;
constexpr size_t WS_VAL = 162 * MiB;
constexpr size_t WS_ZK = 163 * MiB;
constexpr size_t WS_ZV = 235 * MiB;
constexpr size_t WS_ZR = 307 * MiB;
constexpr size_t WS_Q = 371 * MiB;
constexpr size_t WS_KQ = 435 * MiB;
constexpr size_t WS_VQ = 453 * MiB;
constexpr size_t WS_YB = 453 * MiB;
constexpr size_t WS_LA = 471 * MiB;
constexpr size_t WS_H1 = 525 * MiB;
constexpr size_t WS_EW = 525 * MiB;
constexpr size_t WS_ORW = 525 * MiB;
constexpr size_t WS_AS = 669 * MiB;
constexpr size_t WS_G = 813 * MiB;
constexpr size_t WS_VT = 877 * MiB;
constexpr size_t WS_YF = 895 * MiB;
constexpr size_t WS_MERGED = 163 * MiB;
constexpr size_t WS_H2 = 163 * MiB;
constexpr size_t WS_AFF = 291 * MiB;
constexpr size_t WS_XE = 295 * MiB;
constexpr size_t WS_ACT = 551 * MiB;
constexpr size_t WS_END = 959 * MiB;
constexpr int CW_BAR = 4096;

constexpr int RING_BYTES = 131072;
constexpr int LDSCTL_OFF = RING_BYTES, MISC_OFF = LDSCTL_OFF + 320;
constexpr int LDS_BYTES = 147456;

__device__ __forceinline__ unsigned pkbf(float lo, float hi) { f32x2 v = {lo, hi}; return __builtin_bit_cast(unsigned, __builtin_convertvector(v, bf16x2_t)); }
__device__ __forceinline__ float bflo(unsigned u) { return __uint_as_float(u << 16); }
__device__ __forceinline__ float bfhi(unsigned u) { return __uint_as_float(u & 0xffff0000u); }
__device__ __forceinline__ float bf1(bf16 h) { return __uint_as_float(((unsigned)h) << 16); }
__device__ __forceinline__ float sigmoidf_(float x) { return __builtin_amdgcn_rcpf(1.0f + __builtin_amdgcn_exp2f(-1.4426950408889634f * x)); }
__device__ __forceinline__ float tanhf_(float x) { return 1.0f - 2.0f * __builtin_amdgcn_rcpf(__builtin_amdgcn_exp2f(2.8853900817779268f * x) + 1.0f); }
__device__ __forceinline__ float wave_sum(float v) {
#pragma unroll
    for (int o = 1; o < 64; o <<= 1) v += __shfl_xor(v, o);
    return v;
}
__device__ __forceinline__ void unpack8(const v4u w, float (&f)[8]) {
    f[0] = bflo(w.x); f[1] = bfhi(w.x); f[2] = bflo(w.y); f[3] = bfhi(w.y); f[4] = bflo(w.z); f[5] = bfhi(w.z); f[6] = bflo(w.w); f[7] = bfhi(w.w);
}
__device__ __forceinline__ v4u pack8(const float (&f)[8]) { v4u w; w.x = pkbf(f[0], f[1]); w.y = pkbf(f[2], f[3]); w.z = pkbf(f[4], f[5]); w.w = pkbf(f[6], f[7]); return w; }

struct Frame {
    LAS unsigned char* lds;
    volatile LAS unsigned* MISC;
    gu32* ctl;
    int tid, lane, wave, G;
    float* out; unsigned char* ws;
};
enum { I_X = 0, I_C, I_CTX, I_CCTX, I_ADAW, I_ADAB, I_N1G, I_N2G, I_WIN, I_CONV, I_W0, I_W2, I_A0, I_A2, I_KK, I_KA, I_RK, I_G2, I_LNW, I_LNB, I_QG, I_KG, I_SINK,
       I_WBRR, I_WBRA, I_WOUT, I_ROUTER, I_EG, I_EU, I_ED };
typedef const __attribute__((address_space(4))) unsigned char* kptr_t;
__device__ __forceinline__ const float* karg_in(int i) { kptr_t kp = (kptr_t)__builtin_amdgcn_kernarg_segment_ptr(); asm volatile("" : "+s"(kp)); return *(const float* const __attribute__((address_space(4)))*)(kp + 8 * i); }

__device__ __forceinline__ void transpose_item(const float* W, int N, int k0, int n0, bf16* WT, int Kd, int drow0, LAS float* scr, int lane) {
#pragma unroll 8
    for (int i = 0; i < 32; ++i) { const int kk = 2 * i + (lane >> 5); scr[kk * 33 + (lane & 31)] = W[(size_t)(k0 + kk) * N + n0 + (lane & 31)]; }
    LDS_WAIT(); asm volatile("" ::: "memory");
    const int c = lane & 7;
#pragma unroll
    for (int j = 0; j < 4; ++j) { const int n = (lane >> 3) + 8 * j; const LAS float* s = scr + (8 * c) * 33 + n;
        v4u o; o.x = pkbf(s[0 * 33], s[1 * 33]); o.y = pkbf(s[2 * 33], s[3 * 33]); o.z = pkbf(s[4 * 33], s[5 * 33]); o.w = pkbf(s[6 * 33], s[7 * 33]);
        *(GAS v4u*)(WT + (size_t)(drow0 + n) * Kd + k0 + 8 * c) = o; }
    LDS_WAIT(); asm volatile("" ::: "memory");
}
__device__ __forceinline__ int win_dest_block(int sb) {
    if (sb < 4) return 13 + sb;
    if (sb < 8) return sb - 4;
    if (sb < 12) return sb - 4;
    if (sb == 12) return 8;
    if (sb == 13) return 9;
    if (sb == 14) return 10;
    if (sb < 19) return sb + 2;
    if (sb == 19) return 11;
    if (sb == 20) return 12;
    return sb;
}
__device__ __forceinline__ void p0_prologue(Frame& F) {
    if (blockIdx.x < 96) {
        LAS float* cs = (LAS float*)F.lds;
        const float* c = karg_in(I_C); const float* cc = karg_in(I_CCTX);
        for (int i = F.tid; i < 33 * 1024; i += 512) { const float v = i < 32 * 1024 ? c[i] : cc[i - 32 * 1024]; cs[i] = v * sigmoidf_(v); }
        __syncthreads();
        const int col = blockIdx.x * 64 + F.lane; const float* aw = karg_in(I_ADAW);
        float acc[33];
#pragma unroll
        for (int b = 0; b < 33; ++b) acc[b] = 0.f;
        const int kbeg = F.wave * 128;
        for (int k = kbeg; k < kbeg + 128; k += 4) {
            const float w0 = aw[(size_t)(k + 0) * 6144 + col], w1 = aw[(size_t)(k + 1) * 6144 + col], w2 = aw[(size_t)(k + 2) * 6144 + col], w3 = aw[(size_t)(k + 3) * 6144 + col];
#pragma unroll
            for (int b = 0; b < 33; ++b) { const f32x4 cv = *(const LAS f32x4*)(cs + b * 1024 + k); acc[b] += cv.x * w0 + cv.y * w1 + cv.z * w2 + cv.w * w3; }
        }
        __syncthreads();
        LAS float* red = (LAS float*)F.lds;
#pragma unroll
        for (int b = 0; b < 33; ++b) red[(F.wave * 33 + b) * 64 + F.lane] = acc[b];
        __syncthreads();
        float* mod = (float*)(F.ws + WS_MOD); const float* ab = karg_in(I_ADAB);
        for (int i = F.tid; i < 33 * 64; i += 512) { const int b = i >> 6, l = i & 63; float s = 0.f;
#pragma unroll
            for (int w = 0; w < 8; ++w) s += red[(w * 33 + b) * 64 + l];
            mod[(size_t)b * 6144 + blockIdx.x * 64 + l] = s + ab[blockIdx.x * 64 + l]; }
        __syncthreads();
    }
    LAS float* scr = (LAS float*)(F.lds + F.wave * 16384);
    const int gw = blockIdx.x * NWAVES + F.wave, NGW = F.G * NWAVES;
    constexpr int IT_WIN = 16 * 148, IT_G = 16 * 768, IT_BR = 256, IT_OUT = 512;
    constexpr int NITEMS = IT_WIN + 3 * IT_G + 2 * IT_BR + IT_OUT;
    bf16* WIN = (bf16*)(F.ws + WS_WIN); bf16* WGU = (bf16*)(F.ws + WS_WGU); bf16* WD = (bf16*)(F.ws + WS_WD);
    for (int it = gw; it < NITEMS; it += NGW) {
        int r = it;
        if (r < IT_WIN) { const int kb = r / 148, nb = r % 148, n0 = 32 * nb; const int db = win_dest_block(n0 >> 7);
            transpose_item(karg_in(I_WIN), 4736, 64 * kb, n0, WIN, 1024, db * 128 + (n0 & 127), scr, F.lane); continue; }
        r -= IT_WIN;
        if (r < IT_G) { const int e = r / 768, q = r % 768, kb = q / 48, nb = q % 48, n0 = 32 * nb;
            transpose_item(karg_in(I_EG) + (size_t)e * 1024 * 1536, 1536, 64 * kb, n0, WGU, 1024, e * 3072 + 256 * (n0 >> 7) + (n0 & 127), scr, F.lane); continue; }
        r -= IT_G;
        if (r < IT_G) { const int e = r / 768, q = r % 768, kb = q / 48, nb = q % 48, n0 = 32 * nb;
            transpose_item(karg_in(I_EU) + (size_t)e * 1024 * 1536, 1536, 64 * kb, n0, WGU, 1024, e * 3072 + 256 * (n0 >> 7) + 128 + (n0 & 127), scr, F.lane); continue; }
        r -= IT_G;
        if (r < IT_G) { const int e = r / 768, q = r % 768, kb = q / 32, nb = q % 32, n0 = 32 * nb;
            transpose_item(karg_in(I_ED) + (size_t)e * 1536 * 1024, 1024, 64 * kb, n0, WD, 1536, e * 1024 + n0, scr, F.lane); continue; }
        r -= IT_G;
        if (r < IT_BR) { const int kb = r / 32, nb = r % 32; transpose_item(karg_in(I_WBRR), 1024, 64 * kb, 32 * nb, (bf16*)(F.ws + WS_WBRR), 512, 32 * nb, scr, F.lane); continue; }
        r -= IT_BR;
        if (r < IT_BR) { const int kb = r / 32, nb = r % 32; transpose_item(karg_in(I_WBRA), 1024, 64 * kb, 32 * nb, (bf16*)(F.ws + WS_WBRA), 512, 32 * nb, scr, F.lane); continue; }
        r -= IT_BR;
        { const int kb = r / 32, nb = r % 32; transpose_item(karg_in(I_WOUT), 1024, 64 * kb, 32 * nb, (bf16*)(F.ws + WS_WOUT), 1024, 32 * nb, scr, F.lane); }
    }
    const int gt = blockIdx.x * 512 + F.tid, NGT = F.G * 512;
    for (int i = gt; i < 128 * 1024 / 8; i += NGT) *(GAS v4u*)(WIN + (size_t)4736 * 1024 + (size_t)i * 8) = (v4u){0u, 0u, 0u, 0u};
    { bf16* WL = (bf16*)(F.ws + WS_WLORA); const float* w2 = karg_in(I_W2); const float* a2 = karg_in(I_A2); const float* g2 = karg_in(I_G2);
      for (int i = gt; i < LORA_N * (LORA_K / 8); i += NGT) { const int n = i / (LORA_K / 8), k8 = (i % (LORA_K / 8)) * 8; const int rg = n >> 9, col = n & 511; float f[8];
#pragma unroll
          for (int j = 0; j < 8; ++j) { const int k = k8 + j; float v = 0.f;
              if (rg == 0) { if (k < 64) v = w2[(size_t)k * 512 + col]; }
              else if (rg == 1) { if (k >= 64 && k < 128) v = w2[(size_t)(64 + k - 64) * 512 + col]; }
              else if (rg == 2) { if (k >= 128 && k < 192) v = a2[(size_t)(k - 128) * 512 + col]; }
              else if (rg == 3) { if (k >= 192 && k < 256) v = a2[(size_t)(64 + k - 192) * 512 + col]; }
              else { if (k >= 256) v = g2[(size_t)(k - 256) * 512 + col]; }
              f[j] = v; }
          *(GAS v4u*)(WL + (size_t)n * LORA_K + k8) = pack8(f); } }
}

__device__ __forceinline__ void p1_norm1(Frame& F) {
    const int gw = blockIdx.x * NWAVES + F.wave, NGW = F.G * NWAVES;
    const float* mod = (const float*)(F.ws + WS_MOD); bf16* H1 = (bf16*)(F.ws + WS_H1);
    const float* g1 = karg_in(I_N1G); const float* Xp = karg_in(I_X); const float* CTXp = karg_in(I_CTX);
    f32x4 gv[4];
#pragma unroll
    for (int j = 0; j < 4; ++j) gv[j] = *(const f32x4*)(g1 + 4 * F.lane + 256 * j);
    for (int m = gw; m < NTOK; m += NGW) {
        const float* xr = m < NLAT ? Xp + (size_t)m * DM : CTXp + (size_t)(m - NLAT) * DM;
        const int mb = m < NLAT ? (m >> 11) : 32;
        const float* sh = mod + (size_t)mb * 6144; const float* sc = sh + 1024;
        f32x4 v[4]; float s = 0.f;
#pragma unroll
        for (int j = 0; j < 4; ++j) { v[j] = *(const GAS f32x4*)(xr + 4 * F.lane + 256 * j); s += (v[j].x * v[j].x + v[j].y * v[j].y) + (v[j].z * v[j].z + v[j].w * v[j].w); }
        const float rstd = 1.0f / sqrtf(wave_sum(s) * (1.f / DM) + 1e-6f);
#pragma unroll
        for (int j = 0; j < 4; ++j) { const f32x4 a = *(const f32x4*)(sc + 4 * F.lane + 256 * j), bsh = *(const f32x4*)(sh + 4 * F.lane + 256 * j);
            const f32x4 y = v[j] * rstd * gv[j] * (a + 1.0f) + bsh;
            v2u o; o.x = pkbf(y.x, y.y); o.y = pkbf(y.z, y.w);
            *(GAS v2u*)(H1 + (size_t)m * DM + 4 * F.lane + 256 * j) = o; }
    }
}

struct InprojOrder {
    pg8::StaticOrder so; int G, c;
    __device__ void init(int G_, int c_) { so.init(NLAT, WIN_ROWS, G_, c_); G = G_; c = c_; }
    __device__ bool next(int i, Unit& u) const {
        long L = (long)i * G + c; if (L < 4864) return so.next(i, u);
        L -= 4864; if (L >= 224) return false; u.pm = 256 + (int)(L % 32); u.pn = (int)(L / 32); return true; }
    __device__ __forceinline__ void a_ready(const Unit&) const {}
    __device__ __forceinline__ void done(const Unit&) const {}
};
struct EpiInproj {
    static constexpr bool PERM = true, AFTER_DRAIN = false;
    bf16 *zk, *zv, *zr, *q, *kq, *vq, *la, *gates;
    __device__ __forceinline__ void operator()(const f32x4 (&acc)[2][2][4][2], const Unit& u, int wr, int wc, int fr, int fq) const {
        const int row0 = u.pm * 256 + wr * 64 + fr; const bool isctx = u.pm >= 256;
#pragma unroll
        for (int bj = 0; bj < 2; ++bj) {
            const int c128 = 2 * u.pn + bj; bf16* base = nullptr; int pitch = 0, act = 0; bool ok = true;
            if (c128 < 4) { base = zk + c128 * 128; pitch = 512; }
            else if (c128 < 8) { base = zv + (c128 - 4) * 128; pitch = 512; }
            else if (c128 < 11) { base = la + (c128 - 8) * 128; pitch = 384; act = (c128 == 8) ? 1 : ((c128 == 10) ? 2 : 0); }
            else if (c128 == 11) { base = kq; pitch = 128; }
            else if (c128 == 12) { base = vq; pitch = 128; }
            else if (c128 < 17) { base = zr + (c128 - 13) * 128; pitch = 512; ok = !isctx; }
            else if (c128 < 21) { base = q + (c128 - 17) * 128; pitch = 512; ok = !isctx; }
            else if (c128 < 37) { base = gates + (c128 - 21) * 128; pitch = 2048; act = 2; ok = !isctx; }
            else ok = false;
            if (ok) {
#pragma unroll
                for (int ai = 0; ai < 2; ++ai)
#pragma unroll
                    for (int m = 0; m < 4; ++m) {
                        f32x4 v0 = acc[ai][bj][m][0], v1 = acc[ai][bj][m][1];
                        if (act == 1) { v0.x = tanhf_(v0.x); v0.y = tanhf_(v0.y); v0.z = tanhf_(v0.z); v0.w = tanhf_(v0.w); v1.x = tanhf_(v1.x); v1.y = tanhf_(v1.y); v1.z = tanhf_(v1.z); v1.w = tanhf_(v1.w); }
                        else if (act == 2) { v0.x = sigmoidf_(v0.x); v0.y = sigmoidf_(v0.y); v0.z = sigmoidf_(v0.z); v0.w = sigmoidf_(v0.w); v1.x = sigmoidf_(v1.x); v1.y = sigmoidf_(v1.y); v1.z = sigmoidf_(v1.z); v1.w = sigmoidf_(v1.w); }
                        v4u w; w.x = pkbf(v0.x, v0.y); w.y = pkbf(v0.z, v0.w); w.z = pkbf(v1.x, v1.y); w.w = pkbf(v1.z, v1.w);
                        *(GAS v4u*)(base + (size_t)(row0 + ai * 128 + m * 16) * pitch + wc * 32 + 8 * fq) = w;
                    }
            }
        }
    }
};

template <int NKS> __device__ __forceinline__ void lora_item(const bf16* LA, const bf16* WL, bf16* outp, const float* bias, float scale, int act, int tile, int rg, int kbase, int l32, int hi) {
    bf16x8 xf[2][NKS];
#pragma unroll
    for (int s2 = 0; s2 < 2; ++s2)
#pragma unroll
        for (int ks = 0; ks < NKS; ++ks) xf[s2][ks] = *(const GAS bf16x8*)(LA + (size_t)(tile * 64 + s2 * 32 + l32) * LORA_K + kbase + 16 * ks + 8 * hi);
#pragma unroll 1
    for (int nt = 0; nt < 16; ++nt) {
        f32x16 acc0, acc1;
#pragma unroll
        for (int r = 0; r < 16; ++r) { acc0[r] = 0.f; acc1[r] = 0.f; }
        const bf16* wp = WL + (size_t)(rg * 512 + nt * 32 + l32) * LORA_K + kbase + 8 * hi;
#pragma unroll
        for (int ks = 0; ks < NKS; ++ks) { const bf16x8 wf = *(const GAS bf16x8*)(wp + 16 * ks);
            acc0 = __builtin_amdgcn_mfma_f32_32x32x16_bf16(wf, xf[0][ks], acc0, 0, 0, 0); acc1 = __builtin_amdgcn_mfma_f32_32x32x16_bf16(wf, xf[1][ks], acc1, 0, 0, 0); }
#pragma unroll
        for (int r4 = 0; r4 < 4; ++r4) { const int col = nt * 32 + 8 * r4 + 4 * hi;
            f32x4 bv = (f32x4){0.f, 0.f, 0.f, 0.f}; if (act) bv = *(const f32x4*)(bias + col);
            f32x4 v0 = (f32x4){acc0[4 * r4], acc0[4 * r4 + 1], acc0[4 * r4 + 2], acc0[4 * r4 + 3]} + bv, v1 = (f32x4){acc1[4 * r4], acc1[4 * r4 + 1], acc1[4 * r4 + 2], acc1[4 * r4 + 3]} + bv;
            if (act) { v0.x = scale * sigmoidf_(v0.x); v0.y = scale * sigmoidf_(v0.y); v0.z = scale * sigmoidf_(v0.z); v0.w = scale * sigmoidf_(v0.w);
                       v1.x = scale * sigmoidf_(v1.x); v1.y = scale * sigmoidf_(v1.y); v1.z = scale * sigmoidf_(v1.z); v1.w = scale * sigmoidf_(v1.w); }
            v2u o0, o1; o0.x = pkbf(v0.x, v0.y); o0.y = pkbf(v0.z, v0.w); o1.x = pkbf(v1.x, v1.y); o1.y = pkbf(v1.z, v1.w);
            *(GAS v2u*)(outp + (size_t)(tile * 64 + l32) * 512 + col) = o0; *(GAS v2u*)(outp + (size_t)(tile * 64 + 32 + l32) * 512 + col) = o1; }
    }
}
__device__ __forceinline__ void p3a_lora(Frame& F) {
    const bf16* LA = (const bf16*)(F.ws + WS_LA); const bf16* WL = (const bf16*)(F.ws + WS_WLORA);
    bf16* EW = (bf16*)(F.ws + WS_EW); bf16* AS = (bf16*)(F.ws + WS_AS); bf16* G = (bf16*)(F.ws + WS_G);
    const float* w0 = karg_in(I_W0); const float* a0 = karg_in(I_A0);
    const int gw = blockIdx.x * NWAVES + F.wave, NGW = F.G * NWAVES, l32 = F.lane & 31, hi = F.lane >> 5;
    for (int item = gw; item < (NTOK / 64) * 5; item += NGW) {
        const int rg = item % 5, tile = item / 5;
        if (rg == 4) { if (tile < NLAT / 64) lora_item<8>(LA, WL, G, nullptr, 1.0f, 0, tile, 4, 256, l32, hi); }
        else if (rg < 2) lora_item<4>(LA, WL, EW + (size_t)rg * NTOK * 512, w0 + rg * 512, 0.60653066f, 1, tile, rg, 64 * rg, l32, hi);
        else lora_item<4>(LA, WL, AS + (size_t)(rg - 2) * NTOK * 512, a0 + (rg - 2) * 512, 1.0f, 1, tile, rg, 64 * rg, l32, hi);
    }
}

__device__ __forceinline__ void p3b_attn_prep(Frame& F) {
    LAS float* tab = (LAS float*)F.lds;
    for (int i = F.tid; i < 1024; i += 512) { const int pos = i >> 4, fi = i & 15;
        const float invf = exp2f(-(float)fi * (13.287712379549449f / 16.0f));
        const float ang = (float)pos * invf; tab[2 * i] = cosf(ang); tab[2 * i + 1] = sinf(ang); }
    __syncthreads();
    const int gw = blockIdx.x * NWAVES + F.wave, NGW = F.G * NWAVES, lane = F.lane;
    {
        bf16* Q = (bf16*)(F.ws + WS_Q); const float* qg = karg_in(I_QG);
        const int sub = lane & 7; float gq[8];
#pragma unroll
        for (int j = 0; j < 8; ++j) gq[j] = qg[8 * sub + j];
        const float qscale = 0.125f * 1.4426950408889634f;
        for (int m = gw; m < NLAT; m += NGW) {
            const int t = m & 2047; GAS v4u* p = (GAS v4u*)(Q + (size_t)m * 512 + 8 * lane);
            float y[8]; unpack8(*p, y); float ss = 0.f;
#pragma unroll
            for (int j = 0; j < 8; ++j) ss += y[j] * y[j];
            ss += __shfl_xor(ss, 1); ss += __shfl_xor(ss, 2); ss += __shfl_xor(ss, 4);
            const float rstd = 1.0f / sqrtf(ss * (1.f / 64.f) + 1e-6f);
            const int pos = (sub < 4) ? (t >> 6) : (t & 63); const bool second = (sub & 2) != 0; float o[8];
#pragma unroll
            for (int j = 0; j < 8; ++j) { y[j] = y[j] * rstd * gq[j]; }
#pragma unroll
            for (int j = 0; j < 8; ++j) { const float yp = __shfl_xor(y[j], 2); const int fi = 8 * (sub & 1) + j; const float cs = tab[(pos * 16 + fi) * 2], sn = tab[(pos * 16 + fi) * 2 + 1];
                o[j] = (second ? (yp * sn + y[j] * cs) : (y[j] * cs - yp * sn)) * qscale; }
            *p = pack8(o);
        }
    }
    {
        bf16* KQ = (bf16*)(F.ws + WS_KQ); const float* kg = karg_in(I_KG);
        const int l32 = lane & 31; const float g0 = kg[2 * l32], g1 = kg[2 * l32 + 1];
        for (int m = gw; m < NTOK; m += NGW) {
            GAS unsigned* p = (GAS unsigned*)(KQ + (size_t)m * 128 + 2 * lane); const unsigned w = *p;
            float y0 = bflo(w), y1 = bfhi(w); float ss = y0 * y0 + y1 * y1;
            ss += __shfl_xor(ss, 1); ss += __shfl_xor(ss, 2); ss += __shfl_xor(ss, 4); ss += __shfl_xor(ss, 8); ss += __shfl_xor(ss, 16);
            const float rstd = 1.0f / sqrtf(ss * (1.f / 64.f) + 1e-6f);
            y0 = y0 * rstd * g0; y1 = y1 * rstd * g1;
            const float p0 = __shfl_xor(y0, 8), p1 = __shfl_xor(y1, 8);
            if (m < NLAT) { const int t = m & 2047; const int pos = (l32 < 16) ? (t >> 6) : (t & 63); const bool second = (l32 & 8) != 0; const int fi0 = (2 * l32) & 15;
                const float c0 = tab[(pos * 16 + fi0) * 2], s0 = tab[(pos * 16 + fi0) * 2 + 1], c1 = tab[(pos * 16 + fi0 + 1) * 2], s1 = tab[(pos * 16 + fi0 + 1) * 2 + 1];
                const float o0 = second ? (p0 * s0 + y0 * c0) : (y0 * c0 - p0 * s0), o1 = second ? (p1 * s1 + y1 * c1) : (y1 * c1 - p1 * s1);
                y0 = o0; y1 = o1; }
            *p = pkbf(y0, y1);
        }
    }
    {
        const bf16* VQ = (const bf16*)(F.ws + WS_VQ); bf16* VT = (bf16*)(F.ws + WS_VT);
        const int gt = blockIdx.x * 512 + F.tid, NGT = F.G * 512;
        for (int i = gt; i < NB * 2 * (KEYS / 8) * 64; i += NGT) { const int d = i & 63, kg8 = (i >> 6) % (KEYS / 8), bh = (i >> 6) / (KEYS / 8), b = bh >> 1, hk = bh & 1;
            float f[8];
#pragma unroll
            for (int j = 0; j < 8; ++j) { const int key = kg8 * 8 + j; const size_t row = key < SEQ ? (size_t)b * SEQ + key : (size_t)NLAT + b * LC + (key - SEQ); f[j] = bf1(VQ[row * 128 + hk * 64 + d]); }
            *(GAS v4u*)(VT + ((size_t)bh * 64 + d) * KEYS + kg8 * 8) = pack8(f); }
    }
}

__device__ __forceinline__ int key_perm(int i) { const int r = 4 * (i >> 3) + (i & 3), hi = (i >> 2) & 1; return 8 * hi + r + (r >= 8 ? 8 : 0); }
__device__ __forceinline__ void p4a_attention(Frame& F) {
    bf16* Q = (bf16*)(F.ws + WS_Q); const bf16* KQ = (const bf16*)(F.ws + WS_KQ); const bf16* VT = (const bf16*)(F.ws + WS_VT);
    const float* sink = karg_in(I_SINK);
    const int lane = F.lane, l32 = lane & 31, hi = lane >> 5;
    const int kperm = key_perm(l32);
    for (int unit = blockIdx.x; unit < NB * 2 * 16; unit += F.G) {
        const int b = unit >> 5, hk = (unit >> 4) & 1, qb = unit & 15;
        const int g = F.wave >> 1, half = F.wave & 1, h = hk * 4 + g;
        const float sink2 = sink[h] * 1.4426950408889634f;
#pragma unroll 1
        for (int jt = 0; jt < 2; ++jt) {
            const int tq0 = qb * 128 + half * 64 + jt * 32;
            const size_t qrow = (size_t)b * SEQ + tq0 + l32;
            bf16x8 qf[4];
#pragma unroll
            for (int ks = 0; ks < 4; ++ks) qf[ks] = *(const GAS bf16x8*)(Q + qrow * 512 + h * 64 + 16 * ks + 8 * hi);
            float mrun = sink2, lrun = hi == 0 ? 1.0f : 0.0f;
            f32x16 o0, o1;
#pragma unroll
            for (int r = 0; r < 16; ++r) { o0[r] = 0.f; o1[r] = 0.f; }
            const bf16* vbase = VT + ((size_t)(b * 2 + hk) * 64 + l32) * KEYS + 8 * hi;
#pragma unroll 1
            for (int tile = 0; tile < 17; ++tile) {
                int key0; size_t krow; int mask = 0;
                if (tile < 8) { key0 = SEQ + 32 * tile; krow = (size_t)NLAT + b * LC + 32 * tile; }
                else { const int kpos0 = tq0 - 128 + 32 * (tile - 8); if (kpos0 < 0 || kpos0 >= SEQ) continue; key0 = kpos0; krow = (size_t)b * SEQ + kpos0; mask = (tile == 8) ? 1 : ((tile == 16) ? 2 : 0); }
                f32x16 s;
#pragma unroll
                for (int r = 0; r < 16; ++r) s[r] = 0.f;
                const bf16* kp = KQ + (krow + kperm) * 128 + hk * 64 + 8 * hi;
#pragma unroll
                for (int ks = 0; ks < 4; ++ks) { const bf16x8 kf = *(const GAS bf16x8*)(kp + 16 * ks); s = __builtin_amdgcn_mfma_f32_32x32x16_bf16(kf, qf[ks], s, 0, 0, 0); }
                if (mask) {
#pragma unroll
                    for (int r = 0; r < 16; ++r) { const int kk = 8 * hi + r + (r >= 8 ? 8 : 0); const bool ok = (mask == 1) ? (kk >= l32) : (kk <= l32); s[r] = ok ? s[r] : -1e30f; }
                }
                float mx = s[0];
#pragma unroll
                for (int r = 1; r < 16; ++r) mx = fmaxf(mx, s[r]);
                mx = fmaxf(mx, __shfl_xor(mx, 32));
                const float mnew = fmaxf(mrun, mx), alpha = __builtin_amdgcn_exp2f(mrun - mnew);
                float ps = 0.f; float p[16];
#pragma unroll
                for (int r = 0; r < 16; ++r) { p[r] = __builtin_amdgcn_exp2f(s[r] - mnew); ps += p[r]; }
                lrun = lrun * alpha + ps; mrun = mnew;
#pragma unroll
                for (int r = 0; r < 16; ++r) { o0[r] *= alpha; o1[r] *= alpha; }
                v4u pa, pb; pa.x = pkbf(p[0], p[1]); pa.y = pkbf(p[2], p[3]); pa.z = pkbf(p[4], p[5]); pa.w = pkbf(p[6], p[7]);
                pb.x = pkbf(p[8], p[9]); pb.y = pkbf(p[10], p[11]); pb.z = pkbf(p[12], p[13]); pb.w = pkbf(p[14], p[15]);
                const bf16x8 pa8 = __builtin_bit_cast(bf16x8, pa), pb8 = __builtin_bit_cast(bf16x8, pb);
                const bf16* vp = vbase + key0;
                const bf16x8 v00 = *(const GAS bf16x8*)(vp), v01 = *(const GAS bf16x8*)(vp + 16);
                const bf16x8 v10 = *(const GAS bf16x8*)(vp + (size_t)32 * KEYS), v11 = *(const GAS bf16x8*)(vp + (size_t)32 * KEYS + 16);
                o0 = __builtin_amdgcn_mfma_f32_32x32x16_bf16(v00, pa8, o0, 0, 0, 0);
                o0 = __builtin_amdgcn_mfma_f32_32x32x16_bf16(v01, pb8, o0, 0, 0, 0);
                o1 = __builtin_amdgcn_mfma_f32_32x32x16_bf16(v10, pa8, o1, 0, 0, 0);
                o1 = __builtin_amdgcn_mfma_f32_32x32x16_bf16(v11, pb8, o1, 0, 0, 0);
            }
            const float ltot = lrun + __shfl_xor(lrun, 32), inv = 1.0f / ltot;
            bf16* op = Q + qrow * 512 + h * 64 + 4 * hi;
#pragma unroll
            for (int r4 = 0; r4 < 4; ++r4) {
                v2u w0; w0.x = pkbf(o0[4 * r4] * inv, o0[4 * r4 + 1] * inv); w0.y = pkbf(o0[4 * r4 + 2] * inv, o0[4 * r4 + 3] * inv);
                v2u w1; w1.x = pkbf(o1[4 * r4] * inv, o1[4 * r4 + 1] * inv); w1.y = pkbf(o1[4 * r4 + 2] * inv, o1[4 * r4 + 3] * inv);
                *(GAS v2u*)(op + 8 * r4) = w0; *(GAS v2u*)(op + 32 + 8 * r4) = w1;
            }
        }
    }
}

constexpr int SC_T = 16, SC_NCH = (LC + SEQ) / SC_T;
constexpr int SC_STEP_F = 6 * 64;
constexpr int SC_BUF_F = 2 * SC_T * SC_STEP_F;
__device__ __forceinline__ void scan_stage(Frame& F, int b, int h, int chunk, LAS float* buf, int hw, const float (&cw)[9], float kkp, float kap) {
    const bf16* ZK = (const bf16*)(F.ws + WS_ZK); const bf16* ZV = (const bf16*)(F.ws + WS_ZV); const bf16* ZR = (const bf16*)(F.ws + WS_ZR);
    const int dir = hw >> 1, col = h * 64 + F.lane;
    const bf16* EW = (const bf16*)(F.ws + WS_EW) + (size_t)dir * NTOK * 512; const bf16* AS = (const bf16*)(F.ws + WS_AS) + (size_t)dir * NTOK * 512;
#pragma unroll 2
    for (int i = 0; i < 8; ++i) {
        const int step = (hw & 1) * 8 + i, n = chunk * SC_T + step;
        size_t row; bool first, last, lat;
        if (n < LC) { const int t = dir ? (LC - 1 - n) : n; row = (size_t)NLAT + b * LC + t; first = t == 0; last = t == LC - 1; lat = false; }
        else { const int t = dir ? (SEQ - 1 - (n - LC)) : (n - LC); row = (size_t)b * SEQ + t; first = t == 0; last = t == SEQ - 1; lat = true; }
        const size_t o = row * 512 + col;
        const float k0 = first ? 0.f : bf1(ZK[o - 512]), k1 = bf1(ZK[o]), k2 = last ? 0.f : bf1(ZK[o + 512]);
        const float v0 = first ? 0.f : bf1(ZV[o - 512]), v1 = bf1(ZV[o]), v2 = last ? 0.f : bf1(ZV[o + 512]);
        float r = 0.f;
        if (lat) { const float r0 = first ? 0.f : bf1(ZR[o - 512]), r1 = bf1(ZR[o]), r2 = last ? 0.f : bf1(ZR[o + 512]); r = cw[0] * r0 + cw[1] * r1 + cw[2] * r2; }
        const float k = cw[3] * k0 + cw[4] * k1 + cw[5] * k2, v = cw[6] * v0 + cw[7] * v1 + cw[8] * v2;
        const float a = bf1(AS[o]), ew = bf1(EW[o]);
        const float kkv = k * kkp, ss = wave_sum(kkv * kkv), kk = kkv * (1.0f / sqrtf(fmaxf(ss, 1e-24f)));
        LAS float* d = buf + (dir * SC_T + step) * SC_STEP_F + F.lane;
        d[0] = -kk; d[64] = kk * a; d[128] = __expf(-ew); d[192] = k * (1.0f + (a - 1.0f) * kap); d[256] = r; d[320] = v;
    }
}
__device__ __forceinline__ void p4b_scan(Frame& F) {
    LAS float* lbuf = (LAS float*)F.lds;
    const int wave = F.wave, lane = F.lane;
    const bool is_scan = wave < 2, is_helper = (wave & 2) != 0;
    const int hw = (wave & 1) | ((wave >> 2) << 1);
    for (int task = blockIdx.x; task < NB * 8; task += F.G) {
        const int b = task >> 3, h = task & 7;
        float cw[9] = {0.f, 0.f, 0.f, 0.f, 0.f, 0.f, 0.f, 0.f, 0.f}; float kkp = 0.f, kap = 0.f;
        if (is_helper) { const float* conv = karg_in(I_CONV); const int col = h * 64 + lane, dir = hw >> 1;
#pragma unroll
            for (int j = 0; j < 3; ++j) { cw[j] = conv[j * 1536 + col]; cw[3 + j] = conv[j * 1536 + 512 + col]; cw[6 + j] = conv[j * 1536 + 1024 + col]; }
            kkp = karg_in(I_KK)[dir * 512 + col]; kap = karg_in(I_KA)[dir * 512 + col]; }
        f32x2 S[32];
#pragma unroll
        for (int i = 0; i < 32; ++i) S[i] = (f32x2){0.f, 0.f};
        bf16* Y = (bf16*)(F.ws + (wave == 0 ? WS_YF : WS_YB));
        if (is_helper) scan_stage(F, b, h, 0, lbuf, hw, cw, kkp, kap);
        __syncthreads();
#pragma unroll 1
        for (int c = 0; c < SC_NCH; ++c) {
            if (is_helper) { if (c + 1 < SC_NCH) scan_stage(F, b, h, c + 1, lbuf + ((c + 1) & 1) * SC_BUF_F, hw, cw, kkp, kap); }
            else if (is_scan) {
                const LAS float* cb = lbuf + (c & 1) * SC_BUF_F + wave * SC_T * SC_STEP_F;
#pragma unroll 1
                for (int st = 0; st < SC_T; ++st) {
                    const LAS f32x4* pa = (const LAS f32x4*)(cb + st * SC_STEP_F);
                    const float vv = cb[st * SC_STEP_F + 320 + lane];
                    f32x2 sa0 = (f32x2){0.f, 0.f}, sa1 = sa0;
#pragma unroll
                    for (int k4 = 0; k4 < 16; ++k4) { const f32x4 a4 = pa[k4]; sa0 += S[2 * k4] * (f32x2){a4.x, a4.y}; sa1 += S[2 * k4 + 1] * (f32x2){a4.z, a4.w}; }
                    const float sa = (sa0.x + sa0.y) + (sa1.x + sa1.y);
                    const f32x2 sa2 = (f32x2){sa, sa}, vv2 = (f32x2){vv, vv};
                    f32x2 y0 = (f32x2){0.f, 0.f}, y1 = y0;
#pragma unroll
                    for (int k4 = 0; k4 < 16; ++k4) {
                        const f32x4 b4 = pa[16 + k4], w4 = pa[32 + k4], m4 = pa[48 + k4], r4 = pa[64 + k4];
                        f32x2 t0 = sa2 * (f32x2){b4.x, b4.y} + vv2 * (f32x2){m4.x, m4.y};
                        f32x2 t1 = sa2 * (f32x2){b4.z, b4.w} + vv2 * (f32x2){m4.z, m4.w};
                        S[2 * k4] = S[2 * k4] * (f32x2){w4.x, w4.y} + t0; S[2 * k4 + 1] = S[2 * k4 + 1] * (f32x2){w4.z, w4.w} + t1;
                        y0 += S[2 * k4] * (f32x2){r4.x, r4.y}; y1 += S[2 * k4 + 1] * (f32x2){r4.z, r4.w};
                    }
                    const int n = c * SC_T + st;
                    if (n >= LC) { const int t = wave ? (SEQ - 1 - (n - LC)) : (n - LC); const float y = (y0.x + y0.y) + (y1.x + y1.y);
                        Y[((size_t)b * SEQ + t) * 512 + h * 64 + lane] = (bf16)(pkbf(y, 0.f) & 0xffffu); }
                }
            }
            __syncthreads();
        }
    }
}

__device__ __forceinline__ void p5_rwkv_out(Frame& F) {
    const int gw = blockIdx.x * NWAVES + F.wave, NGW = F.G * NWAVES, lane = F.lane, c0 = 8 * lane;
    const bf16* ZK = (const bf16*)(F.ws + WS_ZK); const bf16* ZV = (const bf16*)(F.ws + WS_ZV); const bf16* ZR = (const bf16*)(F.ws + WS_ZR);
    const bf16* AS0 = (const bf16*)(F.ws + WS_AS); const bf16* AS1 = AS0 + (size_t)NTOK * 512;
    const bf16* YF = (const bf16*)(F.ws + WS_YF); const bf16* YB = (const bf16*)(F.ws + WS_YB); const bf16* G = (const bf16*)(F.ws + WS_G);
    bf16* ORW = (bf16*)(F.ws + WS_ORW);
    const float* conv = karg_in(I_CONV); const float* ka = karg_in(I_KA); const float* rk = karg_in(I_RK); const float* lnw = karg_in(I_LNW); const float* lnb = karg_in(I_LNB);
    for (int m = gw; m < NLAT; m += NGW) {
        const int t = m & 2047; const bool first = t == 0, last = t == SEQ - 1; const size_t o = (size_t)m * 512 + c0;
        const v4u z4 = (v4u){0u, 0u, 0u, 0u};
        float r[8], k[8], v[8], tmp[8];
#pragma unroll
        for (int which = 0; which < 3; ++which) {
            const bf16* Z = which == 0 ? ZR : (which == 1 ? ZK : ZV); float (&dst)[8] = which == 0 ? r : (which == 1 ? k : v);
            const v4u a = first ? z4 : *(const GAS v4u*)(Z + o - 512), bq = *(const GAS v4u*)(Z + o), cq = last ? z4 : *(const GAS v4u*)(Z + o + 512);
            float fa[8], fb[8], fc[8]; unpack8(a, fa); unpack8(bq, fb); unpack8(cq, fc);
            const float* cwp = conv + which * 512 + c0;
#pragma unroll
            for (int j = 0; j < 8; ++j) dst[j] = cwp[j] * fa[j] + cwp[1536 + j] * fb[j] + cwp[3072 + j] * fc[j];
        }
        float a0[8], a1[8]; unpack8(*(const GAS v4u*)(AS0 + o), a0); unpack8(*(const GAS v4u*)(AS1 + o), a1);
        float s = 0.f;
#pragma unroll
        for (int j = 0; j < 8; ++j) { const float km0 = k[j] * (1.0f + (a0[j] - 1.0f) * ka[c0 + j]), km1 = k[j] * (1.0f + (a1[j] - 1.0f) * ka[512 + c0 + j]);
            s += r[j] * (km0 * rk[c0 + j] + km1 * rk[512 + c0 + j]); }
        s += __shfl_xor(s, 1); s += __shfl_xor(s, 2); s += __shfl_xor(s, 4);
        float y[8], yb[8]; unpack8(*(const GAS v4u*)(YF + o), y); unpack8(*(const GAS v4u*)(YB + o), yb);
        float sm = 0.f;
#pragma unroll
        for (int j = 0; j < 8; ++j) { y[j] += yb[j]; sm += y[j]; }
        sm += __shfl_xor(sm, 1); sm += __shfl_xor(sm, 2); sm += __shfl_xor(sm, 4);
        const float mean = sm * (1.f / 64.f); float sq = 0.f;
#pragma unroll
        for (int j = 0; j < 8; ++j) { y[j] -= mean; sq += y[j] * y[j]; }
        sq += __shfl_xor(sq, 1); sq += __shfl_xor(sq, 2); sq += __shfl_xor(sq, 4);
        const float rstd = 1.0f / sqrtf(sq * (1.f / 64.f) + 64e-5f);
        float gg[8]; unpack8(*(const GAS v4u*)(G + o), gg);
#pragma unroll
        for (int j = 0; j < 8; ++j) tmp[j] = (y[j] * rstd * lnw[c0 + j] + lnb[c0 + j] + s * v[j]) * gg[j];
        *(GAS v4u*)(ORW + o) = pack8(tmp);
    }
}

struct EpiMerge {
    static constexpr bool PERM = true, AFTER_DRAIN = false;
    bf16* merged; const bf16* gates; int goff; int first;
    __device__ __forceinline__ void operator()(const f32x4 (&acc)[2][2][4][2], const Unit& u, int wr, int wc, int fr, int fq) const {
        const int row0 = u.pm * 256 + wr * 64 + fr, col0 = u.pn * 256 + wc * 32 + 8 * fq;
#pragma unroll
        for (int ai = 0; ai < 2; ++ai)
#pragma unroll
            for (int m = 0; m < 4; ++m) { const size_t row = (size_t)(row0 + ai * 128 + m * 16);
#pragma unroll
                for (int bj = 0; bj < 2; ++bj) { const int col = col0 + bj * 128;
                    float gt[8]; unpack8(*(const GAS v4u*)(gates + row * 2048 + goff + col), gt);
                    const f32x4 v0 = acc[ai][bj][m][0], v1 = acc[ai][bj][m][1];
                    float o[8] = {v0.x * gt[0], v0.y * gt[1], v0.z * gt[2], v0.w * gt[3], v1.x * gt[4], v1.y * gt[5], v1.z * gt[6], v1.w * gt[7]};
                    GAS v4u* p = (GAS v4u*)(merged + row * 1024 + col);
                    if (!first) { float pv[8]; unpack8(*p, pv);
#pragma unroll
                        for (int j = 0; j < 8; ++j) o[j] += pv[j]; }
                    *p = pack8(o); } }
    }
};
struct EpiOutproj {
    static constexpr bool PERM = false, AFTER_DRAIN = false;
    const float* x; float* out; const float* mod;
    __device__ __forceinline__ void operator()(const f32x4 (&acc)[2][2][4][2], const Unit& u, int wr, int wc, int fr, int fq) const {
        const int row0 = u.pm * 256 + wr * 64 + fr, col0 = u.pn * 256 + wc * 32 + 4 * fq; const int b = u.pm >> 3;
        f32x4 gv[2][2];
#pragma unroll
        for (int bj = 0; bj < 2; ++bj)
#pragma unroll
            for (int n = 0; n < 2; ++n) gv[bj][n] = *(const f32x4*)(mod + (size_t)b * 6144 + 2048 + col0 + bj * 128 + n * 16);
#pragma unroll
        for (int ai = 0; ai < 2; ++ai)
#pragma unroll
            for (int m = 0; m < 4; ++m) { const size_t off = (size_t)(row0 + ai * 128 + m * 16) * 1024 + col0;
#pragma unroll
                for (int bj = 0; bj < 2; ++bj)
#pragma unroll
                    for (int n = 0; n < 2; ++n) { const f32x4 xv = *(const GAS f32x4*)(x + off + bj * 128 + n * 16); *(GAS f32x4*)(out + off + bj * 128 + n * 16) = xv + gv[bj][n] * acc[ai][bj][m][n]; } }
    }
};

__device__ __forceinline__ void p8_norm2_router(Frame& F) {
    LAS float* rwT = (LAS float*)F.lds;
    const float* rw = karg_in(I_ROUTER);
    for (int i = F.tid; i < 16384; i += 512) rwT[(i & 15) * 1024 + (i >> 4)] = rw[i];
    __syncthreads();
    const int gw = blockIdx.x * NWAVES + F.wave, NGW = F.G * NWAVES, lane = F.lane;
    const float* mod = (const float*)(F.ws + WS_MOD); bf16* H2 = (bf16*)(F.ws + WS_H2); float* AFF = (float*)(F.ws + WS_AFF);
    const float* g2 = karg_in(I_N2G);
    f32x4 gv[4];
#pragma unroll
    for (int j = 0; j < 4; ++j) gv[j] = *(const f32x4*)(g2 + 4 * lane + 256 * j);
    for (int m = gw; m < NLAT; m += NGW) {
        const int b = m >> 11, t = m & 2047;
        const float* xr = F.out + (size_t)m * DM; const float* sh = mod + (size_t)b * 6144 + 3072; const float* sc = sh + 1024;
        f32x4 v[4]; float s = 0.f;
#pragma unroll
        for (int j = 0; j < 4; ++j) { v[j] = *(const GAS f32x4*)(xr + 4 * lane + 256 * j); s += (v[j].x * v[j].x + v[j].y * v[j].y) + (v[j].z * v[j].z + v[j].w * v[j].w); }
        const float rstd = 1.0f / sqrtf(wave_sum(s) * (1.f / DM) + 1e-6f);
#pragma unroll
        for (int j = 0; j < 4; ++j) { const f32x4 a = *(const f32x4*)(sc + 4 * lane + 256 * j), bsh = *(const f32x4*)(sh + 4 * lane + 256 * j);
            v[j] = v[j] * rstd * gv[j] * (a + 1.0f) + bsh;
            v2u o; o.x = pkbf(v[j].x, v[j].y); o.y = pkbf(v[j].z, v[j].w);
            *(GAS v2u*)(H2 + (size_t)m * DM + 4 * lane + 256 * j) = o; }
        float lg[16];
#pragma unroll
        for (int e = 0; e < 16; ++e) { float a = 0.f;
#pragma unroll
            for (int j = 0; j < 4; ++j) { const f32x4 w = *(const LAS f32x4*)(rwT + e * 1024 + 4 * lane + 256 * j); a += (v[j].x * w.x + v[j].y * w.y) + (v[j].z * w.z + v[j].w * w.w); }
            lg[e] = wave_sum(a); if ((e & 1) == 1) asm volatile("" ::: "memory"); }
        float mx = lg[0];
#pragma unroll
        for (int e = 1; e < 16; ++e) mx = fmaxf(mx, lg[e]);
        float den = 0.f, mine = 0.f;
#pragma unroll
        for (int e = 0; e < 16; ++e) { lg[e] = __expf(lg[e] - mx); den += lg[e]; }
#pragma unroll
        for (int e = 0; e < 16; ++e) mine = (lane == e) ? lg[e] : mine;
        if (lane < 16) AFF[((size_t)b * 16 + lane) * SEQ + t] = mine / den;
    }
}

__device__ __forceinline__ int block_count(Frame& F, LAS int* wc, int slot, bool p0, bool p1, bool p2, bool p3) {
    const int c = __builtin_popcountll(__ballot(p0)) + __builtin_popcountll(__ballot(p1)) + __builtin_popcountll(__ballot(p2)) + __builtin_popcountll(__ballot(p3));
    if (F.lane == 0) wc[slot * 8 + F.wave] = c;
    __syncthreads();
    int s = 0;
#pragma unroll
    for (int w = 0; w < 8; ++w) s += wc[slot * 8 + w];
    return s;
}
__device__ __forceinline__ void p9_topk_gather(Frame& F) {
    LAS int* wc = (LAS int*)F.lds;
    LAS int* sel = (LAS int*)(F.lds + 1024);
    const float* AFF = (const float*)(F.ws + WS_AFF); int* IDX = (int*)(F.ws + WS_IDX); float* VAL = (float*)(F.ws + WS_VAL);
    const bf16* H2 = (const bf16*)(F.ws + WS_H2); bf16* XE = (bf16*)(F.ws + WS_XE);
    const int tid = F.tid, lane = F.lane, wave = F.wave;
    for (int p = blockIdx.x; p < NB * NE; p += F.G) {
        const int b = p >> 4, e = p & 15;
        const f32x4 av = *(const GAS f32x4*)(AFF + (size_t)p * SEQ + 4 * tid);
        const unsigned u0 = __float_as_uint(av.x), u1 = __float_as_uint(av.y), u2 = __float_as_uint(av.z), u3 = __float_as_uint(av.w);
        unsigned tau = 0u; int it = 0;
        for (int bit = 30; bit >= 0; --bit, ++it) { const unsigned cand = tau | (1u << bit);
            const int cnt = block_count(F, wc, it & 1, u0 >= cand, u1 >= cand, u2 >= cand, u3 >= cand);
            if (cnt >= CAP) tau = cand; }
        const int cgt = block_count(F, wc, it & 1, u0 > tau, u1 > tau, u2 > tau, u3 > tau); ++it;
        const int need_eq = CAP - cgt;
        const int ngt = (u0 > tau) + (u1 > tau) + (u2 > tau) + (u3 > tau), neq = (u0 == tau) + (u1 == tau) + (u2 == tau) + (u3 == tau);
        int pk = ngt | (neq << 16), inc = pk;
#pragma unroll
        for (int o = 1; o < 64; o <<= 1) { const int nb = __shfl_up(inc, o); if (lane >= o) inc += nb; }
        if (lane == 63) wc[16 + wave] = inc;
        __syncthreads();
        int base = 0;
#pragma unroll
        for (int w = 0; w < 8; ++w) base += (w < wave) ? wc[16 + w] : 0;
        int ex = base + inc - pk; int gpos = ex & 0xffff, epos = ex >> 16;
        const unsigned uu[4] = {u0, u1, u2, u3}; const float ff[4] = {av.x, av.y, av.z, av.w};
#pragma unroll
        for (int j = 0; j < 4; ++j) { int slot = -1;
            if (uu[j] > tau) { slot = gpos; ++gpos; } else if (uu[j] == tau) { if (epos < need_eq) slot = cgt + epos; ++epos; }
            if (slot >= 0) { IDX[(size_t)(e * NB + b) * CAP + slot] = 4 * tid + j; VAL[(size_t)(e * NB + b) * CAP + slot] = ff[j]; sel[slot] = 4 * tid + j; } }
        __syncthreads();
        for (int slot = wave; slot < CAP; slot += 8) { const int tok = sel[slot];
            const GAS v4u* src = (const GAS v4u*)(H2 + ((size_t)b * SEQ + tok) * DM); GAS v4u* dst = (GAS v4u*)(XE + ((size_t)(e * NB + b) * CAP + slot) * DM);
            const v4u x0 = src[lane], x1 = src[64 + lane]; dst[lane] = x0; dst[64 + lane] = x1; }
        __syncthreads();
    }
}

struct ExpertOrder {
    int G, c, upe, npn;
    __device__ void init(int G_, int c_, int npn_) { G = G_; c = c_; npn = npn_; upe = 32 * npn_; }
    __device__ bool next(int i, Unit& u) const { const long L = (long)i * G + c; if (L >= (long)NE * upe) return false;
        const int e = (int)(L / upe), rem = (int)(L % upe); u.pm = e * 32 + (rem & 31); u.pn = e * npn + (rem >> 5); return true; }
    __device__ __forceinline__ void a_ready(const Unit&) const {}
    __device__ __forceinline__ void done(const Unit&) const {}
};
struct EpiSwiglu {
    static constexpr bool PERM = true, AFTER_DRAIN = false;
    bf16* act;
    __device__ __forceinline__ void operator()(const f32x4 (&acc)[2][2][4][2], const Unit& u, int wr, int wc, int fr, int fq) const {
        const int e = u.pm >> 5, pnl = u.pn - 12 * e; const int row0 = u.pm * 256 + wr * 64 + fr, col = 128 * pnl + wc * 32 + 8 * fq;
#pragma unroll
        for (int ai = 0; ai < 2; ++ai)
#pragma unroll
            for (int m = 0; m < 4; ++m) { const f32x4 g0 = acc[ai][0][m][0], g1 = acc[ai][0][m][1], u0 = acc[ai][1][m][0], u1 = acc[ai][1][m][1];
                float o[8] = {g0.x * sigmoidf_(g0.x) * u0.x, g0.y * sigmoidf_(g0.y) * u0.y, g0.z * sigmoidf_(g0.z) * u0.z, g0.w * sigmoidf_(g0.w) * u0.w,
                              g1.x * sigmoidf_(g1.x) * u1.x, g1.y * sigmoidf_(g1.y) * u1.y, g1.z * sigmoidf_(g1.z) * u1.z, g1.w * sigmoidf_(g1.w) * u1.w};
                *(GAS v4u*)(act + (size_t)(row0 + ai * 128 + m * 16) * DFF + col) = pack8(o); }
    }
};
struct EpiDown {
    static constexpr bool PERM = false, AFTER_DRAIN = false;
    float* out; const float* mod; const int* idx; const float* val;
    __device__ __forceinline__ void operator()(const f32x4 (&acc)[2][2][4][2], const Unit& u, int wr, int wc, int fr, int fq) const {
        const int e = u.pm >> 5, b = u.pm & 31, pnl = u.pn - 4 * e; const int srow0 = u.pm * 256 + wr * 64 + fr, col0 = pnl * 256 + wc * 32 + 4 * fq;
        f32x4 gv[2][2];
#pragma unroll
        for (int bj = 0; bj < 2; ++bj)
#pragma unroll
            for (int n = 0; n < 2; ++n) gv[bj][n] = *(const f32x4*)(mod + (size_t)b * 6144 + 5120 + col0 + bj * 128 + n * 16);
#pragma unroll
        for (int ai = 0; ai < 2; ++ai)
#pragma unroll
            for (int m = 0; m < 4; ++m) { const int srow = srow0 + ai * 128 + m * 16; const int tok = idx[srow]; const float vl = val[srow];
                float* orow = out + ((size_t)b * SEQ + tok) * DM + col0;
#pragma unroll
                for (int bj = 0; bj < 2; ++bj)
#pragma unroll
                    for (int n = 0; n < 2; ++n) { const f32x4 r = gv[bj][n] * acc[ai][bj][m][n] * vl; float* p = orow + bj * 128 + n * 16;
                        unsafeAtomicAdd(p, r.x); unsafeAtomicAdd(p + 1, r.y); unsafeAtomicAdd(p + 2, r.z); unsafeAtomicAdd(p + 3, r.w); } }
    }
};

struct Args { const float* in[30]; float* out; unsigned char* ws; int ph_lo, ph_hi; };
__global__ void __launch_bounds__(NWAVES * 64, 2) mk_fwd(Args args) {
    extern __shared__ __attribute__((aligned(16))) unsigned char lds[];
    Frame F;
    F.lds = (LAS unsigned char*)lds; F.MISC = (volatile LAS unsigned*)(F.lds + MISC_OFF);
    F.tid = threadIdx.x; F.lane = F.tid & 63; F.wave = __builtin_amdgcn_readfirstlane(F.tid >> 6); F.G = gridDim.x;
    F.out = args.out; F.ws = args.ws; F.ctl = (gu32*)(args.ws + WS_CTL);
    for (int u = F.tid; u < (LDS_BYTES - LDSCTL_OFF) / 4; u += NWAVES * 64) ((LAS unsigned*)(F.lds + LDSCTL_OFF))[u] = 0u;
    __syncthreads();
    XcdBarrier bar; bar.bar = (unsigned*)(F.ctl + CW_BAR); bar.x = 0; bar.st = nullptr;
    if (N_LAUNCHES == 1) bar = xcd_barrier_post((unsigned*)(F.ctl + CW_BAR), F.MISC + 8);
#define GRID_BAR() do { if (N_LAUNCHES == 1) xcd_barrier(bar); } while (0)
    const int lo = args.ph_lo, hi = args.ph_hi;
#ifndef PH_MASK
#define PH_MASK 0xFFF
#endif
#define IN(k) (((PH_MASK >> (k)) & 1) && lo <= (k) && (k) < hi)
#define SEAM(k) do { if (IN(k) && IN((k) + 1)) GRID_BAR(); } while (0)
    unsigned char* ws = args.ws;

    if (IN(0)) { p0_prologue(F); } SEAM(0);
    if (IN(1)) { p1_norm1(F); } SEAM(1);
    if (IN(2)) {
        pg8::Gemm g{(const bf16*)(ws + WS_H1), (const bf16*)(ws + WS_WIN), NTOK, WIN_ROWS, DM}; InprojOrder S; S.init(F.G, (int)blockIdx.x);
        EpiInproj E{(bf16*)(ws + WS_ZK), (bf16*)(ws + WS_ZV), (bf16*)(ws + WS_ZR), (bf16*)(ws + WS_Q), (bf16*)(ws + WS_KQ), (bf16*)(ws + WS_VQ), (bf16*)(ws + WS_LA), (bf16*)args.out};
        pg8::gemm_phase<EpiInproj, InprojOrder, true, true>(F.lds, g, S, E);
    } SEAM(2);
    if (IN(3)) {
        p3a_lora(F);
        p3b_attn_prep(F);
    } SEAM(3);
    if (IN(4)) { p4a_attention(F); __syncthreads(); p4b_scan(F); } SEAM(4);
    if (IN(5)) { p5_rwkv_out(F); } SEAM(5);
    if (IN(6)) {
        { pg8::Gemm g{(const bf16*)(ws + WS_ORW), (const bf16*)(ws + WS_WBRR), NLAT, DM, 512}; pg8::StaticOrder S; S.init(NLAT, DM, F.G, (int)blockIdx.x);
          EpiMerge E{(bf16*)(ws + WS_MERGED), (const bf16*)args.out, 0, 1};
          pg8::gemm_phase<EpiMerge, pg8::StaticOrder, true, true>(F.lds, g, S, E); }
        __syncthreads();
        { pg8::Gemm g{(const bf16*)(ws + WS_Q), (const bf16*)(ws + WS_WBRA), NLAT, DM, 512}; pg8::StaticOrder S; S.init(NLAT, DM, F.G, (int)blockIdx.x);
          EpiMerge E{(bf16*)(ws + WS_MERGED), (const bf16*)args.out, 1024, 0};
          pg8::gemm_phase<EpiMerge, pg8::StaticOrder, true, true>(F.lds, g, S, E); }
    } SEAM(6);
    if (IN(7)) {
        pg8::Gemm g{(const bf16*)(ws + WS_MERGED), (const bf16*)(ws + WS_WOUT), NLAT, DM, DM}; pg8::StaticOrder S; S.init(NLAT, DM, F.G, (int)blockIdx.x);
        EpiOutproj E{karg_in(I_X), args.out, (const float*)(ws + WS_MOD)};
        pg8::gemm_phase<EpiOutproj, pg8::StaticOrder, true, true>(F.lds, g, S, E);
    } SEAM(7);
    if (IN(8)) { p8_norm2_router(F); } SEAM(8);
    if (IN(9)) { p9_topk_gather(F); } SEAM(9);
    if (IN(10)) {
        pg8::Gemm g{(const bf16*)(ws + WS_XE), (const bf16*)(ws + WS_WGU), NSLOT, NE * 3072, DM}; ExpertOrder S; S.init(F.G, (int)blockIdx.x, 12);
        EpiSwiglu E{(bf16*)(ws + WS_ACT)};
        pg8::gemm_phase<EpiSwiglu, ExpertOrder, true, true>(F.lds, g, S, E);
    } SEAM(10);
    if (IN(11)) {
        pg8::Gemm g{(const bf16*)(ws + WS_ACT), (const bf16*)(ws + WS_WD), NSLOT, NE * 1024, DFF}; ExpertOrder S; S.init(F.G, (int)blockIdx.x, 4);
        EpiDown E{args.out, (const float*)(ws + WS_MOD), (const int*)(ws + WS_IDX), (const float*)(ws + WS_VAL)};
        pg8::gemm_phase<EpiDown, ExpertOrder, true, true>(F.lds, g, S, E);
    }
#undef IN
#undef SEAM
#undef GRID_BAR
}

extern "C" void kernel_launch(void* const* d_in, const int* in_sizes, int n_in, void* d_out, int out_size, void* d_ws, size_t ws_size, hipStream_t stream) {
    static int grid = 0;
    if (grid == 0) {
        if (n_in != 30 || out_size != NLAT * DM || ws_size < WS_END) { fprintf(stderr, "kernel_launch: unexpected problem (n_in %d out %d ws %zu)\n", n_in, out_size, ws_size); grid = -1; return; }
        int dev = 0, cus = 0, per_cu = 0;
        if (hipGetDevice(&dev) != hipSuccess || hipDeviceGetAttribute(&cus, hipDeviceAttributeMultiprocessorCount, dev) != hipSuccess) { grid = -1; return; }
        if (hipFuncSetAttribute((const void*)mk_fwd, hipFuncAttributeMaxDynamicSharedMemorySize, LDS_BYTES) != hipSuccess) { fprintf(stderr, "kernel_launch: hipFuncSetAttribute failed\n"); grid = -1; return; }
        if (hipOccupancyMaxActiveBlocksPerMultiprocessor(&per_cu, (const void*)mk_fwd, NWAVES * 64, LDS_BYTES) != hipSuccess || per_cu < 1) fprintf(stderr, "kernel_launch: occupancy query says %d\n", per_cu);
        (void)hipGetLastError();
        grid = cus;
    }
    if (grid < 0) return;
    if (hipMemsetAsync((char*)d_ws + WS_CTL, 0, CTL_ZERO_BYTES, stream) != hipSuccess) return;
    Args a{};
    for (int i = 0; i < 30; ++i) a.in[i] = (const float*)d_in[i];
    a.out = (float*)d_out; a.ws = (unsigned char*)d_ws;
    if (N_LAUNCHES == 1) { a.ph_lo = 0; a.ph_hi = N_PHASES; hipLaunchKernelGGL(mk_fwd, dim3(grid), dim3(NWAVES * 64), LDS_BYTES, stream, a); }
    else for (int li = 0; li < N_PHASES; ++li) { a.ph_lo = li; a.ph_hi = li + 1; hipLaunchKernelGGL(mk_fwd, dim3(grid), dim3(NWAVES * 64), LDS_BYTES, stream, a); }
}
```

```cpp
#include <hip/hip_runtime.h>
#include <cstdio>
#include <cstdint>
#define MK_N_LAUNCHES 1
namespace pg8 {
#define PG8_LAS __attribute__((address_space(3)))
typedef unsigned short bf16_t;
typedef short bf16x8 __attribute__((ext_vector_type(8)));
typedef float f32x4 __attribute__((ext_vector_type(4)));
typedef unsigned u32x4 __attribute__((ext_vector_type(4)));
constexpr int BM = 256, BK = 64, HALF = 128, HTB = HALF * BK * 2  , STAGE_BYTES = 8 * HTB, NXCD = 8, WGM = 8;

__host__ __device__ __forceinline__ int lds_byte(int r, int c) { const int st = (r >> 4) * 2 + (c >> 5), rr = r & 15, cc = c & 31, ob = rr * 64 + cc * 2; return st * 1024 + (ob ^ (((ob >> 9) & 1) << 5)); }
__host__ __device__ __forceinline__ void stage_rc(int b, int& R, int& C) { const int st = b / 1024, sb = b % 1024, swz = sb ^ (((sb >> 9) & 1) << 5); R = (st >> 1) * 16 + swz / 64; C = (st & 1) * 32 + (swz % 64) / 2; }
__host__ __device__ __forceinline__ int perm32(int rho) { const int n = rho >> 4, i = rho & 15; return 8 * (i >> 2) + 4 * n + (i & 3); }

struct Unit { int pm, pn; };
struct Gemm { const bf16_t* A; const bf16_t* Bt; int M, N, K; const bf16_t* A2 = nullptr; int lda = 0; };

struct StaticOrder {
    int nM, nN, nwg, G, c;
    __host__ __device__ void init(int M, int N, int G_, int c_) { nM = M / BM; nN = N / BM; nwg = nM * nN; G = G_; c = c_; }
    __host__ __device__ bool next(int i, Unit& u) const {
        const long L = (long)i * G + c; if (L >= nwg) return false;
        int wgid = (int)L; { const int q = nwg / NXCD, r = nwg % NXCD, xcd = wgid % NXCD, off = wgid / NXCD; wgid = (xcd < r ? xcd * (q + 1) : r * (q + 1) + (xcd - r) * q) + off; }
        const int nig = WGM * nN, gid = wgid / nig, fm = gid * WGM, gsz = (nM - fm) < WGM ? (nM - fm) : WGM;
        u.pm = fm + ((wgid % nig) % gsz); u.pn = (wgid % nig) / gsz; return true;
    }
    __device__ __forceinline__ void a_ready(const Unit&) const {}
    __device__ __forceinline__ void done(const Unit&) const {}
};

template <class Epi, class Sched, bool ALIGN_EPI = false, bool SP2 = false, bool SPLITA = false>
__device__ __forceinline__ void gemm_phase(PG8_LAS unsigned char* lds, const Gemm g, const Sched& S, const Epi& E) {
    const int tid = threadIdx.x, wid = __builtin_amdgcn_readfirstlane(tid >> 6), lane = tid & 63, wr = wid >> 2, wc = wid & 3, fr = lane & 15, fq = lane >> 4;
    const int K = g.K, nt = K / BK, lda = g.lda ? g.lda : g.K, nh = nt / 2;
    unsigned voffA[2], voffB[2];
#pragma unroll
    for (int i = 0; i < 2; ++i) { int R, C; stage_rc(tid * 16 + i * 8192, R, C); const int Rb = Epi::PERM ? ((R & ~31) + perm32(R & 31)) : R;
        voffA[i] = (unsigned)(R * lda + C) * 2u; voffB[i] = (unsigned)(Rb * K + C) * 2u; }
    const size_t kstep = (size_t)(BK * 2);
    const size_t hstep = (size_t)HALF * K * 2;
    const size_t tstep = 2 * hstep;
    const size_t hstepA = (size_t)HALF * lda * 2, tstepA = 2 * hstepA;
    const unsigned ldsw = (unsigned)wid * 1024u;
    const int aoff = lds_byte(wr * 64 + fr, fq * 8), boff = lds_byte(wc * 32 + fr, fq * 8);
#define PG8_SA(b, h) (((b) * 2 + (h)) * HTB)
#define PG8_SB(b, h) ((4 + (b) * 2 + (h)) * HTB)
#define PG8_STAGE(bufoff, gbase, voff) do { _Pragma("unroll") for (int _i = 0; _i < 2; ++_i) \
        __builtin_amdgcn_global_load_lds((const unsigned*)((const char*)(gbase) + (voff)[_i]), (PG8_LAS unsigned*)(lds + (bufoff) + ldsw + _i * 8192), 16, 0, 0); } while (0)
#define PG8_LDA(dst, b, h) do { _Pragma("unroll") for (int m = 0; m < 4; ++m) _Pragma("unroll") for (int k = 0; k < 2; ++k) dst[m][k] = *(const PG8_LAS bf16x8*)(lds + PG8_SA(b, h) + aoff + m * 2048 + k * 1024); } while (0)
#define PG8_LDB(dst, b, h) do { _Pragma("unroll") for (int n = 0; n < 2; ++n) _Pragma("unroll") for (int k = 0; k < 2; ++k) dst[n][k] = *(const PG8_LAS bf16x8*)(lds + PG8_SB(b, h) + boff + n * 2048 + k * 1024); } while (0)
#define PG8_MMA(ai, bj, At, Bt) do { __builtin_amdgcn_s_setprio(1); _Pragma("unroll") for (int m = 0; m < 4; ++m) _Pragma("unroll") for (int n = 0; n < 2; ++n) _Pragma("unroll") for (int k = 0; k < 2; ++k) \
        acc[ai][bj][m][n] = __builtin_amdgcn_mfma_f32_16x16x32_bf16(Bt[n][k], At[m][k], acc[ai][bj][m][n], 0, 0, 0); __builtin_amdgcn_s_setprio(0); } while (0)
#define PG8_WAIT_V(n) asm volatile("s_waitcnt vmcnt(" #n ")" ::: "memory")
#define PG8_WAIT_L(n) asm volatile("s_waitcnt lgkmcnt(" #n ")" ::: "memory")
#define PG8_BAR __builtin_amdgcn_s_barrier()
#define PG8_SCHED __builtin_amdgcn_sched_barrier(0)
    Unit cur, nxt; int ui = 0;
    if (!S.next(0, cur)) return;
    f32x4 acc[2][2][4][2];
#pragma unroll
    for (int a = 0; a < 2; ++a)
#pragma unroll
        for (int b = 0; b < 2; ++b)
#pragma unroll
            for (int m = 0; m < 4; ++m)
#pragma unroll
                for (int n = 0; n < 2; ++n) acc[a][b][m][n] = (f32x4){0.f, 0.f, 0.f, 0.f};
    bf16x8 At[4][2], B0[2][2], B1[2][2];
    const char* cA = (const char*)g.A + (size_t)cur.pm * tstepA; const char* cB = (const char*)g.Bt + (size_t)cur.pn * tstep;
    const char* cA2 = SPLITA ? (const char*)g.A2 + (size_t)cur.pm * tstepA : cA;
#define PG8_AADDR(tt) (SPLITA ? (((tt) < nh) ? cA + (size_t)(tt) * kstep : cA2 + (size_t)((tt) - nh) * kstep) : cA + (size_t)(tt) * kstep)
    S.a_ready(cur);
    if constexpr (SP2) {
        PG8_STAGE(PG8_SB(0, 0), cB, voffB); PG8_STAGE(PG8_SB(0, 1), cB + hstep, voffB); PG8_STAGE(PG8_SA(0, 0), cA, voffA); PG8_STAGE(PG8_SA(0, 1), cA + hstepA, voffA);
        if (wr == 1) PG8_BAR;
        PG8_WAIT_V(2); PG8_BAR;
        PG8_STAGE(PG8_SB(1, 0), cB + kstep, voffB); PG8_STAGE(PG8_SA(1, 0), cA + kstep, voffA); PG8_STAGE(PG8_SB(1, 1), cB + hstep + kstep, voffB);
        PG8_WAIT_V(6); PG8_BAR;
    } else {
        PG8_STAGE(PG8_SB(0, 0), cB, voffB); PG8_STAGE(PG8_SA(0, 0), cA, voffA); PG8_STAGE(PG8_SB(0, 1), cB + hstep, voffB); PG8_STAGE(PG8_SA(0, 1), cA + hstepA, voffA);
        if (wr == 1) PG8_BAR;
        PG8_WAIT_V(4); PG8_BAR;
        PG8_STAGE(PG8_SB(1, 0), cB + kstep, voffB); PG8_STAGE(PG8_SA(1, 0), cA + kstep, voffA); PG8_STAGE(PG8_SB(1, 1), cB + hstep + kstep, voffB);
        PG8_WAIT_V(6); PG8_BAR;
    }
    for (;;) {
        const bool has_next = S.next(ui + 1, nxt);
        const char* nA = has_next ? (const char*)g.A + (size_t)nxt.pm * tstepA : cA; const char* nB = has_next ? (const char*)g.Bt + (size_t)nxt.pn * tstep : cB;
        const char* nA2 = (SPLITA && has_next) ? (const char*)g.A2 + (size_t)nxt.pm * tstepA : cA2;
        for (int t = 0; t < nt; t += 2) {
            const bool last = (t == nt - 2);
            const char* a1 = PG8_AADDR(t + 1);
            const char* a2 = last ? nA : PG8_AADDR(t + 2); const char* b2 = last ? nB : cB + (size_t)(t + 2) * kstep;
            const char* a3 = a2 + kstep; const char* b3 = b2 + kstep;
            if (last && has_next) S.a_ready(nxt);
            if constexpr (SPLITA) { if (t == nh) E.mid(acc, cur, wr, wc, fr, fq); }
            if constexpr (SP2) {
            PG8_LDB(B0, 0, 0); PG8_LDB(B1, 0, 1); PG8_SCHED; PG8_LDA(At, 0, 0); PG8_STAGE(PG8_SA(1, 1), a1 + hstepA, voffA);
            PG8_WAIT_V(8); PG8_WAIT_L(0); PG8_BAR; PG8_MMA(0, 0, At, B0); PG8_MMA(0, 1, At, B1); PG8_BAR; PG8_SCHED;
            PG8_LDA(At, 0, 1); PG8_STAGE(PG8_SB(0, 0), b2, voffB); PG8_STAGE(PG8_SB(0, 1), b2 + hstep, voffB); PG8_STAGE(PG8_SA(0, 0), a2, voffA);
            PG8_WAIT_V(8); PG8_WAIT_L(0); PG8_BAR; PG8_MMA(1, 0, At, B0); PG8_MMA(1, 1, At, B1); PG8_BAR; PG8_SCHED;
            PG8_LDB(B0, 1, 0); PG8_LDB(B1, 1, 1); PG8_SCHED; PG8_LDA(At, 1, 0); PG8_STAGE(PG8_SA(0, 1), a2 + hstepA, voffA);
            PG8_WAIT_V(8); PG8_WAIT_L(0); PG8_BAR; PG8_MMA(0, 0, At, B0); PG8_MMA(0, 1, At, B1); PG8_BAR; PG8_SCHED;
            PG8_LDA(At, 1, 1); PG8_STAGE(PG8_SB(1, 0), b3, voffB); PG8_STAGE(PG8_SB(1, 1), b3 + hstep, voffB); PG8_STAGE(PG8_SA(1, 0), a3, voffA);
            PG8_WAIT_V(8); PG8_WAIT_L(0); PG8_BAR; PG8_MMA(1, 0, At, B0); PG8_MMA(1, 1, At, B1); PG8_BAR; PG8_SCHED;
            } else {
            PG8_LDB(B0, 0, 0); PG8_SCHED; PG8_LDA(At, 0, 0); PG8_STAGE(PG8_SA(1, 1), a1 + hstepA, voffA);
            PG8_WAIT_L(8); PG8_BAR; PG8_WAIT_L(0); PG8_MMA(0, 0, At, B0); PG8_BAR; PG8_SCHED;
            PG8_LDB(B1, 0, 1); PG8_STAGE(PG8_SB(0, 0), b2, voffB);
            PG8_BAR; PG8_WAIT_L(0); PG8_MMA(0, 1, At, B1); PG8_BAR;
            PG8_LDA(At, 0, 1); PG8_STAGE(PG8_SA(0, 0), a2, voffA);
            PG8_BAR; PG8_WAIT_L(0); PG8_MMA(1, 0, At, B0); PG8_BAR; PG8_SCHED;
            PG8_STAGE(PG8_SB(0, 1), b2 + hstep, voffB);
            PG8_WAIT_V(6); PG8_BAR; PG8_MMA(1, 1, At, B1); PG8_BAR;
            PG8_LDB(B0, 1, 0); PG8_SCHED; PG8_LDA(At, 1, 0); PG8_STAGE(PG8_SA(0, 1), a2 + hstepA, voffA);
            PG8_WAIT_L(8); PG8_BAR; PG8_WAIT_L(0); PG8_MMA(0, 0, At, B0); PG8_BAR; PG8_SCHED;
            PG8_LDB(B1, 1, 1); PG8_STAGE(PG8_SB(1, 0), b3, voffB);
            PG8_BAR; PG8_WAIT_L(0); PG8_MMA(0, 1, At, B1); PG8_BAR;
            PG8_LDA(At, 1, 1); PG8_STAGE(PG8_SA(1, 0), a3, voffA);
            PG8_BAR; PG8_WAIT_L(0); PG8_MMA(1, 0, At, B0); PG8_BAR; PG8_SCHED;
            PG8_STAGE(PG8_SB(1, 1), b3 + hstep, voffB);
            PG8_WAIT_V(6); PG8_BAR; PG8_MMA(1, 1, At, B1); PG8_BAR;
            }
        }
        if constexpr (ALIGN_EPI) { if (wr == 0) PG8_BAR; }
        if constexpr (!Epi::AFTER_DRAIN) { E(acc, cur, wr, wc, fr, fq); S.done(cur); }
        if (!has_next) break;
#pragma unroll
        for (int a = 0; a < 2; ++a)
#pragma unroll
            for (int b = 0; b < 2; ++b)
#pragma unroll
                for (int m = 0; m < 4; ++m)
#pragma unroll
                    for (int n = 0; n < 2; ++n) acc[a][b][m][n] = (f32x4){0.f, 0.f, 0.f, 0.f};
        cur = nxt; cA = nA; cA2 = nA2; cB = nB; ++ui;
        if constexpr (ALIGN_EPI) { if (wr == 1) PG8_BAR; }
    }
    PG8_WAIT_V(0);
    if constexpr (!ALIGN_EPI) { if (wr == 0) PG8_BAR; }
    PG8_BAR;
    if constexpr (Epi::AFTER_DRAIN) { E.fused(acc, cur, wr, wc, fr, fq, lds, wid, lane); S.done(cur); }
#undef PG8_AADDR
#undef PG8_SA
#undef PG8_SB
#undef PG8_STAGE
#undef PG8_LDA
#undef PG8_LDB
#undef PG8_MMA
#undef PG8_WAIT_V
#undef PG8_WAIT_L
#undef PG8_BAR
#undef PG8_SCHED
}
}
#define GAS __attribute__((address_space(1)))
#define LAS __attribute__((address_space(3)))
typedef unsigned short bf16;
typedef unsigned v4u __attribute__((ext_vector_type(4)));
typedef float f32x4 __attribute__((ext_vector_type(4)));
typedef short bf16x8 __attribute__((ext_vector_type(8)));
typedef GAS unsigned gu32;
typedef GAS unsigned long long gu64;
#define RLX_AGENT __ATOMIC_RELAXED, __HIP_MEMORY_SCOPE_AGENT
#define LDS_WAIT() asm volatile("s_waitcnt lgkmcnt(0)" ::: "memory")
#define VM_WAIT() asm volatile("s_waitcnt vmcnt(0)" ::: "memory")
__device__ __forceinline__ unsigned long long rt() { return __builtin_amdgcn_s_memrealtime(); }
__device__ __forceinline__ unsigned f2bf(float f) { unsigned u = __builtin_bit_cast(unsigned, f); return (u + 0x7fffu + ((u >> 16) & 1u)) >> 16; }
__device__ __forceinline__ unsigned pk2(float lo, float hi) { return f2bf(lo) | (f2bf(hi) << 16); }

#define XB_TMO      128
#define XB_XCNT(j)  (256  + 64 * (j))
#define XB_XSUB(j)  (1280 + 64 * (j))
#define XB_XGEN(j)  (2304 + 64 * (j))
#define XB_TOP      3328
#define XB_TOPGEN   3392
#define XCD_BAR_WORDS 3456
#define XB_SPIN_CAP (1u << 18)

__device__ __forceinline__ unsigned xb_ld(unsigned* p)              { return __hip_atomic_load(p, __ATOMIC_RELAXED, __HIP_MEMORY_SCOPE_AGENT); }
__device__ __forceinline__ unsigned xb_add(unsigned* p, unsigned v) { return __hip_atomic_fetch_add(p, v, __ATOMIC_RELAXED, __HIP_MEMORY_SCOPE_AGENT); }
__device__ __forceinline__ unsigned xb_xcc_id() { return (unsigned)__builtin_amdgcn_s_getreg((3 << 11) | 20) & 0xFu; }
#define XB_SPIN(cond, bar) do { unsigned _sp = 0; while (cond) { __builtin_amdgcn_s_sleep(1); \
    if ((++_sp & 255u) == 0u) { if (xb_ld(&(bar)[XB_TMO])) break; if (_sp > XB_SPIN_CAP) { atomicAdd(&(bar)[XB_TMO], 1u); break; } } } } while (0)

struct XcdBarrier {
    unsigned* bar; unsigned x;
    volatile LAS unsigned* st;
};

__device__ __forceinline__ XcdBarrier xcd_barrier_post(unsigned* bar, volatile LAS unsigned* st) {
    XcdBarrier b; b.bar = bar; b.x = xb_xcc_id(); b.st = st;
    if (threadIdx.x == 0) (void)xb_add(&bar[XB_XCNT(b.x)], 1u);
    return b;
}
__device__ __forceinline__ void xcd_barrier_complete(unsigned* bar, unsigned x, unsigned& nloc, unsigned& nx) {
    const unsigned G = gridDim.x * gridDim.y * gridDim.z;
    unsigned sum, cnt, mine, sp = 0u;
    for (;;) {
        sum = 0u; cnt = 0u; mine = 0u;
#pragma unroll
        for (unsigned j = 0; j < 16; ++j) { const unsigned c = xb_ld(&bar[XB_XCNT(j)]); sum += c; cnt += (c > 0u) ? 1u : 0u; mine = (j == x) ? c : mine; }
        if (sum == G) break;
        __builtin_amdgcn_s_sleep(1);
        if ((++sp & 255u) == 0u) { if (xb_ld(&bar[XB_TMO])) break; if (sp > XB_SPIN_CAP) { atomicAdd(&bar[XB_TMO], 1u); break; } }
    }
    nloc = mine > 0u ? mine : 1u; nx = cnt > 0u ? cnt : 1u;
}

__device__ __forceinline__ void xcd_barrier(const XcdBarrier& b) {
    asm volatile("s_waitcnt vmcnt(0)" ::: "memory");
    __syncthreads();
    if (threadIdx.x == 0) {
        unsigned* bar = b.bar;
        __builtin_amdgcn_s_waitcnt(0);
        unsigned nloc = b.st[0], nx = b.st[1];
        if (nloc == 0u) { xcd_barrier_complete(bar, b.x, nloc, nx); b.st[0] = nloc; b.st[1] = nx; }
        const unsigned old = xb_add(&bar[XB_XSUB(b.x)], 1u);
        const unsigned gen = old / nloc;
        if (old + 1u == (gen + 1u) * nloc) {
            __builtin_amdgcn_fence(__ATOMIC_RELEASE, "agent");
            asm volatile("s_waitcnt vmcnt(0)" ::: "memory");
            const unsigned og = xb_add(&bar[XB_TOP], 1u);
            const unsigned tg = og / nx;
            if (og + 1u == (tg + 1u) * nx) xb_add(&bar[XB_TOPGEN], 1u);
            else XB_SPIN(xb_ld(&bar[XB_TOPGEN]) == tg, bar);
            __builtin_amdgcn_fence(__ATOMIC_ACQUIRE, "agent");
            xb_add(&bar[XB_XGEN(b.x)], 1u);
            asm volatile("s_waitcnt vmcnt(0)" ::: "memory");
        } else {
            XB_SPIN(xb_ld(&bar[XB_XGEN(b.x)]) == gen, bar);
            __builtin_amdgcn_fence(__ATOMIC_ACQUIRE, "agent");
            asm volatile("s_waitcnt vmcnt(0)" ::: "memory");
        }
    }
    __syncthreads();
}

typedef float f32x2 __attribute__((ext_vector_type(2)));
typedef float f32x16 __attribute__((ext_vector_type(16)));
typedef unsigned v2u __attribute__((ext_vector_type(2)));
typedef __bf16 bf16x2_t __attribute__((ext_vector_type(2)));
using pg8::Unit;

constexpr int NWAVES = 8;
#ifndef MK_N_LAUNCHES
#define MK_N_LAUNCHES 1
#endif
constexpr int N_PHASES = 13;
constexpr int N_LAUNCHES = MK_N_LAUNCHES;

constexpr int NB = 32, SEQ = 2048, LC = 256, DM = 1024, NLAT = NB * SEQ, NCTX = NB * LC, NTOK = NLAT + NCTX;
constexpr int NE = 16, CAP = 256, DFF = 1536, NSLOT = NE * NB * CAP;
constexpr int WIN_ROWS = 4864, LORA_N = 2560, LORA_K = 384;
constexpr int KEYS = SEQ + LC;

constexpr size_t MiB = 1u << 20, KiB = 1u << 10;
constexpr size_t WS_CTL = 0, CTL_ZERO_BYTES = 1 * MiB;
constexpr size_t WS_MOD = 1 * MiB;
constexpr size_t WS_WIN = 2 * MiB;
constexpr size_t WS_WLORA = 11 * MiB + 512 * KiB;
constexpr size_t WS_WBRR = 13 * MiB + 512 * KiB;
constexpr size_t WS_WBRA = 14 * MiB + 512 * KiB;
constexpr size_t WS_WOUT = 15 * MiB + 512 * KiB;
constexpr size_t WS_WGU = 17 * MiB + 512 * KiB;
constexpr size_t WS_WD = 113 * MiB + 512 * KiB;
constexpr size_t WS_IDX = 161 * MiB + 512 * KiB;
constexpr size_t WS_VAL = 162 * MiB;
constexpr size_t WS_ZK = 163 * MiB;
constexpr size_t WS_ZV = 235 * MiB;
constexpr size_t WS_ZR = 307 * MiB;
constexpr size_t WS_Q = 371 * MiB;
constexpr size_t WS_KQ = 435 * MiB;
constexpr size_t WS_VQ = 453 * MiB;
constexpr size_t WS_XCH = 453 * MiB;
constexpr size_t WS_YB = 959 * MiB;
constexpr size_t WS_LA = 471 * MiB;
constexpr size_t WS_H1 = 525 * MiB;
constexpr size_t WS_EW = 525 * MiB;
constexpr size_t WS_ORW = 525 * MiB;
constexpr size_t WS_AS = 669 * MiB;
constexpr size_t WS_G = 813 * MiB;
constexpr size_t WS_VT = 877 * MiB;
constexpr size_t WS_YF = 895 * MiB;
constexpr size_t WS_MERGED = 163 * MiB;
constexpr size_t WS_INV = 163 * MiB;
constexpr size_t WS_XE = 167 * MiB;
constexpr size_t WS_Y2 = 167 * MiB;
constexpr size_t WS_H2 = 423 * MiB;
constexpr size_t WS_AFF = 551 * MiB;
constexpr size_t WS_ACT = 423 * MiB;
constexpr size_t WS_DELTA = 807 * MiB;
constexpr size_t WS_END = 1023 * MiB;
constexpr int CW_BAR = 4096;

constexpr int RING_BYTES = 131072;
constexpr int LDSCTL_OFF = 147456 - 1024, MISC_OFF = LDSCTL_OFF + 320;
static_assert(33 * 1024 * 4 <= LDSCTL_OFF, "P0's silu(c) image must stay below the LDS control words");
constexpr int LDS_BYTES = 147456;

__device__ __forceinline__ unsigned pkbf(float lo, float hi) { f32x2 v = {lo, hi}; return __builtin_bit_cast(unsigned, __builtin_convertvector(v, bf16x2_t)); }
__device__ __forceinline__ float bflo(unsigned u) { return __uint_as_float(u << 16); }
__device__ __forceinline__ float bfhi(unsigned u) { return __uint_as_float(u & 0xffff0000u); }
__device__ __forceinline__ float bf1(bf16 h) { return __uint_as_float(((unsigned)h) << 16); }
__device__ __forceinline__ float sigmoidf_(float x) { return __builtin_amdgcn_rcpf(1.0f + __builtin_amdgcn_exp2f(-1.4426950408889634f * x)); }
__device__ __forceinline__ float tanhf_(float x) { return 1.0f - 2.0f * __builtin_amdgcn_rcpf(__builtin_amdgcn_exp2f(2.8853900817779268f * x) + 1.0f); }
__device__ __forceinline__ float wave_sum(float v) {
    int x = __float_as_int(v);
#define WS_DPP(ctrl, rmask) x = __float_as_int(__int_as_float(x) + __int_as_float(__builtin_amdgcn_update_dpp(0, x, ctrl, rmask, 0xf, false)))
    WS_DPP(0x111, 0xf); WS_DPP(0x112, 0xf); WS_DPP(0x114, 0xf); WS_DPP(0x118, 0xf); WS_DPP(0x142, 0xa); WS_DPP(0x143, 0xc);
#undef WS_DPP
    return __int_as_float(__builtin_amdgcn_readlane(x, 63));
}
__device__ __forceinline__ void unpack8(const v4u w, float (&f)[8]) {
    f[0] = bflo(w.x); f[1] = bfhi(w.x); f[2] = bflo(w.y); f[3] = bfhi(w.y); f[4] = bflo(w.z); f[5] = bfhi(w.z); f[6] = bflo(w.w); f[7] = bfhi(w.w);
}
__device__ __forceinline__ v4u pack8(const float (&f)[8]) { v4u w; w.x = pkbf(f[0], f[1]); w.y = pkbf(f[2], f[3]); w.z = pkbf(f[4], f[5]); w.w = pkbf(f[6], f[7]); return w; }

struct Frame {
    LAS unsigned char* lds;
    volatile LAS unsigned* MISC;
    gu32* ctl;
    int tid, lane, wave, G;
    float* out; unsigned char* ws;
};
enum { I_X = 0, I_C, I_CTX, I_CCTX, I_ADAW, I_ADAB, I_N1G, I_N2G, I_WIN, I_CONV, I_W0, I_W2, I_A0, I_A2, I_KK, I_KA, I_RK, I_G2, I_LNW, I_LNB, I_QG, I_KG, I_SINK,
       I_WBRR, I_WBRA, I_WOUT, I_ROUTER, I_EG, I_EU, I_ED };
typedef const __attribute__((address_space(4))) unsigned char* kptr_t;
__device__ __forceinline__ const float* karg_in(int i) { kptr_t kp = (kptr_t)__builtin_amdgcn_kernarg_segment_ptr(); asm volatile("" : "+s"(kp)); return *(const float* const __attribute__((address_space(4)))*)(kp + 8 * i); }

__device__ __forceinline__ void transpose_item(const float* W, int N, int k0, int n0, bf16* WT, int Kd, int drow0, LAS float* scr, int lane) {
#pragma unroll 8
    for (int i = 0; i < 32; ++i) { const int kk = 2 * i + (lane >> 5); scr[kk * 33 + (lane & 31)] = W[(size_t)(k0 + kk) * N + n0 + (lane & 31)]; }
    LDS_WAIT(); asm volatile("" ::: "memory");
    const int c = lane & 7;
#pragma unroll
    for (int j = 0; j < 4; ++j) { const int n = (lane >> 3) + 8 * j; const LAS float* s = scr + (8 * c) * 33 + n;
        v4u o; o.x = pkbf(s[0 * 33], s[1 * 33]); o.y = pkbf(s[2 * 33], s[3 * 33]); o.z = pkbf(s[4 * 33], s[5 * 33]); o.w = pkbf(s[6 * 33], s[7 * 33]);
        *(GAS v4u*)(WT + (size_t)(drow0 + n) * Kd + k0 + 8 * c) = o; }
    LDS_WAIT(); asm volatile("" ::: "memory");
}
__device__ __forceinline__ int win_dest_block(int sb) {
    if (sb < 4) return 13 + sb;
    if (sb < 8) return sb - 4;
    if (sb < 12) return sb - 4;
    if (sb == 12) return 8;
    if (sb == 13) return 9;
    if (sb == 14) return 10;
    if (sb < 19) return sb + 2;
    if (sb == 19) return 11;
    if (sb == 20) return 12;
    return sb;
}
__device__ __forceinline__ void p0_prologue(Frame& F) {
    if (blockIdx.x < 96) {
        LAS float* cs = (LAS float*)F.lds;
        const float* c = karg_in(I_C); const float* cc = karg_in(I_CCTX);
        for (int i = F.tid; i < 33 * 1024; i += 512) { const float v = i < 32 * 1024 ? c[i] : cc[i - 32 * 1024]; cs[i] = v * sigmoidf_(v); }
        __syncthreads();
        const int col = blockIdx.x * 64 + F.lane; const float* aw = karg_in(I_ADAW);
        float acc[33];
#pragma unroll
        for (int b = 0; b < 33; ++b) acc[b] = 0.f;
        const int kbeg = F.wave * 128;
        for (int k = kbeg; k < kbeg + 128; k += 4) {
            const float w0 = aw[(size_t)(k + 0) * 6144 + col], w1 = aw[(size_t)(k + 1) * 6144 + col], w2 = aw[(size_t)(k + 2) * 6144 + col], w3 = aw[(size_t)(k + 3) * 6144 + col];
#pragma unroll
            for (int b = 0; b < 33; ++b) { const f32x4 cv = *(const LAS f32x4*)(cs + b * 1024 + k); acc[b] += cv.x * w0 + cv.y * w1 + cv.z * w2 + cv.w * w3; }
        }
        __syncthreads();
        LAS float* red = (LAS float*)F.lds;
#pragma unroll
        for (int b = 0; b < 33; ++b) red[(F.wave * 33 + b) * 64 + F.lane] = acc[b];
        __syncthreads();
        float* mod = (float*)(F.ws + WS_MOD); const float* ab = karg_in(I_ADAB);
        for (int i = F.tid; i < 33 * 64; i += 512) { const int b = i >> 6, l = i & 63; float s = 0.f;
#pragma unroll
            for (int w = 0; w < 8; ++w) s += red[(w * 33 + b) * 64 + l];
            mod[(size_t)b * 6144 + blockIdx.x * 64 + l] = s + ab[blockIdx.x * 64 + l]; }
        __syncthreads();
    }
    LAS float* scr = (LAS float*)(F.lds + F.wave * 16384);
    const int gw = blockIdx.x * NWAVES + F.wave, NGW = F.G * NWAVES;
    constexpr int IT_WIN = 16 * 148, IT_G = 16 * 768, IT_BR = 256, IT_OUT = 512;
    constexpr int NITEMS = IT_WIN + 3 * IT_G + 2 * IT_BR + IT_OUT;
    bf16* WIN = (bf16*)(F.ws + WS_WIN); bf16* WGU = (bf16*)(F.ws + WS_WGU); bf16* WD = (bf16*)(F.ws + WS_WD);
    for (int it = gw; it < NITEMS; it += NGW) {
        int r = it;
        if (r < IT_WIN) { const int kb = r / 148, nb = r % 148, n0 = 32 * nb; const int db = win_dest_block(n0 >> 7);
            transpose_item(karg_in(I_WIN), 4736, 64 * kb, n0, WIN, 1024, db * 128 + (n0 & 127), scr, F.lane); continue; }
        r -= IT_WIN;
        if (r < IT_G) { const int e = r / 768, q = r % 768, kb = q / 48, nb = q % 48, n0 = 32 * nb;
            transpose_item(karg_in(I_EG) + (size_t)e * 1024 * 1536, 1536, 64 * kb, n0, WGU, 1024, e * 3072 + 256 * (n0 >> 7) + (n0 & 127), scr, F.lane); continue; }
        r -= IT_G;
        if (r < IT_G) { const int e = r / 768, q = r % 768, kb = q / 48, nb = q % 48, n0 = 32 * nb;
            transpose_item(karg_in(I_EU) + (size_t)e * 1024 * 1536, 1536, 64 * kb, n0, WGU, 1024, e * 3072 + 256 * (n0 >> 7) + 128 + (n0 & 127), scr, F.lane); continue; }
        r -= IT_G;
        if (r < IT_G) { const int e = r / 768, q = r % 768, kb = q / 32, nb = q % 32, n0 = 32 * nb;
            transpose_item(karg_in(I_ED) + (size_t)e * 1536 * 1024, 1024, 64 * kb, n0, WD, 1536, e * 1024 + n0, scr, F.lane); continue; }
        r -= IT_G;
        if (r < IT_BR) { const int kb = r / 32, nb = r % 32; transpose_item(karg_in(I_WBRR), 1024, 64 * kb, 32 * nb, (bf16*)(F.ws + WS_WBRR), 1024, 32 * nb, scr, F.lane); continue; }
        r -= IT_BR;
        if (r < IT_BR) { const int kb = r / 32, nb = r % 32; transpose_item(karg_in(I_WBRA), 1024, 64 * kb, 32 * nb, (bf16*)(F.ws + WS_WBRR) + 512, 1024, 32 * nb, scr, F.lane); continue; }
        r -= IT_BR;
        { const int kb = r / 32, nb = r % 32; transpose_item(karg_in(I_WOUT), 1024, 64 * kb, 32 * nb, (bf16*)(F.ws + WS_WOUT), 1024, 32 * nb, scr, F.lane); }
    }
    const int gt = blockIdx.x * 512 + F.tid, NGT = F.G * 512;
    for (int i = gt; i < 128 * 1024 / 8; i += NGT) *(GAS v4u*)(WIN + (size_t)4736 * 1024 + (size_t)i * 8) = (v4u){0u, 0u, 0u, 0u};
    { bf16* WL = (bf16*)(F.ws + WS_WLORA); const float* w2 = karg_in(I_W2); const float* a2 = karg_in(I_A2); const float* g2 = karg_in(I_G2);
      for (int i = gt; i < LORA_N * (LORA_K / 8); i += NGT) { const int n = i / (LORA_K / 8), k8 = (i % (LORA_K / 8)) * 8; const int rg = n >> 9, col = n & 511; float f[8];
#pragma unroll
          for (int j = 0; j < 8; ++j) { const int k = k8 + j; float v = 0.f;
              if (rg == 0) { if (k < 64) v = w2[(size_t)k * 512 + col]; }
              else if (rg == 1) { if (k >= 64 && k < 128) v = w2[(size_t)(64 + k - 64) * 512 + col]; }
              else if (rg == 2) { if (k >= 128 && k < 192) v = a2[(size_t)(k - 128) * 512 + col]; }
              else if (rg == 3) { if (k >= 192 && k < 256) v = a2[(size_t)(64 + k - 192) * 512 + col]; }
              else { if (k >= 256) v = g2[(size_t)(k - 256) * 512 + col]; }
              f[j] = v; }
          *(GAS v4u*)(WL + (size_t)n * LORA_K + k8) = pack8(f); } }
}

__device__ __forceinline__ void p1_norm1(Frame& F) {
    const int gw = blockIdx.x * NWAVES + F.wave, NGW = F.G * NWAVES;
    const float* mod = (const float*)(F.ws + WS_MOD); bf16* H1 = (bf16*)(F.ws + WS_H1);
    const float* g1 = karg_in(I_N1G); const float* Xp = karg_in(I_X); const float* CTXp = karg_in(I_CTX);
    f32x4 gv[4];
#pragma unroll
    for (int j = 0; j < 4; ++j) gv[j] = *(const f32x4*)(g1 + 4 * F.lane + 256 * j);
    for (int m0 = gw; m0 < NTOK; m0 += 4 * NGW) {
        f32x4 v[4][4]; float s[4];
#pragma unroll
        for (int r = 0; r < 4; ++r) { const int m = min(m0 + r * NGW, NTOK - 1); s[r] = 0.f;
            const float* xr = m < NLAT ? Xp + (size_t)m * DM : CTXp + (size_t)(m - NLAT) * DM;
#pragma unroll
            for (int j = 0; j < 4; ++j) v[r][j] = *(const GAS f32x4*)(xr + 4 * F.lane + 256 * j); }
#pragma unroll
        for (int r = 0; r < 4; ++r) { const int m = m0 + r * NGW;
            if (m < NTOK) {
#pragma unroll
                for (int j = 0; j < 4; ++j) s[r] += (v[r][j].x * v[r][j].x + v[r][j].y * v[r][j].y) + (v[r][j].z * v[r][j].z + v[r][j].w * v[r][j].w);
                const float rstd = __builtin_amdgcn_rsqf(wave_sum(s[r]) * (1.f / DM) + 1e-6f);
                const int mb = m < NLAT ? (m >> 11) : 32; const float* sh = mod + (size_t)mb * 6144; const float* sc = sh + 1024;
#pragma unroll
                for (int j = 0; j < 4; ++j) { const f32x4 a = *(const f32x4*)(sc + 4 * F.lane + 256 * j), bsh = *(const f32x4*)(sh + 4 * F.lane + 256 * j);
                    const f32x4 y = v[r][j] * rstd * gv[j] * (a + 1.0f) + bsh;
                    v2u o; o.x = pkbf(y.x, y.y); o.y = pkbf(y.z, y.w);
                    *(GAS v2u*)(H1 + (size_t)m * DM + 4 * F.lane + 256 * j) = o; } } }
    }
}

struct InprojOrder {
    pg8::StaticOrder so; int G, c;
    __device__ void init(int G_, int c_) { so.init(NLAT, WIN_ROWS, G_, c_); G = G_; c = c_; }
    __device__ bool next(int i, Unit& u) const {
        long L = (long)i * G + c; if (L < 4864) return so.next(i, u);
        L -= 4864; if (L >= 224) return false; u.pm = 256 + (int)(L % 32); u.pn = (int)(L / 32); return true; }
    __device__ __forceinline__ void a_ready(const Unit&) const {}
    __device__ __forceinline__ void done(const Unit&) const {}
};
struct EpiInproj {
    static constexpr bool PERM = true, AFTER_DRAIN = false;
    bf16 *zk, *zv, *zr, *q, *kq, *vq, *la, *gates;
    __device__ __forceinline__ void operator()(const f32x4 (&acc)[2][2][4][2], const Unit& u, int wr, int wc, int fr, int fq) const {
        const int row0 = u.pm * 256 + wr * 64 + fr; const bool isctx = u.pm >= 256;
#pragma unroll
        for (int bj = 0; bj < 2; ++bj) {
            const int c128 = 2 * u.pn + bj; bf16* base = nullptr; int pitch = 0, act = 0; bool ok = true;
            if (c128 < 4) { base = zk + c128 * 128; pitch = 512; }
            else if (c128 < 8) { base = zv + (c128 - 4) * 128; pitch = 512; }
            else if (c128 < 11) { base = la + (c128 - 8) * 128; pitch = 384; act = (c128 == 8) ? 1 : ((c128 == 10) ? 2 : 0); }
            else if (c128 == 11) { base = kq; pitch = 128; }
            else if (c128 == 12) { base = vq; pitch = 128; }
            else if (c128 < 17) { base = zr + (c128 - 13) * 128; pitch = 512; ok = !isctx; }
            else if (c128 < 21) { base = q + (c128 - 17) * 128; pitch = 512; ok = !isctx; }
            else if (c128 < 37) { base = gates + (c128 - 21) * 128; pitch = 2048; act = 2; ok = !isctx; }
            else ok = false;
            if (ok) {
#pragma unroll
                for (int ai = 0; ai < 2; ++ai)
#pragma unroll
                    for (int m = 0; m < 4; ++m) {
                        f32x4 v0 = acc[ai][bj][m][0], v1 = acc[ai][bj][m][1];
                        if (act == 1) { v0.x = tanhf_(v0.x); v0.y = tanhf_(v0.y); v0.z = tanhf_(v0.z); v0.w = tanhf_(v0.w); v1.x = tanhf_(v1.x); v1.y = tanhf_(v1.y); v1.z = tanhf_(v1.z); v1.w = tanhf_(v1.w); }
                        else if (act == 2) { v0.x = sigmoidf_(v0.x); v0.y = sigmoidf_(v0.y); v0.z = sigmoidf_(v0.z); v0.w = sigmoidf_(v0.w); v1.x = sigmoidf_(v1.x); v1.y = sigmoidf_(v1.y); v1.z = sigmoidf_(v1.z); v1.w = sigmoidf_(v1.w); }
                        v4u w; w.x = pkbf(v0.x, v0.y); w.y = pkbf(v0.z, v0.w); w.z = pkbf(v1.x, v1.y); w.w = pkbf(v1.z, v1.w);
                        *(GAS v4u*)(base + (size_t)(row0 + ai * 128 + m * 16) * pitch + wc * 32 + 8 * fq) = w;
                    }
            }
        }
    }
};

constexpr int LORA_LP = 144;
template <int NKS> __device__ __forceinline__ void lora_item(const bf16* LA, const bf16* WL, bf16* outp, const float* bias, float scale, int act, int tile, int rg, int kbase, int lane, LAS unsigned char* st) {
    const int l32 = lane & 31, hi = lane >> 5;
    bf16x8 xf[2][NKS];
#pragma unroll
    for (int s2 = 0; s2 < 2; ++s2)
#pragma unroll
        for (int ks = 0; ks < NKS; ++ks) xf[s2][ks] = *(const GAS bf16x8*)(LA + (size_t)(tile * 64 + s2 * 32 + l32) * LORA_K + kbase + 16 * ks + 8 * hi);
    bf16x8 wf[NKS], wn[NKS];
    { const bf16* wp = WL + (size_t)(rg * 512 + l32) * LORA_K + kbase + 8 * hi;
#pragma unroll
      for (int ks = 0; ks < NKS; ++ks) wf[ks] = *(const GAS bf16x8*)(wp + 16 * ks); }
#pragma unroll 1
    for (int np = 0; np < 8; ++np) {
#pragma unroll
        for (int nh = 0; nh < 2; ++nh) { const int nt = 2 * np + nh;
            f32x16 acc0, acc1;
#pragma unroll
            for (int r = 0; r < 16; ++r) { acc0[r] = 0.f; acc1[r] = 0.f; }
            { const int ntn = nt < 15 ? nt + 1 : 15; const bf16* wp = WL + (size_t)(rg * 512 + ntn * 32 + l32) * LORA_K + kbase + 8 * hi;
#pragma unroll
              for (int ks = 0; ks < NKS; ++ks) wn[ks] = *(const GAS bf16x8*)(wp + 16 * ks); }
#pragma unroll
            for (int ks = 0; ks < NKS; ++ks) { acc0 = __builtin_amdgcn_mfma_f32_32x32x16_bf16(wf[ks], xf[0][ks], acc0, 0, 0, 0); acc1 = __builtin_amdgcn_mfma_f32_32x32x16_bf16(wf[ks], xf[1][ks], acc1, 0, 0, 0); }
#pragma unroll
            for (int ks = 0; ks < NKS; ++ks) wf[ks] = wn[ks];
#pragma unroll
            for (int r4 = 0; r4 < 4; ++r4) { const int col = nt * 32 + 8 * r4 + 4 * hi;
                f32x4 bv = (f32x4){0.f, 0.f, 0.f, 0.f}; if (act) bv = *(const f32x4*)(bias + col);
                f32x4 v0 = (f32x4){acc0[4 * r4], acc0[4 * r4 + 1], acc0[4 * r4 + 2], acc0[4 * r4 + 3]} + bv, v1 = (f32x4){acc1[4 * r4], acc1[4 * r4 + 1], acc1[4 * r4 + 2], acc1[4 * r4 + 3]} + bv;
                if (act) { v0.x = scale * sigmoidf_(v0.x); v0.y = scale * sigmoidf_(v0.y); v0.z = scale * sigmoidf_(v0.z); v0.w = scale * sigmoidf_(v0.w);
                           v1.x = scale * sigmoidf_(v1.x); v1.y = scale * sigmoidf_(v1.y); v1.z = scale * sigmoidf_(v1.z); v1.w = scale * sigmoidf_(v1.w); }
                v2u o0, o1; o0.x = pkbf(v0.x, v0.y); o0.y = pkbf(v0.z, v0.w); o1.x = pkbf(v1.x, v1.y); o1.y = pkbf(v1.z, v1.w);
                const int lc = (32 * nh + 8 * r4 + 4 * hi) * 2;
                *(LAS v2u*)(st + l32 * LORA_LP + lc) = o0; *(LAS v2u*)(st + 32 * LORA_LP + l32 * LORA_LP + lc) = o1; }
        }
#pragma unroll
        for (int i = 0; i < 8; ++i) { const int row = 8 * i + (lane >> 3);
            const v4u w = *(const LAS v4u*)(st + row * LORA_LP + (lane & 7) * 16);
            *(GAS v4u*)(outp + (size_t)(tile * 64 + row) * 512 + np * 64 + (lane & 7) * 8) = w; }
    }
}
__device__ __forceinline__ void p3a_lora(Frame& F) {
    const bf16* LA = (const bf16*)(F.ws + WS_LA); const bf16* WL = (const bf16*)(F.ws + WS_WLORA);
    bf16* EW = (bf16*)(F.ws + WS_EW); bf16* AS = (bf16*)(F.ws + WS_AS); bf16* G = (bf16*)(F.ws + WS_G);
    const float* w0 = karg_in(I_W0); const float* a0 = karg_in(I_A0);
    const int gw = blockIdx.x * NWAVES + F.wave, NGW = F.G * NWAVES;
    LAS unsigned char* st = F.lds + 16384 + F.wave * (64 * LORA_LP);
    for (int item = gw; item < (NTOK / 64) * 5; item += NGW) {
        const int rg = item % 5, tile = item / 5;
        if (rg == 4) { if (tile < NLAT / 64) lora_item<8>(LA, WL, G, nullptr, 1.0f, 0, tile, 4, 256, F.lane, st); }
        else if (rg < 2) lora_item<4>(LA, WL, EW + (size_t)rg * NTOK * 512, w0 + rg * 512, 0.60653066f, 1, tile, rg, 64 * rg, F.lane, st);
        else lora_item<4>(LA, WL, AS + (size_t)(rg - 2) * NTOK * 512, a0 + (rg - 2) * 512, 1.0f, 1, tile, rg, 64 * rg, F.lane, st);
    }
}

__device__ __forceinline__ void p3b_attn_prep(Frame& F) {
    LAS float* tab = (LAS float*)F.lds;
    for (int i = F.tid; i < 1024; i += 512) { const int pos = i >> 4, fi = i & 15;
        const float invf = exp2f(-(float)fi * (13.287712379549449f / 16.0f));
        const float ang = (float)pos * invf; tab[2 * i] = cosf(ang); tab[2 * i + 1] = sinf(ang); }
    __syncthreads();
    const int gw = blockIdx.x * NWAVES + F.wave, NGW = F.G * NWAVES, lane = F.lane;
    {
        bf16* Q = (bf16*)(F.ws + WS_Q); const float* qg = karg_in(I_QG);
        const int sub = lane & 7; float gq[8];
#pragma unroll
        for (int j = 0; j < 8; ++j) gq[j] = qg[8 * sub + j];
        const float qscale = 0.125f * 1.4426950408889634f;
        for (int m0 = gw; m0 < NLAT; m0 += 4 * NGW) {
            v4u raw[4];
#pragma unroll
            for (int r = 0; r < 4; ++r) { const int m = min(m0 + r * NGW, NLAT - 1); raw[r] = *(const GAS v4u*)(Q + (size_t)m * 512 + 8 * lane); }
#pragma unroll
            for (int r = 0; r < 4; ++r) { const int m = m0 + r * NGW; if (m >= NLAT) continue;
                const int t = m & 2047; GAS v4u* p = (GAS v4u*)(Q + (size_t)m * 512 + 8 * lane);
                float y[8]; unpack8(raw[r], y); float ss = 0.f;
#pragma unroll
                for (int j = 0; j < 8; ++j) ss += y[j] * y[j];
                ss += __shfl_xor(ss, 1); ss += __shfl_xor(ss, 2); ss += __shfl_xor(ss, 4);
                const float rstd = __builtin_amdgcn_rsqf(ss * (1.f / 64.f) + 1e-6f);
                const int pos = (sub < 4) ? (t >> 6) : (t & 63); const bool second = (sub & 2) != 0; float o[8];
#pragma unroll
                for (int j = 0; j < 8; ++j) { y[j] = y[j] * rstd * gq[j]; }
#pragma unroll
                for (int j = 0; j < 8; ++j) { const float yp = __shfl_xor(y[j], 2); const int fi = 8 * (sub & 1) + j; const float cs = tab[(pos * 16 + fi) * 2], sn = tab[(pos * 16 + fi) * 2 + 1];
                    o[j] = (second ? (yp * sn + y[j] * cs) : (y[j] * cs - yp * sn)) * qscale; }
                *p = pack8(o); }
        }
    }
    {
        bf16* KQ = (bf16*)(F.ws + WS_KQ); const float* kg = karg_in(I_KG);
        const int l32 = lane & 31; const float g0 = kg[2 * l32], g1 = kg[2 * l32 + 1];
        for (int m0 = gw; m0 < NTOK; m0 += 4 * NGW) {
            unsigned raw[4];
#pragma unroll
            for (int r = 0; r < 4; ++r) { const int m = min(m0 + r * NGW, NTOK - 1); raw[r] = *(const GAS unsigned*)(KQ + (size_t)m * 128 + 2 * lane); }
#pragma unroll
            for (int r = 0; r < 4; ++r) { const int m = m0 + r * NGW; if (m >= NTOK) continue;
                GAS unsigned* p = (GAS unsigned*)(KQ + (size_t)m * 128 + 2 * lane); const unsigned w = raw[r];
                float y0 = bflo(w), y1 = bfhi(w); float ss = y0 * y0 + y1 * y1;
                ss += __shfl_xor(ss, 1); ss += __shfl_xor(ss, 2); ss += __shfl_xor(ss, 4); ss += __shfl_xor(ss, 8); ss += __shfl_xor(ss, 16);
                const float rstd = __builtin_amdgcn_rsqf(ss * (1.f / 64.f) + 1e-6f);
                y0 = y0 * rstd * g0; y1 = y1 * rstd * g1;
                const float p0 = __shfl_xor(y0, 8), p1 = __shfl_xor(y1, 8);
                if (m < NLAT) { const int t = m & 2047; const int pos = (l32 < 16) ? (t >> 6) : (t & 63); const bool second = (l32 & 8) != 0; const int fi0 = (2 * l32) & 15;
                    const float c0 = tab[(pos * 16 + fi0) * 2], s0 = tab[(pos * 16 + fi0) * 2 + 1], c1 = tab[(pos * 16 + fi0 + 1) * 2], s1 = tab[(pos * 16 + fi0 + 1) * 2 + 1];
                    const float o0 = second ? (p0 * s0 + y0 * c0) : (y0 * c0 - p0 * s0), o1 = second ? (p1 * s1 + y1 * c1) : (y1 * c1 - p1 * s1);
                    y0 = o0; y1 = o1; }
                *p = pkbf(y0, y1); }
        }
    }
    {
        const bf16* VQ = (const bf16*)(F.ws + WS_VQ); bf16* VT = (bf16*)(F.ws + WS_VT);
        const int gt = blockIdx.x * 512 + F.tid, NGT = F.G * 512;
        for (int i = gt; i < NB * 2 * (KEYS / 8) * 64; i += NGT) { const int d = i & 63, kg8 = (i >> 6) % (KEYS / 8), bh = (i >> 6) / (KEYS / 8), b = bh >> 1, hk = bh & 1;
            float f[8];
#pragma unroll
            for (int j = 0; j < 8; ++j) { const int key = kg8 * 8 + j; const size_t row = key < SEQ ? (size_t)b * SEQ + key : (size_t)NLAT + b * LC + (key - SEQ); f[j] = bf1(VQ[row * 128 + hk * 64 + d]); }
            *(GAS v4u*)(VT + ((size_t)bh * 64 + d) * KEYS + kg8 * 8) = pack8(f); }
    }
}

__device__ __forceinline__ int key_perm(int i) { const int r = 4 * (i >> 3) + (i & 3), hi = (i >> 2) & 1; return 8 * hi + r + (r >= 8 ? 8 : 0); }
__device__ __forceinline__ void attn_tile(const bf16x8 (&kf)[4], const bf16x8 (&vf)[4], const bf16x8 (&qf)[4], f32x16& o0, f32x16& o1, float& mrun, float& lrun, int mask, int l32, int hi) {
    f32x16 s;
#pragma unroll
    for (int r = 0; r < 16; ++r) s[r] = 0.f;
#pragma unroll
    for (int ks = 0; ks < 4; ++ks) s = __builtin_amdgcn_mfma_f32_32x32x16_bf16(kf[ks], qf[ks], s, 0, 0, 0);
    if (mask) {
#pragma unroll
        for (int r = 0; r < 16; ++r) { const int kk = 8 * hi + r + (r >= 8 ? 8 : 0); const bool ok = (mask == 1) ? (kk >= l32) : (kk <= l32); s[r] = ok ? s[r] : -1e30f; }
    }
    float mx = s[0];
#pragma unroll
    for (int r = 1; r < 16; ++r) mx = fmaxf(mx, s[r]);
    mx = fmaxf(mx, __shfl_xor(mx, 32));
    const float mnew = fmaxf(mrun, mx), alpha = __builtin_amdgcn_exp2f(mrun - mnew);
    float ps = 0.f; float p[16];
#pragma unroll
    for (int r = 0; r < 16; ++r) { p[r] = __builtin_amdgcn_exp2f(s[r] - mnew); ps += p[r]; }
    lrun = lrun * alpha + ps; mrun = mnew;
#pragma unroll
    for (int r = 0; r < 16; ++r) { o0[r] *= alpha; o1[r] *= alpha; }
    v4u pa, pb; pa.x = pkbf(p[0], p[1]); pa.y = pkbf(p[2], p[3]); pa.z = pkbf(p[4], p[5]); pa.w = pkbf(p[6], p[7]);
    pb.x = pkbf(p[8], p[9]); pb.y = pkbf(p[10], p[11]); pb.z = pkbf(p[12], p[13]); pb.w = pkbf(p[14], p[15]);
    const bf16x8 pa8 = __builtin_bit_cast(bf16x8, pa), pb8 = __builtin_bit_cast(bf16x8, pb);
    o0 = __builtin_amdgcn_mfma_f32_32x32x16_bf16(vf[0], pa8, o0, 0, 0, 0);
    o0 = __builtin_amdgcn_mfma_f32_32x32x16_bf16(vf[1], pb8, o0, 0, 0, 0);
    o1 = __builtin_amdgcn_mfma_f32_32x32x16_bf16(vf[2], pa8, o1, 0, 0, 0);
    o1 = __builtin_amdgcn_mfma_f32_32x32x16_bf16(vf[3], pb8, o1, 0, 0, 0);
}
__device__ __forceinline__ void p4a_attention(Frame& F, bool dostore = true) {
    bf16* Q = (bf16*)(F.ws + WS_Q); const bf16* KQ = (const bf16*)(F.ws + WS_KQ); const bf16* VT = (const bf16*)(F.ws + WS_VT);
    const float* sink = karg_in(I_SINK);
    const int lane = F.lane, l32 = lane & 31, hi = lane >> 5;
    const int kperm = key_perm(l32);
    for (int unit = blockIdx.x; unit < NB * 2 * 16; unit += F.G) {
        const int b = unit >> 5, hk = (unit >> 4) & 1, qb = unit & 15;
        const int g = F.wave >> 1, half = F.wave & 1, h = hk * 4 + g;
        const float sink2 = sink[h] * 1.4426950408889634f;
        const int tq0 = qb * 128 + half * 64;
        const size_t qrow = (size_t)b * SEQ + tq0 + l32;
        bf16x8 qf0[4], qf1[4];
#pragma unroll
        for (int ks = 0; ks < 4; ++ks) { qf0[ks] = *(const GAS bf16x8*)(Q + qrow * 512 + h * 64 + 16 * ks + 8 * hi); qf1[ks] = *(const GAS bf16x8*)(Q + (qrow + 32) * 512 + h * 64 + 16 * ks + 8 * hi); }
        float m0 = sink2, m1 = sink2, l0 = hi == 0 ? 1.0f : 0.0f, l1 = l0;
        f32x16 oa0, oa1, ob0, ob1;
#pragma unroll
        for (int r = 0; r < 16; ++r) { oa0[r] = 0.f; oa1[r] = 0.f; ob0[r] = 0.f; ob1[r] = 0.f; }
        const bf16* vbase = VT + ((size_t)(b * 2 + hk) * 64 + l32) * KEYS + 8 * hi;
        const bf16* kbase = KQ + (size_t)kperm * 128 + hk * 64 + 8 * hi;
        bf16x8 kf[4], vf[4], kn[4], vn[4];
#define ATT_ADDR(tile, key0, krow, valid) do { if ((tile) < 8) { key0 = SEQ + 32 * (tile); krow = (size_t)NLAT + b * LC + 32 * (tile); valid = true; } \
            else { const int kp0 = tq0 - 128 + 32 * ((tile) - 8); valid = (tile) < 18 && kp0 >= 0 && kp0 < SEQ; key0 = valid ? kp0 : 0; krow = (size_t)b * SEQ + key0; } } while (0)
#define ATT_LOAD(kd, vd, key0, krow) do { const bf16* kp_ = kbase + (krow) * 128; const bf16* vp_ = vbase + (key0); \
            _Pragma("unroll") for (int ks = 0; ks < 4; ++ks) kd[ks] = *(const GAS bf16x8*)(kp_ + 16 * ks); \
            vd[0] = *(const GAS bf16x8*)(vp_); vd[1] = *(const GAS bf16x8*)(vp_ + 16); vd[2] = *(const GAS bf16x8*)(vp_ + (size_t)32 * KEYS); vd[3] = *(const GAS bf16x8*)(vp_ + (size_t)32 * KEYS + 16); } while (0)
        { int key0; size_t krow; bool valid; ATT_ADDR(0, key0, krow, valid); ATT_LOAD(kf, vf, key0, krow); }
#pragma unroll 1
        for (int tile = 0; tile < 18; ++tile) {
            int nkey0; size_t nkrow; bool nvalid; ATT_ADDR(tile + 1, nkey0, nkrow, nvalid);
            ATT_LOAD(kn, vn, nkey0, nkrow);
            int key0; size_t krow; bool valid; ATT_ADDR(tile, key0, krow, valid);
            if (valid) {
                const int bi = tile - 8;
                if (tile < 8 || bi <= 8) attn_tile(kf, vf, qf0, oa0, oa1, m0, l0, bi == 0 ? 1 : (bi == 8 ? 2 : 0), l32, hi);
                if (tile < 8 || bi >= 1) attn_tile(kf, vf, qf1, ob0, ob1, m1, l1, bi == 1 ? 1 : (bi == 9 ? 2 : 0), l32, hi);
            }
#pragma unroll
            for (int ks = 0; ks < 4; ++ks) { kf[ks] = kn[ks]; vf[ks] = vn[ks]; }
        }
#undef ATT_ADDR
#undef ATT_LOAD
#pragma unroll
        for (int qi = 0; qi < 2; ++qi) {
            const float lr = qi ? l1 : l0; const float ltot = lr + __shfl_xor(lr, 32), inv = 1.0f / ltot;
            const f32x16& o0 = qi ? ob0 : oa0; const f32x16& o1 = qi ? ob1 : oa1;
            bf16* op = Q + (qrow + 32 * qi) * 512 + h * 64 + 4 * hi;
#pragma unroll
            for (int r4 = 0; r4 < 4; ++r4) {
                v2u w0; w0.x = pkbf(o0[4 * r4] * inv, o0[4 * r4 + 1] * inv); w0.y = pkbf(o0[4 * r4 + 2] * inv, o0[4 * r4 + 3] * inv);
                v2u w1; w1.x = pkbf(o1[4 * r4] * inv, o1[4 * r4 + 1] * inv); w1.y = pkbf(o1[4 * r4 + 2] * inv, o1[4 * r4 + 3] * inv);
                if (dostore) { *(GAS v2u*)(op + 8 * r4) = w0; *(GAS v2u*)(op + 32 + 8 * r4) = w1; }
            }
        }
    }
}

constexpr int SC_C = 32, SC_NCH = (LC + SEQ) / SC_C;
constexpr int SC_RP = 3;
constexpr int SC_ROUNDS = SC_NCH / SC_RP;
constexpr int SC_TASK_BYTES = 24576;
constexpr int SC_SLOT_BYTES = 2 * SC_RP * SC_TASK_BYTES;
constexpr int SC_PITCH = 144;
constexpr int SC_PLDS = 4 * 32 * SC_PITCH + 256;
__device__ __forceinline__ int launder(int v) { asm volatile("" : "+v"(v)); return v; }
__device__ __forceinline__ int crow_(int r, int hi) { return (r & 3) + 8 * (r >> 2) + 4 * hi; }
__device__ __forceinline__ bf16x8 packacc(const f32x16& x, int s) {
    v4u p; p.x = pkbf(x[8 * s], x[8 * s + 1]); p.y = pkbf(x[8 * s + 2], x[8 * s + 3]); p.z = pkbf(x[8 * s + 4], x[8 * s + 5]); p.w = pkbf(x[8 * s + 6], x[8 * s + 7]);
    return __builtin_bit_cast(bf16x8, p); }
#define MF(a, b, c) __builtin_amdgcn_mfma_f32_32x32x16_bf16((a), (b), (c), 0, 0, 0)
__device__ __forceinline__ f32x16 zero16() { f32x16 z;
#pragma unroll
    for (int r = 0; r < 16; ++r) z[r] = 0.f;
    return z; }
__device__ __forceinline__ void st_acc_bf16(unsigned char* p, const f32x16& x) {
    v4u a, b; a.x = pkbf(x[0], x[1]); a.y = pkbf(x[2], x[3]); a.z = pkbf(x[4], x[5]); a.w = pkbf(x[6], x[7]); b.x = pkbf(x[8], x[9]); b.y = pkbf(x[10], x[11]); b.z = pkbf(x[12], x[13]); b.w = pkbf(x[14], x[15]);
    *(GAS v4u*)p = a; *(GAS v4u*)(p + 16) = b; }
__device__ __forceinline__ f32x16 ld_acc_bf16(const unsigned char* p) {
    const v4u a = *(const GAS v4u*)p, b = *(const GAS v4u*)(p + 16); f32x16 x;
    x[0] = bflo(a.x); x[1] = bfhi(a.x); x[2] = bflo(a.y); x[3] = bfhi(a.y); x[4] = bflo(a.z); x[5] = bfhi(a.z); x[6] = bflo(a.w); x[7] = bfhi(a.w);
    x[8] = bflo(b.x); x[9] = bfhi(b.x); x[10] = bflo(b.y); x[11] = bfhi(b.y); x[12] = bflo(b.z); x[13] = bfhi(b.z); x[14] = bflo(b.w); x[15] = bfhi(b.w); return x; }

__device__ __forceinline__ void chan_to_frags(const unsigned (&pp)[16], int hi, bf16x8 (&fr)[2][2]) {
    unsigned mine[8], recv[8];
#pragma unroll
    for (int q = 0; q < 8; ++q) { const int plo = (q >> 1) * 4 + (q & 1), phi = plo + 2;
        mine[q] = hi ? pp[phi] : pp[plo]; const unsigned snd = hi ? pp[plo] : pp[phi]; recv[q] = (unsigned)__shfl_xor((int)snd, 32); }
#pragma unroll
    for (int s2 = 0; s2 < 2; ++s2) { v4u t0, t1;
        t0.x = hi ? recv[4 * s2] : mine[4 * s2]; t0.y = hi ? recv[4 * s2 + 1] : mine[4 * s2 + 1]; t0.z = hi ? recv[4 * s2 + 2] : mine[4 * s2 + 2]; t0.w = hi ? recv[4 * s2 + 3] : mine[4 * s2 + 3];
        t1.x = hi ? mine[4 * s2] : recv[4 * s2]; t1.y = hi ? mine[4 * s2 + 1] : recv[4 * s2 + 1]; t1.z = hi ? mine[4 * s2 + 2] : recv[4 * s2 + 2]; t1.w = hi ? mine[4 * s2 + 3] : recv[4 * s2 + 3];
        fr[0][s2] = __builtin_bit_cast(bf16x8, t0); fr[1][s2] = __builtin_bit_cast(bf16x8, t1); }
}
__device__ __forceinline__ void scan_produce(unsigned char* ws, int b, int h, int dir, int chunk, LAS unsigned char* pl, unsigned char* xo, int lane_in, const float* conv, const float* kkpp, const float* kapp) {
    int lane = launder(lane_in);
    float cw[9]; float kkp, kap;
    { const int colc = h * 64 + lane;
#pragma unroll
      for (int j = 0; j < 3; ++j) { cw[j] = conv[j * 1536 + colc]; cw[3 + j] = conv[j * 1536 + 512 + colc]; cw[6 + j] = conv[j * 1536 + 1024 + colc]; }
      kkp = kkpp[dir * 512 + colc]; kap = kapp[dir * 512 + colc]; }
    const bf16* ZK = (const bf16*)(ws + WS_ZK); const bf16* ZV = (const bf16*)(ws + WS_ZV); const bf16* ZR = (const bf16*)(ws + WS_ZR);
    const bf16* EW = (const bf16*)(ws + WS_EW) + (size_t)dir * NTOK * 512; const bf16* AS = (const bf16*)(ws + WS_AS) + (size_t)dir * NTOK * 512;
    int l32 = lane & 31, hi = lane >> 5; const int col = h * 64 + lane;
    const bool lat = chunk >= LC / SC_C; const int len = lat ? SEQ : LC, n0 = lat ? chunk * SC_C - LC : chunk * SC_C;
    const int rowbase = lat ? b * SEQ : NLAT + b * LC;
    LAS unsigned char* mA = pl; LAS unsigned char* mB = pl + 32 * SC_PITCH; LAS unsigned char* mK = pl + 64 * SC_PITCH; LAS unsigned char* mR = pl + 96 * SC_PITCH;
    LAS float* pcs = (LAS float*)(pl + 128 * SC_PITCH);
    unsigned pa[16], pb[16], pk[16], pv[16]; float P = 1.0f;
    const float latf = lat ? 1.0f : 0.0f;
    const float cwr_m = latf * (dir ? cw[2] : cw[0]), cwr_c = latf * cw[1], cwr_p = latf * (dir ? cw[0] : cw[2]), cwk_m = dir ? cw[5] : cw[3], cwk_p = dir ? cw[3] : cw[5], cwv_m = dir ? cw[8] : cw[6], cwv_p = dir ? cw[6] : cw[8];
    const int tk0 = dir ? (len - 1 - n0) : n0, tstep = dir ? -1 : 1;
    const unsigned ob0 = ((unsigned)(rowbase + tk0) * 512u + (unsigned)col) * 2u;
    const long ostepb = (long)tstep * 1024;
    const bool vm1 = n0 > 0, vp32 = n0 + SC_C < len;
    const char* ZKc = (const char*)ZK; const char* ZVc = (const char*)ZV; const char* ZRc = lat ? (const char*)ZR : (const char*)ZK;
    const char* EWc = (const char*)EW; const char* ASc = (const char*)AS;
#define SC_LD(base, j) (*(const GAS bf16*)((base) + (long)(j) * ostepb + ob0))
    const long jm1 = vm1 ? -1 : 0;
    float km = bf1(SC_LD(ZKc, jm1)), kc = bf1(SC_LD(ZKc, 0)), vm = bf1(SC_LD(ZVc, jm1)), vc = bf1(SC_LD(ZVc, 0)), rm = bf1(SC_LD(ZRc, jm1)), rc = bf1(SC_LD(ZRc, 0));
    km = vm1 ? km : 0.f; vm = vm1 ? vm : 0.f; rm = vm1 ? rm : 0.f;
    bf16 gk[2][8], gv[2][8], gr[2][8], ge[2][8], ga[2][8];
#define SC_LOADG(g, bu) do { _Pragma("unroll") for (int jj = 0; jj < 8; ++jj) { const int j = 8 * (g) + jj; \
        const bool vn = (j + 1 < SC_C) || vp32; const long jn = vn ? (j + 1) : j; const bf16 tk_ = SC_LD(ZKc, jn), tv_ = SC_LD(ZVc, jn), tr_ = SC_LD(ZRc, jn); \
        gk[bu][jj] = vn ? tk_ : (bf16)0; gv[bu][jj] = vn ? tv_ : (bf16)0; gr[bu][jj] = vn ? tr_ : (bf16)0; \
        ge[bu][jj] = SC_LD(EWc, j); ga[bu][jj] = SC_LD(ASc, j); } } while (0)
    SC_LOADG(0, 0);
    asm volatile("" ::: "memory");
#pragma unroll
    for (int g = 0; g < 4; ++g) {
        if (g < 3) SC_LOADG(g + 1, (g + 1) & 1);
#pragma unroll
        for (int jj = 0; jj < 8; jj += 2) {
            float va[2], vb[2], vk[2], vv[2];
#pragma unroll
            for (int u = 0; u < 2; ++u) {
                const int i = 8 * g + jj + u;
                const float kp = bf1(gk[g & 1][jj + u]), vp = bf1(gv[g & 1][jj + u]), rp = bf1(gr[g & 1][jj + u]);
                const float k = cwk_m * km + cw[4] * kc + cwk_p * kp, v = cwv_m * vm + cw[7] * vc + cwv_p * vp, r = cwr_m * rm + cwr_c * rc + cwr_p * rp;
                km = kc; kc = kp; vm = vc; vc = vp; rm = rc; rc = rp;
                const float a = bf1(ga[g & 1][jj + u]), ew = bf1(ge[g & 1][jj + u]), w = __expf(-ew);
                const float kkv = k * kkp, ss = wave_sum(kkv * kkv), kk = kkv * __builtin_amdgcn_rsqf(fmaxf(ss, 1e-24f));
                const float kmod = k * (1.0f + (a - 1.0f) * kap);
                const float Pprev = P; P *= w; const float invP = __builtin_amdgcn_rcpf(P);
                const float at = -kk * Pprev, bt = kk * a * invP, kt = kmod * invP, rt = r * P;
                *(LAS bf16*)(mA + i * SC_PITCH + 2 * lane) = (bf16)(pkbf(at, 0.f) & 0xffffu); *(LAS bf16*)(mB + i * SC_PITCH + 2 * lane) = (bf16)(pkbf(bt, 0.f) & 0xffffu);
                *(LAS bf16*)(mK + i * SC_PITCH + 2 * lane) = (bf16)(pkbf(kt, 0.f) & 0xffffu); *(LAS bf16*)(mR + i * SC_PITCH + 2 * lane) = (bf16)(pkbf(rt, 0.f) & 0xffffu);
                va[u] = at; vb[u] = bt; vk[u] = kt; vv[u] = v;
            }
            const int p = 4 * g + (jj >> 1);
            pa[p] = pkbf(va[0], va[1]); pb[p] = pkbf(vb[0], vb[1]); pk[p] = pkbf(vk[0], vk[1]); pv[p] = pkbf(vv[0], vv[1]);
        }
        asm volatile("" ::: "memory");
    }
#undef SC_LOADG
#undef SC_LD
    pcs[lane] = P;
    const float pc_o = __shfl_xor(P, 32); const float pcn0 = hi ? pc_o : P, pcn1 = hi ? P : pc_o;
    bf16x8 fA[2][2], fB[2][2], fK[2][2], fV[2][2];
    chan_to_frags(pa, hi, fA); chan_to_frags(pb, hi, fB); chan_to_frags(pk, hi, fK); chan_to_frags(pv, hi, fV);
    LDS_WAIT(); asm volatile("" ::: "memory");
    __builtin_amdgcn_sched_barrier(0);
    lane = launder(lane_in); l32 = lane & 31; hi = lane >> 5;
    f32x16 X = zero16(), XT = zero16(), LakT = zero16(), MrbT = zero16(), MrkT = zero16();
    const int roff = l32 * SC_PITCH + 16 * hi;
#pragma unroll
    for (int ks = 0; ks < 4; ++ks) {
        const bf16x8 ga = *(const LAS bf16x8*)(mA + roff + 32 * ks), gb = *(const LAS bf16x8*)(mB + roff + 32 * ks), gk = *(const LAS bf16x8*)(mK + roff + 32 * ks), gr = *(const LAS bf16x8*)(mR + roff + 32 * ks);
        X = MF(ga, gb, X); XT = MF(gb, ga, XT); LakT = MF(gk, ga, LakT); MrbT = MF(gb, gr, MrbT); MrkT = MF(gk, gr, MrkT);
    }
    f32x16 TmT;
#pragma unroll
    for (int r = 0; r < 16; ++r) { const int row = crow_(r, hi);
        X[r] = (l32 < row) ? X[r] : 0.f; XT[r] = (row < l32) ? XT[r] : 0.f; LakT[r] = (row < l32) ? LakT[r] : 0.f;
        MrbT[r] = (row <= l32) ? MrbT[r] : 0.f; MrkT[r] = (row <= l32) ? MrkT[r] : 0.f; TmT[r] = XT[r] + ((row == l32) ? 1.0f : 0.f); }
    const bf16x8 la0 = packacc(LakT, 0), la1 = packacc(LakT, 1), rb0 = packacc(MrbT, 0), rb1 = packacc(MrbT, 1), rk0 = packacc(MrkT, 0), rk1 = packacc(MrkT, 1);
    __builtin_amdgcn_sched_barrier(0);
#pragma unroll
    for (int it = 0; it < 4; ++it) {
        const bf16x8 x0 = packacc(X, 0), x1 = packacc(X, 1), y0 = packacc(XT, 0), y1 = packacc(XT, 1), t0 = packacc(TmT, 0), t1 = packacc(TmT, 1);
        f32x16 Xn = zero16(), XnT = zero16();
        Xn = MF(y0, x0, Xn); Xn = MF(y1, x1, Xn); XnT = MF(x0, y0, XnT); XnT = MF(x1, y1, XnT);
        const bf16x8 n0 = packacc(Xn, 0), n1 = packacc(Xn, 1);
        TmT = MF(n0, t0, TmT); TmT = MF(n1, t1, TmT);
        X = Xn; XT = XnT;
    }
    __builtin_amdgcn_sched_barrier(0);
    const bf16x8 tt0 = packacc(TmT, 0), tt1 = packacc(TmT, 1);
    f32x16 W[2], Ut[2];
#pragma unroll
    for (int ct = 0; ct < 2; ++ct) { f32x16 w = zero16(); w = MF(tt0, fA[ct][0], w); w = MF(tt1, fA[ct][1], w); W[ct] = w;
        f32x16 x1 = zero16(); x1 = MF(la0, fV[ct][0], x1); x1 = MF(la1, fV[ct][1], x1);
        f32x16 u = zero16(); u = MF(tt0, packacc(x1, 0), u); u = MF(tt1, packacc(x1, 1), u); Ut[ct] = u; }
    bf16x8 fW[2][2], fU[2][2];
#pragma unroll
    for (int ct = 0; ct < 2; ++ct) { fW[ct][0] = packacc(W[ct], 0); fW[ct][1] = packacc(W[ct], 1); fU[ct][0] = packacc(Ut[ct], 0); fU[ct][1] = packacc(Ut[ct], 1); }
    __builtin_amdgcn_sched_barrier(0);
    lane = launder(lane_in); l32 = lane & 31; hi = lane >> 5;
#pragma unroll
    for (int kt = 0; kt < 2; ++kt) { f32x16 acc;
#pragma unroll
        for (int r4 = 0; r4 < 4; ++r4) { const v2u rr = *(const LAS v2u*)(mR + l32 * SC_PITCH + 2 * (32 * kt + 8 * r4 + 4 * hi));
            acc[4 * r4] = bflo(rr.x); acc[4 * r4 + 1] = bfhi(rr.x); acc[4 * r4 + 2] = bflo(rr.y); acc[4 * r4 + 3] = bfhi(rr.y); }
        acc = MF(fW[kt][0], rb0, acc); acc = MF(fW[kt][1], rb1, acc);
        *(GAS bf16x8*)(xo + 16384 + (kt * 2 + 0) * 1024 + lane * 16) = packacc(acc, 0); *(GAS bf16x8*)(xo + 16384 + (kt * 2 + 1) * 1024 + lane * 16) = packacc(acc, 1); }
#pragma unroll
    for (int vt = 0; vt < 2; ++vt) { f32x16 acc = zero16();
        acc = MF(rb0, fU[vt][0], acc); acc = MF(rb1, fU[vt][1], acc); acc = MF(rk0, fV[vt][0], acc); acc = MF(rk1, fV[vt][1], acc);
        st_acc_bf16(xo + 20480 + vt * 2048 + lane * 32, acc); }
    __builtin_amdgcn_sched_barrier(0);
    lane = launder(lane_in); l32 = lane & 31; hi = lane >> 5;
#pragma unroll
    for (int kt = 0; kt < 2; ++kt)
#pragma unroll
        for (int nt = 0; nt < 2; ++nt) { f32x16 acc = zero16(); acc = MF(fW[kt][0], fB[nt][0], acc); acc = MF(fW[kt][1], fB[nt][1], acc);
            const float pc = nt ? pcn1 : pcn0;
#pragma unroll
            for (int r = 0; r < 16; ++r) acc[r] = (acc[r] + ((kt == nt && crow_(r, hi) == l32) ? 1.0f : 0.f)) * pc;
            *(GAS bf16x8*)(xo + ((kt * 2 + nt) * 2 + 0) * 1024 + lane * 16) = packacc(acc, 0); *(GAS bf16x8*)(xo + ((kt * 2 + nt) * 2 + 1) * 1024 + lane * 16) = packacc(acc, 1); }
    __builtin_amdgcn_sched_barrier(0);
    lane = launder(lane_in); l32 = lane & 31; hi = lane >> 5;
#pragma unroll
    for (int kt = 0; kt < 2; ++kt)
#pragma unroll
        for (int vt = 0; vt < 2; ++vt) { f32x16 acc = zero16();
            acc = MF(fB[kt][0], fU[vt][0], acc); acc = MF(fB[kt][1], fU[vt][1], acc); acc = MF(fK[kt][0], fV[vt][0], acc); acc = MF(fK[kt][1], fV[vt][1], acc);
#pragma unroll
            for (int r4 = 0; r4 < 4; ++r4) { const f32x4 pr = *(const LAS f32x4*)(pcs + 32 * kt + 8 * r4 + 4 * hi);
                acc[4 * r4] *= pr.x; acc[4 * r4 + 1] *= pr.y; acc[4 * r4 + 2] *= pr.z; acc[4 * r4 + 3] *= pr.w; }
            st_acc_bf16(xo + 8192 + (kt * 2 + vt) * 2048 + lane * 32, acc); }
    LDS_WAIT();
}
__device__ __forceinline__ void scan_consume(unsigned char* ws, int b, int h, int dir, int chunk, const unsigned char* xi, int lane, f32x16 (&H)[2][2]) {
    const int l32 = lane & 31, hi = lane >> 5;
    bf16x8 hb[2][2][2];
#pragma unroll
    for (int kt = 0; kt < 2; ++kt)
#pragma unroll
        for (int vt = 0; vt < 2; ++vt) { hb[kt][vt][0] = packacc(H[kt][vt], 0); hb[kt][vt][1] = packacc(H[kt][vt], 1); }
    if (chunk >= LC / SC_C) {
        bf16x8 rf[2][2];
#pragma unroll
        for (int kt = 0; kt < 2; ++kt)
#pragma unroll
            for (int s2 = 0; s2 < 2; ++s2) rf[kt][s2] = *(const GAS bf16x8*)(xi + 16384 + (kt * 2 + s2) * 1024 + lane * 16);
        bf16* Y = (bf16*)(ws + (dir ? WS_YB : WS_YF)); const int n0 = chunk * SC_C - LC;
#pragma unroll
        for (int vt = 0; vt < 2; ++vt) { f32x16 acc = ld_acc_bf16(xi + 20480 + vt * 2048 + lane * 32);
#pragma unroll
            for (int kt = 0; kt < 2; ++kt) { acc = MF(rf[kt][0], hb[kt][vt][0], acc); acc = MF(rf[kt][1], hb[kt][vt][1], acc); }
#pragma unroll
            for (int r = 0; r < 16; ++r) { const int i = crow_(r, hi), tk = dir ? (SEQ - 1 - (n0 + i)) : (n0 + i);
                Y[((size_t)b * SEQ + tk) * 512 + h * 64 + 32 * vt + l32] = (bf16)(pkbf(acc[r], 0.f) & 0xffffu); } }
    }
    f32x16 Hn[2][2];
#pragma unroll
    for (int nt = 0; nt < 2; ++nt)
#pragma unroll
        for (int vt = 0; vt < 2; ++vt) Hn[nt][vt] = ld_acc_bf16(xi + 8192 + (nt * 2 + vt) * 2048 + lane * 32);
#pragma unroll
    for (int kt = 0; kt < 2; ++kt)
#pragma unroll
        for (int nt = 0; nt < 2; ++nt) { const bf16x8 g0 = *(const GAS bf16x8*)(xi + ((kt * 2 + nt) * 2 + 0) * 1024 + lane * 16), g1 = *(const GAS bf16x8*)(xi + ((kt * 2 + nt) * 2 + 1) * 1024 + lane * 16);
#pragma unroll
            for (int vt = 0; vt < 2; ++vt) { Hn[nt][vt] = MF(g0, hb[kt][vt][0], Hn[nt][vt]); Hn[nt][vt] = MF(g1, hb[kt][vt][1], Hn[nt][vt]); } }
#pragma unroll
    for (int nt = 0; nt < 2; ++nt)
#pragma unroll
        for (int vt = 0; vt < 2; ++vt) H[nt][vt] = Hn[nt][vt];
}
__device__ __forceinline__ void p4b_scan(Frame& F) {
    const int wave = F.wave, lane = F.lane;
    const bool is_cons = wave < 2; const int pw = wave - 2;
    unsigned char* xch = F.ws + WS_XCH + (size_t)blockIdx.x * (2 * SC_SLOT_BYTES);
    LAS unsigned char* pl = F.lds + (is_cons ? 0 : pw) * SC_PLDS;
    for (int task = blockIdx.x; task < NB * 8; task += F.G) {
        const int b = task >> 3, h = task & 7; const int pdir = is_cons ? wave : pw / SC_RP, pci = is_cons ? 0 : pw % SC_RP;
        const float* conv = karg_in(I_CONV); const float* kkpp = karg_in(I_KK); const float* kapp = karg_in(I_KA);
#define SC_SYNC() do { asm volatile("s_waitcnt vmcnt(0) lgkmcnt(0)" ::: "memory"); __builtin_amdgcn_s_barrier(); asm volatile("" ::: "memory"); } while (0)
        if (is_cons) {
            f32x16 H[2][2];
#pragma unroll
            for (int i = 0; i < 2; ++i)
#pragma unroll
                for (int j = 0; j < 2; ++j) H[i][j] = zero16();
#pragma unroll 1
            for (int q = -1; q < SC_ROUNDS; ++q) {
                if (q >= 0) { __builtin_amdgcn_fence(__ATOMIC_ACQUIRE, "agent");
#pragma unroll 1
                    for (int i = 0; i < SC_RP; ++i) scan_consume(F.ws, b, h, wave, q * SC_RP + i, xch + (size_t)(q & 1) * SC_SLOT_BYTES + (size_t)(wave * SC_RP + i) * SC_TASK_BYTES, lane, H); }
                SC_SYNC();
            }
        } else {
#pragma unroll 1
            for (int q = -1; q < SC_ROUNDS; ++q) {
                if (q + 1 < SC_ROUNDS) scan_produce(F.ws, b, h, pdir, (q + 1) * SC_RP + pci, pl, xch + (size_t)((q + 1) & 1) * SC_SLOT_BYTES + (size_t)(pdir * SC_RP + pci) * SC_TASK_BYTES, lane, conv, kkpp, kapp);
                SC_SYNC();
            }
        }
#undef SC_SYNC
    }
}
#undef MF

__device__ __forceinline__ void p5_rwkv_out(Frame& F) {
    const int gw = blockIdx.x * NWAVES + F.wave, NGW = F.G * NWAVES, lane = F.lane, c0 = 8 * lane;
    const bf16* ZK = (const bf16*)(F.ws + WS_ZK); const bf16* ZV = (const bf16*)(F.ws + WS_ZV); const bf16* ZR = (const bf16*)(F.ws + WS_ZR);
    const bf16* AS0 = (const bf16*)(F.ws + WS_AS); const bf16* AS1 = AS0 + (size_t)NTOK * 512;
    const bf16* YF = (const bf16*)(F.ws + WS_YF); const bf16* YB = (const bf16*)(F.ws + WS_YB); const bf16* G = (const bf16*)(F.ws + WS_G);
    bf16* ORW = (bf16*)(F.ws + WS_ORW);
    LAS float* PL = (LAS float*)F.lds;
    { const float* convg = karg_in(I_CONV); const float* kag = karg_in(I_KA); const float* rkg = karg_in(I_RK); const float* lnwg = karg_in(I_LNW); const float* lnbg = karg_in(I_LNB);
      for (int i = F.tid; i < 15 * 512; i += 512) { const int row = i >> 9, c = i & 511; float v;
          if (row < 9) v = convg[(row % 3) * 1536 + (row / 3) * 512 + c]; else if (row < 11) v = kag[(row - 9) * 512 + c]; else if (row < 13) v = rkg[(row - 11) * 512 + c]; else if (row == 13) v = lnwg[c]; else v = lnbg[c];
          PL[i] = v; }
      __syncthreads(); }
    const LAS float* conv = PL; const LAS float* ka = PL + 9 * 512; const LAS float* rk = PL + 11 * 512; const LAS float* lnw = PL + 13 * 512; const LAS float* lnb = PL + 14 * 512;
    for (int m0 = gw; m0 < NLAT; m0 += 2 * NGW) {
        v4u raw[2][14];
        const v4u z4 = (v4u){0u, 0u, 0u, 0u};
#pragma unroll
        for (int rr = 0; rr < 2; ++rr) { const int m = min(m0 + rr * NGW, NLAT - 1);
            const int t = m & 2047; const bool first = t == 0, last = t == SEQ - 1; const size_t o = (size_t)m * 512 + c0;
            const size_t om = first ? o : o - 512, op = last ? o : o + 512;
#pragma unroll
            for (int which = 0; which < 3; ++which) { const bf16* Z = which == 0 ? ZR : (which == 1 ? ZK : ZV);
                const v4u ra = *(const GAS v4u*)(Z + om), rc_ = *(const GAS v4u*)(Z + op);
                raw[rr][3 * which] = first ? z4 : ra; raw[rr][3 * which + 1] = *(const GAS v4u*)(Z + o); raw[rr][3 * which + 2] = last ? z4 : rc_; }
            raw[rr][9] = *(const GAS v4u*)(AS0 + o); raw[rr][10] = *(const GAS v4u*)(AS1 + o); raw[rr][11] = *(const GAS v4u*)(YF + o); raw[rr][12] = *(const GAS v4u*)(YB + o); raw[rr][13] = *(const GAS v4u*)(G + o); }
#pragma unroll
        for (int rr = 0; rr < 2; ++rr) { const int m = m0 + rr * NGW; if (m >= NLAT) continue;
            const size_t o = (size_t)m * 512 + c0;
            float r[8], k[8], v[8], tmp[8];
            asm volatile("" ::: "memory");
#pragma unroll
            for (int which = 0; which < 3; ++which) { float (&dst)[8] = which == 0 ? r : (which == 1 ? k : v);
                asm volatile("" ::: "memory");
                float fa[8], fb[8], fc[8]; unpack8(raw[rr][3 * which], fa); unpack8(raw[rr][3 * which + 1], fb); unpack8(raw[rr][3 * which + 2], fc);
                const LAS float* cwp = conv + (3 * which) * 512 + c0;
#pragma unroll
                for (int j = 0; j < 8; ++j) dst[j] = cwp[j] * fa[j] + cwp[512 + j] * fb[j] + cwp[1024 + j] * fc[j]; }
            asm volatile("" ::: "memory");
            float a0[8], a1[8]; unpack8(raw[rr][9], a0); unpack8(raw[rr][10], a1);
            float s = 0.f;
#pragma unroll
            for (int j = 0; j < 8; ++j) { const float km0 = k[j] * (1.0f + (a0[j] - 1.0f) * ka[c0 + j]), km1 = k[j] * (1.0f + (a1[j] - 1.0f) * ka[512 + c0 + j]);
                s += r[j] * (km0 * rk[c0 + j] + km1 * rk[512 + c0 + j]); }
            s += __shfl_xor(s, 1); s += __shfl_xor(s, 2); s += __shfl_xor(s, 4);
            asm volatile("" ::: "memory");
            float y[8], yb[8]; unpack8(raw[rr][11], y); unpack8(raw[rr][12], yb);
            float sm = 0.f;
#pragma unroll
            for (int j = 0; j < 8; ++j) { y[j] += yb[j]; sm += y[j]; }
            sm += __shfl_xor(sm, 1); sm += __shfl_xor(sm, 2); sm += __shfl_xor(sm, 4);
            const float mean = sm * (1.f / 64.f); float sq = 0.f;
#pragma unroll
            for (int j = 0; j < 8; ++j) { y[j] -= mean; sq += y[j] * y[j]; }
            sq += __shfl_xor(sq, 1); sq += __shfl_xor(sq, 2); sq += __shfl_xor(sq, 4);
            const float rstd = __builtin_amdgcn_rsqf(sq * (1.f / 64.f) + 64e-5f);
            float gg[8]; unpack8(raw[rr][13], gg);
#pragma unroll
            for (int j = 0; j < 8; ++j) tmp[j] = (y[j] * rstd * lnw[c0 + j] + lnb[c0 + j] + s * v[j]) * gg[j];
            *(GAS v4u*)(ORW + o) = pack8(tmp); }
    }
}

struct EpiMerge {
    static constexpr bool PERM = true, AFTER_DRAIN = false;
    bf16* merged; const bf16* gates; int goff; int first;
    __device__ __forceinline__ void operator()(const f32x4 (&acc)[2][2][4][2], const Unit& u, int wr, int wc, int fr, int fq) const {
        const int row0 = u.pm * 256 + wr * 64 + fr, col0 = u.pn * 256 + wc * 32 + 8 * fq;
#pragma unroll
        for (int ai = 0; ai < 2; ++ai)
#pragma unroll
            for (int m = 0; m < 4; ++m) { const size_t row = (size_t)(row0 + ai * 128 + m * 16);
#pragma unroll
                for (int bj = 0; bj < 2; ++bj) { const int col = col0 + bj * 128;
                    float gt[8]; unpack8(*(const GAS v4u*)(gates + row * 2048 + goff + col), gt);
                    const f32x4 v0 = acc[ai][bj][m][0], v1 = acc[ai][bj][m][1];
                    float o[8] = {v0.x * gt[0], v0.y * gt[1], v0.z * gt[2], v0.w * gt[3], v1.x * gt[4], v1.y * gt[5], v1.z * gt[6], v1.w * gt[7]};
                    GAS v4u* p = (GAS v4u*)(merged + row * 1024 + col);
                    if (!first) { float pv[8]; unpack8(*p, pv);
#pragma unroll
                        for (int j = 0; j < 8; ++j) o[j] += pv[j]; }
                    *p = pack8(o); } }
    }
};
struct EpiMerge2 {
    static constexpr bool PERM = true, AFTER_DRAIN = false;
    bf16* merged; const bf16* gates;
    __device__ __forceinline__ void mid(f32x4 (&acc)[2][2][4][2], const Unit& u, int wr, int wc, int fr, int fq) const {
        const int row0 = u.pm * 256 + wr * 64 + fr, col0 = u.pn * 256 + wc * 32 + 8 * fq;
#pragma unroll
        for (int ai = 0; ai < 2; ++ai)
#pragma unroll
            for (int m = 0; m < 4; ++m) { const size_t row = (size_t)(row0 + ai * 128 + m * 16);
#pragma unroll
                for (int bj = 0; bj < 2; ++bj) { const int col = col0 + bj * 128;
                    float gr[8], ga[8]; unpack8(*(const GAS v4u*)(gates + row * 2048 + col), gr); unpack8(*(const GAS v4u*)(gates + row * 2048 + 1024 + col), ga);
                    float q[8];
#pragma unroll
                    for (int j = 0; j < 8; ++j) q[j] = gr[j] * __builtin_amdgcn_rcpf(fmaxf(ga[j], 1e-30f));
                    acc[ai][bj][m][0] *= (f32x4){q[0], q[1], q[2], q[3]}; acc[ai][bj][m][1] *= (f32x4){q[4], q[5], q[6], q[7]}; } }
    }
    __device__ __forceinline__ void operator()(const f32x4 (&acc)[2][2][4][2], const Unit& u, int wr, int wc, int fr, int fq) const {
        const int row0 = u.pm * 256 + wr * 64 + fr, col0 = u.pn * 256 + wc * 32 + 8 * fq;
#pragma unroll
        for (int ai = 0; ai < 2; ++ai)
#pragma unroll
            for (int m = 0; m < 4; ++m) { const size_t row = (size_t)(row0 + ai * 128 + m * 16);
#pragma unroll
                for (int bj = 0; bj < 2; ++bj) { const int col = col0 + bj * 128;
                    float ga[8]; unpack8(*(const GAS v4u*)(gates + row * 2048 + 1024 + col), ga);
                    const f32x4 v0 = acc[ai][bj][m][0], v1 = acc[ai][bj][m][1];
                    float o[8] = {v0.x * fmaxf(ga[0], 1e-30f), v0.y * fmaxf(ga[1], 1e-30f), v0.z * fmaxf(ga[2], 1e-30f), v0.w * fmaxf(ga[3], 1e-30f),
                                  v1.x * fmaxf(ga[4], 1e-30f), v1.y * fmaxf(ga[5], 1e-30f), v1.z * fmaxf(ga[6], 1e-30f), v1.w * fmaxf(ga[7], 1e-30f)};
                    *(GAS v4u*)(merged + row * 1024 + col) = pack8(o); } }
    }
};
struct EpiOutproj {
    static constexpr bool PERM = true, AFTER_DRAIN = false;
    bf16* delta; const float* mod;
    __device__ __forceinline__ void operator()(const f32x4 (&acc)[2][2][4][2], const Unit& u, int wr, int wc, int fr, int fq) const {
        const int row0 = u.pm * 256 + wr * 64 + fr, col0 = u.pn * 256 + wc * 32 + 8 * fq; const int b = u.pm >> 3;
        f32x4 gv[2][2];
#pragma unroll
        for (int bj = 0; bj < 2; ++bj)
#pragma unroll
            for (int n = 0; n < 2; ++n) gv[bj][n] = *(const f32x4*)(mod + (size_t)b * 6144 + 2048 + col0 + bj * 128 + 4 * n);
#pragma unroll
        for (int ai = 0; ai < 2; ++ai)
#pragma unroll
            for (int m = 0; m < 4; ++m) { const size_t off = (size_t)(row0 + ai * 128 + m * 16) * 1024 + col0;
#pragma unroll
                for (int bj = 0; bj < 2; ++bj) { const f32x4 v0 = gv[bj][0] * acc[ai][bj][m][0], v1 = gv[bj][1] * acc[ai][bj][m][1];
                    v4u w; w.x = pkbf(v0.x, v0.y); w.y = pkbf(v0.z, v0.w); w.z = pkbf(v1.x, v1.y); w.w = pkbf(v1.z, v1.w);
                    *(GAS v4u*)(delta + off + bj * 128) = w; } }
    }
};

constexpr int RW_PITCH = 2064;
__device__ __forceinline__ void p8_norm2_router(Frame& F) {
    LAS unsigned char* rhi = F.lds; LAS unsigned char* rlo = F.lds + 32 * RW_PITCH;
    const float* rw = karg_in(I_ROUTER);
    for (int i = F.tid; i < 16384; i += 512) { const int e = i & 15, k = i >> 4; const float w = rw[i]; const unsigned h = pkbf(w, 0.f) & 0xffffu; const float wl = w - __uint_as_float(h << 16);
        *(LAS bf16*)(rhi + e * RW_PITCH + 2 * k) = (bf16)h; *(LAS bf16*)(rlo + e * RW_PITCH + 2 * k) = (bf16)(pkbf(wl, 0.f) & 0xffffu); }
    for (int i = F.tid; i < 16 * 1024 / 2; i += 512) { const int e = 16 + i / 512, k2 = i % 512; *(LAS unsigned*)(rhi + e * RW_PITCH + 4 * k2) = 0u; *(LAS unsigned*)(rlo + e * RW_PITCH + 4 * k2) = 0u; }
    __syncthreads();
    const int gw = blockIdx.x * NWAVES + F.wave, NGW = F.G * NWAVES, lane = F.lane, l32 = lane & 31, hi = lane >> 5;
    const float* mod = (const float*)(F.ws + WS_MOD); bf16* H2 = (bf16*)(F.ws + WS_H2); float* AFF = (float*)(F.ws + WS_AFF);
    const float* g2 = karg_in(I_N2G); const float* Xp = karg_in(I_X); const bf16* DELTA = (const bf16*)(F.ws + WS_DELTA);
    f32x4 gv[4];
#pragma unroll
    for (int j = 0; j < 4; ++j) gv[j] = *(const f32x4*)(g2 + 4 * lane + 256 * j);
    for (int tile = gw; tile < NLAT / 32; tile += NGW) {
        const int mbase = tile * 32, b = mbase >> 11; const float* sh = mod + (size_t)b * 6144 + 3072; const float* sc = sh + 1024;
        f32x4 av[4], bv[4];
#pragma unroll
        for (int j = 0; j < 4; ++j) { av[j] = *(const f32x4*)(sc + 4 * lane + 256 * j) + 1.0f; bv[j] = *(const f32x4*)(sh + 4 * lane + 256 * j); }
#pragma unroll 1
        for (int r0 = 0; r0 < 32; r0 += 4) {
            f32x4 v[4][4];
#pragma unroll
            for (int r = 0; r < 4; ++r) { const float* xr = Xp + (size_t)(mbase + r0 + r) * DM; const bf16* dr = DELTA + (size_t)(mbase + r0 + r) * DM;
#pragma unroll
                for (int j = 0; j < 4; ++j) { const v2u d = *(const GAS v2u*)(dr + 4 * lane + 256 * j);
                    v[r][j] = *(const GAS f32x4*)(xr + 4 * lane + 256 * j) + (f32x4){bflo(d.x), bfhi(d.x), bflo(d.y), bfhi(d.y)}; } }
#pragma unroll
            for (int r = 0; r < 4; ++r) { float s = 0.f;
#pragma unroll
                for (int j = 0; j < 4; ++j) s += (v[r][j].x * v[r][j].x + v[r][j].y * v[r][j].y) + (v[r][j].z * v[r][j].z + v[r][j].w * v[r][j].w);
                const float rstd = __builtin_amdgcn_rsqf(wave_sum(s) * (1.f / DM) + 1e-6f);
#pragma unroll
                for (int j = 0; j < 4; ++j) { const f32x4 y = v[r][j] * rstd * gv[j] * av[j] + bv[j];
                    v2u o; o.x = pkbf(y.x, y.y); o.y = pkbf(y.z, y.w);
                    *(GAS v2u*)(H2 + (size_t)(mbase + r0 + r) * DM + 4 * lane + 256 * j) = o; } }
        }
        asm volatile("s_waitcnt vmcnt(0)" ::: "memory");
        f32x16 acc;
#pragma unroll
        for (int r = 0; r < 16; ++r) acc[r] = 0.f;
        const bf16* hrow = H2 + (size_t)(mbase + l32) * DM + 8 * hi;
        const LAS unsigned char* ah = rhi + l32 * RW_PITCH + 16 * hi; const LAS unsigned char* al = rlo + l32 * RW_PITCH + 16 * hi;
#pragma unroll 8
        for (int ks = 0; ks < 64; ++ks) { const bf16x8 bf = *(const GAS bf16x8*)(hrow + 16 * ks);
            const bf16x8 fh = *(const LAS bf16x8*)(ah + 32 * ks), fl = *(const LAS bf16x8*)(al + 32 * ks);
            acc = __builtin_amdgcn_mfma_f32_32x32x16_bf16(fh, bf, acc, 0, 0, 0); acc = __builtin_amdgcn_mfma_f32_32x32x16_bf16(fl, bf, acc, 0, 0, 0); }
        float mx = acc[0];
#pragma unroll
        for (int r = 1; r < 8; ++r) mx = fmaxf(mx, acc[r]);
        mx = fmaxf(mx, __shfl_xor(mx, 32));
        float pe[8], den = 0.f;
#pragma unroll
        for (int r = 0; r < 8; ++r) { pe[r] = __expf(acc[r] - mx); den += pe[r]; }
        den += __shfl_xor(den, 32);
        const float inv = 1.0f / den; const int t = (mbase & 2047) + l32;
#pragma unroll
        for (int r = 0; r < 8; ++r) { const int e = (r & 3) + 8 * (r >> 2) + 4 * hi; AFF[((size_t)b * 16 + e) * SEQ + t] = pe[r] * inv; }
    }
}

__device__ __forceinline__ int block_count(Frame& F, LAS int* wc, int slot, bool p0, bool p1, bool p2, bool p3) {
    const int c = __builtin_popcountll(__ballot(p0)) + __builtin_popcountll(__ballot(p1)) + __builtin_popcountll(__ballot(p2)) + __builtin_popcountll(__ballot(p3));
    if (F.lane == 0) wc[slot * 8 + F.wave] = c;
    __syncthreads();
    int s = 0;
#pragma unroll
    for (int w = 0; w < 8; ++w) s += wc[slot * 8 + w];
    return s;
}
__device__ __forceinline__ void p9_topk_gather(Frame& F) {
    LAS int* wc = (LAS int*)F.lds;
    LAS int* sel = (LAS int*)(F.lds + 1024);
    const float* AFF = (const float*)(F.ws + WS_AFF); int* IDX = (int*)(F.ws + WS_IDX); float* VAL = (float*)(F.ws + WS_VAL);
    const bf16* H2 = (const bf16*)(F.ws + WS_H2); bf16* XE = (bf16*)(F.ws + WS_XE); int* INV = (int*)(F.ws + WS_INV);
    const int tid = F.tid, lane = F.lane, wave = F.wave;
    for (int p = blockIdx.x; p < NB * NE; p += F.G) {
        const int b = p >> 4, e = p & 15;
        const f32x4 av = *(const GAS f32x4*)(AFF + (size_t)p * SEQ + 4 * tid);
        const unsigned u0 = __float_as_uint(av.x), u1 = __float_as_uint(av.y), u2 = __float_as_uint(av.z), u3 = __float_as_uint(av.w);
        unsigned tau = 0u; int it = 0;
        for (int bit = 30; bit >= 0; --bit, ++it) { const unsigned cand = tau | (1u << bit);
            const int cnt = block_count(F, wc, it & 1, u0 >= cand, u1 >= cand, u2 >= cand, u3 >= cand);
            if (cnt >= CAP) tau = cand; }
        const int cgt = block_count(F, wc, it & 1, u0 > tau, u1 > tau, u2 > tau, u3 > tau); ++it;
        const int need_eq = CAP - cgt;
        const int ngt = (u0 > tau) + (u1 > tau) + (u2 > tau) + (u3 > tau), neq = (u0 == tau) + (u1 == tau) + (u2 == tau) + (u3 == tau);
        int pk = ngt | (neq << 16), inc = pk;
#pragma unroll
        for (int o = 1; o < 64; o <<= 1) { const int nb = __shfl_up(inc, o); if (lane >= o) inc += nb; }
        if (lane == 63) wc[16 + wave] = inc;
        __syncthreads();
        int base = 0;
#pragma unroll
        for (int w = 0; w < 8; ++w) base += (w < wave) ? wc[16 + w] : 0;
        int ex = base + inc - pk; int gpos = ex & 0xffff, epos = ex >> 16;
        const unsigned uu[4] = {u0, u1, u2, u3}; const float ff[4] = {av.x, av.y, av.z, av.w};
#pragma unroll
        for (int j = 0; j < 4; ++j) { int slot = -1;
            if (uu[j] > tau) { slot = gpos; ++gpos; } else if (uu[j] == tau) { if (epos < need_eq) slot = cgt + epos; ++epos; }
            if (slot >= 0) { IDX[(size_t)(e * NB + b) * CAP + slot] = 4 * tid + j; VAL[(size_t)(e * NB + b) * CAP + slot] = ff[j]; sel[slot] = 4 * tid + j; }
            INV[((size_t)b * SEQ + 4 * tid + j) * 16 + e] = slot; }
        __syncthreads();
#pragma unroll 1
        for (int s0 = wave * 8; s0 < CAP; s0 += 64) {
            v4u x0[8], x1[8];
#pragma unroll
            for (int r = 0; r < 8; ++r) { const int tok = sel[s0 + r]; const GAS v4u* src = (const GAS v4u*)(H2 + ((size_t)b * SEQ + tok) * DM); x0[r] = src[lane]; x1[r] = src[64 + lane]; }
#pragma unroll
            for (int r = 0; r < 8; ++r) { GAS v4u* dst = (GAS v4u*)(XE + ((size_t)(e * NB + b) * CAP + s0 + r) * DM); dst[lane] = x0[r]; dst[64 + lane] = x1[r]; } }
        __syncthreads();
    }
}

struct ExpertOrder {
    int G, c, upe, npn;
    __device__ void init(int G_, int c_, int npn_) { G = G_; c = c_; npn = npn_; upe = 32 * npn_; }
    __device__ bool next(int i, Unit& u) const { const long L = (long)i * G + c; if (L >= (long)NE * upe) return false;
        const int e = (int)(L / upe), rem = (int)(L % upe); u.pm = e * 32 + (rem & 31); u.pn = e * npn + (rem >> 5); return true; }
    __device__ __forceinline__ void a_ready(const Unit&) const {}
    __device__ __forceinline__ void done(const Unit&) const {}
};
struct EpiSwiglu {
    static constexpr bool PERM = true, AFTER_DRAIN = false;
    bf16* act;
    __device__ __forceinline__ void operator()(const f32x4 (&acc)[2][2][4][2], const Unit& u, int wr, int wc, int fr, int fq) const {
        const int e = u.pm >> 5, pnl = u.pn - 12 * e; const int row0 = u.pm * 256 + wr * 64 + fr, col = 128 * pnl + wc * 32 + 8 * fq;
#pragma unroll
        for (int ai = 0; ai < 2; ++ai)
#pragma unroll
            for (int m = 0; m < 4; ++m) { const f32x4 g0 = acc[ai][0][m][0], g1 = acc[ai][0][m][1], u0 = acc[ai][1][m][0], u1 = acc[ai][1][m][1];
                float o[8] = {g0.x * sigmoidf_(g0.x) * u0.x, g0.y * sigmoidf_(g0.y) * u0.y, g0.z * sigmoidf_(g0.z) * u0.z, g0.w * sigmoidf_(g0.w) * u0.w,
                              g1.x * sigmoidf_(g1.x) * u1.x, g1.y * sigmoidf_(g1.y) * u1.y, g1.z * sigmoidf_(g1.z) * u1.z, g1.w * sigmoidf_(g1.w) * u1.w};
                *(GAS v4u*)(act + (size_t)(row0 + ai * 128 + m * 16) * DFF + col) = pack8(o); }
    }
};
struct EpiDown {
    static constexpr bool PERM = true, AFTER_DRAIN = false;
    bf16* y2; const float* val;
    __device__ __forceinline__ void operator()(const f32x4 (&acc)[2][2][4][2], const Unit& u, int wr, int wc, int fr, int fq) const {
        const int e = u.pm >> 5, pnl = u.pn - 4 * e; const int srow0 = u.pm * 256 + wr * 64 + fr, col0 = pnl * 256 + wc * 32 + 8 * fq;
#pragma unroll
        for (int ai = 0; ai < 2; ++ai)
#pragma unroll
            for (int m = 0; m < 4; ++m) { const int srow = srow0 + ai * 128 + m * 16; const float vl = val[srow];
#pragma unroll
                for (int bj = 0; bj < 2; ++bj) { const f32x4 v0 = acc[ai][bj][m][0] * vl, v1 = acc[ai][bj][m][1] * vl;
                    v4u w; w.x = pkbf(v0.x, v0.y); w.y = pkbf(v0.z, v0.w); w.z = pkbf(v1.x, v1.y); w.w = pkbf(v1.z, v1.w);
                    *(GAS v4u*)(y2 + (size_t)srow * DM + col0 + bj * 128) = w; } }
    }
};
__device__ __forceinline__ void p12_combine(Frame& F, bool dostore = true) {
    const int gw = blockIdx.x * NWAVES + F.wave, NGW = F.G * NWAVES, lane = F.lane;
    const int* INV = (const int*)(F.ws + WS_INV); const bf16* Y2 = (const bf16*)(F.ws + WS_Y2); const float* mod = (const float*)(F.ws + WS_MOD);
    const float* Xp = karg_in(I_X); const bf16* DELTA = (const bf16*)(F.ws + WS_DELTA);
    for (int m0 = gw; m0 < NLAT; m0 += 2 * NGW) {
        int inv[2]; f32x4 xv[2][4];
#pragma unroll
        for (int r = 0; r < 2; ++r) { const int m = min(m0 + r * NGW, NLAT - 1);
            { const int iv = INV[(size_t)m * 16 + (lane & 15)]; inv[r] = lane < 16 ? iv : -1; const float* orow = Xp + (size_t)m * DM; const bf16* dr = DELTA + (size_t)m * DM;
                const v4u d0 = *(const GAS v4u*)(dr + 8 * lane), d1 = *(const GAS v4u*)(dr + 512 + 8 * lane);
                xv[r][0] = *(const GAS f32x4*)(orow + 8 * lane) + (f32x4){bflo(d0.x), bfhi(d0.x), bflo(d0.y), bfhi(d0.y)}; xv[r][1] = *(const GAS f32x4*)(orow + 8 * lane + 4) + (f32x4){bflo(d0.z), bfhi(d0.z), bflo(d0.w), bfhi(d0.w)};
                xv[r][2] = *(const GAS f32x4*)(orow + 512 + 8 * lane) + (f32x4){bflo(d1.x), bfhi(d1.x), bflo(d1.y), bfhi(d1.y)}; xv[r][3] = *(const GAS f32x4*)(orow + 512 + 8 * lane + 4) + (f32x4){bflo(d1.z), bfhi(d1.z), bflo(d1.w), bfhi(d1.w)}; } }
#pragma unroll
        for (int r = 0; r < 2; ++r) { const int m = m0 + r * NGW; if (m >= NLAT) continue;
            const int b = m >> 11; unsigned long long mk = __ballot(inv[r] >= 0);
            float a0[8] = {0.f, 0.f, 0.f, 0.f, 0.f, 0.f, 0.f, 0.f}, a1[8] = {0.f, 0.f, 0.f, 0.f, 0.f, 0.f, 0.f, 0.f};
            while (mk) {
                const int e = __builtin_ctzll(mk); mk &= mk - 1; const int slot = __builtin_amdgcn_readlane(inv[r], e);
                const bool two = mk != 0; int e2 = e, slot2 = slot; if (two) { e2 = __builtin_ctzll(mk); mk &= mk - 1; slot2 = __builtin_amdgcn_readlane(inv[r], e2); }
                const bf16* yr = Y2 + ((size_t)(e * NB + b) * CAP + slot) * DM; const bf16* yr2 = Y2 + ((size_t)(e2 * NB + b) * CAP + slot2) * DM;
                const v4u q0 = *(const GAS v4u*)(yr + 8 * lane), q1 = *(const GAS v4u*)(yr + 512 + 8 * lane), q2 = *(const GAS v4u*)(yr2 + 8 * lane), q3 = *(const GAS v4u*)(yr2 + 512 + 8 * lane);
                float f0[8], f1[8], f2[8], f3[8]; unpack8(q0, f0); unpack8(q1, f1); unpack8(q2, f2); unpack8(q3, f3);
                const float w2 = two ? 1.0f : 0.0f;
#pragma unroll
                for (int j = 0; j < 8; ++j) { a0[j] += f0[j] + w2 * f2[j]; a1[j] += f1[j] + w2 * f3[j]; }
            }
            float* orow = F.out + (size_t)m * DM; const float* g = mod + (size_t)b * 6144 + 5120;
            const f32x4 g0 = *(const f32x4*)(g + 8 * lane), g1 = *(const f32x4*)(g + 8 * lane + 4), g2 = *(const f32x4*)(g + 512 + 8 * lane), g3 = *(const f32x4*)(g + 512 + 8 * lane + 4);
            if (dostore) {
            *(GAS f32x4*)(orow + 8 * lane) = xv[r][0] + g0 * (f32x4){a0[0], a0[1], a0[2], a0[3]}; *(GAS f32x4*)(orow + 8 * lane + 4) = xv[r][1] + g1 * (f32x4){a0[4], a0[5], a0[6], a0[7]};
            *(GAS f32x4*)(orow + 512 + 8 * lane) = xv[r][2] + g2 * (f32x4){a1[0], a1[1], a1[2], a1[3]}; *(GAS f32x4*)(orow + 512 + 8 * lane + 4) = xv[r][3] + g3 * (f32x4){a1[4], a1[5], a1[6], a1[7]}; }
        }
    }
}

struct Args { const float* in[30]; float* out; unsigned char* ws; int ph_lo, ph_hi; };
__global__ void __launch_bounds__(NWAVES * 64, 2) mk_fwd(Args args) {
    extern __shared__ __attribute__((aligned(16))) unsigned char lds[];
    Frame F;
    F.lds = (LAS unsigned char*)lds; F.MISC = (volatile LAS unsigned*)(F.lds + MISC_OFF);
    F.tid = threadIdx.x; F.lane = F.tid & 63; F.wave = __builtin_amdgcn_readfirstlane(F.tid >> 6); F.G = gridDim.x;
    F.out = args.out; F.ws = args.ws; F.ctl = (gu32*)(args.ws + WS_CTL);
    for (int u = F.tid; u < (LDS_BYTES - LDSCTL_OFF) / 4; u += NWAVES * 64) ((LAS unsigned*)(F.lds + LDSCTL_OFF))[u] = 0u;
    __syncthreads();
    XcdBarrier bar; bar.bar = (unsigned*)(F.ctl + CW_BAR); bar.x = 0; bar.st = nullptr;
    if (N_LAUNCHES == 1) bar = xcd_barrier_post((unsigned*)(F.ctl + CW_BAR), F.MISC + 8);
#define GRID_BAR() do { if (N_LAUNCHES == 1) xcd_barrier(bar); } while (0)
    const int lo = args.ph_lo, hi = args.ph_hi;
#ifndef PH_MASK
#define PH_MASK 0x1FFF
#endif
#define IN(k) (((PH_MASK >> (k)) & 1) && lo <= (k) && (k) < hi)
#define SEAM(k) do { if (IN(k) && IN((k) + 1)) GRID_BAR(); } while (0)
    unsigned char* ws = args.ws;

    if (IN(0)) { p0_prologue(F); } SEAM(0);
    if (IN(1)) { p1_norm1(F); } SEAM(1);
    if (IN(2)) {
        pg8::Gemm g{(const bf16*)(ws + WS_H1), (const bf16*)(ws + WS_WIN), NTOK, WIN_ROWS, DM}; InprojOrder S; S.init(F.G, (int)blockIdx.x);
        EpiInproj E{(bf16*)(ws + WS_ZK), (bf16*)(ws + WS_ZV), (bf16*)(ws + WS_ZR), (bf16*)(ws + WS_Q), (bf16*)(ws + WS_KQ), (bf16*)(ws + WS_VQ), (bf16*)(ws + WS_LA), (bf16*)args.out};
        pg8::gemm_phase<EpiInproj, InprojOrder, true, true>(F.lds, g, S, E);
    } SEAM(2);
    if (IN(3)) {
        p3a_lora(F);
        p3b_attn_prep(F);
    } SEAM(3);
    if (IN(4)) { p4a_attention(F); __syncthreads(); p4b_scan(F); } SEAM(4);
    if (IN(5)) { p5_rwkv_out(F); } SEAM(5);
    if (IN(6)) {
        pg8::Gemm g{(const bf16*)(ws + WS_ORW), (const bf16*)(ws + WS_WBRR), NLAT, DM, DM, (const bf16*)(ws + WS_Q), 512}; pg8::StaticOrder S; S.init(NLAT, DM, F.G, (int)blockIdx.x);
        EpiMerge2 E{(bf16*)(ws + WS_MERGED), (const bf16*)args.out};
        pg8::gemm_phase<EpiMerge2, pg8::StaticOrder, true, true, true>(F.lds, g, S, E);
    } SEAM(6);
    if (IN(7)) {
        pg8::Gemm g{(const bf16*)(ws + WS_MERGED), (const bf16*)(ws + WS_WOUT), NLAT, DM, DM}; pg8::StaticOrder S; S.init(NLAT, DM, F.G, (int)blockIdx.x);
        EpiOutproj E{(bf16*)(ws + WS_DELTA), (const float*)(ws + WS_MOD)};
        pg8::gemm_phase<EpiOutproj, pg8::StaticOrder, true, true>(F.lds, g, S, E);
    } SEAM(7);
    if (IN(8)) { p8_norm2_router(F); } SEAM(8);
    if (IN(9)) { p9_topk_gather(F); } SEAM(9);
    if (IN(10)) {
        pg8::Gemm g{(const bf16*)(ws + WS_XE), (const bf16*)(ws + WS_WGU), NSLOT, NE * 3072, DM}; ExpertOrder S; S.init(F.G, (int)blockIdx.x, 12);
        EpiSwiglu E{(bf16*)(ws + WS_ACT)};
        pg8::gemm_phase<EpiSwiglu, ExpertOrder, true, true>(F.lds, g, S, E);
    } SEAM(10);
    if (IN(11)) {
        pg8::Gemm g{(const bf16*)(ws + WS_ACT), (const bf16*)(ws + WS_WD), NSLOT, NE * 1024, DFF}; ExpertOrder S; S.init(F.G, (int)blockIdx.x, 4);
        EpiDown E{(bf16*)(ws + WS_Y2), (const float*)(ws + WS_VAL)};
        pg8::gemm_phase<EpiDown, ExpertOrder, true, true>(F.lds, g, S, E);
    } SEAM(11);
    if (IN(12)) { p12_combine(F); }
#undef IN
#undef SEAM
#undef GRID_BAR
}

extern "C" void kernel_launch(void* const* d_in, const int* in_sizes, int n_in, void* d_out, int out_size, void* d_ws, size_t ws_size, hipStream_t stream) {
    static int grid = 0;
    if (grid == 0) {
        if (n_in != 30 || out_size != NLAT * DM || ws_size < WS_END) { fprintf(stderr, "kernel_launch: unexpected problem (n_in %d out %d ws %zu)\n", n_in, out_size, ws_size); grid = -1; return; }
        int dev = 0, cus = 0, per_cu = 0;
        if (hipGetDevice(&dev) != hipSuccess || hipDeviceGetAttribute(&cus, hipDeviceAttributeMultiprocessorCount, dev) != hipSuccess) { grid = -1; return; }
        if (hipFuncSetAttribute((const void*)mk_fwd, hipFuncAttributeMaxDynamicSharedMemorySize, LDS_BYTES) != hipSuccess) { fprintf(stderr, "kernel_launch: hipFuncSetAttribute failed\n"); grid = -1; return; }
        if (hipOccupancyMaxActiveBlocksPerMultiprocessor(&per_cu, (const void*)mk_fwd, NWAVES * 64, LDS_BYTES) != hipSuccess || per_cu < 1) fprintf(stderr, "kernel_launch: occupancy query says %d\n", per_cu);
        (void)hipGetLastError();
        grid = cus;
    }
    if (grid < 0) return;
    if (hipMemsetAsync((char*)d_ws + WS_CTL, 0, CTL_ZERO_BYTES, stream) != hipSuccess) return;
    Args a{};
    for (int i = 0; i < 30; ++i) a.in[i] = (const float*)d_in[i];
    a.out = (float*)d_out; a.ws = (unsigned char*)d_ws;
    if (N_LAUNCHES == 1) { a.ph_lo = 0; a.ph_hi = N_PHASES; hipLaunchKernelGGL(mk_fwd, dim3(grid), dim3(NWAVES * 64), LDS_BYTES, stream, a); }
    else for (int li = 0; li < N_PHASES; ++li) { a.ph_lo = li; a.ph_hi = li + 1; hipLaunchKernelGGL(mk_fwd, dim3(grid), dim3(NWAVES * 64), LDS_BYTES, stream, a); }
}
```

```cpp
#include <hip/hip_runtime.h>
#include <cstdio>
#include <cstdint>
#define MK_N_LAUNCHES 1
namespace pg8 {
#define PG8_LAS __attribute__((address_space(3)))
typedef unsigned short bf16_t;
typedef short bf16x8 __attribute__((ext_vector_type(8)));
typedef float f32x4 __attribute__((ext_vector_type(4)));
typedef unsigned u32x4 __attribute__((ext_vector_type(4)));
constexpr int BM = 256, BK = 64, HALF = 128, HTB = HALF * BK * 2  , STAGE_BYTES = 8 * HTB, NXCD = 8, WGM = 8;

__host__ __device__ __forceinline__ int lds_byte(int r, int c) { const int st = (r >> 4) * 2 + (c >> 5), rr = r & 15, cc = c & 31, ob = rr * 64 + cc * 2; return st * 1024 + (ob ^ (((ob >> 9) & 1) << 5)); }
__host__ __device__ __forceinline__ void stage_rc(int b, int& R, int& C) { const int st = b / 1024, sb = b % 1024, swz = sb ^ (((sb >> 9) & 1) << 5); R = (st >> 1) * 16 + swz / 64; C = (st & 1) * 32 + (swz % 64) / 2; }
__host__ __device__ __forceinline__ int perm32(int rho) { const int n = rho >> 4, i = rho & 15; return 8 * (i >> 2) + 4 * n + (i & 3); }

struct Unit { int pm, pn; };
struct Gemm { const bf16_t* A; const bf16_t* Bt; int M, N, K; const bf16_t* A2 = nullptr; int lda = 0; };

struct StaticOrder {
    int nM, nN, nwg, G, c;
    __host__ __device__ void init(int M, int N, int G_, int c_) { nM = M / BM; nN = N / BM; nwg = nM * nN; G = G_; c = c_; }
    __host__ __device__ bool next(int i, Unit& u) const {
        const long L = (long)i * G + c; if (L >= nwg) return false;
        int wgid = (int)L; { const int q = nwg / NXCD, r = nwg % NXCD, xcd = wgid % NXCD, off = wgid / NXCD; wgid = (xcd < r ? xcd * (q + 1) : r * (q + 1) + (xcd - r) * q) + off; }
        const int nig = WGM * nN, gid = wgid / nig, fm = gid * WGM, gsz = (nM - fm) < WGM ? (nM - fm) : WGM;
        u.pm = fm + ((wgid % nig) % gsz); u.pn = (wgid % nig) / gsz; return true;
    }
    __device__ __forceinline__ void a_ready(const Unit&) const {}
    __device__ __forceinline__ void done(const Unit&) const {}
};

template <class Epi, class Sched, bool ALIGN_EPI = false, bool SP2 = false, bool SPLITA = false>
__device__ __forceinline__ void gemm_phase(PG8_LAS unsigned char* lds, const Gemm g, const Sched& S, const Epi& E) {
    const int tid = threadIdx.x, wid = __builtin_amdgcn_readfirstlane(tid >> 6), lane = tid & 63, wr = wid >> 2, wc = wid & 3, fr = lane & 15, fq = lane >> 4;
    const int K = g.K, nt = K / BK, lda = g.lda ? g.lda : g.K, nh = nt / 2;
    unsigned voffA[2], voffB[2];
#pragma unroll
    for (int i = 0; i < 2; ++i) { int R, C; stage_rc(tid * 16 + i * 8192, R, C); const int Rb = Epi::PERM ? ((R & ~31) + perm32(R & 31)) : R;
        voffA[i] = (unsigned)(R * lda + C) * 2u; voffB[i] = (unsigned)(Rb * K + C) * 2u; }
    const size_t kstep = (size_t)(BK * 2);
    const size_t hstep = (size_t)HALF * K * 2;
    const size_t tstep = 2 * hstep;
    const size_t hstepA = (size_t)HALF * lda * 2, tstepA = 2 * hstepA;
    const unsigned ldsw = (unsigned)wid * 1024u;
    const int aoff = lds_byte(wr * 64 + fr, fq * 8), boff = lds_byte(wc * 32 + fr, fq * 8);
#define PG8_SA(b, h) (((b) * 2 + (h)) * HTB)
#define PG8_SB(b, h) ((4 + (b) * 2 + (h)) * HTB)
#define PG8_STAGE(bufoff, gbase, voff) do { _Pragma("unroll") for (int _i = 0; _i < 2; ++_i) \
        __builtin_amdgcn_global_load_lds((const unsigned*)((const char*)(gbase) + (voff)[_i]), (PG8_LAS unsigned*)(lds + (bufoff) + ldsw + _i * 8192), 16, 0, 0); } while (0)
#define PG8_LDA(dst, b, h) do { _Pragma("unroll") for (int m = 0; m < 4; ++m) _Pragma("unroll") for (int k = 0; k < 2; ++k) dst[m][k] = *(const PG8_LAS bf16x8*)(lds + PG8_SA(b, h) + aoff + m * 2048 + k * 1024); } while (0)
#define PG8_LDB(dst, b, h) do { _Pragma("unroll") for (int n = 0; n < 2; ++n) _Pragma("unroll") for (int k = 0; k < 2; ++k) dst[n][k] = *(const PG8_LAS bf16x8*)(lds + PG8_SB(b, h) + boff + n * 2048 + k * 1024); } while (0)
#define PG8_MMA(ai, bj, At, Bt) do { __builtin_amdgcn_s_setprio(1); _Pragma("unroll") for (int m = 0; m < 4; ++m) _Pragma("unroll") for (int n = 0; n < 2; ++n) _Pragma("unroll") for (int k = 0; k < 2; ++k) \
        acc[ai][bj][m][n] = __builtin_amdgcn_mfma_f32_16x16x32_bf16(Bt[n][k], At[m][k], acc[ai][bj][m][n], 0, 0, 0); __builtin_amdgcn_s_setprio(0); } while (0)
#define PG8_WAIT_V(n) asm volatile("s_waitcnt vmcnt(" #n ")" ::: "memory")
#define PG8_WAIT_L(n) asm volatile("s_waitcnt lgkmcnt(" #n ")" ::: "memory")
#define PG8_BAR __builtin_amdgcn_s_barrier()
#define PG8_SCHED __builtin_amdgcn_sched_barrier(0)
    Unit cur, nxt; int ui = 0;
    if (!S.next(0, cur)) return;
    f32x4 acc[2][2][4][2];
#pragma unroll
    for (int a = 0; a < 2; ++a)
#pragma unroll
        for (int b = 0; b < 2; ++b)
#pragma unroll
            for (int m = 0; m < 4; ++m)
#pragma unroll
                for (int n = 0; n < 2; ++n) acc[a][b][m][n] = (f32x4){0.f, 0.f, 0.f, 0.f};
    bf16x8 At[4][2], B0[2][2], B1[2][2];
    const char* cA = (const char*)g.A + (size_t)cur.pm * tstepA; const char* cB = (const char*)g.Bt + (size_t)cur.pn * tstep;
    const char* cA2 = SPLITA ? (const char*)g.A2 + (size_t)cur.pm * tstepA : cA;
#define PG8_AADDR(tt) (SPLITA ? (((tt) < nh) ? cA + (size_t)(tt) * kstep : cA2 + (size_t)((tt) - nh) * kstep) : cA + (size_t)(tt) * kstep)
    S.a_ready(cur);
    if constexpr (SP2) {
        PG8_STAGE(PG8_SB(0, 0), cB, voffB); PG8_STAGE(PG8_SB(0, 1), cB + hstep, voffB); PG8_STAGE(PG8_SA(0, 0), cA, voffA); PG8_STAGE(PG8_SA(0, 1), cA + hstepA, voffA);
        if (wr == 1) PG8_BAR;
        PG8_WAIT_V(2); PG8_BAR;
        PG8_STAGE(PG8_SB(1, 0), cB + kstep, voffB); PG8_STAGE(PG8_SA(1, 0), cA + kstep, voffA); PG8_STAGE(PG8_SB(1, 1), cB + hstep + kstep, voffB);
        PG8_WAIT_V(6); PG8_BAR;
    } else {
        PG8_STAGE(PG8_SB(0, 0), cB, voffB); PG8_STAGE(PG8_SA(0, 0), cA, voffA); PG8_STAGE(PG8_SB(0, 1), cB + hstep, voffB); PG8_STAGE(PG8_SA(0, 1), cA + hstepA, voffA);
        if (wr == 1) PG8_BAR;
        PG8_WAIT_V(4); PG8_BAR;
        PG8_STAGE(PG8_SB(1, 0), cB + kstep, voffB); PG8_STAGE(PG8_SA(1, 0), cA + kstep, voffA); PG8_STAGE(PG8_SB(1, 1), cB + hstep + kstep, voffB);
        PG8_WAIT_V(6); PG8_BAR;
    }
    for (;;) {
        const bool has_next = S.next(ui + 1, nxt);
        const char* nA = has_next ? (const char*)g.A + (size_t)nxt.pm * tstepA : cA; const char* nB = has_next ? (const char*)g.Bt + (size_t)nxt.pn * tstep : cB;
        const char* nA2 = (SPLITA && has_next) ? (const char*)g.A2 + (size_t)nxt.pm * tstepA : cA2;
        for (int t = 0; t < nt; t += 2) {
            const bool last = (t == nt - 2);
            const char* a1 = PG8_AADDR(t + 1);
            const char* a2 = last ? nA : PG8_AADDR(t + 2); const char* b2 = last ? nB : cB + (size_t)(t + 2) * kstep;
            const char* a3 = a2 + kstep; const char* b3 = b2 + kstep;
            if (last && has_next) S.a_ready(nxt);
            if constexpr (SPLITA) { if (t == nh) E.mid(acc, cur, wr, wc, fr, fq); }
            if constexpr (SP2) {
            PG8_LDB(B0, 0, 0); PG8_LDB(B1, 0, 1); PG8_SCHED; PG8_LDA(At, 0, 0); PG8_STAGE(PG8_SA(1, 1), a1 + hstepA, voffA);
            PG8_WAIT_V(8); PG8_WAIT_L(0); PG8_BAR; PG8_MMA(0, 0, At, B0); PG8_MMA(0, 1, At, B1); PG8_BAR; PG8_SCHED;
            PG8_LDA(At, 0, 1); PG8_STAGE(PG8_SB(0, 0), b2, voffB); PG8_STAGE(PG8_SB(0, 1), b2 + hstep, voffB); PG8_STAGE(PG8_SA(0, 0), a2, voffA);
            PG8_WAIT_V(8); PG8_WAIT_L(0); PG8_BAR; PG8_MMA(1, 0, At, B0); PG8_MMA(1, 1, At, B1); PG8_BAR; PG8_SCHED;
            PG8_LDB(B0, 1, 0); PG8_LDB(B1, 1, 1); PG8_SCHED; PG8_LDA(At, 1, 0); PG8_STAGE(PG8_SA(0, 1), a2 + hstepA, voffA);
            PG8_WAIT_V(8); PG8_WAIT_L(0); PG8_BAR; PG8_MMA(0, 0, At, B0); PG8_MMA(0, 1, At, B1); PG8_BAR; PG8_SCHED;
            PG8_LDA(At, 1, 1); PG8_STAGE(PG8_SB(1, 0), b3, voffB); PG8_STAGE(PG8_SB(1, 1), b3 + hstep, voffB); PG8_STAGE(PG8_SA(1, 0), a3, voffA);
            PG8_WAIT_V(8); PG8_WAIT_L(0); PG8_BAR; PG8_MMA(1, 0, At, B0); PG8_MMA(1, 1, At, B1); PG8_BAR; PG8_SCHED;
            } else {
            PG8_LDB(B0, 0, 0); PG8_SCHED; PG8_LDA(At, 0, 0); PG8_STAGE(PG8_SA(1, 1), a1 + hstepA, voffA);
            PG8_WAIT_L(8); PG8_BAR; PG8_WAIT_L(0); PG8_MMA(0, 0, At, B0); PG8_BAR; PG8_SCHED;
            PG8_LDB(B1, 0, 1); PG8_STAGE(PG8_SB(0, 0), b2, voffB);
            PG8_BAR; PG8_WAIT_L(0); PG8_MMA(0, 1, At, B1); PG8_BAR;
            PG8_LDA(At, 0, 1); PG8_STAGE(PG8_SA(0, 0), a2, voffA);
            PG8_BAR; PG8_WAIT_L(0); PG8_MMA(1, 0, At, B0); PG8_BAR; PG8_SCHED;
            PG8_STAGE(PG8_SB(0, 1), b2 + hstep, voffB);
            PG8_WAIT_V(6); PG8_BAR; PG8_MMA(1, 1, At, B1); PG8_BAR;
            PG8_LDB(B0, 1, 0); PG8_SCHED; PG8_LDA(At, 1, 0); PG8_STAGE(PG8_SA(0, 1), a2 + hstepA, voffA);
            PG8_WAIT_L(8); PG8_BAR; PG8_WAIT_L(0); PG8_MMA(0, 0, At, B0); PG8_BAR; PG8_SCHED;
            PG8_LDB(B1, 1, 1); PG8_STAGE(PG8_SB(1, 0), b3, voffB);
            PG8_BAR; PG8_WAIT_L(0); PG8_MMA(0, 1, At, B1); PG8_BAR;
            PG8_LDA(At, 1, 1); PG8_STAGE(PG8_SA(1, 0), a3, voffA);
            PG8_BAR; PG8_WAIT_L(0); PG8_MMA(1, 0, At, B0); PG8_BAR; PG8_SCHED;
            PG8_STAGE(PG8_SB(1, 1), b3 + hstep, voffB);
            PG8_WAIT_V(6); PG8_BAR; PG8_MMA(1, 1, At, B1); PG8_BAR;
            }
        }
        if constexpr (ALIGN_EPI) { if (wr == 0) PG8_BAR; }
        if constexpr (!Epi::AFTER_DRAIN) { E(acc, cur, wr, wc, fr, fq); S.done(cur); }
        if (!has_next) break;
#pragma unroll
        for (int a = 0; a < 2; ++a)
#pragma unroll
            for (int b = 0; b < 2; ++b)
#pragma unroll
                for (int m = 0; m < 4; ++m)
#pragma unroll
                    for (int n = 0; n < 2; ++n) acc[a][b][m][n] = (f32x4){0.f, 0.f, 0.f, 0.f};
        cur = nxt; cA = nA; cA2 = nA2; cB = nB; ++ui;
        if constexpr (ALIGN_EPI) { if (wr == 1) PG8_BAR; }
    }
    PG8_WAIT_V(0);
    if constexpr (!ALIGN_EPI) { if (wr == 0) PG8_BAR; }
    PG8_BAR;
    if constexpr (Epi::AFTER_DRAIN) { E.fused(acc, cur, wr, wc, fr, fq, lds, wid, lane); S.done(cur); }
#undef PG8_AADDR
#undef PG8_SA
#undef PG8_SB
#undef PG8_STAGE
#undef PG8_LDA
#undef PG8_LDB
#undef PG8_MMA
#undef PG8_WAIT_V
#undef PG8_WAIT_L
#undef PG8_BAR
#undef PG8_SCHED
}
}
#define GAS __attribute__((address_space(1)))
#define LAS __attribute__((address_space(3)))
typedef unsigned short bf16;
typedef unsigned v4u __attribute__((ext_vector_type(4)));
typedef float f32x4 __attribute__((ext_vector_type(4)));
typedef short bf16x8 __attribute__((ext_vector_type(8)));
typedef GAS unsigned gu32;
typedef GAS unsigned long long gu64;
#define RLX_AGENT __ATOMIC_RELAXED, __HIP_MEMORY_SCOPE_AGENT
#define LDS_WAIT() asm volatile("s_waitcnt lgkmcnt(0)" ::: "memory")
#define VM_WAIT() asm volatile("s_waitcnt vmcnt(0)" ::: "memory")
__device__ __forceinline__ unsigned long long rt() { return __builtin_amdgcn_s_memrealtime(); }
__device__ __forceinline__ unsigned f2bf(float f) { unsigned u = __builtin_bit_cast(unsigned, f); return (u + 0x7fffu + ((u >> 16) & 1u)) >> 16; }
__device__ __forceinline__ unsigned pk2(float lo, float hi) { return f2bf(lo) | (f2bf(hi) << 16); }

#define XB_TMO      128
#define XB_XCNT(j)  (256  + 64 * (j))
#define XB_XSUB(j)  (1280 + 64 * (j))
#define XB_XGEN(j)  (2304 + 64 * (j))
#define XB_TOP      3328
#define XB_TOPGEN   3392
#define XCD_BAR_WORDS 3456
#define XB_SPIN_CAP (1u << 18)

__device__ __forceinline__ unsigned xb_ld(unsigned* p)              { return __hip_atomic_load(p, __ATOMIC_RELAXED, __HIP_MEMORY_SCOPE_AGENT); }
__device__ __forceinline__ unsigned xb_add(unsigned* p, unsigned v) { return __hip_atomic_fetch_add(p, v, __ATOMIC_RELAXED, __HIP_MEMORY_SCOPE_AGENT); }
__device__ __forceinline__ unsigned xb_xcc_id() { return (unsigned)__builtin_amdgcn_s_getreg((3 << 11) | 20) & 0xFu; }
#define XB_SPIN(cond, bar) do { unsigned _sp = 0; while (cond) { __builtin_amdgcn_s_sleep(1); \
    if ((++_sp & 255u) == 0u) { if (xb_ld(&(bar)[XB_TMO])) break; if (_sp > XB_SPIN_CAP) { atomicAdd(&(bar)[XB_TMO], 1u); break; } } } } while (0)

struct XcdBarrier {
    unsigned* bar; unsigned x;
    volatile LAS unsigned* st;
};

__device__ __forceinline__ XcdBarrier xcd_barrier_post(unsigned* bar, volatile LAS unsigned* st) {
    XcdBarrier b; b.bar = bar; b.x = xb_xcc_id(); b.st = st;
    if (threadIdx.x == 0) (void)xb_add(&bar[XB_XCNT(b.x)], 1u);
    return b;
}
__device__ __forceinline__ void xcd_barrier_complete(unsigned* bar, unsigned x, unsigned& nloc, unsigned& nx) {
    const unsigned G = gridDim.x * gridDim.y * gridDim.z;
    unsigned sum, cnt, mine, sp = 0u;
    for (;;) {
        sum = 0u; cnt = 0u; mine = 0u;
#pragma unroll
        for (unsigned j = 0; j < 16; ++j) { const unsigned c = xb_ld(&bar[XB_XCNT(j)]); sum += c; cnt += (c > 0u) ? 1u : 0u; mine = (j == x) ? c : mine; }
        if (sum == G) break;
        __builtin_amdgcn_s_sleep(1);
        if ((++sp & 255u) == 0u) { if (xb_ld(&bar[XB_TMO])) break; if (sp > XB_SPIN_CAP) { atomicAdd(&bar[XB_TMO], 1u); break; } }
    }
    nloc = mine > 0u ? mine : 1u; nx = cnt > 0u ? cnt : 1u;
}

__device__ __forceinline__ void xcd_barrier(const XcdBarrier& b) {
    asm volatile("s_waitcnt vmcnt(0)" ::: "memory");
    __syncthreads();
    if (threadIdx.x == 0) {
        unsigned* bar = b.bar;
        __builtin_amdgcn_s_waitcnt(0);
        unsigned nloc = b.st[0], nx = b.st[1];
        if (nloc == 0u) { xcd_barrier_complete(bar, b.x, nloc, nx); b.st[0] = nloc; b.st[1] = nx; }
        const unsigned old = xb_add(&bar[XB_XSUB(b.x)], 1u);
        const unsigned gen = old / nloc;
        if (old + 1u == (gen + 1u) * nloc) {
            __builtin_amdgcn_fence(__ATOMIC_RELEASE, "agent");
            asm volatile("s_waitcnt vmcnt(0)" ::: "memory");
            const unsigned og = xb_add(&bar[XB_TOP], 1u);
            const unsigned tg = og / nx;
            if (og + 1u == (tg + 1u) * nx) xb_add(&bar[XB_TOPGEN], 1u);
            else XB_SPIN(xb_ld(&bar[XB_TOPGEN]) == tg, bar);
            __builtin_amdgcn_fence(__ATOMIC_ACQUIRE, "agent");
            xb_add(&bar[XB_XGEN(b.x)], 1u);
            asm volatile("s_waitcnt vmcnt(0)" ::: "memory");
        } else {
            XB_SPIN(xb_ld(&bar[XB_XGEN(b.x)]) == gen, bar);
            __builtin_amdgcn_fence(__ATOMIC_ACQUIRE, "agent");
            asm volatile("s_waitcnt vmcnt(0)" ::: "memory");
        }
    }
    __syncthreads();
}

typedef float f32x2 __attribute__((ext_vector_type(2)));
typedef float f32x16 __attribute__((ext_vector_type(16)));
typedef unsigned v2u __attribute__((ext_vector_type(2)));
typedef __bf16 bf16x2_t __attribute__((ext_vector_type(2)));
using pg8::Unit;

constexpr int NWAVES = 8;
#ifndef MK_N_LAUNCHES
#define MK_N_LAUNCHES 1
#endif
constexpr int N_PHASES = 13;
constexpr int N_LAUNCHES = MK_N_LAUNCHES;

constexpr int NB = 32, SEQ = 2048, LC = 256, DM = 1024, NLAT = NB * SEQ, NCTX = NB * LC, NTOK = NLAT + NCTX;
constexpr int NE = 16, CAP = 256, DFF = 1536, NSLOT = NE * NB * CAP;
constexpr int WIN_ROWS = 4864, LORA_N = 2560, LORA_K = 384;
constexpr int KEYS = SEQ + LC;

constexpr size_t MiB = 1u << 20, KiB = 1u << 10;
constexpr size_t WS_CTL = 0, CTL_ZERO_BYTES = 1 * MiB;
constexpr size_t WS_MOD = 1 * MiB;
constexpr size_t WS_WIN = 2 * MiB;
constexpr size_t WS_WLORA = 11 * MiB + 512 * KiB;
constexpr size_t WS_WBRR = 13 * MiB + 512 * KiB;
constexpr size_t WS_WBRA = 14 * MiB + 512 * KiB;
constexpr size_t WS_WOUT = 15 * MiB + 512 * KiB;
constexpr size_t WS_WGU = 17 * MiB + 512 * KiB;
constexpr size_t WS_WD = 113 * MiB + 512 * KiB;
constexpr size_t WS_IDX = 161 * MiB + 512 * KiB;
constexpr size_t WS_VAL = 162 * MiB;
constexpr size_t WS_ZK = 163 * MiB;
constexpr size_t WS_ZV = 235 * MiB;
constexpr size_t WS_ZR = 307 * MiB;
constexpr size_t WS_Q = 371 * MiB;
constexpr size_t WS_KQ = 435 * MiB;
constexpr size_t WS_VQ = 453 * MiB;
constexpr size_t WS_XCH = 453 * MiB;
constexpr size_t WS_YB = 959 * MiB;
constexpr size_t WS_LA = 471 * MiB;
constexpr size_t WS_H1 = 525 * MiB;
constexpr size_t WS_EW = 525 * MiB;
constexpr size_t WS_ORW = 525 * MiB;
constexpr size_t WS_AS = 669 * MiB;
constexpr size_t WS_G = 813 * MiB;
constexpr size_t WS_VT = 877 * MiB;
constexpr size_t WS_YF = 895 * MiB;
constexpr size_t WS_MERGED = 163 * MiB;
constexpr size_t WS_INV = 163 * MiB;
constexpr size_t WS_XE = 167 * MiB;
constexpr size_t WS_Y2 = 167 * MiB;
constexpr size_t WS_H2 = 423 * MiB;
constexpr size_t WS_AFF = 551 * MiB;
constexpr size_t WS_ACT = 423 * MiB;
constexpr size_t WS_DELTA = 807 * MiB;
constexpr size_t WS_END = 1023 * MiB;
constexpr int CW_BAR = 4096;

constexpr int RING_BYTES = 131072;
constexpr int LDSCTL_OFF = 147456 - 1024, MISC_OFF = LDSCTL_OFF + 320;
static_assert(33 * 1024 * 4 <= LDSCTL_OFF, "P0's silu(c) image must stay below the LDS control words");
constexpr int LDS_BYTES = 147456;

__device__ __forceinline__ unsigned pkbf(float lo, float hi) { f32x2 v = {lo, hi}; return __builtin_bit_cast(unsigned, __builtin_convertvector(v, bf16x2_t)); }
__device__ __forceinline__ float bflo(unsigned u) { return __uint_as_float(u << 16); }
__device__ __forceinline__ float bfhi(unsigned u) { return __uint_as_float(u & 0xffff0000u); }
__device__ __forceinline__ float bf1(bf16 h) { return __uint_as_float(((unsigned)h) << 16); }
__device__ __forceinline__ float sigmoidf_(float x) { return __builtin_amdgcn_rcpf(1.0f + __builtin_amdgcn_exp2f(-1.4426950408889634f * x)); }
__device__ __forceinline__ float tanhf_(float x) { return 1.0f - 2.0f * __builtin_amdgcn_rcpf(__builtin_amdgcn_exp2f(2.8853900817779268f * x) + 1.0f); }
__device__ __forceinline__ float wave_sum(float v) {
    int x = __float_as_int(v);
#define WS_DPP(ctrl, rmask) x = __float_as_int(__int_as_float(x) + __int_as_float(__builtin_amdgcn_update_dpp(0, x, ctrl, rmask, 0xf, false)))
    WS_DPP(0x111, 0xf); WS_DPP(0x112, 0xf); WS_DPP(0x114, 0xf); WS_DPP(0x118, 0xf); WS_DPP(0x142, 0xa); WS_DPP(0x143, 0xc);
#undef WS_DPP
    return __int_as_float(__builtin_amdgcn_readlane(x, 63));
}
__device__ __forceinline__ void unpack8(const v4u w, float (&f)[8]) {
    f[0] = bflo(w.x); f[1] = bfhi(w.x); f[2] = bflo(w.y); f[3] = bfhi(w.y); f[4] = bflo(w.z); f[5] = bfhi(w.z); f[6] = bflo(w.w); f[7] = bfhi(w.w);
}
__device__ __forceinline__ v4u pack8(const float (&f)[8]) { v4u w; w.x = pkbf(f[0], f[1]); w.y = pkbf(f[2], f[3]); w.z = pkbf(f[4], f[5]); w.w = pkbf(f[6], f[7]); return w; }

struct Frame {
    LAS unsigned char* lds;
    volatile LAS unsigned* MISC;
    gu32* ctl;
    int tid, lane, wave, G;
    float* out; unsigned char* ws;
};
enum { I_X = 0, I_C, I_CTX, I_CCTX, I_ADAW, I_ADAB, I_N1G, I_N2G, I_WIN, I_CONV, I_W0, I_W2, I_A0, I_A2, I_KK, I_KA, I_RK, I_G2, I_LNW, I_LNB, I_QG, I_KG, I_SINK,
       I_WBRR, I_WBRA, I_WOUT, I_ROUTER, I_EG, I_EU, I_ED };
typedef const __attribute__((address_space(4))) unsigned char* kptr_t;
__device__ __forceinline__ const float* karg_in(int i) { kptr_t kp = (kptr_t)__builtin_amdgcn_kernarg_segment_ptr(); asm volatile("" : "+s"(kp)); return *(const float* const __attribute__((address_space(4)))*)(kp + 8 * i); }

__device__ __forceinline__ void transpose_item(const float* W, int N, int k0, int n0, bf16* WT, int Kd, int drow0, LAS float* scr, int lane) {
#pragma unroll 8
    for (int i = 0; i < 32; ++i) { const int kk = 2 * i + (lane >> 5); scr[kk * 33 + (lane & 31)] = W[(size_t)(k0 + kk) * N + n0 + (lane & 31)]; }
    LDS_WAIT(); asm volatile("" ::: "memory");
    const int c = lane & 7;
#pragma unroll
    for (int j = 0; j < 4; ++j) { const int n = (lane >> 3) + 8 * j; const LAS float* s = scr + (8 * c) * 33 + n;
        v4u o; o.x = pkbf(s[0 * 33], s[1 * 33]); o.y = pkbf(s[2 * 33], s[3 * 33]); o.z = pkbf(s[4 * 33], s[5 * 33]); o.w = pkbf(s[6 * 33], s[7 * 33]);
        *(GAS v4u*)(WT + (size_t)(drow0 + n) * Kd + k0 + 8 * c) = o; }
    LDS_WAIT(); asm volatile("" ::: "memory");
}
__device__ __forceinline__ int win_dest_block(int sb) {
    if (sb < 4) return 13 + sb;
    if (sb < 8) return sb - 4;
    if (sb < 12) return sb - 4;
    if (sb == 12) return 8;
    if (sb == 13) return 9;
    if (sb == 14) return 10;
    if (sb < 19) return sb + 2;
    if (sb == 19) return 11;
    if (sb == 20) return 12;
    return sb;
}
__device__ __forceinline__ void p0_prologue(Frame& F) {
    if (blockIdx.x < 96) {
        LAS float* cs = (LAS float*)F.lds;
        const float* c = karg_in(I_C); const float* cc = karg_in(I_CCTX);
        for (int i = F.tid; i < 33 * 1024; i += 512) { const float v = i < 32 * 1024 ? c[i] : cc[i - 32 * 1024]; cs[i] = v * sigmoidf_(v); }
        __syncthreads();
        const int col = blockIdx.x * 64 + F.lane; const float* aw = karg_in(I_ADAW);
        float acc[33];
#pragma unroll
        for (int b = 0; b < 33; ++b) acc[b] = 0.f;
        const int kbeg = F.wave * 128;
        for (int k = kbeg; k < kbeg + 128; k += 4) {
            const float w0 = aw[(size_t)(k + 0) * 6144 + col], w1 = aw[(size_t)(k + 1) * 6144 + col], w2 = aw[(size_t)(k + 2) * 6144 + col], w3 = aw[(size_t)(k + 3) * 6144 + col];
#pragma unroll
            for (int b = 0; b < 33; ++b) { const f32x4 cv = *(const LAS f32x4*)(cs + b * 1024 + k); acc[b] += cv.x * w0 + cv.y * w1 + cv.z * w2 + cv.w * w3; }
        }
        __syncthreads();
        LAS float* red = (LAS float*)F.lds;
#pragma unroll
        for (int b = 0; b < 33; ++b) red[(F.wave * 33 + b) * 64 + F.lane] = acc[b];
        __syncthreads();
        float* mod = (float*)(F.ws + WS_MOD); const float* ab = karg_in(I_ADAB);
        for (int i = F.tid; i < 33 * 64; i += 512) { const int b = i >> 6, l = i & 63; float s = 0.f;
#pragma unroll
            for (int w = 0; w < 8; ++w) s += red[(w * 33 + b) * 64 + l];
            mod[(size_t)b * 6144 + blockIdx.x * 64 + l] = s + ab[blockIdx.x * 64 + l]; }
        __syncthreads();
    }
    LAS float* scr = (LAS float*)(F.lds + F.wave * 16384);
    const int gw = blockIdx.x * NWAVES + F.wave, NGW = F.G * NWAVES;
    constexpr int IT_WIN = 16 * 148, IT_G = 16 * 768, IT_BR = 256, IT_OUT = 512;
    constexpr int NITEMS = IT_WIN + 3 * IT_G + 2 * IT_BR + IT_OUT;
    bf16* WIN = (bf16*)(F.ws + WS_WIN); bf16* WGU = (bf16*)(F.ws + WS_WGU); bf16* WD = (bf16*)(F.ws + WS_WD);
    for (int it = gw; it < NITEMS; it += NGW) {
        int r = it;
        if (r < IT_WIN) { const int kb = r / 148, nb = r % 148, n0 = 32 * nb; const int db = win_dest_block(n0 >> 7);
            transpose_item(karg_in(I_WIN), 4736, 64 * kb, n0, WIN, 1024, db * 128 + (n0 & 127), scr, F.lane); continue; }
        r -= IT_WIN;
        if (r < IT_G) { const int e = r / 768, q = r % 768, kb = q / 48, nb = q % 48, n0 = 32 * nb;
            transpose_item(karg_in(I_EG) + (size_t)e * 1024 * 1536, 1536, 64 * kb, n0, WGU, 1024, e * 3072 + 256 * (n0 >> 7) + (n0 & 127), scr, F.lane); continue; }
        r -= IT_G;
        if (r < IT_G) { const int e = r / 768, q = r % 768, kb = q / 48, nb = q % 48, n0 = 32 * nb;
            transpose_item(karg_in(I_EU) + (size_t)e * 1024 * 1536, 1536, 64 * kb, n0, WGU, 1024, e * 3072 + 256 * (n0 >> 7) + 128 + (n0 & 127), scr, F.lane); continue; }
        r -= IT_G;
        if (r < IT_G) { const int e = r / 768, q = r % 768, kb = q / 32, nb = q % 32, n0 = 32 * nb;
            transpose_item(karg_in(I_ED) + (size_t)e * 1536 * 1024, 1024, 64 * kb, n0, WD, 1536, e * 1024 + n0, scr, F.lane); continue; }
        r -= IT_G;
        if (r < IT_BR) { const int kb = r / 32, nb = r % 32; transpose_item(karg_in(I_WBRR), 1024, 64 * kb, 32 * nb, (bf16*)(F.ws + WS_WBRR), 1024, 32 * nb, scr, F.lane); continue; }
        r -= IT_BR;
        if (r < IT_BR) { const int kb = r / 32, nb = r % 32; transpose_item(karg_in(I_WBRA), 1024, 64 * kb, 32 * nb, (bf16*)(F.ws + WS_WBRR) + 512, 1024, 32 * nb, scr, F.lane); continue; }
        r -= IT_BR;
        { const int kb = r / 32, nb = r % 32; transpose_item(karg_in(I_WOUT), 1024, 64 * kb, 32 * nb, (bf16*)(F.ws + WS_WOUT), 1024, 32 * nb, scr, F.lane); }
    }
    const int gt = blockIdx.x * 512 + F.tid, NGT = F.G * 512;
    for (int i = gt; i < 128 * 1024 / 8; i += NGT) *(GAS v4u*)(WIN + (size_t)4736 * 1024 + (size_t)i * 8) = (v4u){0u, 0u, 0u, 0u};
    { bf16* WL = (bf16*)(F.ws + WS_WLORA); const float* w2 = karg_in(I_W2); const float* a2 = karg_in(I_A2); const float* g2 = karg_in(I_G2);
      for (int i = gt; i < LORA_N * (LORA_K / 8); i += NGT) { const int n = i / (LORA_K / 8), k8 = (i % (LORA_K / 8)) * 8; const int rg = n >> 9, col = n & 511; float f[8];
#pragma unroll
          for (int j = 0; j < 8; ++j) { const int k = k8 + j; float v = 0.f;
              if (rg == 0) { if (k < 64) v = w2[(size_t)k * 512 + col]; }
              else if (rg == 1) { if (k >= 64 && k < 128) v = w2[(size_t)(64 + k - 64) * 512 + col]; }
              else if (rg == 2) { if (k >= 128 && k < 192) v = a2[(size_t)(k - 128) * 512 + col]; }
              else if (rg == 3) { if (k >= 192 && k < 256) v = a2[(size_t)(64 + k - 192) * 512 + col]; }
              else { if (k >= 256) v = g2[(size_t)(k - 256) * 512 + col]; }
              f[j] = v; }
          *(GAS v4u*)(WL + (size_t)n * LORA_K + k8) = pack8(f); } }
}

__device__ __forceinline__ void p1_norm1(Frame& F) {
    const int gw = blockIdx.x * NWAVES + F.wave, NGW = F.G * NWAVES;
    const float* mod = (const float*)(F.ws + WS_MOD); bf16* H1 = (bf16*)(F.ws + WS_H1);
    const float* g1 = karg_in(I_N1G); const float* Xp = karg_in(I_X); const float* CTXp = karg_in(I_CTX);
    f32x4 gv[4];
#pragma unroll
    for (int j = 0; j < 4; ++j) gv[j] = *(const f32x4*)(g1 + 4 * F.lane + 256 * j);
    for (int m0 = gw; m0 < NTOK; m0 += 4 * NGW) {
        f32x4 v[4][4]; float s[4];
#pragma unroll
        for (int r = 0; r < 4; ++r) { const int m = min(m0 + r * NGW, NTOK - 1); s[r] = 0.f;
            const float* xr = m < NLAT ? Xp + (size_t)m * DM : CTXp + (size_t)(m - NLAT) * DM;
#pragma unroll
            for (int j = 0; j < 4; ++j) v[r][j] = *(const GAS f32x4*)(xr + 4 * F.lane + 256 * j); }
#pragma unroll
        for (int r = 0; r < 4; ++r) { const int m = m0 + r * NGW;
            if (m < NTOK) {
#pragma unroll
                for (int j = 0; j < 4; ++j) s[r] += (v[r][j].x * v[r][j].x + v[r][j].y * v[r][j].y) + (v[r][j].z * v[r][j].z + v[r][j].w * v[r][j].w);
                const float rstd = __builtin_amdgcn_rsqf(wave_sum(s[r]) * (1.f / DM) + 1e-6f);
                const int mb = m < NLAT ? (m >> 11) : 32; const float* sh = mod + (size_t)mb * 6144; const float* sc = sh + 1024;
#pragma unroll
                for (int j = 0; j < 4; ++j) { const f32x4 a = *(const f32x4*)(sc + 4 * F.lane + 256 * j), bsh = *(const f32x4*)(sh + 4 * F.lane + 256 * j);
                    const f32x4 y = v[r][j] * rstd * gv[j] * (a + 1.0f) + bsh;
                    v2u o; o.x = pkbf(y.x, y.y); o.y = pkbf(y.z, y.w);
                    *(GAS v2u*)(H1 + (size_t)m * DM + 4 * F.lane + 256 * j) = o; } } }
    }
}

struct InprojOrder {
    pg8::StaticOrder so; int G, c;
    __device__ void init(int G_, int c_) { so.init(NLAT, WIN_ROWS, G_, c_); G = G_; c = c_; }
    __device__ bool next(int i, Unit& u) const {
        long L = (long)i * G + c; if (L < 4864) return so.next(i, u);
        L -= 4864; if (L >= 224) return false; u.pm = 256 + (int)(L % 32); u.pn = (int)(L / 32); return true; }
    __device__ __forceinline__ void a_ready(const Unit&) const {}
    __device__ __forceinline__ void done(const Unit&) const {}
};
struct EpiInproj {
    static constexpr bool PERM = true, AFTER_DRAIN = false;
    bf16 *zk, *zv, *zr, *q, *kq, *vq, *la, *gates;
    __device__ __forceinline__ void operator()(const f32x4 (&acc)[2][2][4][2], const Unit& u, int wr, int wc, int fr, int fq) const {
        const int row0 = u.pm * 256 + wr * 64 + fr; const bool isctx = u.pm >= 256;
#pragma unroll
        for (int bj = 0; bj < 2; ++bj) {
            const int c128 = 2 * u.pn + bj; bf16* base = nullptr; int pitch = 0, act = 0; bool ok = true;
            if (c128 < 4) { base = zk + c128 * 128; pitch = 512; }
            else if (c128 < 8) { base = zv + (c128 - 4) * 128; pitch = 512; }
            else if (c128 < 11) { base = la + (c128 - 8) * 128; pitch = 384; act = (c128 == 8) ? 1 : ((c128 == 10) ? 2 : 0); }
            else if (c128 == 11) { base = kq; pitch = 128; }
            else if (c128 == 12) { base = vq; pitch = 128; }
            else if (c128 < 17) { base = zr + (c128 - 13) * 128; pitch = 512; ok = !isctx; }
            else if (c128 < 21) { base = q + (c128 - 17) * 128; pitch = 512; ok = !isctx; }
            else if (c128 < 37) { base = gates + (c128 - 21) * 128; pitch = 2048; act = 2; ok = !isctx; }
            else ok = false;
            if (ok) {
#pragma unroll
                for (int ai = 0; ai < 2; ++ai)
#pragma unroll
                    for (int m = 0; m < 4; ++m) {
                        f32x4 v0 = acc[ai][bj][m][0], v1 = acc[ai][bj][m][1];
                        if (act == 1) { v0.x = tanhf_(v0.x); v0.y = tanhf_(v0.y); v0.z = tanhf_(v0.z); v0.w = tanhf_(v0.w); v1.x = tanhf_(v1.x); v1.y = tanhf_(v1.y); v1.z = tanhf_(v1.z); v1.w = tanhf_(v1.w); }
                        else if (act == 2) { v0.x = sigmoidf_(v0.x); v0.y = sigmoidf_(v0.y); v0.z = sigmoidf_(v0.z); v0.w = sigmoidf_(v0.w); v1.x = sigmoidf_(v1.x); v1.y = sigmoidf_(v1.y); v1.z = sigmoidf_(v1.z); v1.w = sigmoidf_(v1.w); }
                        v4u w; w.x = pkbf(v0.x, v0.y); w.y = pkbf(v0.z, v0.w); w.z = pkbf(v1.x, v1.y); w.w = pkbf(v1.z, v1.w);
                        *(GAS v4u*)(base + (size_t)(row0 + ai * 128 + m * 16) * pitch + wc * 32 + 8 * fq) = w;
                    }
            }
        }
    }
};

constexpr int LORA_LP = 144;
template <int NKS> __device__ __forceinline__ void lora_item(const bf16* LA, const bf16* WL, bf16* outp, const float* bias, float scale, int act, int tile, int rg, int kbase, int lane, LAS unsigned char* st) {
    const int l32 = lane & 31, hi = lane >> 5;
    bf16x8 xf[2][NKS];
#pragma unroll
    for (int s2 = 0; s2 < 2; ++s2)
#pragma unroll
        for (int ks = 0; ks < NKS; ++ks) xf[s2][ks] = *(const GAS bf16x8*)(LA + (size_t)(tile * 64 + s2 * 32 + l32) * LORA_K + kbase + 16 * ks + 8 * hi);
    bf16x8 wf[NKS], wn[NKS];
    { const bf16* wp = WL + (size_t)(rg * 512 + l32) * LORA_K + kbase + 8 * hi;
#pragma unroll
      for (int ks = 0; ks < NKS; ++ks) wf[ks] = *(const GAS bf16x8*)(wp + 16 * ks); }
#pragma unroll 1
    for (int np = 0; np < 8; ++np) {
#pragma unroll
        for (int nh = 0; nh < 2; ++nh) { const int nt = 2 * np + nh;
            f32x16 acc0, acc1;
#pragma unroll
            for (int r = 0; r < 16; ++r) { acc0[r] = 0.f; acc1[r] = 0.f; }
            { const int ntn = nt < 15 ? nt + 1 : 15; const bf16* wp = WL + (size_t)(rg * 512 + ntn * 32 + l32) * LORA_K + kbase + 8 * hi;
#pragma unroll
              for (int ks = 0; ks < NKS; ++ks) wn[ks] = *(const GAS bf16x8*)(wp + 16 * ks); }
#pragma unroll
            for (int ks = 0; ks < NKS; ++ks) { acc0 = __builtin_amdgcn_mfma_f32_32x32x16_bf16(wf[ks], xf[0][ks], acc0, 0, 0, 0); acc1 = __builtin_amdgcn_mfma_f32_32x32x16_bf16(wf[ks], xf[1][ks], acc1, 0, 0, 0); }
#pragma unroll
            for (int ks = 0; ks < NKS; ++ks) wf[ks] = wn[ks];
#pragma unroll
            for (int r4 = 0; r4 < 4; ++r4) { const int col = nt * 32 + 8 * r4 + 4 * hi;
                f32x4 bv = (f32x4){0.f, 0.f, 0.f, 0.f}; if (act) bv = *(const f32x4*)(bias + col);
                f32x4 v0 = (f32x4){acc0[4 * r4], acc0[4 * r4 + 1], acc0[4 * r4 + 2], acc0[4 * r4 + 3]} + bv, v1 = (f32x4){acc1[4 * r4], acc1[4 * r4 + 1], acc1[4 * r4 + 2], acc1[4 * r4 + 3]} + bv;
                if (act) { v0.x = scale * sigmoidf_(v0.x); v0.y = scale * sigmoidf_(v0.y); v0.z = scale * sigmoidf_(v0.z); v0.w = scale * sigmoidf_(v0.w);
                           v1.x = scale * sigmoidf_(v1.x); v1.y = scale * sigmoidf_(v1.y); v1.z = scale * sigmoidf_(v1.z); v1.w = scale * sigmoidf_(v1.w); }
                v2u o0, o1; o0.x = pkbf(v0.x, v0.y); o0.y = pkbf(v0.z, v0.w); o1.x = pkbf(v1.x, v1.y); o1.y = pkbf(v1.z, v1.w);
                const int lc = (32 * nh + 8 * r4 + 4 * hi) * 2;
                *(LAS v2u*)(st + l32 * LORA_LP + lc) = o0; *(LAS v2u*)(st + 32 * LORA_LP + l32 * LORA_LP + lc) = o1; }
        }
#pragma unroll
        for (int i = 0; i < 8; ++i) { const int row = 8 * i + (lane >> 3);
            const v4u w = *(const LAS v4u*)(st + row * LORA_LP + (lane & 7) * 16);
            *(GAS v4u*)(outp + (size_t)(tile * 64 + row) * 512 + np * 64 + (lane & 7) * 8) = w; }
    }
}
__device__ __forceinline__ void p3a_lora(Frame& F) {
    const bf16* LA = (const bf16*)(F.ws + WS_LA); const bf16* WL = (const bf16*)(F.ws + WS_WLORA);
    bf16* EW = (bf16*)(F.ws + WS_EW); bf16* AS = (bf16*)(F.ws + WS_AS); bf16* G = (bf16*)(F.ws + WS_G);
    const float* w0 = karg_in(I_W0); const float* a0 = karg_in(I_A0);
    const int gw = blockIdx.x * NWAVES + F.wave, NGW = F.G * NWAVES;
    LAS unsigned char* st = F.lds + 16384 + F.wave * (64 * LORA_LP);
    for (int item = gw; item < (NTOK / 64) * 5; item += NGW) {
        const int rg = item % 5, tile = item / 5;
        if (rg == 4) { if (tile < NLAT / 64) lora_item<8>(LA, WL, G, nullptr, 1.0f, 0, tile, 4, 256, F.lane, st); }
        else if (rg < 2) lora_item<4>(LA, WL, EW + (size_t)rg * NTOK * 512, w0 + rg * 512, 0.60653066f, 1, tile, rg, 64 * rg, F.lane, st);
        else lora_item<4>(LA, WL, AS + (size_t)(rg - 2) * NTOK * 512, a0 + (rg - 2) * 512, 1.0f, 1, tile, rg, 64 * rg, F.lane, st);
    }
}

__device__ __forceinline__ void p3b_attn_prep(Frame& F) {
    LAS float* tab = (LAS float*)F.lds;
    for (int i = F.tid; i < 1024; i += 512) { const int pos = i >> 4, fi = i & 15;
        const float invf = exp2f(-(float)fi * (13.287712379549449f / 16.0f));
        const float ang = (float)pos * invf; tab[2 * i] = cosf(ang); tab[2 * i + 1] = sinf(ang); }
    __syncthreads();
    const int gw = blockIdx.x * NWAVES + F.wave, NGW = F.G * NWAVES, lane = F.lane;
    {
        bf16* Q = (bf16*)(F.ws + WS_Q); const float* qg = karg_in(I_QG);
        const int sub = lane & 7; float gq[8];
#pragma unroll
        for (int j = 0; j < 8; ++j) gq[j] = qg[8 * sub + j];
        const float qscale = 0.125f * 1.4426950408889634f;
        for (int m0 = gw; m0 < NLAT; m0 += 4 * NGW) {
            v4u raw[4];
#pragma unroll
            for (int r = 0; r < 4; ++r) { const int m = min(m0 + r * NGW, NLAT - 1); raw[r] = *(const GAS v4u*)(Q + (size_t)m * 512 + 8 * lane); }
#pragma unroll
            for (int r = 0; r < 4; ++r) { const int m = m0 + r * NGW; if (m >= NLAT) continue;
                const int t = m & 2047; GAS v4u* p = (GAS v4u*)(Q + (size_t)m * 512 + 8 * lane);
                float y[8]; unpack8(raw[r], y); float ss = 0.f;
#pragma unroll
                for (int j = 0; j < 8; ++j) ss += y[j] * y[j];
                ss += __shfl_xor(ss, 1); ss += __shfl_xor(ss, 2); ss += __shfl_xor(ss, 4);
                const float rstd = __builtin_amdgcn_rsqf(ss * (1.f / 64.f) + 1e-6f);
                const int pos = (sub < 4) ? (t >> 6) : (t & 63); const bool second = (sub & 2) != 0; float o[8];
#pragma unroll
                for (int j = 0; j < 8; ++j) { y[j] = y[j] * rstd * gq[j]; }
#pragma unroll
                for (int j = 0; j < 8; ++j) { const float yp = __shfl_xor(y[j], 2); const int fi = 8 * (sub & 1) + j; const float cs = tab[(pos * 16 + fi) * 2], sn = tab[(pos * 16 + fi) * 2 + 1];
                    o[j] = (second ? (yp * sn + y[j] * cs) : (y[j] * cs - yp * sn)) * qscale; }
                *p = pack8(o); }
        }
    }
    {
        bf16* KQ = (bf16*)(F.ws + WS_KQ); const float* kg = karg_in(I_KG);
        const int l32 = lane & 31; const float g0 = kg[2 * l32], g1 = kg[2 * l32 + 1];
        for (int m0 = gw; m0 < NTOK; m0 += 4 * NGW) {
            unsigned raw[4];
#pragma unroll
            for (int r = 0; r < 4; ++r) { const int m = min(m0 + r * NGW, NTOK - 1); raw[r] = *(const GAS unsigned*)(KQ + (size_t)m * 128 + 2 * lane); }
#pragma unroll
            for (int r = 0; r < 4; ++r) { const int m = m0 + r * NGW; if (m >= NTOK) continue;
                GAS unsigned* p = (GAS unsigned*)(KQ + (size_t)m * 128 + 2 * lane); const unsigned w = raw[r];
                float y0 = bflo(w), y1 = bfhi(w); float ss = y0 * y0 + y1 * y1;
                ss += __shfl_xor(ss, 1); ss += __shfl_xor(ss, 2); ss += __shfl_xor(ss, 4); ss += __shfl_xor(ss, 8); ss += __shfl_xor(ss, 16);
                const float rstd = __builtin_amdgcn_rsqf(ss * (1.f / 64.f) + 1e-6f);
                y0 = y0 * rstd * g0; y1 = y1 * rstd * g1;
                const float p0 = __shfl_xor(y0, 8), p1 = __shfl_xor(y1, 8);
                if (m < NLAT) { const int t = m & 2047; const int pos = (l32 < 16) ? (t >> 6) : (t & 63); const bool second = (l32 & 8) != 0; const int fi0 = (2 * l32) & 15;
                    const float c0 = tab[(pos * 16 + fi0) * 2], s0 = tab[(pos * 16 + fi0) * 2 + 1], c1 = tab[(pos * 16 + fi0 + 1) * 2], s1 = tab[(pos * 16 + fi0 + 1) * 2 + 1];
                    const float o0 = second ? (p0 * s0 + y0 * c0) : (y0 * c0 - p0 * s0), o1 = second ? (p1 * s1 + y1 * c1) : (y1 * c1 - p1 * s1);
                    y0 = o0; y1 = o1; }
                *p = pkbf(y0, y1); }
        }
    }
    {
        const bf16* VQ = (const bf16*)(F.ws + WS_VQ); bf16* VT = (bf16*)(F.ws + WS_VT);
        const int gt = blockIdx.x * 512 + F.tid, NGT = F.G * 512;
        for (int i = gt; i < NB * 2 * (KEYS / 8) * 64; i += NGT) { const int d = i & 63, kg8 = (i >> 6) % (KEYS / 8), bh = (i >> 6) / (KEYS / 8), b = bh >> 1, hk = bh & 1;
            float f[8];
#pragma unroll
            for (int j = 0; j < 8; ++j) { const int key = kg8 * 8 + j; const size_t row = key < SEQ ? (size_t)b * SEQ + key : (size_t)NLAT + b * LC + (key - SEQ); f[j] = bf1(VQ[row * 128 + hk * 64 + d]); }
            *(GAS v4u*)(VT + ((size_t)bh * 64 + d) * KEYS + kg8 * 8) = pack8(f); }
    }
}

__device__ __forceinline__ int key_perm(int i) { const int r = 4 * (i >> 3) + (i & 3), hi = (i >> 2) & 1; return 8 * hi + r + (r >= 8 ? 8 : 0); }
__device__ __forceinline__ void attn_tile(const bf16x8 (&kf)[4], const bf16x8 (&vf)[4], const bf16x8 (&qf)[4], f32x16& o0, f32x16& o1, float& mrun, float& lrun, int mask, int l32, int hi) {
    f32x16 s;
#pragma unroll
    for (int r = 0; r < 16; ++r) s[r] = 0.f;
#pragma unroll
    for (int ks = 0; ks < 4; ++ks) s = __builtin_amdgcn_mfma_f32_32x32x16_bf16(kf[ks], qf[ks], s, 0, 0, 0);
    if (mask) {
#pragma unroll
        for (int r = 0; r < 16; ++r) { const int kk = 8 * hi + r + (r >= 8 ? 8 : 0); const bool ok = (mask == 1) ? (kk >= l32) : (kk <= l32); s[r] = ok ? s[r] : -1e30f; }
    }
    float mx = s[0];
#pragma unroll
    for (int r = 1; r < 16; ++r) mx = fmaxf(mx, s[r]);
    mx = fmaxf(mx, __shfl_xor(mx, 32));
    const float mnew = fmaxf(mrun, mx), alpha = __builtin_amdgcn_exp2f(mrun - mnew);
    float ps = 0.f; float p[16];
#pragma unroll
    for (int r = 0; r < 16; ++r) { p[r] = __builtin_amdgcn_exp2f(s[r] - mnew); ps += p[r]; }
    lrun = lrun * alpha + ps; mrun = mnew;
#pragma unroll
    for (int r = 0; r < 16; ++r) { o0[r] *= alpha; o1[r] *= alpha; }
    v4u pa, pb; pa.x = pkbf(p[0], p[1]); pa.y = pkbf(p[2], p[3]); pa.z = pkbf(p[4], p[5]); pa.w = pkbf(p[6], p[7]);
    pb.x = pkbf(p[8], p[9]); pb.y = pkbf(p[10], p[11]); pb.z = pkbf(p[12], p[13]); pb.w = pkbf(p[14], p[15]);
    const bf16x8 pa8 = __builtin_bit_cast(bf16x8, pa), pb8 = __builtin_bit_cast(bf16x8, pb);
    o0 = __builtin_amdgcn_mfma_f32_32x32x16_bf16(vf[0], pa8, o0, 0, 0, 0);
    o0 = __builtin_amdgcn_mfma_f32_32x32x16_bf16(vf[1], pb8, o0, 0, 0, 0);
    o1 = __builtin_amdgcn_mfma_f32_32x32x16_bf16(vf[2], pa8, o1, 0, 0, 0);
    o1 = __builtin_amdgcn_mfma_f32_32x32x16_bf16(vf[3], pb8, o1, 0, 0, 0);
}
constexpr int AT_KP = 144, AT_VP = 80, AT_KB = 32 * AT_KP, AT_VB = 64 * AT_VP, AT_BUF = AT_KB + AT_VB;
__device__ __forceinline__ void p4a_attention(Frame& F, bool dostore = true) {
    bf16* Q = (bf16*)(F.ws + WS_Q); const bf16* KQ = (const bf16*)(F.ws + WS_KQ); const bf16* VT = (const bf16*)(F.ws + WS_VT);
    const float* sink = karg_in(I_SINK);
    const int tid = F.tid, lane = F.lane, l32 = lane & 31, hi = lane >> 5;
    const int kperm = key_perm(l32);
    LAS unsigned char* lb = F.lds;
    const bool kpart = tid < 256; const int tt = tid & 255;
    const int skey = tt >> 3, skc = tt & 7, sd = tt >> 2, svc = tt & 3;
    const int sdst = kpart ? (skey * AT_KP + skc * 16) : (AT_KB + sd * AT_VP + svc * 16);
    for (int unit = blockIdx.x; unit < NB * 2 * 16; unit += F.G) {
        const int b = unit >> 5, hk = (unit >> 4) & 1, qb = unit & 15;
        const int g = F.wave >> 1, half = F.wave & 1, h = hk * 4 + g;
        const float sink2 = sink[h] * 1.4426950408889634f;
        const int tq0 = qb * 128 + half * 64;
        const size_t qrow = (size_t)b * SEQ + tq0 + l32;
        bf16x8 qf0[4], qf1[4];
#pragma unroll
        for (int ks = 0; ks < 4; ++ks) { qf0[ks] = *(const GAS bf16x8*)(Q + qrow * 512 + h * 64 + 16 * ks + 8 * hi); qf1[ks] = *(const GAS bf16x8*)(Q + (qrow + 32) * 512 + h * 64 + 16 * ks + 8 * hi); }
        float m0 = sink2, m1 = sink2, l0 = hi == 0 ? 1.0f : 0.0f, l1 = l0;
        f32x16 oa0, oa1, ob0, ob1;
#pragma unroll
        for (int r = 0; r < 16; ++r) { oa0[r] = 0.f; oa1[r] = 0.f; ob0[r] = 0.f; ob1[r] = 0.f; }
        const bf16* vsrc0 = VT + ((size_t)(b * 2 + hk) * 64 + sd) * KEYS + 8 * svc;
        const bf16* ksrc0 = KQ + (size_t)skey * 128 + hk * 64 + 8 * skc;
#define AT_SRC(s_, ptr_) do { int key0_; size_t krow_; if ((s_) < 8) { key0_ = SEQ + 32 * (s_); krow_ = (size_t)NLAT + b * LC + 32 * (s_); } \
            else { int kp_ = qb * 128 - 128 + 32 * ((s_) - 8); kp_ = (kp_ >= 0 && kp_ < SEQ) ? kp_ : 0; key0_ = kp_; krow_ = (size_t)b * SEQ + kp_; } \
            ptr_ = kpart ? (ksrc0 + krow_ * 128) : (vsrc0 + key0_); } while (0)
        v4u stg;
        { const bf16* sp; AT_SRC(0, sp); stg = *(const GAS v4u*)sp; }
        __syncthreads();
        *(LAS v4u*)(lb + sdst) = stg;
        __syncthreads();
#pragma unroll 1
        for (int s = 0; s < 20; ++s) {
            if (s + 1 < 20) { const bf16* sp; AT_SRC(s + 1, sp); stg = *(const GAS v4u*)sp; }
            const LAS unsigned char* kb_ = lb + (s & 1) * AT_BUF; const LAS unsigned char* vb_ = kb_ + AT_KB;
            bool use0, use1; int mk0 = 0, mk1 = 0;
            if (s < 8) { use0 = true; use1 = true; }
            else { const int j = s - 8, kp0 = qb * 128 - 128 + 32 * j, bi = j - 2 * half; const bool inr = kp0 >= 0 && kp0 < SEQ;
                use0 = inr && bi >= 0 && bi <= 8; use1 = inr && bi >= 1 && bi <= 9; mk0 = bi == 0 ? 1 : (bi == 8 ? 2 : 0); mk1 = bi == 1 ? 1 : (bi == 9 ? 2 : 0); }
            if (use0 || use1) {
                bf16x8 kf[4], vf[4];
#pragma unroll
                for (int ks = 0; ks < 4; ++ks) kf[ks] = *(const LAS bf16x8*)(kb_ + kperm * AT_KP + 32 * ks + 16 * hi);
                vf[0] = *(const LAS bf16x8*)(vb_ + l32 * AT_VP + 16 * hi); vf[1] = *(const LAS bf16x8*)(vb_ + l32 * AT_VP + 32 + 16 * hi);
                vf[2] = *(const LAS bf16x8*)(vb_ + (32 + l32) * AT_VP + 16 * hi); vf[3] = *(const LAS bf16x8*)(vb_ + (32 + l32) * AT_VP + 32 + 16 * hi);
                if (use0) attn_tile(kf, vf, qf0, oa0, oa1, m0, l0, mk0, l32, hi);
                if (use1) attn_tile(kf, vf, qf1, ob0, ob1, m1, l1, mk1, l32, hi);
            }
            if (s + 1 < 20) *(LAS v4u*)(lb + ((s + 1) & 1) * AT_BUF + sdst) = stg;
            __syncthreads();
        }
#undef AT_SRC
#pragma unroll
        for (int qi = 0; qi < 2; ++qi) {
            const float lr = qi ? l1 : l0; const float ltot = lr + __shfl_xor(lr, 32), inv = 1.0f / ltot;
            const f32x16& o0 = qi ? ob0 : oa0; const f32x16& o1 = qi ? ob1 : oa1;
            bf16* op = Q + (qrow + 32 * qi) * 512 + h * 64 + 4 * hi;
#pragma unroll
            for (int r4 = 0; r4 < 4; ++r4) {
                v2u w0; w0.x = pkbf(o0[4 * r4] * inv, o0[4 * r4 + 1] * inv); w0.y = pkbf(o0[4 * r4 + 2] * inv, o0[4 * r4 + 3] * inv);
                v2u w1; w1.x = pkbf(o1[4 * r4] * inv, o1[4 * r4 + 1] * inv); w1.y = pkbf(o1[4 * r4 + 2] * inv, o1[4 * r4 + 3] * inv);
                if (dostore) { *(GAS v2u*)(op + 8 * r4) = w0; *(GAS v2u*)(op + 32 + 8 * r4) = w1; }
            }
        }
    }
}

constexpr int SC_C = 32, SC_NCH = (LC + SEQ) / SC_C;
constexpr int SC_RP = 3;
constexpr int SC_ROUNDS = SC_NCH / SC_RP;
constexpr int SC_TASK_BYTES = 24576;
constexpr int SC_SLOT_BYTES = 2 * SC_RP * SC_TASK_BYTES;
constexpr int SC_PITCH = 144;
constexpr int SC_PLDS = 4 * 32 * SC_PITCH + 256;
__device__ __forceinline__ int launder(int v) { asm volatile("" : "+v"(v)); return v; }
__device__ __forceinline__ int crow_(int r, int hi) { return (r & 3) + 8 * (r >> 2) + 4 * hi; }
__device__ __forceinline__ bf16x8 packacc(const f32x16& x, int s) {
    v4u p; p.x = pkbf(x[8 * s], x[8 * s + 1]); p.y = pkbf(x[8 * s + 2], x[8 * s + 3]); p.z = pkbf(x[8 * s + 4], x[8 * s + 5]); p.w = pkbf(x[8 * s + 6], x[8 * s + 7]);
    return __builtin_bit_cast(bf16x8, p); }
#define MF(a, b, c) __builtin_amdgcn_mfma_f32_32x32x16_bf16((a), (b), (c), 0, 0, 0)
__device__ __forceinline__ f32x16 zero16() { f32x16 z;
#pragma unroll
    for (int r = 0; r < 16; ++r) z[r] = 0.f;
    return z; }
__device__ __forceinline__ void st_acc_bf16(unsigned char* p, const f32x16& x) {
    v4u a, b; a.x = pkbf(x[0], x[1]); a.y = pkbf(x[2], x[3]); a.z = pkbf(x[4], x[5]); a.w = pkbf(x[6], x[7]); b.x = pkbf(x[8], x[9]); b.y = pkbf(x[10], x[11]); b.z = pkbf(x[12], x[13]); b.w = pkbf(x[14], x[15]);
    *(GAS v4u*)p = a; *(GAS v4u*)(p + 16) = b; }
__device__ __forceinline__ f32x16 ld_acc_bf16(const unsigned char* p) {
    const v4u a = *(const GAS v4u*)p, b = *(const GAS v4u*)(p + 16); f32x16 x;
    x[0] = bflo(a.x); x[1] = bfhi(a.x); x[2] = bflo(a.y); x[3] = bfhi(a.y); x[4] = bflo(a.z); x[5] = bfhi(a.z); x[6] = bflo(a.w); x[7] = bfhi(a.w);
    x[8] = bflo(b.x); x[9] = bfhi(b.x); x[10] = bflo(b.y); x[11] = bfhi(b.y); x[12] = bflo(b.z); x[13] = bfhi(b.z); x[14] = bflo(b.w); x[15] = bfhi(b.w); return x; }

__device__ __forceinline__ void chan_to_frags(const unsigned (&pp)[16], int hi, bf16x8 (&fr)[2][2]) {
    unsigned mine[8], recv[8];
#pragma unroll
    for (int q = 0; q < 8; ++q) { const int plo = (q >> 1) * 4 + (q & 1), phi = plo + 2;
        mine[q] = hi ? pp[phi] : pp[plo]; const unsigned snd = hi ? pp[plo] : pp[phi]; recv[q] = (unsigned)__shfl_xor((int)snd, 32); }
#pragma unroll
    for (int s2 = 0; s2 < 2; ++s2) { v4u t0, t1;
        t0.x = hi ? recv[4 * s2] : mine[4 * s2]; t0.y = hi ? recv[4 * s2 + 1] : mine[4 * s2 + 1]; t0.z = hi ? recv[4 * s2 + 2] : mine[4 * s2 + 2]; t0.w = hi ? recv[4 * s2 + 3] : mine[4 * s2 + 3];
        t1.x = hi ? mine[4 * s2] : recv[4 * s2]; t1.y = hi ? mine[4 * s2 + 1] : recv[4 * s2 + 1]; t1.z = hi ? mine[4 * s2 + 2] : recv[4 * s2 + 2]; t1.w = hi ? mine[4 * s2 + 3] : recv[4 * s2 + 3];
        fr[0][s2] = __builtin_bit_cast(bf16x8, t0); fr[1][s2] = __builtin_bit_cast(bf16x8, t1); }
}
__device__ __forceinline__ void scan_produce(unsigned char* ws, int b, int h, int dir, int chunk, LAS unsigned char* pl, unsigned char* xo, int lane_in, const float* conv, const float* kkpp, const float* kapp) {
    int lane = launder(lane_in);
    float cw[9]; float kkp, kap;
    { const int colc = h * 64 + lane;
#pragma unroll
      for (int j = 0; j < 3; ++j) { cw[j] = conv[j * 1536 + colc]; cw[3 + j] = conv[j * 1536 + 512 + colc]; cw[6 + j] = conv[j * 1536 + 1024 + colc]; }
      kkp = kkpp[dir * 512 + colc]; kap = kapp[dir * 512 + colc]; }
    const bf16* ZK = (const bf16*)(ws + WS_ZK); const bf16* ZV = (const bf16*)(ws + WS_ZV); const bf16* ZR = (const bf16*)(ws + WS_ZR);
    const bf16* EW = (const bf16*)(ws + WS_EW) + (size_t)dir * NTOK * 512; const bf16* AS = (const bf16*)(ws + WS_AS) + (size_t)dir * NTOK * 512;
    int l32 = lane & 31, hi = lane >> 5; const int col = h * 64 + lane;
    const bool lat = chunk >= LC / SC_C; const int len = lat ? SEQ : LC, n0 = lat ? chunk * SC_C - LC : chunk * SC_C;
    const int rowbase = lat ? b * SEQ : NLAT + b * LC;
    LAS unsigned char* mA = pl; LAS unsigned char* mB = pl + 32 * SC_PITCH; LAS unsigned char* mK = pl + 64 * SC_PITCH; LAS unsigned char* mR = pl + 96 * SC_PITCH;
    LAS float* pcs = (LAS float*)(pl + 128 * SC_PITCH);
    unsigned pa[16], pb[16], pk[16], pv[16]; float P = 1.0f;
    const float latf = lat ? 1.0f : 0.0f;
    const float cwr_m = latf * (dir ? cw[2] : cw[0]), cwr_c = latf * cw[1], cwr_p = latf * (dir ? cw[0] : cw[2]), cwk_m = dir ? cw[5] : cw[3], cwk_p = dir ? cw[3] : cw[5], cwv_m = dir ? cw[8] : cw[6], cwv_p = dir ? cw[6] : cw[8];
    const int tk0 = dir ? (len - 1 - n0) : n0, tstep = dir ? -1 : 1;
    const unsigned ob0 = ((unsigned)(rowbase + tk0) * 512u + (unsigned)col) * 2u;
    const long ostepb = (long)tstep * 1024;
    const bool vm1 = n0 > 0, vp32 = n0 + SC_C < len;
    const char* ZKc = (const char*)ZK; const char* ZVc = (const char*)ZV; const char* ZRc = lat ? (const char*)ZR : (const char*)ZK;
    const char* EWc = (const char*)EW; const char* ASc = (const char*)AS;
#define SC_LD(base, j) (*(const GAS bf16*)((base) + (long)(j) * ostepb + ob0))
    const long jm1 = vm1 ? -1 : 0;
    float km = bf1(SC_LD(ZKc, jm1)), kc = bf1(SC_LD(ZKc, 0)), vm = bf1(SC_LD(ZVc, jm1)), vc = bf1(SC_LD(ZVc, 0)), rm = bf1(SC_LD(ZRc, jm1)), rc = bf1(SC_LD(ZRc, 0));
    km = vm1 ? km : 0.f; vm = vm1 ? vm : 0.f; rm = vm1 ? rm : 0.f;
    bf16 gk[2][8], gv[2][8], gr[2][8], ge[2][8], ga[2][8];
#define SC_LOADG(g, bu) do { _Pragma("unroll") for (int jj = 0; jj < 8; ++jj) { const int j = 8 * (g) + jj; \
        const bool vn = (j + 1 < SC_C) || vp32; const long jn = vn ? (j + 1) : j; const bf16 tk_ = SC_LD(ZKc, jn), tv_ = SC_LD(ZVc, jn), tr_ = SC_LD(ZRc, jn); \
        gk[bu][jj] = vn ? tk_ : (bf16)0; gv[bu][jj] = vn ? tv_ : (bf16)0; gr[bu][jj] = vn ? tr_ : (bf16)0; \
        ge[bu][jj] = SC_LD(EWc, j); ga[bu][jj] = SC_LD(ASc, j); } } while (0)
    SC_LOADG(0, 0);
    asm volatile("" ::: "memory");
#pragma unroll
    for (int g = 0; g < 4; ++g) {
        if (g < 3) SC_LOADG(g + 1, (g + 1) & 1);
#pragma unroll
        for (int jj = 0; jj < 8; jj += 2) {
            float va[2], vb[2], vk[2], vv[2];
#pragma unroll
            for (int u = 0; u < 2; ++u) {
                const int i = 8 * g + jj + u;
                const float kp = bf1(gk[g & 1][jj + u]), vp = bf1(gv[g & 1][jj + u]), rp = bf1(gr[g & 1][jj + u]);
                const float k = cwk_m * km + cw[4] * kc + cwk_p * kp, v = cwv_m * vm + cw[7] * vc + cwv_p * vp, r = cwr_m * rm + cwr_c * rc + cwr_p * rp;
                km = kc; kc = kp; vm = vc; vc = vp; rm = rc; rc = rp;
                const float a = bf1(ga[g & 1][jj + u]), ew = bf1(ge[g & 1][jj + u]), w = __expf(-ew);
                const float kkv = k * kkp, ss = wave_sum(kkv * kkv), kk = kkv * __builtin_amdgcn_rsqf(fmaxf(ss, 1e-24f));
                const float kmod = k * (1.0f + (a - 1.0f) * kap);
                const float Pprev = P; P *= w; const float invP = __builtin_amdgcn_rcpf(P);
                const float at = -kk * Pprev, bt = kk * a * invP, kt = kmod * invP, rt = r * P;
                *(LAS bf16*)(mA + i * SC_PITCH + 2 * lane) = (bf16)(pkbf(at, 0.f) & 0xffffu); *(LAS bf16*)(mB + i * SC_PITCH + 2 * lane) = (bf16)(pkbf(bt, 0.f) & 0xffffu);
                *(LAS bf16*)(mK + i * SC_PITCH + 2 * lane) = (bf16)(pkbf(kt, 0.f) & 0xffffu); *(LAS bf16*)(mR + i * SC_PITCH + 2 * lane) = (bf16)(pkbf(rt, 0.f) & 0xffffu);
                va[u] = at; vb[u] = bt; vk[u] = kt; vv[u] = v;
            }
            const int p = 4 * g + (jj >> 1);
            pa[p] = pkbf(va[0], va[1]); pb[p] = pkbf(vb[0], vb[1]); pk[p] = pkbf(vk[0], vk[1]); pv[p] = pkbf(vv[0], vv[1]);
        }
        asm volatile("" ::: "memory");
    }
#undef SC_LOADG
#undef SC_LD
    pcs[lane] = P;
    const float pc_o = __shfl_xor(P, 32); const float pcn0 = hi ? pc_o : P, pcn1 = hi ? P : pc_o;
    bf16x8 fA[2][2], fB[2][2], fK[2][2], fV[2][2];
    chan_to_frags(pa, hi, fA); chan_to_frags(pb, hi, fB); chan_to_frags(pk, hi, fK); chan_to_frags(pv, hi, fV);
    LDS_WAIT(); asm volatile("" ::: "memory");
    __builtin_amdgcn_sched_barrier(0);
    lane = launder(lane_in); l32 = lane & 31; hi = lane >> 5;
    f32x16 X = zero16(), XT = zero16(), LakT = zero16(), MrbT = zero16(), MrkT = zero16();
    const int roff = l32 * SC_PITCH + 16 * hi;
#pragma unroll
    for (int ks = 0; ks < 4; ++ks) {
        const bf16x8 ga = *(const LAS bf16x8*)(mA + roff + 32 * ks), gb = *(const LAS bf16x8*)(mB + roff + 32 * ks), gk = *(const LAS bf16x8*)(mK + roff + 32 * ks), gr = *(const LAS bf16x8*)(mR + roff + 32 * ks);
        X = MF(ga, gb, X); XT = MF(gb, ga, XT); LakT = MF(gk, ga, LakT); MrbT = MF(gb, gr, MrbT); MrkT = MF(gk, gr, MrkT);
    }
    f32x16 TmT;
#pragma unroll
    for (int r = 0; r < 16; ++r) { const int row = crow_(r, hi);
        X[r] = (l32 < row) ? X[r] : 0.f; XT[r] = (row < l32) ? XT[r] : 0.f; LakT[r] = (row < l32) ? LakT[r] : 0.f;
        MrbT[r] = (row <= l32) ? MrbT[r] : 0.f; MrkT[r] = (row <= l32) ? MrkT[r] : 0.f; TmT[r] = XT[r] + ((row == l32) ? 1.0f : 0.f); }
    const bf16x8 la0 = packacc(LakT, 0), la1 = packacc(LakT, 1), rb0 = packacc(MrbT, 0), rb1 = packacc(MrbT, 1), rk0 = packacc(MrkT, 0), rk1 = packacc(MrkT, 1);
    __builtin_amdgcn_sched_barrier(0);
#pragma unroll
    for (int it = 0; it < 4; ++it) {
        const bf16x8 x0 = packacc(X, 0), x1 = packacc(X, 1), y0 = packacc(XT, 0), y1 = packacc(XT, 1), t0 = packacc(TmT, 0), t1 = packacc(TmT, 1);
        f32x16 Xn = zero16(), XnT = zero16();
        Xn = MF(y0, x0, Xn); Xn = MF(y1, x1, Xn); XnT = MF(x0, y0, XnT); XnT = MF(x1, y1, XnT);
        const bf16x8 n0 = packacc(Xn, 0), n1 = packacc(Xn, 1);
        TmT = MF(n0, t0, TmT); TmT = MF(n1, t1, TmT);
        X = Xn; XT = XnT;
    }
    __builtin_amdgcn_sched_barrier(0);
    const bf16x8 tt0 = packacc(TmT, 0), tt1 = packacc(TmT, 1);
    f32x16 W[2], Ut[2];
#pragma unroll
    for (int ct = 0; ct < 2; ++ct) { f32x16 w = zero16(); w = MF(tt0, fA[ct][0], w); w = MF(tt1, fA[ct][1], w); W[ct] = w;
        f32x16 x1 = zero16(); x1 = MF(la0, fV[ct][0], x1); x1 = MF(la1, fV[ct][1], x1);
        f32x16 u = zero16(); u = MF(tt0, packacc(x1, 0), u); u = MF(tt1, packacc(x1, 1), u); Ut[ct] = u; }
    bf16x8 fW[2][2], fU[2][2];
#pragma unroll
    for (int ct = 0; ct < 2; ++ct) { fW[ct][0] = packacc(W[ct], 0); fW[ct][1] = packacc(W[ct], 1); fU[ct][0] = packacc(Ut[ct], 0); fU[ct][1] = packacc(Ut[ct], 1); }
    __builtin_amdgcn_sched_barrier(0);
    lane = launder(lane_in); l32 = lane & 31; hi = lane >> 5;
#pragma unroll
    for (int kt = 0; kt < 2; ++kt) { f32x16 acc;
#pragma unroll
        for (int r4 = 0; r4 < 4; ++r4) { const v2u rr = *(const LAS v2u*)(mR + l32 * SC_PITCH + 2 * (32 * kt + 8 * r4 + 4 * hi));
            acc[4 * r4] = bflo(rr.x); acc[4 * r4 + 1] = bfhi(rr.x); acc[4 * r4 + 2] = bflo(rr.y); acc[4 * r4 + 3] = bfhi(rr.y); }
        acc = MF(fW[kt][0], rb0, acc); acc = MF(fW[kt][1], rb1, acc);
        *(GAS bf16x8*)(xo + 16384 + (kt * 2 + 0) * 1024 + lane * 16) = packacc(acc, 0); *(GAS bf16x8*)(xo + 16384 + (kt * 2 + 1) * 1024 + lane * 16) = packacc(acc, 1); }
#pragma unroll
    for (int vt = 0; vt < 2; ++vt) { f32x16 acc = zero16();
        acc = MF(rb0, fU[vt][0], acc); acc = MF(rb1, fU[vt][1], acc); acc = MF(rk0, fV[vt][0], acc); acc = MF(rk1, fV[vt][1], acc);
        st_acc_bf16(xo + 20480 + vt * 2048 + lane * 32, acc); }
    __builtin_amdgcn_sched_barrier(0);
    lane = launder(lane_in); l32 = lane & 31; hi = lane >> 5;
#pragma unroll
    for (int kt = 0; kt < 2; ++kt)
#pragma unroll
        for (int nt = 0; nt < 2; ++nt) { f32x16 acc = zero16(); acc = MF(fW[kt][0], fB[nt][0], acc); acc = MF(fW[kt][1], fB[nt][1], acc);
            const float pc = nt ? pcn1 : pcn0;
#pragma unroll
            for (int r = 0; r < 16; ++r) acc[r] = (acc[r] + ((kt == nt && crow_(r, hi) == l32) ? 1.0f : 0.f)) * pc;
            *(GAS bf16x8*)(xo + ((kt * 2 + nt) * 2 + 0) * 1024 + lane * 16) = packacc(acc, 0); *(GAS bf16x8*)(xo + ((kt * 2 + nt) * 2 + 1) * 1024 + lane * 16) = packacc(acc, 1); }
    __builtin_amdgcn_sched_barrier(0);
    lane = launder(lane_in); l32 = lane & 31; hi = lane >> 5;
#pragma unroll
    for (int kt = 0; kt < 2; ++kt)
#pragma unroll
        for (int vt = 0; vt < 2; ++vt) { f32x16 acc = zero16();
            acc = MF(fB[kt][0], fU[vt][0], acc); acc = MF(fB[kt][1], fU[vt][1], acc); acc = MF(fK[kt][0], fV[vt][0], acc); acc = MF(fK[kt][1], fV[vt][1], acc);
#pragma unroll
            for (int r4 = 0; r4 < 4; ++r4) { const f32x4 pr = *(const LAS f32x4*)(pcs + 32 * kt + 8 * r4 + 4 * hi);
                acc[4 * r4] *= pr.x; acc[4 * r4 + 1] *= pr.y; acc[4 * r4 + 2] *= pr.z; acc[4 * r4 + 3] *= pr.w; }
            st_acc_bf16(xo + 8192 + (kt * 2 + vt) * 2048 + lane * 32, acc); }
    LDS_WAIT();
}
__device__ __forceinline__ void scan_consume(unsigned char* ws, int b, int h, int dir, int chunk, const unsigned char* xi, int lane, f32x16 (&H)[2][2]) {
    const int l32 = lane & 31, hi = lane >> 5;
    bf16x8 hb[2][2][2];
#pragma unroll
    for (int kt = 0; kt < 2; ++kt)
#pragma unroll
        for (int vt = 0; vt < 2; ++vt) { hb[kt][vt][0] = packacc(H[kt][vt], 0); hb[kt][vt][1] = packacc(H[kt][vt], 1); }
    if (chunk >= LC / SC_C) {
        bf16x8 rf[2][2];
#pragma unroll
        for (int kt = 0; kt < 2; ++kt)
#pragma unroll
            for (int s2 = 0; s2 < 2; ++s2) rf[kt][s2] = *(const GAS bf16x8*)(xi + 16384 + (kt * 2 + s2) * 1024 + lane * 16);
        bf16* Y = (bf16*)(ws + (dir ? WS_YB : WS_YF)); const int n0 = chunk * SC_C - LC;
#pragma unroll
        for (int vt = 0; vt < 2; ++vt) { f32x16 acc = ld_acc_bf16(xi + 20480 + vt * 2048 + lane * 32);
#pragma unroll
            for (int kt = 0; kt < 2; ++kt) { acc = MF(rf[kt][0], hb[kt][vt][0], acc); acc = MF(rf[kt][1], hb[kt][vt][1], acc); }
#pragma unroll
            for (int r = 0; r < 16; ++r) { const int i = crow_(r, hi), tk = dir ? (SEQ - 1 - (n0 + i)) : (n0 + i);
                Y[((size_t)b * SEQ + tk) * 512 + h * 64 + 32 * vt + l32] = (bf16)(pkbf(acc[r], 0.f) & 0xffffu); } }
    }
    f32x16 Hn[2][2];
#pragma unroll
    for (int nt = 0; nt < 2; ++nt)
#pragma unroll
        for (int vt = 0; vt < 2; ++vt) Hn[nt][vt] = ld_acc_bf16(xi + 8192 + (nt * 2 + vt) * 2048 + lane * 32);
#pragma unroll
    for (int kt = 0; kt < 2; ++kt)
#pragma unroll
        for (int nt = 0; nt < 2; ++nt) { const bf16x8 g0 = *(const GAS bf16x8*)(xi + ((kt * 2 + nt) * 2 + 0) * 1024 + lane * 16), g1 = *(const GAS bf16x8*)(xi + ((kt * 2 + nt) * 2 + 1) * 1024 + lane * 16);
#pragma unroll
            for (int vt = 0; vt < 2; ++vt) { Hn[nt][vt] = MF(g0, hb[kt][vt][0], Hn[nt][vt]); Hn[nt][vt] = MF(g1, hb[kt][vt][1], Hn[nt][vt]); } }
#pragma unroll
    for (int nt = 0; nt < 2; ++nt)
#pragma unroll
        for (int vt = 0; vt < 2; ++vt) H[nt][vt] = Hn[nt][vt];
}
__device__ __forceinline__ void p4b_scan(Frame& F) {
    const int wave = F.wave, lane = F.lane;
    const bool is_cons = wave < 2; const int pw = wave - 2;
    unsigned char* xch = F.ws + WS_XCH + (size_t)blockIdx.x * (2 * SC_SLOT_BYTES);
    LAS unsigned char* pl = F.lds + (is_cons ? 0 : pw) * SC_PLDS;
    for (int task = blockIdx.x; task < NB * 8; task += F.G) {
        const int b = task >> 3, h = task & 7; const int pdir = is_cons ? wave : pw / SC_RP, pci = is_cons ? 0 : pw % SC_RP;
        const float* conv = karg_in(I_CONV); const float* kkpp = karg_in(I_KK); const float* kapp = karg_in(I_KA);
#define SC_SYNC() do { asm volatile("s_waitcnt vmcnt(0) lgkmcnt(0)" ::: "memory"); __builtin_amdgcn_s_barrier(); asm volatile("" ::: "memory"); } while (0)
        if (is_cons) {
            f32x16 H[2][2];
#pragma unroll
            for (int i = 0; i < 2; ++i)
#pragma unroll
                for (int j = 0; j < 2; ++j) H[i][j] = zero16();
#pragma unroll 1
            for (int q = -1; q < SC_ROUNDS; ++q) {
                if (q >= 0) { __builtin_amdgcn_fence(__ATOMIC_ACQUIRE, "agent");
#pragma unroll 1
                    for (int i = 0; i < SC_RP; ++i) scan_consume(F.ws, b, h, wave, q * SC_RP + i, xch + (size_t)(q & 1) * SC_SLOT_BYTES + (size_t)(wave * SC_RP + i) * SC_TASK_BYTES, lane, H); }
                SC_SYNC();
            }
        } else {
#pragma unroll 1
            for (int q = -1; q < SC_ROUNDS; ++q) {
                if (q + 1 < SC_ROUNDS) scan_produce(F.ws, b, h, pdir, (q + 1) * SC_RP + pci, pl, xch + (size_t)((q + 1) & 1) * SC_SLOT_BYTES + (size_t)(pdir * SC_RP + pci) * SC_TASK_BYTES, lane, conv, kkpp, kapp);
                SC_SYNC();
            }
        }
#undef SC_SYNC
    }
}
#undef MF

__device__ __forceinline__ void p5_rwkv_out(Frame& F) {
    const int gw = blockIdx.x * NWAVES + F.wave, NGW = F.G * NWAVES, lane = F.lane, c0 = 8 * lane;
    const bf16* ZK = (const bf16*)(F.ws + WS_ZK); const bf16* ZV = (const bf16*)(F.ws + WS_ZV); const bf16* ZR = (const bf16*)(F.ws + WS_ZR);
    const bf16* AS0 = (const bf16*)(F.ws + WS_AS); const bf16* AS1 = AS0 + (size_t)NTOK * 512;
    const bf16* YF = (const bf16*)(F.ws + WS_YF); const bf16* YB = (const bf16*)(F.ws + WS_YB); const bf16* G = (const bf16*)(F.ws + WS_G);
    bf16* ORW = (bf16*)(F.ws + WS_ORW);
    LAS float* PL = (LAS float*)F.lds;
    { const float* convg = karg_in(I_CONV); const float* kag = karg_in(I_KA); const float* rkg = karg_in(I_RK); const float* lnwg = karg_in(I_LNW); const float* lnbg = karg_in(I_LNB);
      for (int i = F.tid; i < 15 * 512; i += 512) { const int row = i >> 9, c = i & 511; float v;
          if (row < 9) v = convg[(row % 3) * 1536 + (row / 3) * 512 + c]; else if (row < 11) v = kag[(row - 9) * 512 + c]; else if (row < 13) v = rkg[(row - 11) * 512 + c]; else if (row == 13) v = lnwg[c]; else v = lnbg[c];
          PL[i] = v; }
      __syncthreads(); }
    const LAS float* conv = PL; const LAS float* ka = PL + 9 * 512; const LAS float* rk = PL + 11 * 512; const LAS float* lnw = PL + 13 * 512; const LAS float* lnb = PL + 14 * 512;
    for (int m0 = gw; m0 < NLAT; m0 += 2 * NGW) {
        v4u raw[2][14];
        const v4u z4 = (v4u){0u, 0u, 0u, 0u};
#pragma unroll
        for (int rr = 0; rr < 2; ++rr) { const int m = min(m0 + rr * NGW, NLAT - 1);
            const int t = m & 2047; const bool first = t == 0, last = t == SEQ - 1; const size_t o = (size_t)m * 512 + c0;
            const size_t om = first ? o : o - 512, op = last ? o : o + 512;
#pragma unroll
            for (int which = 0; which < 3; ++which) { const bf16* Z = which == 0 ? ZR : (which == 1 ? ZK : ZV);
                const v4u ra = *(const GAS v4u*)(Z + om), rc_ = *(const GAS v4u*)(Z + op);
                raw[rr][3 * which] = first ? z4 : ra; raw[rr][3 * which + 1] = *(const GAS v4u*)(Z + o); raw[rr][3 * which + 2] = last ? z4 : rc_; }
            raw[rr][9] = *(const GAS v4u*)(AS0 + o); raw[rr][10] = *(const GAS v4u*)(AS1 + o); raw[rr][11] = *(const GAS v4u*)(YF + o); raw[rr][12] = *(const GAS v4u*)(YB + o); raw[rr][13] = *(const GAS v4u*)(G + o); }
#pragma unroll
        for (int rr = 0; rr < 2; ++rr) { const int m = m0 + rr * NGW; if (m >= NLAT) continue;
            const size_t o = (size_t)m * 512 + c0;
            float r[8], k[8], v[8], tmp[8];
            asm volatile("" ::: "memory");
#pragma unroll
            for (int which = 0; which < 3; ++which) { float (&dst)[8] = which == 0 ? r : (which == 1 ? k : v);
                asm volatile("" ::: "memory");
                float fa[8], fb[8], fc[8]; unpack8(raw[rr][3 * which], fa); unpack8(raw[rr][3 * which + 1], fb); unpack8(raw[rr][3 * which + 2], fc);
                const LAS float* cwp = conv + (3 * which) * 512 + c0;
#pragma unroll
                for (int j = 0; j < 8; ++j) dst[j] = cwp[j] * fa[j] + cwp[512 + j] * fb[j] + cwp[1024 + j] * fc[j]; }
            asm volatile("" ::: "memory");
            float a0[8], a1[8]; unpack8(raw[rr][9], a0); unpack8(raw[rr][10], a1);
            float s = 0.f;
#pragma unroll
            for (int j = 0; j < 8; ++j) { const float km0 = k[j] * (1.0f + (a0[j] - 1.0f) * ka[c0 + j]), km1 = k[j] * (1.0f + (a1[j] - 1.0f) * ka[512 + c0 + j]);
                s += r[j] * (km0 * rk[c0 + j] + km1 * rk[512 + c0 + j]); }
            s += __shfl_xor(s, 1); s += __shfl_xor(s, 2); s += __shfl_xor(s, 4);
            asm volatile("" ::: "memory");
            float y[8], yb[8]; unpack8(raw[rr][11], y); unpack8(raw[rr][12], yb);
            float sm = 0.f;
#pragma unroll
            for (int j = 0; j < 8; ++j) { y[j] += yb[j]; sm += y[j]; }
            sm += __shfl_xor(sm, 1); sm += __shfl_xor(sm, 2); sm += __shfl_xor(sm, 4);
            const float mean = sm * (1.f / 64.f); float sq = 0.f;
#pragma unroll
            for (int j = 0; j < 8; ++j) { y[j] -= mean; sq += y[j] * y[j]; }
            sq += __shfl_xor(sq, 1); sq += __shfl_xor(sq, 2); sq += __shfl_xor(sq, 4);
            const float rstd = __builtin_amdgcn_rsqf(sq * (1.f / 64.f) + 64e-5f);
            float gg[8]; unpack8(raw[rr][13], gg);
#pragma unroll
            for (int j = 0; j < 8; ++j) tmp[j] = (y[j] * rstd * lnw[c0 + j] + lnb[c0 + j] + s * v[j]) * gg[j];
            *(GAS v4u*)(ORW + o) = pack8(tmp); }
    }
}

struct EpiMerge {
    static constexpr bool PERM = true, AFTER_DRAIN = false;
    bf16* merged; const bf16* gates; int goff; int first;
    __device__ __forceinline__ void operator()(const f32x4 (&acc)[2][2][4][2], const Unit& u, int wr, int wc, int fr, int fq) const {
        const int row0 = u.pm * 256 + wr * 64 + fr, col0 = u.pn * 256 + wc * 32 + 8 * fq;
#pragma unroll
        for (int ai = 0; ai < 2; ++ai)
#pragma unroll
            for (int m = 0; m < 4; ++m) { const size_t row = (size_t)(row0 + ai * 128 + m * 16);
#pragma unroll
                for (int bj = 0; bj < 2; ++bj) { const int col = col0 + bj * 128;
                    float gt[8]; unpack8(*(const GAS v4u*)(gates + row * 2048 + goff + col), gt);
                    const f32x4 v0 = acc[ai][bj][m][0], v1 = acc[ai][bj][m][1];
                    float o[8] = {v0.x * gt[0], v0.y * gt[1], v0.z * gt[2], v0.w * gt[3], v1.x * gt[4], v1.y * gt[5], v1.z * gt[6], v1.w * gt[7]};
                    GAS v4u* p = (GAS v4u*)(merged + row * 1024 + col);
                    if (!first) { float pv[8]; unpack8(*p, pv);
#pragma unroll
                        for (int j = 0; j < 8; ++j) o[j] += pv[j]; }
                    *p = pack8(o); } }
    }
};
struct EpiMerge2 {
    static constexpr bool PERM = true, AFTER_DRAIN = false;
    bf16* merged; const bf16* gates;
    __device__ __forceinline__ void mid(f32x4 (&acc)[2][2][4][2], const Unit& u, int wr, int wc, int fr, int fq) const {
        const int row0 = u.pm * 256 + wr * 64 + fr, col0 = u.pn * 256 + wc * 32 + 8 * fq;
#pragma unroll
        for (int ai = 0; ai < 2; ++ai)
#pragma unroll
            for (int m = 0; m < 4; ++m) { const size_t row = (size_t)(row0 + ai * 128 + m * 16);
#pragma unroll
                for (int bj = 0; bj < 2; ++bj) { const int col = col0 + bj * 128;
                    float gr[8], ga[8]; unpack8(*(const GAS v4u*)(gates + row * 2048 + col), gr); unpack8(*(const GAS v4u*)(gates + row * 2048 + 1024 + col), ga);
                    float q[8];
#pragma unroll
                    for (int j = 0; j < 8; ++j) q[j] = gr[j] * __builtin_amdgcn_rcpf(fmaxf(ga[j], 1e-30f));
                    acc[ai][bj][m][0] *= (f32x4){q[0], q[1], q[2], q[3]}; acc[ai][bj][m][1] *= (f32x4){q[4], q[5], q[6], q[7]}; } }
    }
    __device__ __forceinline__ void operator()(const f32x4 (&acc)[2][2][4][2], const Unit& u, int wr, int wc, int fr, int fq) const {
        const int row0 = u.pm * 256 + wr * 64 + fr, col0 = u.pn * 256 + wc * 32 + 8 * fq;
#pragma unroll
        for (int ai = 0; ai < 2; ++ai)
#pragma unroll
            for (int m = 0; m < 4; ++m) { const size_t row = (size_t)(row0 + ai * 128 + m * 16);
#pragma unroll
                for (int bj = 0; bj < 2; ++bj) { const int col = col0 + bj * 128;
                    float ga[8]; unpack8(*(const GAS v4u*)(gates + row * 2048 + 1024 + col), ga);
                    const f32x4 v0 = acc[ai][bj][m][0], v1 = acc[ai][bj][m][1];
                    float o[8] = {v0.x * fmaxf(ga[0], 1e-30f), v0.y * fmaxf(ga[1], 1e-30f), v0.z * fmaxf(ga[2], 1e-30f), v0.w * fmaxf(ga[3], 1e-30f),
                                  v1.x * fmaxf(ga[4], 1e-30f), v1.y * fmaxf(ga[5], 1e-30f), v1.z * fmaxf(ga[6], 1e-30f), v1.w * fmaxf(ga[7], 1e-30f)};
                    *(GAS v4u*)(merged + row * 1024 + col) = pack8(o); } }
    }
};
struct EpiOutproj {
    static constexpr bool PERM = true, AFTER_DRAIN = false;
    bf16* delta; const float* mod;
    __device__ __forceinline__ void operator()(const f32x4 (&acc)[2][2][4][2], const Unit& u, int wr, int wc, int fr, int fq) const {
        const int row0 = u.pm * 256 + wr * 64 + fr, col0 = u.pn * 256 + wc * 32 + 8 * fq; const int b = u.pm >> 3;
        f32x4 gv[2][2];
#pragma unroll
        for (int bj = 0; bj < 2; ++bj)
#pragma unroll
            for (int n = 0; n < 2; ++n) gv[bj][n] = *(const f32x4*)(mod + (size_t)b * 6144 + 2048 + col0 + bj * 128 + 4 * n);
#pragma unroll
        for (int ai = 0; ai < 2; ++ai)
#pragma unroll
            for (int m = 0; m < 4; ++m) { const size_t off = (size_t)(row0 + ai * 128 + m * 16) * 1024 + col0;
#pragma unroll
                for (int bj = 0; bj < 2; ++bj) { const f32x4 v0 = gv[bj][0] * acc[ai][bj][m][0], v1 = gv[bj][1] * acc[ai][bj][m][1];
                    v4u w; w.x = pkbf(v0.x, v0.y); w.y = pkbf(v0.z, v0.w); w.z = pkbf(v1.x, v1.y); w.w = pkbf(v1.z, v1.w);
                    *(GAS v4u*)(delta + off + bj * 128) = w; } }
    }
};

constexpr int RW_PITCH = 2064;
__device__ __forceinline__ void p8_norm2_router(Frame& F) {
    LAS unsigned char* rhi = F.lds; LAS unsigned char* rlo = F.lds + 32 * RW_PITCH;
    const float* rw = karg_in(I_ROUTER);
    for (int i = F.tid; i < 16384; i += 512) { const int e = i & 15, k = i >> 4; const float w = rw[i]; const unsigned h = pkbf(w, 0.f) & 0xffffu; const float wl = w - __uint_as_float(h << 16);
        *(LAS bf16*)(rhi + e * RW_PITCH + 2 * k) = (bf16)h; *(LAS bf16*)(rlo + e * RW_PITCH + 2 * k) = (bf16)(pkbf(wl, 0.f) & 0xffffu); }
    for (int i = F.tid; i < 16 * 1024 / 2; i += 512) { const int e = 16 + i / 512, k2 = i % 512; *(LAS unsigned*)(rhi + e * RW_PITCH + 4 * k2) = 0u; *(LAS unsigned*)(rlo + e * RW_PITCH + 4 * k2) = 0u; }
    __syncthreads();
    const int gw = blockIdx.x * NWAVES + F.wave, NGW = F.G * NWAVES, lane = F.lane, l32 = lane & 31, hi = lane >> 5;
    const float* mod = (const float*)(F.ws + WS_MOD); bf16* H2 = (bf16*)(F.ws + WS_H2); float* AFF = (float*)(F.ws + WS_AFF);
    const float* g2 = karg_in(I_N2G); const float* Xp = karg_in(I_X); const bf16* DELTA = (const bf16*)(F.ws + WS_DELTA);
    f32x4 gv[4];
#pragma unroll
    for (int j = 0; j < 4; ++j) gv[j] = *(const f32x4*)(g2 + 4 * lane + 256 * j);
    for (int tile = gw; tile < NLAT / 32; tile += NGW) {
        const int mbase = tile * 32, b = mbase >> 11; const float* sh = mod + (size_t)b * 6144 + 3072; const float* sc = sh + 1024;
        f32x4 av[4], bv[4];
#pragma unroll
        for (int j = 0; j < 4; ++j) { av[j] = *(const f32x4*)(sc + 4 * lane + 256 * j) + 1.0f; bv[j] = *(const f32x4*)(sh + 4 * lane + 256 * j); }
#pragma unroll 1
        for (int r0 = 0; r0 < 32; r0 += 4) {
            f32x4 v[4][4];
#pragma unroll
            for (int r = 0; r < 4; ++r) { const float* xr = Xp + (size_t)(mbase + r0 + r) * DM; const bf16* dr = DELTA + (size_t)(mbase + r0 + r) * DM;
#pragma unroll
                for (int j = 0; j < 4; ++j) { const v2u d = *(const GAS v2u*)(dr + 4 * lane + 256 * j);
                    v[r][j] = *(const GAS f32x4*)(xr + 4 * lane + 256 * j) + (f32x4){bflo(d.x), bfhi(d.x), bflo(d.y), bfhi(d.y)}; } }
#pragma unroll
            for (int r = 0; r < 4; ++r) { float s = 0.f;
#pragma unroll
                for (int j = 0; j < 4; ++j) s += (v[r][j].x * v[r][j].x + v[r][j].y * v[r][j].y) + (v[r][j].z * v[r][j].z + v[r][j].w * v[r][j].w);
                const float rstd = __builtin_amdgcn_rsqf(wave_sum(s) * (1.f / DM) + 1e-6f);
#pragma unroll
                for (int j = 0; j < 4; ++j) { const f32x4 y = v[r][j] * rstd * gv[j] * av[j] + bv[j];
                    v2u o; o.x = pkbf(y.x, y.y); o.y = pkbf(y.z, y.w);
                    *(GAS v2u*)(H2 + (size_t)(mbase + r0 + r) * DM + 4 * lane + 256 * j) = o; } }
        }
        asm volatile("s_waitcnt vmcnt(0)" ::: "memory");
        f32x16 acc;
#pragma unroll
        for (int r = 0; r < 16; ++r) acc[r] = 0.f;
        const bf16* hrow = H2 + (size_t)(mbase + l32) * DM + 8 * hi;
        const LAS unsigned char* ah = rhi + l32 * RW_PITCH + 16 * hi; const LAS unsigned char* al = rlo + l32 * RW_PITCH + 16 * hi;
#pragma unroll 8
        for (int ks = 0; ks < 64; ++ks) { const bf16x8 bf = *(const GAS bf16x8*)(hrow + 16 * ks);
            const bf16x8 fh = *(const LAS bf16x8*)(ah + 32 * ks), fl = *(const LAS bf16x8*)(al + 32 * ks);
            acc = __builtin_amdgcn_mfma_f32_32x32x16_bf16(fh, bf, acc, 0, 0, 0); acc = __builtin_amdgcn_mfma_f32_32x32x16_bf16(fl, bf, acc, 0, 0, 0); }
        float mx = acc[0];
#pragma unroll
        for (int r = 1; r < 8; ++r) mx = fmaxf(mx, acc[r]);
        mx = fmaxf(mx, __shfl_xor(mx, 32));
        float pe[8], den = 0.f;
#pragma unroll
        for (int r = 0; r < 8; ++r) { pe[r] = __expf(acc[r] - mx); den += pe[r]; }
        den += __shfl_xor(den, 32);
        const float inv = 1.0f / den; const int t = (mbase & 2047) + l32;
#pragma unroll
        for (int r = 0; r < 8; ++r) { const int e = (r & 3) + 8 * (r >> 2) + 4 * hi; AFF[((size_t)b * 16 + e) * SEQ + t] = pe[r] * inv; }
    }
}

__device__ __forceinline__ int block_count(Frame& F, LAS int* wc, int slot, bool p0, bool p1, bool p2, bool p3) {
    const int c = __builtin_popcountll(__ballot(p0)) + __builtin_popcountll(__ballot(p1)) + __builtin_popcountll(__ballot(p2)) + __builtin_popcountll(__ballot(p3));
    if (F.lane == 0) wc[slot * 8 + F.wave] = c;
    __syncthreads();
    int s = 0;
#pragma unroll
    for (int w = 0; w < 8; ++w) s += wc[slot * 8 + w];
    return s;
}
__device__ __forceinline__ void p9_topk_gather(Frame& F) {
    LAS int* wc = (LAS int*)F.lds;
    LAS int* sel = (LAS int*)(F.lds + 1024);
    const float* AFF = (const float*)(F.ws + WS_AFF); int* IDX = (int*)(F.ws + WS_IDX); float* VAL = (float*)(F.ws + WS_VAL);
    const bf16* H2 = (const bf16*)(F.ws + WS_H2); bf16* XE = (bf16*)(F.ws + WS_XE); int* INV = (int*)(F.ws + WS_INV);
    const int tid = F.tid, lane = F.lane, wave = F.wave;
    for (int p = blockIdx.x; p < NB * NE; p += F.G) {
        const int b = p >> 4, e = p & 15;
        const f32x4 av = *(const GAS f32x4*)(AFF + (size_t)p * SEQ + 4 * tid);
        const unsigned u0 = __float_as_uint(av.x), u1 = __float_as_uint(av.y), u2 = __float_as_uint(av.z), u3 = __float_as_uint(av.w);
        unsigned tau = 0u; int it = 0;
        for (int bit = 30; bit >= 0; --bit, ++it) { const unsigned cand = tau | (1u << bit);
            const int cnt = block_count(F, wc, it & 1, u0 >= cand, u1 >= cand, u2 >= cand, u3 >= cand);
            if (cnt >= CAP) tau = cand; }
        const int cgt = block_count(F, wc, it & 1, u0 > tau, u1 > tau, u2 > tau, u3 > tau); ++it;
        const int need_eq = CAP - cgt;
        const int ngt = (u0 > tau) + (u1 > tau) + (u2 > tau) + (u3 > tau), neq = (u0 == tau) + (u1 == tau) + (u2 == tau) + (u3 == tau);
        int pk = ngt | (neq << 16), inc = pk;
#pragma unroll
        for (int o = 1; o < 64; o <<= 1) { const int nb = __shfl_up(inc, o); if (lane >= o) inc += nb; }
        if (lane == 63) wc[16 + wave] = inc;
        __syncthreads();
        int base = 0;
#pragma unroll
        for (int w = 0; w < 8; ++w) base += (w < wave) ? wc[16 + w] : 0;
        int ex = base + inc - pk; int gpos = ex & 0xffff, epos = ex >> 16;
        const unsigned uu[4] = {u0, u1, u2, u3}; const float ff[4] = {av.x, av.y, av.z, av.w};
#pragma unroll
        for (int j = 0; j < 4; ++j) { int slot = -1;
            if (uu[j] > tau) { slot = gpos; ++gpos; } else if (uu[j] == tau) { if (epos < need_eq) slot = cgt + epos; ++epos; }
            if (slot >= 0) { IDX[(size_t)(e * NB + b) * CAP + slot] = 4 * tid + j; VAL[(size_t)(e * NB + b) * CAP + slot] = ff[j]; sel[slot] = 4 * tid + j; }
            INV[((size_t)b * SEQ + 4 * tid + j) * 16 + e] = slot; }
        __syncthreads();
#pragma unroll 1
        for (int s0 = wave * 8; s0 < CAP; s0 += 64) {
            v4u x0[8], x1[8];
#pragma unroll
            for (int r = 0; r < 8; ++r) { const int tok = sel[s0 + r]; const GAS v4u* src = (const GAS v4u*)(H2 + ((size_t)b * SEQ + tok) * DM); x0[r] = src[lane]; x1[r] = src[64 + lane]; }
#pragma unroll
            for (int r = 0; r < 8; ++r) { GAS v4u* dst = (GAS v4u*)(XE + ((size_t)(e * NB + b) * CAP + s0 + r) * DM); dst[lane] = x0[r]; dst[64 + lane] = x1[r]; } }
        __syncthreads();
    }
}

struct ExpertOrder {
    int G, c, upe, npn;
    __device__ void init(int G_, int c_, int npn_) { G = G_; c = c_; npn = npn_; upe = 32 * npn_; }
    __device__ bool next(int i, Unit& u) const { const long L = (long)i * G + c; if (L >= (long)NE * upe) return false;
        const int e = (int)(L / upe), rem = (int)(L % upe); u.pm = e * 32 + (rem & 31); u.pn = e * npn + (rem >> 5); return true; }
    __device__ __forceinline__ void a_ready(const Unit&) const {}
    __device__ __forceinline__ void done(const Unit&) const {}
};
struct EpiSwiglu {
    static constexpr bool PERM = true, AFTER_DRAIN = false;
    bf16* act;
    __device__ __forceinline__ void operator()(const f32x4 (&acc)[2][2][4][2], const Unit& u, int wr, int wc, int fr, int fq) const {
        const int e = u.pm >> 5, pnl = u.pn - 12 * e; const int row0 = u.pm * 256 + wr * 64 + fr, col = 128 * pnl + wc * 32 + 8 * fq;
#pragma unroll
        for (int ai = 0; ai < 2; ++ai)
#pragma unroll
            for (int m = 0; m < 4; ++m) { const f32x4 g0 = acc[ai][0][m][0], g1 = acc[ai][0][m][1], u0 = acc[ai][1][m][0], u1 = acc[ai][1][m][1];
                float o[8] = {g0.x * sigmoidf_(g0.x) * u0.x, g0.y * sigmoidf_(g0.y) * u0.y, g0.z * sigmoidf_(g0.z) * u0.z, g0.w * sigmoidf_(g0.w) * u0.w,
                              g1.x * sigmoidf_(g1.x) * u1.x, g1.y * sigmoidf_(g1.y) * u1.y, g1.z * sigmoidf_(g1.z) * u1.z, g1.w * sigmoidf_(g1.w) * u1.w};
                *(GAS v4u*)(act + (size_t)(row0 + ai * 128 + m * 16) * DFF + col) = pack8(o); }
    }
};
struct EpiDown {
    static constexpr bool PERM = true, AFTER_DRAIN = false;
    bf16* y2; const float* val;
    __device__ __forceinline__ void operator()(const f32x4 (&acc)[2][2][4][2], const Unit& u, int wr, int wc, int fr, int fq) const {
        const int e = u.pm >> 5, pnl = u.pn - 4 * e; const int srow0 = u.pm * 256 + wr * 64 + fr, col0 = pnl * 256 + wc * 32 + 8 * fq;
#pragma unroll
        for (int ai = 0; ai < 2; ++ai)
#pragma unroll
            for (int m = 0; m < 4; ++m) { const int srow = srow0 + ai * 128 + m * 16; const float vl = val[srow];
#pragma unroll
                for (int bj = 0; bj < 2; ++bj) { const f32x4 v0 = acc[ai][bj][m][0] * vl, v1 = acc[ai][bj][m][1] * vl;
                    v4u w; w.x = pkbf(v0.x, v0.y); w.y = pkbf(v0.z, v0.w); w.z = pkbf(v1.x, v1.y); w.w = pkbf(v1.z, v1.w);
                    *(GAS v4u*)(y2 + (size_t)srow * DM + col0 + bj * 128) = w; } }
    }
};
__device__ __forceinline__ void p12_combine(Frame& F, bool dostore = true) {
    const int gw = blockIdx.x * NWAVES + F.wave, NGW = F.G * NWAVES, lane = F.lane;
    const int* INV = (const int*)(F.ws + WS_INV); const bf16* Y2 = (const bf16*)(F.ws + WS_Y2); const float* mod = (const float*)(F.ws + WS_MOD);
    const float* Xp = karg_in(I_X); const bf16* DELTA = (const bf16*)(F.ws + WS_DELTA);
    for (int m0 = gw; m0 < NLAT; m0 += 2 * NGW) {
        int inv[2]; f32x4 xv[2][4];
#pragma unroll
        for (int r = 0; r < 2; ++r) { const int m = min(m0 + r * NGW, NLAT - 1);
            { const int iv = INV[(size_t)m * 16 + (lane & 15)]; inv[r] = lane < 16 ? iv : -1; const float* orow = Xp + (size_t)m * DM; const bf16* dr = DELTA + (size_t)m * DM;
                const v4u d0 = *(const GAS v4u*)(dr + 8 * lane), d1 = *(const GAS v4u*)(dr + 512 + 8 * lane);
                xv[r][0] = *(const GAS f32x4*)(orow + 8 * lane) + (f32x4){bflo(d0.x), bfhi(d0.x), bflo(d0.y), bfhi(d0.y)}; xv[r][1] = *(const GAS f32x4*)(orow + 8 * lane + 4) + (f32x4){bflo(d0.z), bfhi(d0.z), bflo(d0.w), bfhi(d0.w)};
                xv[r][2] = *(const GAS f32x4*)(orow + 512 + 8 * lane) + (f32x4){bflo(d1.x), bfhi(d1.x), bflo(d1.y), bfhi(d1.y)}; xv[r][3] = *(const GAS f32x4*)(orow + 512 + 8 * lane + 4) + (f32x4){bflo(d1.z), bfhi(d1.z), bflo(d1.w), bfhi(d1.w)}; } }
#pragma unroll
        for (int r = 0; r < 2; ++r) { const int m = m0 + r * NGW; if (m >= NLAT) continue;
            const int b = m >> 11; unsigned long long mk = __ballot(inv[r] >= 0);
            float a0[8] = {0.f, 0.f, 0.f, 0.f, 0.f, 0.f, 0.f, 0.f}, a1[8] = {0.f, 0.f, 0.f, 0.f, 0.f, 0.f, 0.f, 0.f};
            while (mk) {
                const int e = __builtin_ctzll(mk); mk &= mk - 1; const int slot = __builtin_amdgcn_readlane(inv[r], e);
                const bool two = mk != 0; int e2 = e, slot2 = slot; if (two) { e2 = __builtin_ctzll(mk); mk &= mk - 1; slot2 = __builtin_amdgcn_readlane(inv[r], e2); }
                const bf16* yr = Y2 + ((size_t)(e * NB + b) * CAP + slot) * DM; const bf16* yr2 = Y2 + ((size_t)(e2 * NB + b) * CAP + slot2) * DM;
                const v4u q0 = *(const GAS v4u*)(yr + 8 * lane), q1 = *(const GAS v4u*)(yr + 512 + 8 * lane), q2 = *(const GAS v4u*)(yr2 + 8 * lane), q3 = *(const GAS v4u*)(yr2 + 512 + 8 * lane);
                float f0[8], f1[8], f2[8], f3[8]; unpack8(q0, f0); unpack8(q1, f1); unpack8(q2, f2); unpack8(q3, f3);
                const float w2 = two ? 1.0f : 0.0f;
#pragma unroll
                for (int j = 0; j < 8; ++j) { a0[j] += f0[j] + w2 * f2[j]; a1[j] += f1[j] + w2 * f3[j]; }
            }
            float* orow = F.out + (size_t)m * DM; const float* g = mod + (size_t)b * 6144 + 5120;
            const f32x4 g0 = *(const f32x4*)(g + 8 * lane), g1 = *(const f32x4*)(g + 8 * lane + 4), g2 = *(const f32x4*)(g + 512 + 8 * lane), g3 = *(const f32x4*)(g + 512 + 8 * lane + 4);
            if (dostore) {
            *(GAS f32x4*)(orow + 8 * lane) = xv[r][0] + g0 * (f32x4){a0[0], a0[1], a0[2], a0[3]}; *(GAS f32x4*)(orow + 8 * lane + 4) = xv[r][1] + g1 * (f32x4){a0[4], a0[5], a0[6], a0[7]};
            *(GAS f32x4*)(orow + 512 + 8 * lane) = xv[r][2] + g2 * (f32x4){a1[0], a1[1], a1[2], a1[3]}; *(GAS f32x4*)(orow + 512 + 8 * lane + 4) = xv[r][3] + g3 * (f32x4){a1[4], a1[5], a1[6], a1[7]}; }
        }
    }
}

struct Args { const float* in[30]; float* out; unsigned char* ws; int ph_lo, ph_hi; };
__global__ void __launch_bounds__(NWAVES * 64, 2) mk_fwd(Args args) {
    extern __shared__ __attribute__((aligned(16))) unsigned char lds[];
    Frame F;
    F.lds = (LAS unsigned char*)lds; F.MISC = (volatile LAS unsigned*)(F.lds + MISC_OFF);
    F.tid = threadIdx.x; F.lane = F.tid & 63; F.wave = __builtin_amdgcn_readfirstlane(F.tid >> 6); F.G = gridDim.x;
    F.out = args.out; F.ws = args.ws; F.ctl = (gu32*)(args.ws + WS_CTL);
    for (int u = F.tid; u < (LDS_BYTES - LDSCTL_OFF) / 4; u += NWAVES * 64) ((LAS unsigned*)(F.lds + LDSCTL_OFF))[u] = 0u;
    __syncthreads();
    XcdBarrier bar; bar.bar = (unsigned*)(F.ctl + CW_BAR); bar.x = 0; bar.st = nullptr;
    if (N_LAUNCHES == 1) bar = xcd_barrier_post((unsigned*)(F.ctl + CW_BAR), F.MISC + 8);
#define GRID_BAR() do { if (N_LAUNCHES == 1) xcd_barrier(bar); } while (0)
    const int lo = args.ph_lo, hi = args.ph_hi;
#ifndef PH_MASK
#define PH_MASK 0x1FFF
#endif
#define IN(k) (((PH_MASK >> (k)) & 1) && lo <= (k) && (k) < hi)
#define SEAM(k) do { if (IN(k) && IN((k) + 1)) GRID_BAR(); } while (0)
    unsigned char* ws = args.ws;

    if (IN(0)) { p0_prologue(F); } SEAM(0);
    if (IN(1)) { p1_norm1(F); } SEAM(1);
    if (IN(2)) {
        pg8::Gemm g{(const bf16*)(ws + WS_H1), (const bf16*)(ws + WS_WIN), NTOK, WIN_ROWS, DM}; InprojOrder S; S.init(F.G, (int)blockIdx.x);
        EpiInproj E{(bf16*)(ws + WS_ZK), (bf16*)(ws + WS_ZV), (bf16*)(ws + WS_ZR), (bf16*)(ws + WS_Q), (bf16*)(ws + WS_KQ), (bf16*)(ws + WS_VQ), (bf16*)(ws + WS_LA), (bf16*)args.out};
        pg8::gemm_phase<EpiInproj, InprojOrder, true, true>(F.lds, g, S, E);
    } SEAM(2);
    if (IN(3)) {
        p3a_lora(F);
        p3b_attn_prep(F);
    } SEAM(3);
    if (IN(4)) { p4a_attention(F); __syncthreads(); p4b_scan(F); } SEAM(4);
    if (IN(5)) { p5_rwkv_out(F); } SEAM(5);
    if (IN(6)) {
        pg8::Gemm g{(const bf16*)(ws + WS_ORW), (const bf16*)(ws + WS_WBRR), NLAT, DM, DM, (const bf16*)(ws + WS_Q), 512}; pg8::StaticOrder S; S.init(NLAT, DM, F.G, (int)blockIdx.x);
        EpiMerge2 E{(bf16*)(ws + WS_MERGED), (const bf16*)args.out};
        pg8::gemm_phase<EpiMerge2, pg8::StaticOrder, true, true, true>(F.lds, g, S, E);
    } SEAM(6);
    if (IN(7)) {
        pg8::Gemm g{(const bf16*)(ws + WS_MERGED), (const bf16*)(ws + WS_WOUT), NLAT, DM, DM}; pg8::StaticOrder S; S.init(NLAT, DM, F.G, (int)blockIdx.x);
        EpiOutproj E{(bf16*)(ws + WS_DELTA), (const float*)(ws + WS_MOD)};
        pg8::gemm_phase<EpiOutproj, pg8::StaticOrder, true, true>(F.lds, g, S, E);
    } SEAM(7);
    if (IN(8)) { p8_norm2_router(F); } SEAM(8);
    if (IN(9)) { p9_topk_gather(F); } SEAM(9);
    if (IN(10)) {
        pg8::Gemm g{(const bf16*)(ws + WS_XE), (const bf16*)(ws + WS_WGU), NSLOT, NE * 3072, DM}; ExpertOrder S; S.init(F.G, (int)blockIdx.x, 12);
        EpiSwiglu E{(bf16*)(ws + WS_ACT)};
        pg8::gemm_phase<EpiSwiglu, ExpertOrder, true, true>(F.lds, g, S, E);
    } SEAM(10);
    if (IN(11)) {
        pg8::Gemm g{(const bf16*)(ws + WS_ACT), (const bf16*)(ws + WS_WD), NSLOT, NE * 1024, DFF}; ExpertOrder S; S.init(F.G, (int)blockIdx.x, 4);
        EpiDown E{(bf16*)(ws + WS_Y2), (const float*)(ws + WS_VAL)};
        pg8::gemm_phase<EpiDown, ExpertOrder, true, true>(F.lds, g, S, E);
    } SEAM(11);
    if (IN(12)) { p12_combine(F); }
#undef IN
#undef SEAM
#undef GRID_BAR
}

extern "C" void kernel_launch(void* const* d_in, const int* in_sizes, int n_in, void* d_out, int out_size, void* d_ws, size_t ws_size, hipStream_t stream) {
    static int grid = 0;
    if (grid == 0) {
        if (n_in != 30 || out_size != NLAT * DM || ws_size < WS_END) { fprintf(stderr, "kernel_launch: unexpected problem (n_in %d out %d ws %zu)\n", n_in, out_size, ws_size); grid = -1; return; }
        int dev = 0, cus = 0, per_cu = 0;
        if (hipGetDevice(&dev) != hipSuccess || hipDeviceGetAttribute(&cus, hipDeviceAttributeMultiprocessorCount, dev) != hipSuccess) { grid = -1; return; }
        if (hipFuncSetAttribute((const void*)mk_fwd, hipFuncAttributeMaxDynamicSharedMemorySize, LDS_BYTES) != hipSuccess) { fprintf(stderr, "kernel_launch: hipFuncSetAttribute failed\n"); grid = -1; return; }
        if (hipOccupancyMaxActiveBlocksPerMultiprocessor(&per_cu, (const void*)mk_fwd, NWAVES * 64, LDS_BYTES) != hipSuccess || per_cu < 1) fprintf(stderr, "kernel_launch: occupancy query says %d\n", per_cu);
        (void)hipGetLastError();
        grid = cus;
    }
    if (grid < 0) return;
    if (hipMemsetAsync((char*)d_ws + WS_CTL, 0, CTL_ZERO_BYTES, stream) != hipSuccess) return;
    Args a{};
    for (int i = 0; i < 30; ++i) a.in[i] = (const float*)d_in[i];
    a.out = (float*)d_out; a.ws = (unsigned char*)d_ws;
    if (N_LAUNCHES == 1) { a.ph_lo = 0; a.ph_hi = N_PHASES; hipLaunchKernelGGL(mk_fwd, dim3(grid), dim3(NWAVES * 64), LDS_BYTES, stream, a); }
    else for (int li = 0; li < N_PHASES; ++li) { a.ph_lo = li; a.ph_hi = li + 1; hipLaunchKernelGGL(mk_fwd, dim3(grid), dim3(NWAVES * 64), LDS_BYTES, stream, a); }
}
```

```cpp
#include <hip/hip_runtime.h>
#include <cstdio>
#include <cstdint>
#define MK_N_LAUNCHES 1
namespace pg8 {
#define PG8_LAS __attribute__((address_space(3)))
typedef unsigned short bf16_t;
typedef short bf16x8 __attribute__((ext_vector_type(8)));
typedef float f32x4 __attribute__((ext_vector_type(4)));
typedef unsigned u32x4 __attribute__((ext_vector_type(4)));
constexpr int BM = 256, BK = 64, HALF = 128, HTB = HALF * BK * 2  , STAGE_BYTES = 8 * HTB, NXCD = 8, WGM = 8;

__host__ __device__ __forceinline__ int lds_byte(int r, int c) { const int st = (r >> 4) * 2 + (c >> 5), rr = r & 15, cc = c & 31, ob = rr * 64 + cc * 2; return st * 1024 + (ob ^ (((ob >> 9) & 1) << 5)); }
__host__ __device__ __forceinline__ void stage_rc(int b, int& R, int& C) { const int st = b / 1024, sb = b % 1024, swz = sb ^ (((sb >> 9) & 1) << 5); R = (st >> 1) * 16 + swz / 64; C = (st & 1) * 32 + (swz % 64) / 2; }
__host__ __device__ __forceinline__ int perm32(int rho) { const int n = rho >> 4, i = rho & 15; return 8 * (i >> 2) + 4 * n + (i & 3); }

struct Unit { int pm, pn; };
struct Gemm { const bf16_t* A; const bf16_t* Bt; int M, N, K; const bf16_t* A2 = nullptr; int lda = 0; const int* gidx = nullptr; PG8_LAS int* glds = nullptr; };

struct StaticOrder {
    int nM, nN, nwg, G, c;
    __host__ __device__ void init(int M, int N, int G_, int c_) { nM = M / BM; nN = N / BM; nwg = nM * nN; G = G_; c = c_; }
    __host__ __device__ bool next(int i, Unit& u) const {
        const long L = (long)i * G + c; if (L >= nwg) return false;
        int wgid = (int)L; { const int q = nwg / NXCD, r = nwg % NXCD, xcd = wgid % NXCD, off = wgid / NXCD; wgid = (xcd < r ? xcd * (q + 1) : r * (q + 1) + (xcd - r) * q) + off; }
        const int nig = WGM * nN, gid = wgid / nig, fm = gid * WGM, gsz = (nM - fm) < WGM ? (nM - fm) : WGM;
        u.pm = fm + ((wgid % nig) % gsz); u.pn = (wgid % nig) / gsz; return true;
    }
    __device__ __forceinline__ void a_ready(const Unit&) const {}
    __device__ __forceinline__ void done(const Unit&) const {}
};

template <class Epi, class Sched, bool ALIGN_EPI = false, bool SP2 = false, bool SPLITA = false, bool GATHERA = false>
__device__ __forceinline__ void gemm_phase(PG8_LAS unsigned char* lds, const Gemm g, const Sched& S, const Epi& E) {
    const int tid = threadIdx.x, wid = __builtin_amdgcn_readfirstlane(tid >> 6), lane = tid & 63, wr = wid >> 2, wc = wid & 3, fr = lane & 15, fq = lane >> 4;
    const int K = g.K, nt = K / BK, lda = g.lda ? g.lda : g.K, nh = nt / 2;
    unsigned voffA[2], voffB[2];
#pragma unroll
    for (int i = 0; i < 2; ++i) { int R, C; stage_rc(tid * 16 + i * 8192, R, C); const int Rb = Epi::PERM ? ((R & ~31) + perm32(R & 31)) : R;
        voffA[i] = (unsigned)(R * lda + C) * 2u; voffB[i] = (unsigned)(Rb * K + C) * 2u; }
    const size_t kstep = (size_t)(BK * 2);
    const size_t hstep = (size_t)HALF * K * 2;
    const size_t tstep = 2 * hstep;
    const size_t hstepA = (size_t)HALF * lda * 2, tstepA = 2 * hstepA;
    const unsigned ldsw = (unsigned)wid * 1024u;
    const int aoff = lds_byte(wr * 64 + fr, fq * 8), boff = lds_byte(wc * 32 + fr, fq * 8);
#define PG8_SA(b, h) (((b) * 2 + (h)) * HTB)
#define PG8_SB(b, h) ((4 + (b) * 2 + (h)) * HTB)
#define PG8_STAGE(bufoff, gbase, voff) do { _Pragma("unroll") for (int _i = 0; _i < 2; ++_i) \
        __builtin_amdgcn_global_load_lds((const unsigned*)((const char*)(gbase) + (voff)[_i]), (PG8_LAS unsigned*)(lds + (bufoff) + ldsw + _i * 8192), 16, 0, 0); } while (0)
#define PG8_LDA(dst, b, h) do { _Pragma("unroll") for (int m = 0; m < 4; ++m) _Pragma("unroll") for (int k = 0; k < 2; ++k) dst[m][k] = *(const PG8_LAS bf16x8*)(lds + PG8_SA(b, h) + aoff + m * 2048 + k * 1024); } while (0)
#define PG8_LDB(dst, b, h) do { _Pragma("unroll") for (int n = 0; n < 2; ++n) _Pragma("unroll") for (int k = 0; k < 2; ++k) dst[n][k] = *(const PG8_LAS bf16x8*)(lds + PG8_SB(b, h) + boff + n * 2048 + k * 1024); } while (0)
#define PG8_MMA(ai, bj, At, Bt) do { __builtin_amdgcn_s_setprio(1); _Pragma("unroll") for (int m = 0; m < 4; ++m) _Pragma("unroll") for (int n = 0; n < 2; ++n) _Pragma("unroll") for (int k = 0; k < 2; ++k) \
        acc[ai][bj][m][n] = __builtin_amdgcn_mfma_f32_16x16x32_bf16(Bt[n][k], At[m][k], acc[ai][bj][m][n], 0, 0, 0); __builtin_amdgcn_s_setprio(0); } while (0)
#define PG8_WAIT_V(n) asm volatile("s_waitcnt vmcnt(" #n ")" ::: "memory")
#define PG8_WAIT_L(n) asm volatile("s_waitcnt lgkmcnt(" #n ")" ::: "memory")
#define PG8_BAR __builtin_amdgcn_s_barrier()
#define PG8_SCHED __builtin_amdgcn_sched_barrier(0)
    Unit cur, nxt; int ui = 0;
    if (!S.next(0, cur)) return;
    f32x4 acc[2][2][4][2];
#pragma unroll
    for (int a = 0; a < 2; ++a)
#pragma unroll
        for (int b = 0; b < 2; ++b)
#pragma unroll
            for (int m = 0; m < 4; ++m)
#pragma unroll
                for (int n = 0; n < 2; ++n) acc[a][b][m][n] = (f32x4){0.f, 0.f, 0.f, 0.f};
    bf16x8 At[4][2], B0[2][2], B1[2][2];
    const char* cA = (const char*)g.A + (size_t)cur.pm * tstepA; const char* cB = (const char*)g.Bt + (size_t)cur.pn * tstep;
    const char* cA2 = SPLITA ? (const char*)g.A2 + (size_t)cur.pm * tstepA : cA;
#define PG8_AADDR(tt) (SPLITA ? (((tt) < nh) ? cA + (size_t)(tt) * kstep : cA2 + (size_t)((tt) - nh) * kstep) : cA + (size_t)(tt) * kstep)
    unsigned gofc[2][2] = {{0u, 0u}, {0u, 0u}}, gofn[2][2] = {{0u, 0u}, {0u, 0u}}; int gR[2] = {0, 0}, gC[2] = {0, 0};
    if constexpr (GATHERA) {
#pragma unroll
        for (int i = 0; i < 2; ++i) { int R, C; stage_rc(tid * 16 + i * 8192, R, C); gR[i] = R; gC[i] = C; }
        if (tid < 256) g.glds[tid] = g.gidx[cur.pm * 256 + tid];
        asm volatile("s_waitcnt vmcnt(0) lgkmcnt(0)" ::: "memory"); __builtin_amdgcn_s_barrier(); asm volatile("" ::: "memory");
#pragma unroll
        for (int hh = 0; hh < 2; ++hh)
#pragma unroll
            for (int i = 0; i < 2; ++i) gofc[hh][i] = (unsigned)(((cur.pm & 31) * 2048 + g.glds[hh * 128 + gR[i]]) * lda + gC[i]) * 2u;
        cA = (const char*)g.A; cA2 = cA;
    }
#define PG8_GA(hh) (GATHERA ? gofc[hh] : voffA)
#define PG8_GN(hh) (GATHERA ? (last ? gofn[hh] : gofc[hh]) : voffA)
#define PG8_HA(x) (GATHERA ? (x) : (x) + hstepA)
    S.a_ready(cur);
    if constexpr (SP2) {
        PG8_STAGE(PG8_SB(0, 0), cB, voffB); PG8_STAGE(PG8_SB(0, 1), cB + hstep, voffB); PG8_STAGE(PG8_SA(0, 0), cA, PG8_GA(0)); PG8_STAGE(PG8_SA(0, 1), PG8_HA(cA), PG8_GA(1));
        if (wr == 1) PG8_BAR;
        PG8_WAIT_V(2); PG8_BAR;
        PG8_STAGE(PG8_SB(1, 0), cB + kstep, voffB); PG8_STAGE(PG8_SA(1, 0), cA + kstep, PG8_GA(0)); PG8_STAGE(PG8_SB(1, 1), cB + hstep + kstep, voffB);
        PG8_WAIT_V(6); PG8_BAR;
    } else {
        PG8_STAGE(PG8_SB(0, 0), cB, voffB); PG8_STAGE(PG8_SA(0, 0), cA, voffA); PG8_STAGE(PG8_SB(0, 1), cB + hstep, voffB); PG8_STAGE(PG8_SA(0, 1), cA + hstepA, voffA);
        if (wr == 1) PG8_BAR;
        PG8_WAIT_V(4); PG8_BAR;
        PG8_STAGE(PG8_SB(1, 0), cB + kstep, voffB); PG8_STAGE(PG8_SA(1, 0), cA + kstep, PG8_GA(0)); PG8_STAGE(PG8_SB(1, 1), cB + hstep + kstep, voffB);
        PG8_WAIT_V(6); PG8_BAR;
    }
    for (;;) {
        const bool has_next = S.next(ui + 1, nxt);
        const char* nA = has_next ? (const char*)g.A + (size_t)nxt.pm * tstepA : cA; const char* nB = has_next ? (const char*)g.Bt + (size_t)nxt.pn * tstep : cB;
        const char* nA2 = (SPLITA && has_next) ? (const char*)g.A2 + (size_t)nxt.pm * tstepA : cA2;
        if constexpr (GATHERA) { nA = cA;
            if (has_next) __builtin_amdgcn_global_load_lds((const unsigned*)(g.gidx + nxt.pm * 256 + (wid & 3) * 64 + lane), (PG8_LAS unsigned*)(g.glds + ((ui + 1) & 1) * 256 + (wid & 3) * 64), 4, 0, 0); }
        for (int t = 0; t < nt; t += 2) {
            const bool last = (t == nt - 2);
            const char* a1 = PG8_AADDR(t + 1);
            const char* a2 = last ? nA : PG8_AADDR(t + 2); const char* b2 = last ? nB : cB + (size_t)(t + 2) * kstep;
            const char* a3 = a2 + kstep; const char* b3 = b2 + kstep;
            if (last && has_next) S.a_ready(nxt);
            if constexpr (GATHERA) { if (last && has_next) {
#pragma unroll
                for (int hh = 0; hh < 2; ++hh)
#pragma unroll
                    for (int i = 0; i < 2; ++i) gofn[hh][i] = (unsigned)(((nxt.pm & 31) * 2048 + g.glds[((ui + 1) & 1) * 256 + hh * 128 + gR[i]]) * lda + gC[i]) * 2u; } }
            if constexpr (SPLITA) { if (t == nh) E.mid(acc, cur, wr, wc, fr, fq); }
            if constexpr (SP2) {
            PG8_LDB(B0, 0, 0); PG8_LDB(B1, 0, 1); PG8_SCHED; PG8_LDA(At, 0, 0); PG8_STAGE(PG8_SA(1, 1), PG8_HA(a1), PG8_GA(1));
            PG8_WAIT_V(8); PG8_WAIT_L(0); PG8_BAR; PG8_MMA(0, 0, At, B0); PG8_MMA(0, 1, At, B1); PG8_BAR; PG8_SCHED;
            PG8_LDA(At, 0, 1); PG8_STAGE(PG8_SB(0, 0), b2, voffB); PG8_STAGE(PG8_SB(0, 1), b2 + hstep, voffB); PG8_STAGE(PG8_SA(0, 0), a2, PG8_GN(0));
            PG8_WAIT_V(8); PG8_WAIT_L(0); PG8_BAR; PG8_MMA(1, 0, At, B0); PG8_MMA(1, 1, At, B1); PG8_BAR; PG8_SCHED;
            PG8_LDB(B0, 1, 0); PG8_LDB(B1, 1, 1); PG8_SCHED; PG8_LDA(At, 1, 0); PG8_STAGE(PG8_SA(0, 1), PG8_HA(a2), PG8_GN(1));
            PG8_WAIT_V(8); PG8_WAIT_L(0); PG8_BAR; PG8_MMA(0, 0, At, B0); PG8_MMA(0, 1, At, B1); PG8_BAR; PG8_SCHED;
            PG8_LDA(At, 1, 1); PG8_STAGE(PG8_SB(1, 0), b3, voffB); PG8_STAGE(PG8_SB(1, 1), b3 + hstep, voffB); PG8_STAGE(PG8_SA(1, 0), a3, PG8_GN(0));
            PG8_WAIT_V(8); PG8_WAIT_L(0); PG8_BAR; PG8_MMA(1, 0, At, B0); PG8_MMA(1, 1, At, B1); PG8_BAR; PG8_SCHED;
            } else {
            PG8_LDB(B0, 0, 0); PG8_SCHED; PG8_LDA(At, 0, 0); PG8_STAGE(PG8_SA(1, 1), a1 + hstepA, voffA);
            PG8_WAIT_L(8); PG8_BAR; PG8_WAIT_L(0); PG8_MMA(0, 0, At, B0); PG8_BAR; PG8_SCHED;
            PG8_LDB(B1, 0, 1); PG8_STAGE(PG8_SB(0, 0), b2, voffB);
            PG8_BAR; PG8_WAIT_L(0); PG8_MMA(0, 1, At, B1); PG8_BAR;
            PG8_LDA(At, 0, 1); PG8_STAGE(PG8_SA(0, 0), a2, voffA);
            PG8_BAR; PG8_WAIT_L(0); PG8_MMA(1, 0, At, B0); PG8_BAR; PG8_SCHED;
            PG8_STAGE(PG8_SB(0, 1), b2 + hstep, voffB);
            PG8_WAIT_V(6); PG8_BAR; PG8_MMA(1, 1, At, B1); PG8_BAR;
            PG8_LDB(B0, 1, 0); PG8_SCHED; PG8_LDA(At, 1, 0); PG8_STAGE(PG8_SA(0, 1), a2 + hstepA, voffA);
            PG8_WAIT_L(8); PG8_BAR; PG8_WAIT_L(0); PG8_MMA(0, 0, At, B0); PG8_BAR; PG8_SCHED;
            PG8_LDB(B1, 1, 1); PG8_STAGE(PG8_SB(1, 0), b3, voffB);
            PG8_BAR; PG8_WAIT_L(0); PG8_MMA(0, 1, At, B1); PG8_BAR;
            PG8_LDA(At, 1, 1); PG8_STAGE(PG8_SA(1, 0), a3, voffA);
            PG8_BAR; PG8_WAIT_L(0); PG8_MMA(1, 0, At, B0); PG8_BAR; PG8_SCHED;
            PG8_STAGE(PG8_SB(1, 1), b3 + hstep, voffB);
            PG8_WAIT_V(6); PG8_BAR; PG8_MMA(1, 1, At, B1); PG8_BAR;
            }
        }
        if constexpr (ALIGN_EPI) { if (wr == 0) PG8_BAR; }
        if constexpr (!Epi::AFTER_DRAIN) { E(acc, cur, wr, wc, fr, fq); S.done(cur); }
        if (!has_next) break;
#pragma unroll
        for (int a = 0; a < 2; ++a)
#pragma unroll
            for (int b = 0; b < 2; ++b)
#pragma unroll
                for (int m = 0; m < 4; ++m)
#pragma unroll
                    for (int n = 0; n < 2; ++n) acc[a][b][m][n] = (f32x4){0.f, 0.f, 0.f, 0.f};
        cur = nxt; cA = nA; cA2 = nA2; cB = nB; ++ui;
        if constexpr (GATHERA) {
#pragma unroll
            for (int hh = 0; hh < 2; ++hh) { gofc[hh][0] = gofn[hh][0]; gofc[hh][1] = gofn[hh][1]; } }
        if constexpr (ALIGN_EPI) { if (wr == 1) PG8_BAR; }
    }
    PG8_WAIT_V(0);
    if constexpr (!ALIGN_EPI) { if (wr == 0) PG8_BAR; }
    PG8_BAR;
    if constexpr (Epi::AFTER_DRAIN) { E.fused(acc, cur, wr, wc, fr, fq, lds, wid, lane); S.done(cur); }
#undef PG8_AADDR
#undef PG8_GA
#undef PG8_GN
#undef PG8_HA
#undef PG8_SA
#undef PG8_SB
#undef PG8_STAGE
#undef PG8_LDA
#undef PG8_LDB
#undef PG8_MMA
#undef PG8_WAIT_V
#undef PG8_WAIT_L
#undef PG8_BAR
#undef PG8_SCHED
}
}
#define GAS __attribute__((address_space(1)))
#define LAS __attribute__((address_space(3)))
typedef unsigned short bf16;
typedef unsigned v4u __attribute__((ext_vector_type(4)));
typedef float f32x4 __attribute__((ext_vector_type(4)));
typedef short bf16x8 __attribute__((ext_vector_type(8)));
typedef GAS unsigned gu32;
typedef GAS unsigned long long gu64;
#define RLX_AGENT __ATOMIC_RELAXED, __HIP_MEMORY_SCOPE_AGENT
#define LDS_WAIT() asm volatile("s_waitcnt lgkmcnt(0)" ::: "memory")
#define VM_WAIT() asm volatile("s_waitcnt vmcnt(0)" ::: "memory")
__device__ __forceinline__ unsigned long long rt() { return __builtin_amdgcn_s_memrealtime(); }
__device__ __forceinline__ unsigned f2bf(float f) { unsigned u = __builtin_bit_cast(unsigned, f); return (u + 0x7fffu + ((u >> 16) & 1u)) >> 16; }
__device__ __forceinline__ unsigned pk2(float lo, float hi) { return f2bf(lo) | (f2bf(hi) << 16); }

#define XB_TMO      128
#define XB_XCNT(j)  (256  + 64 * (j))
#define XB_XSUB(j)  (1280 + 64 * (j))
#define XB_XGEN(j)  (2304 + 64 * (j))
#define XB_TOP      3328
#define XB_TOPGEN   3392
#define XCD_BAR_WORDS 3456
#define XB_SPIN_CAP (1u << 18)

__device__ __forceinline__ unsigned xb_ld(unsigned* p)              { return __hip_atomic_load(p, __ATOMIC_RELAXED, __HIP_MEMORY_SCOPE_AGENT); }
__device__ __forceinline__ unsigned xb_add(unsigned* p, unsigned v) { return __hip_atomic_fetch_add(p, v, __ATOMIC_RELAXED, __HIP_MEMORY_SCOPE_AGENT); }
__device__ __forceinline__ unsigned xb_xcc_id() { return (unsigned)__builtin_amdgcn_s_getreg((3 << 11) | 20) & 0xFu; }
#define XB_SPIN(cond, bar) do { unsigned _sp = 0; while (cond) { __builtin_amdgcn_s_sleep(1); \
    if ((++_sp & 255u) == 0u) { if (xb_ld(&(bar)[XB_TMO])) break; if (_sp > XB_SPIN_CAP) { atomicAdd(&(bar)[XB_TMO], 1u); break; } } } } while (0)

struct XcdBarrier {
    unsigned* bar; unsigned x;
    volatile LAS unsigned* st;
};

__device__ __forceinline__ XcdBarrier xcd_barrier_post(unsigned* bar, volatile LAS unsigned* st) {
    XcdBarrier b; b.bar = bar; b.x = xb_xcc_id(); b.st = st;
    if (threadIdx.x == 0) (void)xb_add(&bar[XB_XCNT(b.x)], 1u);
    return b;
}
__device__ __forceinline__ void xcd_barrier_complete(unsigned* bar, unsigned x, unsigned& nloc, unsigned& nx) {
    const unsigned G = gridDim.x * gridDim.y * gridDim.z;
    unsigned sum, cnt, mine, sp = 0u;
    for (;;) {
        sum = 0u; cnt = 0u; mine = 0u;
#pragma unroll
        for (unsigned j = 0; j < 16; ++j) { const unsigned c = xb_ld(&bar[XB_XCNT(j)]); sum += c; cnt += (c > 0u) ? 1u : 0u; mine = (j == x) ? c : mine; }
        if (sum == G) break;
        __builtin_amdgcn_s_sleep(1);
        if ((++sp & 255u) == 0u) { if (xb_ld(&bar[XB_TMO])) break; if (sp > XB_SPIN_CAP) { atomicAdd(&bar[XB_TMO], 1u); break; } }
    }
    nloc = mine > 0u ? mine : 1u; nx = cnt > 0u ? cnt : 1u;
}

__device__ __forceinline__ void xcd_barrier(const XcdBarrier& b) {
    asm volatile("s_waitcnt vmcnt(0)" ::: "memory");
    __syncthreads();
    if (threadIdx.x == 0) {
        unsigned* bar = b.bar;
        __builtin_amdgcn_s_waitcnt(0);
        unsigned nloc = b.st[0], nx = b.st[1];
        if (nloc == 0u) { xcd_barrier_complete(bar, b.x, nloc, nx); b.st[0] = nloc; b.st[1] = nx; }
        const unsigned old = xb_add(&bar[XB_XSUB(b.x)], 1u);
        const unsigned gen = old / nloc;
        if (old + 1u == (gen + 1u) * nloc) {
            __builtin_amdgcn_fence(__ATOMIC_RELEASE, "agent");
            asm volatile("s_waitcnt vmcnt(0)" ::: "memory");
            const unsigned og = xb_add(&bar[XB_TOP], 1u);
            const unsigned tg = og / nx;
            if (og + 1u == (tg + 1u) * nx) xb_add(&bar[XB_TOPGEN], 1u);
            else XB_SPIN(xb_ld(&bar[XB_TOPGEN]) == tg, bar);
            __builtin_amdgcn_fence(__ATOMIC_ACQUIRE, "agent");
            xb_add(&bar[XB_XGEN(b.x)], 1u);
            asm volatile("s_waitcnt vmcnt(0)" ::: "memory");
        } else {
            XB_SPIN(xb_ld(&bar[XB_XGEN(b.x)]) == gen, bar);
            __builtin_amdgcn_fence(__ATOMIC_ACQUIRE, "agent");
            asm volatile("s_waitcnt vmcnt(0)" ::: "memory");
        }
    }
    __syncthreads();
}

typedef float f32x2 __attribute__((ext_vector_type(2)));
typedef float f32x16 __attribute__((ext_vector_type(16)));
typedef unsigned v2u __attribute__((ext_vector_type(2)));
typedef __bf16 bf16x2_t __attribute__((ext_vector_type(2)));
using pg8::Unit;

constexpr int NWAVES = 8;
#ifndef MK_N_LAUNCHES
#define MK_N_LAUNCHES 1
#endif
constexpr int N_PHASES = 13;
constexpr int N_LAUNCHES = MK_N_LAUNCHES;

constexpr int NB = 32, SEQ = 2048, LC = 256, DM = 1024, NLAT = NB * SEQ, NCTX = NB * LC, NTOK = NLAT + NCTX;
constexpr int NE = 16, CAP = 256, DFF = 1536, NSLOT = NE * NB * CAP;
constexpr int WIN_ROWS = 4864, LORA_N = 2560, LORA_K = 384;
constexpr int KEYS = SEQ + LC;

constexpr size_t MiB = 1u << 20, KiB = 1u << 10;
constexpr size_t WS_CTL = 0, CTL_ZERO_BYTES = 1 * MiB;
constexpr size_t WS_MOD = 1 * MiB;
constexpr size_t WS_WIN = 2 * MiB;
constexpr size_t WS_WLORA = 11 * MiB + 512 * KiB;
constexpr size_t WS_WBRR = 13 * MiB + 512 * KiB;
constexpr size_t WS_WBRA = 14 * MiB + 512 * KiB;
constexpr size_t WS_WOUT = 15 * MiB + 512 * KiB;
constexpr size_t WS_WGU = 17 * MiB + 512 * KiB;
constexpr size_t WS_WD = 113 * MiB + 512 * KiB;
constexpr size_t WS_IDX = 161 * MiB + 512 * KiB;
constexpr size_t WS_VAL = 162 * MiB;
constexpr size_t WS_ZK = 163 * MiB;
constexpr size_t WS_ZV = 235 * MiB;
constexpr size_t WS_ZR = 307 * MiB;
constexpr size_t WS_Q = 371 * MiB;
constexpr size_t WS_KQ = 435 * MiB;
constexpr size_t WS_VQ = 453 * MiB;
constexpr size_t WS_XCH = 453 * MiB;
constexpr size_t WS_YB = 959 * MiB;
constexpr size_t WS_LA = 471 * MiB;
constexpr size_t WS_H1 = 525 * MiB;
constexpr size_t WS_EW = 525 * MiB;
constexpr size_t WS_ORW = 525 * MiB;
constexpr size_t WS_AS = 669 * MiB;
constexpr size_t WS_G = 813 * MiB;
constexpr size_t WS_VT = 877 * MiB;
constexpr size_t WS_YF = 895 * MiB;
constexpr size_t WS_MERGED = 163 * MiB;
constexpr size_t WS_INV = 163 * MiB;
constexpr size_t WS_XE = 167 * MiB;
constexpr size_t WS_Y2 = 167 * MiB;
constexpr size_t WS_H2 = 167 * MiB;
constexpr size_t WS_AFF = 551 * MiB;
constexpr size_t WS_ACT = 423 * MiB;
constexpr size_t WS_DELTA = 807 * MiB;
constexpr size_t WS_END = 1023 * MiB;
constexpr int CW_BAR = 4096;

constexpr int RING_BYTES = 131072;
constexpr int LDSCTL_OFF = 147456 - 1024, MISC_OFF = LDSCTL_OFF + 320;
static_assert(33 * 1024 * 4 <= LDSCTL_OFF, "P0's silu(c) image must stay below the LDS control words");
constexpr int LDS_BYTES = 147456;

__device__ __forceinline__ unsigned pkbf(float lo, float hi) { f32x2 v = {lo, hi}; return __builtin_bit_cast(unsigned, __builtin_convertvector(v, bf16x2_t)); }
__device__ __forceinline__ float bflo(unsigned u) { return __uint_as_float(u << 16); }
__device__ __forceinline__ float bfhi(unsigned u) { return __uint_as_float(u & 0xffff0000u); }
__device__ __forceinline__ float bf1(bf16 h) { return __uint_as_float(((unsigned)h) << 16); }
__device__ __forceinline__ float sigmoidf_(float x) { return __builtin_amdgcn_rcpf(1.0f + __builtin_amdgcn_exp2f(-1.4426950408889634f * x)); }
__device__ __forceinline__ float tanhf_(float x) { return 1.0f - 2.0f * __builtin_amdgcn_rcpf(__builtin_amdgcn_exp2f(2.8853900817779268f * x) + 1.0f); }
__device__ __forceinline__ float wave_sum(float v) {
    int x = __float_as_int(v);
#define WS_DPP(ctrl, rmask) x = __float_as_int(__int_as_float(x) + __int_as_float(__builtin_amdgcn_update_dpp(0, x, ctrl, rmask, 0xf, false)))
    WS_DPP(0x111, 0xf); WS_DPP(0x112, 0xf); WS_DPP(0x114, 0xf); WS_DPP(0x118, 0xf); WS_DPP(0x142, 0xa); WS_DPP(0x143, 0xc);
#undef WS_DPP
    return __int_as_float(__builtin_amdgcn_readlane(x, 63));
}
__device__ __forceinline__ void unpack8(const v4u w, float (&f)[8]) {
    f[0] = bflo(w.x); f[1] = bfhi(w.x); f[2] = bflo(w.y); f[3] = bfhi(w.y); f[4] = bflo(w.z); f[5] = bfhi(w.z); f[6] = bflo(w.w); f[7] = bfhi(w.w);
}
__device__ __forceinline__ v4u pack8(const float (&f)[8]) { v4u w; w.x = pkbf(f[0], f[1]); w.y = pkbf(f[2], f[3]); w.z = pkbf(f[4], f[5]); w.w = pkbf(f[6], f[7]); return w; }

struct Frame {
    LAS unsigned char* lds;
    volatile LAS unsigned* MISC;
    gu32* ctl;
    int tid, lane, wave, G;
    float* out; unsigned char* ws;
};
enum { I_X = 0, I_C, I_CTX, I_CCTX, I_ADAW, I_ADAB, I_N1G, I_N2G, I_WIN, I_CONV, I_W0, I_W2, I_A0, I_A2, I_KK, I_KA, I_RK, I_G2, I_LNW, I_LNB, I_QG, I_KG, I_SINK,
       I_WBRR, I_WBRA, I_WOUT, I_ROUTER, I_EG, I_EU, I_ED };
typedef const __attribute__((address_space(4))) unsigned char* kptr_t;
__device__ __forceinline__ const float* karg_in(int i) { kptr_t kp = (kptr_t)__builtin_amdgcn_kernarg_segment_ptr(); asm volatile("" : "+s"(kp)); return *(const float* const __attribute__((address_space(4)))*)(kp + 8 * i); }

__device__ __forceinline__ void transpose_item(const float* W, int N, int k0, int n0, bf16* WT, int Kd, int drow0, LAS float* scr, int lane) {
#pragma unroll 8
    for (int i = 0; i < 32; ++i) { const int kk = 2 * i + (lane >> 5); scr[kk * 33 + (lane & 31)] = W[(size_t)(k0 + kk) * N + n0 + (lane & 31)]; }
    LDS_WAIT(); asm volatile("" ::: "memory");
    const int c = lane & 7;
#pragma unroll
    for (int j = 0; j < 4; ++j) { const int n = (lane >> 3) + 8 * j; const LAS float* s = scr + (8 * c) * 33 + n;
        v4u o; o.x = pkbf(s[0 * 33], s[1 * 33]); o.y = pkbf(s[2 * 33], s[3 * 33]); o.z = pkbf(s[4 * 33], s[5 * 33]); o.w = pkbf(s[6 * 33], s[7 * 33]);
        *(GAS v4u*)(WT + (size_t)(drow0 + n) * Kd + k0 + 8 * c) = o; }
    LDS_WAIT(); asm volatile("" ::: "memory");
}
__device__ __forceinline__ int win_dest_block(int sb) {
    if (sb < 4) return 13 + sb;
    if (sb < 8) return sb - 4;
    if (sb < 12) return sb - 4;
    if (sb == 12) return 8;
    if (sb == 13) return 9;
    if (sb == 14) return 10;
    if (sb < 19) return sb + 2;
    if (sb == 19) return 11;
    if (sb == 20) return 12;
    return sb;
}
__device__ __forceinline__ void p0_prologue(Frame& F) {
    if (blockIdx.x < 96) {
        LAS float* cs = (LAS float*)F.lds;
        const float* c = karg_in(I_C); const float* cc = karg_in(I_CCTX);
        for (int i = F.tid; i < 33 * 1024; i += 512) { const float v = i < 32 * 1024 ? c[i] : cc[i - 32 * 1024]; cs[i] = v * sigmoidf_(v); }
        __syncthreads();
        const int col = blockIdx.x * 64 + F.lane; const float* aw = karg_in(I_ADAW);
        float acc[33];
#pragma unroll
        for (int b = 0; b < 33; ++b) acc[b] = 0.f;
        const int kbeg = F.wave * 128;
        for (int k = kbeg; k < kbeg + 128; k += 4) {
            const float w0 = aw[(size_t)(k + 0) * 6144 + col], w1 = aw[(size_t)(k + 1) * 6144 + col], w2 = aw[(size_t)(k + 2) * 6144 + col], w3 = aw[(size_t)(k + 3) * 6144 + col];
#pragma unroll
            for (int b = 0; b < 33; ++b) { const f32x4 cv = *(const LAS f32x4*)(cs + b * 1024 + k); acc[b] += cv.x * w0 + cv.y * w1 + cv.z * w2 + cv.w * w3; }
        }
        __syncthreads();
        LAS float* red = (LAS float*)F.lds;
#pragma unroll
        for (int b = 0; b < 33; ++b) red[(F.wave * 33 + b) * 64 + F.lane] = acc[b];
        __syncthreads();
        float* mod = (float*)(F.ws + WS_MOD); const float* ab = karg_in(I_ADAB);
        for (int i = F.tid; i < 33 * 64; i += 512) { const int b = i >> 6, l = i & 63; float s = 0.f;
#pragma unroll
            for (int w = 0; w < 8; ++w) s += red[(w * 33 + b) * 64 + l];
            mod[(size_t)b * 6144 + blockIdx.x * 64 + l] = s + ab[blockIdx.x * 64 + l]; }
        __syncthreads();
    }
    LAS float* scr = (LAS float*)(F.lds + F.wave * 16384);
    const int gw = blockIdx.x * NWAVES + F.wave, NGW = F.G * NWAVES;
    constexpr int IT_WIN = 16 * 148, IT_G = 16 * 768, IT_BR = 256, IT_OUT = 512;
    constexpr int NITEMS = IT_WIN + 3 * IT_G + 2 * IT_BR + IT_OUT;
    bf16* WIN = (bf16*)(F.ws + WS_WIN); bf16* WGU = (bf16*)(F.ws + WS_WGU); bf16* WD = (bf16*)(F.ws + WS_WD);
    for (int it = gw; it < NITEMS; it += NGW) {
        int r = it;
        if (r < IT_WIN) { const int kb = r / 148, nb = r % 148, n0 = 32 * nb; const int db = win_dest_block(n0 >> 7);
            transpose_item(karg_in(I_WIN), 4736, 64 * kb, n0, WIN, 1024, db * 128 + (n0 & 127), scr, F.lane); continue; }
        r -= IT_WIN;
        if (r < IT_G) { const int e = r / 768, q = r % 768, kb = q / 48, nb = q % 48, n0 = 32 * nb;
            transpose_item(karg_in(I_EG) + (size_t)e * 1024 * 1536, 1536, 64 * kb, n0, WGU, 1024, e * 3072 + 256 * (n0 >> 7) + (n0 & 127), scr, F.lane); continue; }
        r -= IT_G;
        if (r < IT_G) { const int e = r / 768, q = r % 768, kb = q / 48, nb = q % 48, n0 = 32 * nb;
            transpose_item(karg_in(I_EU) + (size_t)e * 1024 * 1536, 1536, 64 * kb, n0, WGU, 1024, e * 3072 + 256 * (n0 >> 7) + 128 + (n0 & 127), scr, F.lane); continue; }
        r -= IT_G;
        if (r < IT_G) { const int e = r / 768, q = r % 768, kb = q / 32, nb = q % 32, n0 = 32 * nb;
            transpose_item(karg_in(I_ED) + (size_t)e * 1536 * 1024, 1024, 64 * kb, n0, WD, 1536, e * 1024 + n0, scr, F.lane); continue; }
        r -= IT_G;
        if (r < IT_BR) { const int kb = r / 32, nb = r % 32; transpose_item(karg_in(I_WBRR), 1024, 64 * kb, 32 * nb, (bf16*)(F.ws + WS_WBRR), 1024, 32 * nb, scr, F.lane); continue; }
        r -= IT_BR;
        if (r < IT_BR) { const int kb = r / 32, nb = r % 32; transpose_item(karg_in(I_WBRA), 1024, 64 * kb, 32 * nb, (bf16*)(F.ws + WS_WBRR) + 512, 1024, 32 * nb, scr, F.lane); continue; }
        r -= IT_BR;
        { const int kb = r / 32, nb = r % 32; transpose_item(karg_in(I_WOUT), 1024, 64 * kb, 32 * nb, (bf16*)(F.ws + WS_WOUT), 1024, 32 * nb, scr, F.lane); }
    }
    const int gt = blockIdx.x * 512 + F.tid, NGT = F.G * 512;
    for (int i = gt; i < 128 * 1024 / 8; i += NGT) *(GAS v4u*)(WIN + (size_t)4736 * 1024 + (size_t)i * 8) = (v4u){0u, 0u, 0u, 0u};
    { bf16* WL = (bf16*)(F.ws + WS_WLORA); const float* w2 = karg_in(I_W2); const float* a2 = karg_in(I_A2); const float* g2 = karg_in(I_G2);
      for (int i = gt; i < LORA_N * (LORA_K / 8); i += NGT) { const int n = i / (LORA_K / 8), k8 = (i % (LORA_K / 8)) * 8; const int rg = n >> 9, col = n & 511; float f[8];
#pragma unroll
          for (int j = 0; j < 8; ++j) { const int k = k8 + j; float v = 0.f;
              if (rg == 0) { if (k < 64) v = w2[(size_t)k * 512 + col]; }
              else if (rg == 1) { if (k >= 64 && k < 128) v = w2[(size_t)(64 + k - 64) * 512 + col]; }
              else if (rg == 2) { if (k >= 128 && k < 192) v = a2[(size_t)(k - 128) * 512 + col]; }
              else if (rg == 3) { if (k >= 192 && k < 256) v = a2[(size_t)(64 + k - 192) * 512 + col]; }
              else { if (k >= 256) v = g2[(size_t)(k - 256) * 512 + col]; }
              f[j] = v; }
          *(GAS v4u*)(WL + (size_t)n * LORA_K + k8) = pack8(f); } }
}

__device__ __forceinline__ void p1_norm1(Frame& F) {
    const int gw = blockIdx.x * NWAVES + F.wave, NGW = F.G * NWAVES;
    const float* mod = (const float*)(F.ws + WS_MOD); bf16* H1 = (bf16*)(F.ws + WS_H1);
    const float* g1 = karg_in(I_N1G); const float* Xp = karg_in(I_X); const float* CTXp = karg_in(I_CTX);
    f32x4 gv[4];
#pragma unroll
    for (int j = 0; j < 4; ++j) gv[j] = *(const f32x4*)(g1 + 4 * F.lane + 256 * j);
    for (int m0 = gw; m0 < NTOK; m0 += 4 * NGW) {
        f32x4 v[4][4]; float s[4];
#pragma unroll
        for (int r = 0; r < 4; ++r) { const int m = min(m0 + r * NGW, NTOK - 1); s[r] = 0.f;
            const float* xr = m < NLAT ? Xp + (size_t)m * DM : CTXp + (size_t)(m - NLAT) * DM;
#pragma unroll
            for (int j = 0; j < 4; ++j) v[r][j] = *(const GAS f32x4*)(xr + 4 * F.lane + 256 * j); }
#pragma unroll
        for (int r = 0; r < 4; ++r) { const int m = m0 + r * NGW;
            if (m < NTOK) {
#pragma unroll
                for (int j = 0; j < 4; ++j) s[r] += (v[r][j].x * v[r][j].x + v[r][j].y * v[r][j].y) + (v[r][j].z * v[r][j].z + v[r][j].w * v[r][j].w);
                const float rstd = __builtin_amdgcn_rsqf(wave_sum(s[r]) * (1.f / DM) + 1e-6f);
                const int mb = m < NLAT ? (m >> 11) : 32; const float* sh = mod + (size_t)mb * 6144; const float* sc = sh + 1024;
#pragma unroll
                for (int j = 0; j < 4; ++j) { const f32x4 a = *(const f32x4*)(sc + 4 * F.lane + 256 * j), bsh = *(const f32x4*)(sh + 4 * F.lane + 256 * j);
                    const f32x4 y = v[r][j] * rstd * gv[j] * (a + 1.0f) + bsh;
                    v2u o; o.x = pkbf(y.x, y.y); o.y = pkbf(y.z, y.w);
                    *(GAS v2u*)(H1 + (size_t)m * DM + 4 * F.lane + 256 * j) = o; } } }
    }
}

struct InprojOrder {
    pg8::StaticOrder so; int G, c;
    __device__ void init(int G_, int c_) { so.init(NLAT, WIN_ROWS, G_, c_); G = G_; c = c_; }
    __device__ bool next(int i, Unit& u) const {
        long L = (long)i * G + c; if (L < 4864) return so.next(i, u);
        L -= 4864; if (L >= 224) return false; u.pm = 256 + (int)(L % 32); u.pn = (int)(L / 32); return true; }
    __device__ __forceinline__ void a_ready(const Unit&) const {}
    __device__ __forceinline__ void done(const Unit&) const {}
};
struct EpiInproj {
    static constexpr bool PERM = true, AFTER_DRAIN = false;
    bf16 *zk, *zv, *zr, *q, *kq, *vq, *la, *gates;
    __device__ __forceinline__ void operator()(const f32x4 (&acc)[2][2][4][2], const Unit& u, int wr, int wc, int fr, int fq) const {
        const int row0 = u.pm * 256 + wr * 64 + fr; const bool isctx = u.pm >= 256;
#pragma unroll
        for (int bj = 0; bj < 2; ++bj) {
            const int c128 = 2 * u.pn + bj; bf16* base = nullptr; int pitch = 0, act = 0; bool ok = true;
            if (c128 < 4) { base = zk + c128 * 128; pitch = 512; }
            else if (c128 < 8) { base = zv + (c128 - 4) * 128; pitch = 512; }
            else if (c128 < 11) { base = la + (c128 - 8) * 128; pitch = 384; act = (c128 == 8) ? 1 : ((c128 == 10) ? 2 : 0); }
            else if (c128 == 11) { base = kq; pitch = 128; }
            else if (c128 == 12) { base = vq; pitch = 128; }
            else if (c128 < 17) { base = zr + (c128 - 13) * 128; pitch = 512; ok = !isctx; }
            else if (c128 < 21) { base = q + (c128 - 17) * 128; pitch = 512; ok = !isctx; }
            else if (c128 < 37) { base = gates + (c128 - 21) * 128; pitch = 2048; act = 2; ok = !isctx; }
            else ok = false;
            if (ok) {
#pragma unroll
                for (int ai = 0; ai < 2; ++ai)
#pragma unroll
                    for (int m = 0; m < 4; ++m) {
                        f32x4 v0 = acc[ai][bj][m][0], v1 = acc[ai][bj][m][1];
                        if (act == 1) { v0.x = tanhf_(v0.x); v0.y = tanhf_(v0.y); v0.z = tanhf_(v0.z); v0.w = tanhf_(v0.w); v1.x = tanhf_(v1.x); v1.y = tanhf_(v1.y); v1.z = tanhf_(v1.z); v1.w = tanhf_(v1.w); }
                        else if (act == 2) { v0.x = sigmoidf_(v0.x); v0.y = sigmoidf_(v0.y); v0.z = sigmoidf_(v0.z); v0.w = sigmoidf_(v0.w); v1.x = sigmoidf_(v1.x); v1.y = sigmoidf_(v1.y); v1.z = sigmoidf_(v1.z); v1.w = sigmoidf_(v1.w); }
                        v4u w; w.x = pkbf(v0.x, v0.y); w.y = pkbf(v0.z, v0.w); w.z = pkbf(v1.x, v1.y); w.w = pkbf(v1.z, v1.w);
                        *(GAS v4u*)(base + (size_t)(row0 + ai * 128 + m * 16) * pitch + wc * 32 + 8 * fq) = w;
                    }
            }
        }
    }
};

constexpr int LORA_LP = 144;
template <int NKS> __device__ __forceinline__ void lora_item(const bf16* LA, const bf16* WL, bf16* outp, const float* bias, float scale, int act, int tile, int rg, int kbase, int lane, LAS unsigned char* st) {
    const int l32 = lane & 31, hi = lane >> 5;
    bf16x8 xf[2][NKS];
#pragma unroll
    for (int s2 = 0; s2 < 2; ++s2)
#pragma unroll
        for (int ks = 0; ks < NKS; ++ks) xf[s2][ks] = *(const GAS bf16x8*)(LA + (size_t)(tile * 64 + s2 * 32 + l32) * LORA_K + kbase + 16 * ks + 8 * hi);
    bf16x8 wf[NKS], wn[NKS];
    { const bf16* wp = WL + (size_t)(rg * 512 + l32) * LORA_K + kbase + 8 * hi;
#pragma unroll
      for (int ks = 0; ks < NKS; ++ks) wf[ks] = *(const GAS bf16x8*)(wp + 16 * ks); }
#pragma unroll 1
    for (int np = 0; np < 8; ++np) {
#pragma unroll
        for (int nh = 0; nh < 2; ++nh) { const int nt = 2 * np + nh;
            f32x16 acc0, acc1;
#pragma unroll
            for (int r = 0; r < 16; ++r) { acc0[r] = 0.f; acc1[r] = 0.f; }
            { const int ntn = nt < 15 ? nt + 1 : 15; const bf16* wp = WL + (size_t)(rg * 512 + ntn * 32 + l32) * LORA_K + kbase + 8 * hi;
#pragma unroll
              for (int ks = 0; ks < NKS; ++ks) wn[ks] = *(const GAS bf16x8*)(wp + 16 * ks); }
#pragma unroll
            for (int ks = 0; ks < NKS; ++ks) { acc0 = __builtin_amdgcn_mfma_f32_32x32x16_bf16(wf[ks], xf[0][ks], acc0, 0, 0, 0); acc1 = __builtin_amdgcn_mfma_f32_32x32x16_bf16(wf[ks], xf[1][ks], acc1, 0, 0, 0); }
#pragma unroll
            for (int ks = 0; ks < NKS; ++ks) wf[ks] = wn[ks];
#pragma unroll
            for (int r4 = 0; r4 < 4; ++r4) { const int col = nt * 32 + 8 * r4 + 4 * hi;
                f32x4 bv = (f32x4){0.f, 0.f, 0.f, 0.f}; if (act) bv = *(const f32x4*)(bias + col);
                f32x4 v0 = (f32x4){acc0[4 * r4], acc0[4 * r4 + 1], acc0[4 * r4 + 2], acc0[4 * r4 + 3]} + bv, v1 = (f32x4){acc1[4 * r4], acc1[4 * r4 + 1], acc1[4 * r4 + 2], acc1[4 * r4 + 3]} + bv;
                if (act) { v0.x = scale * sigmoidf_(v0.x); v0.y = scale * sigmoidf_(v0.y); v0.z = scale * sigmoidf_(v0.z); v0.w = scale * sigmoidf_(v0.w);
                           v1.x = scale * sigmoidf_(v1.x); v1.y = scale * sigmoidf_(v1.y); v1.z = scale * sigmoidf_(v1.z); v1.w = scale * sigmoidf_(v1.w); }
                v2u o0, o1; o0.x = pkbf(v0.x, v0.y); o0.y = pkbf(v0.z, v0.w); o1.x = pkbf(v1.x, v1.y); o1.y = pkbf(v1.z, v1.w);
                const int lc = (32 * nh + 8 * r4 + 4 * hi) * 2;
                *(LAS v2u*)(st + l32 * LORA_LP + lc) = o0; *(LAS v2u*)(st + 32 * LORA_LP + l32 * LORA_LP + lc) = o1; }
        }
#pragma unroll
        for (int i = 0; i < 8; ++i) { const int row = 8 * i + (lane >> 3);
            const v4u w = *(const LAS v4u*)(st + row * LORA_LP + (lane & 7) * 16);
            *(GAS v4u*)(outp + (size_t)(tile * 64 + row) * 512 + np * 64 + (lane & 7) * 8) = w; }
    }
}
__device__ __forceinline__ void p3a_lora(Frame& F) {
    const bf16* LA = (const bf16*)(F.ws + WS_LA); const bf16* WL = (const bf16*)(F.ws + WS_WLORA);
    bf16* EW = (bf16*)(F.ws + WS_EW); bf16* AS = (bf16*)(F.ws + WS_AS); bf16* G = (bf16*)(F.ws + WS_G);
    const float* w0 = karg_in(I_W0); const float* a0 = karg_in(I_A0);
    const int gw = blockIdx.x * NWAVES + F.wave, NGW = F.G * NWAVES;
    LAS unsigned char* st = F.lds + 16384 + F.wave * (64 * LORA_LP);
    for (int item = gw; item < (NTOK / 64) * 5; item += NGW) {
        const int rg = item % 5, tile = item / 5;
        if (rg == 4) { if (tile < NLAT / 64) lora_item<8>(LA, WL, G, nullptr, 1.0f, 0, tile, 4, 256, F.lane, st); }
        else if (rg < 2) lora_item<4>(LA, WL, EW + (size_t)rg * NTOK * 512, w0 + rg * 512, 0.60653066f, 1, tile, rg, 64 * rg, F.lane, st);
        else lora_item<4>(LA, WL, AS + (size_t)(rg - 2) * NTOK * 512, a0 + (rg - 2) * 512, 1.0f, 1, tile, rg, 64 * rg, F.lane, st);
    }
}

__device__ __forceinline__ void p3b_attn_prep(Frame& F) {
    LAS float* tab = (LAS float*)F.lds;
    for (int i = F.tid; i < 1024; i += 512) { const int pos = i >> 4, fi = i & 15;
        const float invf = exp2f(-(float)fi * (13.287712379549449f / 16.0f));
        const float ang = (float)pos * invf; tab[2 * i] = cosf(ang); tab[2 * i + 1] = sinf(ang); }
    __syncthreads();
    const int gw = blockIdx.x * NWAVES + F.wave, NGW = F.G * NWAVES, lane = F.lane;
    {
        bf16* Q = (bf16*)(F.ws + WS_Q); const float* qg = karg_in(I_QG);
        const int sub = lane & 7; float gq[8];
#pragma unroll
        for (int j = 0; j < 8; ++j) gq[j] = qg[8 * sub + j];
        const float qscale = 0.125f * 1.4426950408889634f;
        for (int m0 = gw; m0 < NLAT; m0 += 4 * NGW) {
            v4u raw[4];
#pragma unroll
            for (int r = 0; r < 4; ++r) { const int m = min(m0 + r * NGW, NLAT - 1); raw[r] = *(const GAS v4u*)(Q + (size_t)m * 512 + 8 * lane); }
#pragma unroll
            for (int r = 0; r < 4; ++r) { const int m = m0 + r * NGW; if (m >= NLAT) continue;
                const int t = m & 2047; GAS v4u* p = (GAS v4u*)(Q + (size_t)m * 512 + 8 * lane);
                float y[8]; unpack8(raw[r], y); float ss = 0.f;
#pragma unroll
                for (int j = 0; j < 8; ++j) ss += y[j] * y[j];
                ss += __shfl_xor(ss, 1); ss += __shfl_xor(ss, 2); ss += __shfl_xor(ss, 4);
                const float rstd = __builtin_amdgcn_rsqf(ss * (1.f / 64.f) + 1e-6f);
                const int pos = (sub < 4) ? (t >> 6) : (t & 63); const bool second = (sub & 2) != 0; float o[8];
#pragma unroll
                for (int j = 0; j < 8; ++j) { y[j] = y[j] * rstd * gq[j]; }
#pragma unroll
                for (int j = 0; j < 8; ++j) { const float yp = __shfl_xor(y[j], 2); const int fi = 8 * (sub & 1) + j; const float cs = tab[(pos * 16 + fi) * 2], sn = tab[(pos * 16 + fi) * 2 + 1];
                    o[j] = (second ? (yp * sn + y[j] * cs) : (y[j] * cs - yp * sn)) * qscale; }
                *p = pack8(o); }
        }
    }
    {
        bf16* KQ = (bf16*)(F.ws + WS_KQ); const float* kg = karg_in(I_KG);
        const int l32 = lane & 31; const float g0 = kg[2 * l32], g1 = kg[2 * l32 + 1];
        for (int m0 = gw; m0 < NTOK; m0 += 4 * NGW) {
            unsigned raw[4];
#pragma unroll
            for (int r = 0; r < 4; ++r) { const int m = min(m0 + r * NGW, NTOK - 1); raw[r] = *(const GAS unsigned*)(KQ + (size_t)m * 128 + 2 * lane); }
#pragma unroll
            for (int r = 0; r < 4; ++r) { const int m = m0 + r * NGW; if (m >= NTOK) continue;
                GAS unsigned* p = (GAS unsigned*)(KQ + (size_t)m * 128 + 2 * lane); const unsigned w = raw[r];
                float y0 = bflo(w), y1 = bfhi(w); float ss = y0 * y0 + y1 * y1;
                ss += __shfl_xor(ss, 1); ss += __shfl_xor(ss, 2); ss += __shfl_xor(ss, 4); ss += __shfl_xor(ss, 8); ss += __shfl_xor(ss, 16);
                const float rstd = __builtin_amdgcn_rsqf(ss * (1.f / 64.f) + 1e-6f);
                y0 = y0 * rstd * g0; y1 = y1 * rstd * g1;
                const float p0 = __shfl_xor(y0, 8), p1 = __shfl_xor(y1, 8);
                if (m < NLAT) { const int t = m & 2047; const int pos = (l32 < 16) ? (t >> 6) : (t & 63); const bool second = (l32 & 8) != 0; const int fi0 = (2 * l32) & 15;
                    const float c0 = tab[(pos * 16 + fi0) * 2], s0 = tab[(pos * 16 + fi0) * 2 + 1], c1 = tab[(pos * 16 + fi0 + 1) * 2], s1 = tab[(pos * 16 + fi0 + 1) * 2 + 1];
                    const float o0 = second ? (p0 * s0 + y0 * c0) : (y0 * c0 - p0 * s0), o1 = second ? (p1 * s1 + y1 * c1) : (y1 * c1 - p1 * s1);
                    y0 = o0; y1 = o1; }
                *p = pkbf(y0, y1); }
        }
    }
    {
        const bf16* VQ = (const bf16*)(F.ws + WS_VQ); bf16* VT = (bf16*)(F.ws + WS_VT);
        const int gt = blockIdx.x * 512 + F.tid, NGT = F.G * 512;
        for (int i = gt; i < NB * 2 * (KEYS / 8) * 64; i += NGT) { const int d = i & 63, kg8 = (i >> 6) % (KEYS / 8), bh = (i >> 6) / (KEYS / 8), b = bh >> 1, hk = bh & 1;
            float f[8];
#pragma unroll
            for (int j = 0; j < 8; ++j) { const int key = kg8 * 8 + j; const size_t row = key < SEQ ? (size_t)b * SEQ + key : (size_t)NLAT + b * LC + (key - SEQ); f[j] = bf1(VQ[row * 128 + hk * 64 + d]); }
            *(GAS v4u*)(VT + ((size_t)bh * 64 + d) * KEYS + kg8 * 8) = pack8(f); }
    }
}

__device__ __forceinline__ int key_perm(int i) { const int r = 4 * (i >> 3) + (i & 3), hi = (i >> 2) & 1; return 8 * hi + r + (r >= 8 ? 8 : 0); }
__device__ __forceinline__ void attn_tile(const bf16x8 (&kf)[4], const bf16x8 (&vf)[4], const bf16x8 (&qf)[4], f32x16& o0, f32x16& o1, float& mrun, float& lrun, int mask, int l32, int hi) {
    f32x16 s;
#pragma unroll
    for (int r = 0; r < 16; ++r) s[r] = 0.f;
#pragma unroll
    for (int ks = 0; ks < 4; ++ks) s = __builtin_amdgcn_mfma_f32_32x32x16_bf16(kf[ks], qf[ks], s, 0, 0, 0);
    if (mask) {
#pragma unroll
        for (int r = 0; r < 16; ++r) { const int kk = 8 * hi + r + (r >= 8 ? 8 : 0); const bool ok = (mask == 1) ? (kk >= l32) : (kk <= l32); s[r] = ok ? s[r] : -1e30f; }
    }
    float mx = s[0];
#pragma unroll
    for (int r = 1; r < 16; ++r) mx = fmaxf(mx, s[r]);
    mx = fmaxf(mx, __shfl_xor(mx, 32));
    const float mnew = fmaxf(mrun, mx), alpha = __builtin_amdgcn_exp2f(mrun - mnew);
    float ps = 0.f; float p[16];
#pragma unroll
    for (int r = 0; r < 16; ++r) { p[r] = __builtin_amdgcn_exp2f(s[r] - mnew); ps += p[r]; }
    lrun = lrun * alpha + ps; mrun = mnew;
#pragma unroll
    for (int r = 0; r < 16; ++r) { o0[r] *= alpha; o1[r] *= alpha; }
    v4u pa, pb; pa.x = pkbf(p[0], p[1]); pa.y = pkbf(p[2], p[3]); pa.z = pkbf(p[4], p[5]); pa.w = pkbf(p[6], p[7]);
    pb.x = pkbf(p[8], p[9]); pb.y = pkbf(p[10], p[11]); pb.z = pkbf(p[12], p[13]); pb.w = pkbf(p[14], p[15]);
    const bf16x8 pa8 = __builtin_bit_cast(bf16x8, pa), pb8 = __builtin_bit_cast(bf16x8, pb);
    o0 = __builtin_amdgcn_mfma_f32_32x32x16_bf16(vf[0], pa8, o0, 0, 0, 0);
    o0 = __builtin_amdgcn_mfma_f32_32x32x16_bf16(vf[1], pb8, o0, 0, 0, 0);
    o1 = __builtin_amdgcn_mfma_f32_32x32x16_bf16(vf[2], pa8, o1, 0, 0, 0);
    o1 = __builtin_amdgcn_mfma_f32_32x32x16_bf16(vf[3], pb8, o1, 0, 0, 0);
}
constexpr int AT_KP = 144, AT_VP = 80, AT_KB = 32 * AT_KP, AT_VB = 64 * AT_VP, AT_BUF = AT_KB + AT_VB;
__device__ __forceinline__ void p4a_attention(Frame& F, bool dostore = true) {
    bf16* Q = (bf16*)(F.ws + WS_Q); const bf16* KQ = (const bf16*)(F.ws + WS_KQ); const bf16* VT = (const bf16*)(F.ws + WS_VT);
    const float* sink = karg_in(I_SINK);
    const int tid = F.tid, lane = F.lane, l32 = lane & 31, hi = lane >> 5;
    const int kperm = key_perm(l32);
    LAS unsigned char* lb = F.lds;
    const bool kpart = tid < 256; const int tt = tid & 255;
    const int skey = tt >> 3, skc = tt & 7, sd = tt >> 2, svc = tt & 3;
    const int sdst = kpart ? (skey * AT_KP + skc * 16) : (AT_KB + sd * AT_VP + svc * 16);
    for (int unit = blockIdx.x; unit < NB * 2 * 16; unit += F.G) {
        const int b = unit >> 5, hk = (unit >> 4) & 1, qb = unit & 15;
        const int g = F.wave >> 1, half = F.wave & 1, h = hk * 4 + g;
        const float sink2 = sink[h] * 1.4426950408889634f;
        const int tq0 = qb * 128 + half * 64;
        const size_t qrow = (size_t)b * SEQ + tq0 + l32;
        bf16x8 qf0[4], qf1[4];
#pragma unroll
        for (int ks = 0; ks < 4; ++ks) { qf0[ks] = *(const GAS bf16x8*)(Q + qrow * 512 + h * 64 + 16 * ks + 8 * hi); qf1[ks] = *(const GAS bf16x8*)(Q + (qrow + 32) * 512 + h * 64 + 16 * ks + 8 * hi); }
        float m0 = sink2, m1 = sink2, l0 = hi == 0 ? 1.0f : 0.0f, l1 = l0;
        f32x16 oa0, oa1, ob0, ob1;
#pragma unroll
        for (int r = 0; r < 16; ++r) { oa0[r] = 0.f; oa1[r] = 0.f; ob0[r] = 0.f; ob1[r] = 0.f; }
        const bf16* vsrc0 = VT + ((size_t)(b * 2 + hk) * 64 + sd) * KEYS + 8 * svc;
        const bf16* ksrc0 = KQ + (size_t)skey * 128 + hk * 64 + 8 * skc;
#define AT_SRC(s_, ptr_) do { int key0_; size_t krow_; if ((s_) < 8) { key0_ = SEQ + 32 * (s_); krow_ = (size_t)NLAT + b * LC + 32 * (s_); } \
            else { int kp_ = qb * 128 - 128 + 32 * ((s_) - 8); kp_ = (kp_ >= 0 && kp_ < SEQ) ? kp_ : 0; key0_ = kp_; krow_ = (size_t)b * SEQ + kp_; } \
            ptr_ = kpart ? (ksrc0 + krow_ * 128) : (vsrc0 + key0_); } while (0)
        v4u stg;
        { const bf16* sp; AT_SRC(0, sp); stg = *(const GAS v4u*)sp; }
        __syncthreads();
        *(LAS v4u*)(lb + sdst) = stg;
        __syncthreads();
#pragma unroll 1
        for (int s = 0; s < 20; ++s) {
            if (s + 1 < 20) { const bf16* sp; AT_SRC(s + 1, sp); stg = *(const GAS v4u*)sp; }
            const LAS unsigned char* kb_ = lb + (s & 1) * AT_BUF; const LAS unsigned char* vb_ = kb_ + AT_KB;
            bool use0, use1; int mk0 = 0, mk1 = 0;
            if (s < 8) { use0 = true; use1 = true; }
            else { const int j = s - 8, kp0 = qb * 128 - 128 + 32 * j, bi = j - 2 * half; const bool inr = kp0 >= 0 && kp0 < SEQ;
                use0 = inr && bi >= 0 && bi <= 8; use1 = inr && bi >= 1 && bi <= 9; mk0 = bi == 0 ? 1 : (bi == 8 ? 2 : 0); mk1 = bi == 1 ? 1 : (bi == 9 ? 2 : 0); }
            if (use0 || use1) {
                bf16x8 kf[4], vf[4];
#pragma unroll
                for (int ks = 0; ks < 4; ++ks) kf[ks] = *(const LAS bf16x8*)(kb_ + kperm * AT_KP + 32 * ks + 16 * hi);
                vf[0] = *(const LAS bf16x8*)(vb_ + l32 * AT_VP + 16 * hi); vf[1] = *(const LAS bf16x8*)(vb_ + l32 * AT_VP + 32 + 16 * hi);
                vf[2] = *(const LAS bf16x8*)(vb_ + (32 + l32) * AT_VP + 16 * hi); vf[3] = *(const LAS bf16x8*)(vb_ + (32 + l32) * AT_VP + 32 + 16 * hi);
                if (use0) attn_tile(kf, vf, qf0, oa0, oa1, m0, l0, mk0, l32, hi);
                if (use1) attn_tile(kf, vf, qf1, ob0, ob1, m1, l1, mk1, l32, hi);
            }
            if (s + 1 < 20) *(LAS v4u*)(lb + ((s + 1) & 1) * AT_BUF + sdst) = stg;
            __syncthreads();
        }
#undef AT_SRC
#pragma unroll
        for (int qi = 0; qi < 2; ++qi) {
            const float lr = qi ? l1 : l0; const float ltot = lr + __shfl_xor(lr, 32), inv = 1.0f / ltot;
            const f32x16& o0 = qi ? ob0 : oa0; const f32x16& o1 = qi ? ob1 : oa1;
            bf16* op = Q + (qrow + 32 * qi) * 512 + h * 64 + 4 * hi;
#pragma unroll
            for (int r4 = 0; r4 < 4; ++r4) {
                v2u w0; w0.x = pkbf(o0[4 * r4] * inv, o0[4 * r4 + 1] * inv); w0.y = pkbf(o0[4 * r4 + 2] * inv, o0[4 * r4 + 3] * inv);
                v2u w1; w1.x = pkbf(o1[4 * r4] * inv, o1[4 * r4 + 1] * inv); w1.y = pkbf(o1[4 * r4 + 2] * inv, o1[4 * r4 + 3] * inv);
                if (dostore) { *(GAS v2u*)(op + 8 * r4) = w0; *(GAS v2u*)(op + 32 + 8 * r4) = w1; }
            }
        }
    }
}

constexpr int SC_C = 32, SC_NCH = (LC + SEQ) / SC_C;
constexpr int SC_RP = 3;
constexpr int SC_ROUNDS = SC_NCH / SC_RP;
constexpr int SC_TASK_BYTES = 24576;
constexpr int SC_SLOT_BYTES = 2 * SC_RP * SC_TASK_BYTES;
constexpr int SC_PITCH = 144;
constexpr int SC_PLDS = 4 * 32 * SC_PITCH + 256;
__device__ __forceinline__ int launder(int v) { asm volatile("" : "+v"(v)); return v; }
__device__ __forceinline__ int crow_(int r, int hi) { return (r & 3) + 8 * (r >> 2) + 4 * hi; }
__device__ __forceinline__ bf16x8 packacc(const f32x16& x, int s) {
    v4u p; p.x = pkbf(x[8 * s], x[8 * s + 1]); p.y = pkbf(x[8 * s + 2], x[8 * s + 3]); p.z = pkbf(x[8 * s + 4], x[8 * s + 5]); p.w = pkbf(x[8 * s + 6], x[8 * s + 7]);
    return __builtin_bit_cast(bf16x8, p); }
#define MF(a, b, c) __builtin_amdgcn_mfma_f32_32x32x16_bf16((a), (b), (c), 0, 0, 0)
__device__ __forceinline__ f32x16 zero16() { f32x16 z;
#pragma unroll
    for (int r = 0; r < 16; ++r) z[r] = 0.f;
    return z; }
__device__ __forceinline__ void st_acc_bf16(unsigned char* p, const f32x16& x) {
    v4u a, b; a.x = pkbf(x[0], x[1]); a.y = pkbf(x[2], x[3]); a.z = pkbf(x[4], x[5]); a.w = pkbf(x[6], x[7]); b.x = pkbf(x[8], x[9]); b.y = pkbf(x[10], x[11]); b.z = pkbf(x[12], x[13]); b.w = pkbf(x[14], x[15]);
    *(GAS v4u*)p = a; *(GAS v4u*)(p + 16) = b; }
__device__ __forceinline__ f32x16 ld_acc_bf16(const unsigned char* p) {
    const v4u a = *(const GAS v4u*)p, b = *(const GAS v4u*)(p + 16); f32x16 x;
    x[0] = bflo(a.x); x[1] = bfhi(a.x); x[2] = bflo(a.y); x[3] = bfhi(a.y); x[4] = bflo(a.z); x[5] = bfhi(a.z); x[6] = bflo(a.w); x[7] = bfhi(a.w);
    x[8] = bflo(b.x); x[9] = bfhi(b.x); x[10] = bflo(b.y); x[11] = bfhi(b.y); x[12] = bflo(b.z); x[13] = bfhi(b.z); x[14] = bflo(b.w); x[15] = bfhi(b.w); return x; }

__device__ __forceinline__ void chan_to_frags(const unsigned (&pp)[16], int hi, bf16x8 (&fr)[2][2]) {
    unsigned mine[8], recv[8];
#pragma unroll
    for (int q = 0; q < 8; ++q) { const int plo = (q >> 1) * 4 + (q & 1), phi = plo + 2;
        mine[q] = hi ? pp[phi] : pp[plo]; const unsigned snd = hi ? pp[plo] : pp[phi]; recv[q] = (unsigned)__shfl_xor((int)snd, 32); }
#pragma unroll
    for (int s2 = 0; s2 < 2; ++s2) { v4u t0, t1;
        t0.x = hi ? recv[4 * s2] : mine[4 * s2]; t0.y = hi ? recv[4 * s2 + 1] : mine[4 * s2 + 1]; t0.z = hi ? recv[4 * s2 + 2] : mine[4 * s2 + 2]; t0.w = hi ? recv[4 * s2 + 3] : mine[4 * s2 + 3];
        t1.x = hi ? mine[4 * s2] : recv[4 * s2]; t1.y = hi ? mine[4 * s2 + 1] : recv[4 * s2 + 1]; t1.z = hi ? mine[4 * s2 + 2] : recv[4 * s2 + 2]; t1.w = hi ? mine[4 * s2 + 3] : recv[4 * s2 + 3];
        fr[0][s2] = __builtin_bit_cast(bf16x8, t0); fr[1][s2] = __builtin_bit_cast(bf16x8, t1); }
}
__device__ __forceinline__ void scan_produce(unsigned char* ws, int b, int h, int dir, int chunk, LAS unsigned char* pl, unsigned char* xo, int lane_in, const float* conv, const float* kkpp, const float* kapp) {
    int lane = launder(lane_in);
    float cw[9]; float kkp, kap;
    { const int colc = h * 64 + lane;
#pragma unroll
      for (int j = 0; j < 3; ++j) { cw[j] = conv[j * 1536 + colc]; cw[3 + j] = conv[j * 1536 + 512 + colc]; cw[6 + j] = conv[j * 1536 + 1024 + colc]; }
      kkp = kkpp[dir * 512 + colc]; kap = kapp[dir * 512 + colc]; }
    const bf16* ZK = (const bf16*)(ws + WS_ZK); const bf16* ZV = (const bf16*)(ws + WS_ZV); const bf16* ZR = (const bf16*)(ws + WS_ZR);
    const bf16* EW = (const bf16*)(ws + WS_EW) + (size_t)dir * NTOK * 512; const bf16* AS = (const bf16*)(ws + WS_AS) + (size_t)dir * NTOK * 512;
    int l32 = lane & 31, hi = lane >> 5; const int col = h * 64 + lane;
    const bool lat = chunk >= LC / SC_C; const int len = lat ? SEQ : LC, n0 = lat ? chunk * SC_C - LC : chunk * SC_C;
    const int rowbase = lat ? b * SEQ : NLAT + b * LC;
    LAS unsigned char* mA = pl; LAS unsigned char* mB = pl + 32 * SC_PITCH; LAS unsigned char* mK = pl + 64 * SC_PITCH; LAS unsigned char* mR = pl + 96 * SC_PITCH;
    LAS float* pcs = (LAS float*)(pl + 128 * SC_PITCH);
    unsigned pa[16], pb[16], pk[16], pv[16]; float P = 1.0f;
    const float latf = lat ? 1.0f : 0.0f;
    const float cwr_m = latf * (dir ? cw[2] : cw[0]), cwr_c = latf * cw[1], cwr_p = latf * (dir ? cw[0] : cw[2]), cwk_m = dir ? cw[5] : cw[3], cwk_p = dir ? cw[3] : cw[5], cwv_m = dir ? cw[8] : cw[6], cwv_p = dir ? cw[6] : cw[8];
    const int tk0 = dir ? (len - 1 - n0) : n0, tstep = dir ? -1 : 1;
    const unsigned ob0 = ((unsigned)(rowbase + tk0) * 512u + (unsigned)col) * 2u;
    const long ostepb = (long)tstep * 1024;
    const bool vm1 = n0 > 0, vp32 = n0 + SC_C < len;
    const char* ZKc = (const char*)ZK; const char* ZVc = (const char*)ZV; const char* ZRc = lat ? (const char*)ZR : (const char*)ZK;
    const char* EWc = (const char*)EW; const char* ASc = (const char*)AS;
#define SC_LD(base, j) (*(const GAS bf16*)((base) + (long)(j) * ostepb + ob0))
    const long jm1 = vm1 ? -1 : 0;
    float km = bf1(SC_LD(ZKc, jm1)), kc = bf1(SC_LD(ZKc, 0)), vm = bf1(SC_LD(ZVc, jm1)), vc = bf1(SC_LD(ZVc, 0)), rm = bf1(SC_LD(ZRc, jm1)), rc = bf1(SC_LD(ZRc, 0));
    km = vm1 ? km : 0.f; vm = vm1 ? vm : 0.f; rm = vm1 ? rm : 0.f;
    bf16 gk[2][8], gv[2][8], gr[2][8], ge[2][8], ga[2][8];
#define SC_LOADG(g, bu) do { _Pragma("unroll") for (int jj = 0; jj < 8; ++jj) { const int j = 8 * (g) + jj; \
        const bool vn = (j + 1 < SC_C) || vp32; const long jn = vn ? (j + 1) : j; const bf16 tk_ = SC_LD(ZKc, jn), tv_ = SC_LD(ZVc, jn), tr_ = SC_LD(ZRc, jn); \
        gk[bu][jj] = vn ? tk_ : (bf16)0; gv[bu][jj] = vn ? tv_ : (bf16)0; gr[bu][jj] = vn ? tr_ : (bf16)0; \
        ge[bu][jj] = SC_LD(EWc, j); ga[bu][jj] = SC_LD(ASc, j); } } while (0)
    SC_LOADG(0, 0);
    asm volatile("" ::: "memory");
#pragma unroll
    for (int g = 0; g < 4; ++g) {
        if (g < 3) SC_LOADG(g + 1, (g + 1) & 1);
#pragma unroll
        for (int jj = 0; jj < 8; jj += 2) {
            float va[2], vb[2], vk[2], vv[2];
#pragma unroll
            for (int u = 0; u < 2; ++u) {
                const int i = 8 * g + jj + u;
                const float kp = bf1(gk[g & 1][jj + u]), vp = bf1(gv[g & 1][jj + u]), rp = bf1(gr[g & 1][jj + u]);
                const float k = cwk_m * km + cw[4] * kc + cwk_p * kp, v = cwv_m * vm + cw[7] * vc + cwv_p * vp, r = cwr_m * rm + cwr_c * rc + cwr_p * rp;
                km = kc; kc = kp; vm = vc; vc = vp; rm = rc; rc = rp;
                const float a = bf1(ga[g & 1][jj + u]), ew = bf1(ge[g & 1][jj + u]), w = __expf(-ew);
                const float kkv = k * kkp, ss = wave_sum(kkv * kkv), kk = kkv * __builtin_amdgcn_rsqf(fmaxf(ss, 1e-24f));
                const float kmod = k * (1.0f + (a - 1.0f) * kap);
                const float Pprev = P; P *= w; const float invP = __builtin_amdgcn_rcpf(P);
                const float at = -kk * Pprev, bt = kk * a * invP, kt = kmod * invP, rt = r * P;
                *(LAS bf16*)(mA + i * SC_PITCH + 2 * lane) = (bf16)(pkbf(at, 0.f) & 0xffffu); *(LAS bf16*)(mB + i * SC_PITCH + 2 * lane) = (bf16)(pkbf(bt, 0.f) & 0xffffu);
                *(LAS bf16*)(mK + i * SC_PITCH + 2 * lane) = (bf16)(pkbf(kt, 0.f) & 0xffffu); *(LAS bf16*)(mR + i * SC_PITCH + 2 * lane) = (bf16)(pkbf(rt, 0.f) & 0xffffu);
                va[u] = at; vb[u] = bt; vk[u] = kt; vv[u] = v;
            }
            const int p = 4 * g + (jj >> 1);
            pa[p] = pkbf(va[0], va[1]); pb[p] = pkbf(vb[0], vb[1]); pk[p] = pkbf(vk[0], vk[1]); pv[p] = pkbf(vv[0], vv[1]);
        }
        asm volatile("" ::: "memory");
    }
#undef SC_LOADG
#undef SC_LD
    pcs[lane] = P;
    const float pc_o = __shfl_xor(P, 32); const float pcn0 = hi ? pc_o : P, pcn1 = hi ? P : pc_o;
    bf16x8 fA[2][2], fB[2][2], fK[2][2], fV[2][2];
    chan_to_frags(pa, hi, fA); chan_to_frags(pb, hi, fB); chan_to_frags(pk, hi, fK); chan_to_frags(pv, hi, fV);
    LDS_WAIT(); asm volatile("" ::: "memory");
    __builtin_amdgcn_sched_barrier(0);
    lane = launder(lane_in); l32 = lane & 31; hi = lane >> 5;
    f32x16 X = zero16(), XT = zero16(), LakT = zero16(), MrbT = zero16(), MrkT = zero16();
    const int roff = l32 * SC_PITCH + 16 * hi;
#pragma unroll
    for (int ks = 0; ks < 4; ++ks) {
        const bf16x8 ga = *(const LAS bf16x8*)(mA + roff + 32 * ks), gb = *(const LAS bf16x8*)(mB + roff + 32 * ks), gk = *(const LAS bf16x8*)(mK + roff + 32 * ks), gr = *(const LAS bf16x8*)(mR + roff + 32 * ks);
        X = MF(ga, gb, X); XT = MF(gb, ga, XT); LakT = MF(gk, ga, LakT); MrbT = MF(gb, gr, MrbT); MrkT = MF(gk, gr, MrkT);
    }
    f32x16 TmT;
#pragma unroll
    for (int r = 0; r < 16; ++r) { const int row = crow_(r, hi);
        X[r] = (l32 < row) ? X[r] : 0.f; XT[r] = (row < l32) ? XT[r] : 0.f; LakT[r] = (row < l32) ? LakT[r] : 0.f;
        MrbT[r] = (row <= l32) ? MrbT[r] : 0.f; MrkT[r] = (row <= l32) ? MrkT[r] : 0.f; TmT[r] = XT[r] + ((row == l32) ? 1.0f : 0.f); }
    const bf16x8 la0 = packacc(LakT, 0), la1 = packacc(LakT, 1), rb0 = packacc(MrbT, 0), rb1 = packacc(MrbT, 1), rk0 = packacc(MrkT, 0), rk1 = packacc(MrkT, 1);
    __builtin_amdgcn_sched_barrier(0);
#pragma unroll
    for (int it = 0; it < 4; ++it) {
        const bf16x8 x0 = packacc(X, 0), x1 = packacc(X, 1), y0 = packacc(XT, 0), y1 = packacc(XT, 1), t0 = packacc(TmT, 0), t1 = packacc(TmT, 1);
        f32x16 Xn = zero16(), XnT = zero16();
        Xn = MF(y0, x0, Xn); Xn = MF(y1, x1, Xn); XnT = MF(x0, y0, XnT); XnT = MF(x1, y1, XnT);
        const bf16x8 n0 = packacc(Xn, 0), n1 = packacc(Xn, 1);
        TmT = MF(n0, t0, TmT); TmT = MF(n1, t1, TmT);
        X = Xn; XT = XnT;
    }
    __builtin_amdgcn_sched_barrier(0);
    const bf16x8 tt0 = packacc(TmT, 0), tt1 = packacc(TmT, 1);
    f32x16 W[2], Ut[2];
#pragma unroll
    for (int ct = 0; ct < 2; ++ct) { f32x16 w = zero16(); w = MF(tt0, fA[ct][0], w); w = MF(tt1, fA[ct][1], w); W[ct] = w;
        f32x16 x1 = zero16(); x1 = MF(la0, fV[ct][0], x1); x1 = MF(la1, fV[ct][1], x1);
        f32x16 u = zero16(); u = MF(tt0, packacc(x1, 0), u); u = MF(tt1, packacc(x1, 1), u); Ut[ct] = u; }
    bf16x8 fW[2][2], fU[2][2];
#pragma unroll
    for (int ct = 0; ct < 2; ++ct) { fW[ct][0] = packacc(W[ct], 0); fW[ct][1] = packacc(W[ct], 1); fU[ct][0] = packacc(Ut[ct], 0); fU[ct][1] = packacc(Ut[ct], 1); }
    __builtin_amdgcn_sched_barrier(0);
    lane = launder(lane_in); l32 = lane & 31; hi = lane >> 5;
#pragma unroll
    for (int kt = 0; kt < 2; ++kt) { f32x16 acc;
#pragma unroll
        for (int r4 = 0; r4 < 4; ++r4) { const v2u rr = *(const LAS v2u*)(mR + l32 * SC_PITCH + 2 * (32 * kt + 8 * r4 + 4 * hi));
            acc[4 * r4] = bflo(rr.x); acc[4 * r4 + 1] = bfhi(rr.x); acc[4 * r4 + 2] = bflo(rr.y); acc[4 * r4 + 3] = bfhi(rr.y); }
        acc = MF(fW[kt][0], rb0, acc); acc = MF(fW[kt][1], rb1, acc);
        *(GAS bf16x8*)(xo + 16384 + (kt * 2 + 0) * 1024 + lane * 16) = packacc(acc, 0); *(GAS bf16x8*)(xo + 16384 + (kt * 2 + 1) * 1024 + lane * 16) = packacc(acc, 1); }
#pragma unroll
    for (int vt = 0; vt < 2; ++vt) { f32x16 acc = zero16();
        acc = MF(rb0, fU[vt][0], acc); acc = MF(rb1, fU[vt][1], acc); acc = MF(rk0, fV[vt][0], acc); acc = MF(rk1, fV[vt][1], acc);
        st_acc_bf16(xo + 20480 + vt * 2048 + lane * 32, acc); }
    __builtin_amdgcn_sched_barrier(0);
    lane = launder(lane_in); l32 = lane & 31; hi = lane >> 5;
#pragma unroll
    for (int kt = 0; kt < 2; ++kt)
#pragma unroll
        for (int nt = 0; nt < 2; ++nt) { f32x16 acc = zero16(); acc = MF(fW[kt][0], fB[nt][0], acc); acc = MF(fW[kt][1], fB[nt][1], acc);
            const float pc = nt ? pcn1 : pcn0;
#pragma unroll
            for (int r = 0; r < 16; ++r) acc[r] = (acc[r] + ((kt == nt && crow_(r, hi) == l32) ? 1.0f : 0.f)) * pc;
            *(GAS bf16x8*)(xo + ((kt * 2 + nt) * 2 + 0) * 1024 + lane * 16) = packacc(acc, 0); *(GAS bf16x8*)(xo + ((kt * 2 + nt) * 2 + 1) * 1024 + lane * 16) = packacc(acc, 1); }
    __builtin_amdgcn_sched_barrier(0);
    lane = launder(lane_in); l32 = lane & 31; hi = lane >> 5;
#pragma unroll
    for (int kt = 0; kt < 2; ++kt)
#pragma unroll
        for (int vt = 0; vt < 2; ++vt) { f32x16 acc = zero16();
            acc = MF(fB[kt][0], fU[vt][0], acc); acc = MF(fB[kt][1], fU[vt][1], acc); acc = MF(fK[kt][0], fV[vt][0], acc); acc = MF(fK[kt][1], fV[vt][1], acc);
#pragma unroll
            for (int r4 = 0; r4 < 4; ++r4) { const f32x4 pr = *(const LAS f32x4*)(pcs + 32 * kt + 8 * r4 + 4 * hi);
                acc[4 * r4] *= pr.x; acc[4 * r4 + 1] *= pr.y; acc[4 * r4 + 2] *= pr.z; acc[4 * r4 + 3] *= pr.w; }
            st_acc_bf16(xo + 8192 + (kt * 2 + vt) * 2048 + lane * 32, acc); }
    LDS_WAIT();
}
__device__ __forceinline__ void scan_consume(unsigned char* ws, int b, int h, int dir, int chunk, const unsigned char* xi, int lane, f32x16 (&H)[2][2]) {
    const int l32 = lane & 31, hi = lane >> 5;
    bf16x8 hb[2][2][2];
#pragma unroll
    for (int kt = 0; kt < 2; ++kt)
#pragma unroll
        for (int vt = 0; vt < 2; ++vt) { hb[kt][vt][0] = packacc(H[kt][vt], 0); hb[kt][vt][1] = packacc(H[kt][vt], 1); }
    if (chunk >= LC / SC_C) {
        bf16x8 rf[2][2];
#pragma unroll
        for (int kt = 0; kt < 2; ++kt)
#pragma unroll
            for (int s2 = 0; s2 < 2; ++s2) rf[kt][s2] = *(const GAS bf16x8*)(xi + 16384 + (kt * 2 + s2) * 1024 + lane * 16);
        bf16* Y = (bf16*)(ws + (dir ? WS_YB : WS_YF)); const int n0 = chunk * SC_C - LC;
#pragma unroll
        for (int vt = 0; vt < 2; ++vt) { f32x16 acc = ld_acc_bf16(xi + 20480 + vt * 2048 + lane * 32);
#pragma unroll
            for (int kt = 0; kt < 2; ++kt) { acc = MF(rf[kt][0], hb[kt][vt][0], acc); acc = MF(rf[kt][1], hb[kt][vt][1], acc); }
#pragma unroll
            for (int r = 0; r < 16; ++r) { const int i = crow_(r, hi), tk = dir ? (SEQ - 1 - (n0 + i)) : (n0 + i);
                Y[((size_t)b * SEQ + tk) * 512 + h * 64 + 32 * vt + l32] = (bf16)(pkbf(acc[r], 0.f) & 0xffffu); } }
    }
    f32x16 Hn[2][2];
#pragma unroll
    for (int nt = 0; nt < 2; ++nt)
#pragma unroll
        for (int vt = 0; vt < 2; ++vt) Hn[nt][vt] = ld_acc_bf16(xi + 8192 + (nt * 2 + vt) * 2048 + lane * 32);
#pragma unroll
    for (int kt = 0; kt < 2; ++kt)
#pragma unroll
        for (int nt = 0; nt < 2; ++nt) { const bf16x8 g0 = *(const GAS bf16x8*)(xi + ((kt * 2 + nt) * 2 + 0) * 1024 + lane * 16), g1 = *(const GAS bf16x8*)(xi + ((kt * 2 + nt) * 2 + 1) * 1024 + lane * 16);
#pragma unroll
            for (int vt = 0; vt < 2; ++vt) { Hn[nt][vt] = MF(g0, hb[kt][vt][0], Hn[nt][vt]); Hn[nt][vt] = MF(g1, hb[kt][vt][1], Hn[nt][vt]); } }
#pragma unroll
    for (int nt = 0; nt < 2; ++nt)
#pragma unroll
        for (int vt = 0; vt < 2; ++vt) H[nt][vt] = Hn[nt][vt];
}
__device__ __forceinline__ void p4b_scan(Frame& F) {
    const int wave = F.wave, lane = F.lane;
    const bool is_cons = wave < 2; const int pw = wave - 2;
    unsigned char* xch = F.ws + WS_XCH + (size_t)blockIdx.x * (2 * SC_SLOT_BYTES);
    LAS unsigned char* pl = F.lds + (is_cons ? 0 : pw) * SC_PLDS;
    for (int task = blockIdx.x; task < NB * 8; task += F.G) {
        const int b = task >> 3, h = task & 7; const int pdir = is_cons ? wave : pw / SC_RP, pci = is_cons ? 0 : pw % SC_RP;
        const float* conv = karg_in(I_CONV); const float* kkpp = karg_in(I_KK); const float* kapp = karg_in(I_KA);
#define SC_SYNC() do { asm volatile("s_waitcnt vmcnt(0) lgkmcnt(0)" ::: "memory"); __builtin_amdgcn_s_barrier(); asm volatile("" ::: "memory"); } while (0)
        if (is_cons) {
            f32x16 H[2][2];
#pragma unroll
            for (int i = 0; i < 2; ++i)
#pragma unroll
                for (int j = 0; j < 2; ++j) H[i][j] = zero16();
#pragma unroll 1
            for (int q = -1; q < SC_ROUNDS; ++q) {
                if (q >= 0) { __builtin_amdgcn_fence(__ATOMIC_ACQUIRE, "agent");
#pragma unroll 1
                    for (int i = 0; i < SC_RP; ++i) scan_consume(F.ws, b, h, wave, q * SC_RP + i, xch + (size_t)(q & 1) * SC_SLOT_BYTES + (size_t)(wave * SC_RP + i) * SC_TASK_BYTES, lane, H); }
                SC_SYNC();
            }
        } else {
#pragma unroll 1
            for (int q = -1; q < SC_ROUNDS; ++q) {
                if (q + 1 < SC_ROUNDS) scan_produce(F.ws, b, h, pdir, (q + 1) * SC_RP + pci, pl, xch + (size_t)((q + 1) & 1) * SC_SLOT_BYTES + (size_t)(pdir * SC_RP + pci) * SC_TASK_BYTES, lane, conv, kkpp, kapp);
                SC_SYNC();
            }
        }
#undef SC_SYNC
    }
}
#undef MF

__device__ __forceinline__ void p5_rwkv_out(Frame& F) {
    const int gw = blockIdx.x * NWAVES + F.wave, NGW = F.G * NWAVES, lane = F.lane, c0 = 8 * lane;
    const bf16* ZK = (const bf16*)(F.ws + WS_ZK); const bf16* ZV = (const bf16*)(F.ws + WS_ZV); const bf16* ZR = (const bf16*)(F.ws + WS_ZR);
    const bf16* AS0 = (const bf16*)(F.ws + WS_AS); const bf16* AS1 = AS0 + (size_t)NTOK * 512;
    const bf16* YF = (const bf16*)(F.ws + WS_YF); const bf16* YB = (const bf16*)(F.ws + WS_YB); const bf16* G = (const bf16*)(F.ws + WS_G);
    bf16* ORW = (bf16*)(F.ws + WS_ORW);
    LAS float* PL = (LAS float*)F.lds;
    { const float* convg = karg_in(I_CONV); const float* kag = karg_in(I_KA); const float* rkg = karg_in(I_RK); const float* lnwg = karg_in(I_LNW); const float* lnbg = karg_in(I_LNB);
      for (int i = F.tid; i < 15 * 512; i += 512) { const int row = i >> 9, c = i & 511; float v;
          if (row < 9) v = convg[(row % 3) * 1536 + (row / 3) * 512 + c]; else if (row < 11) v = kag[(row - 9) * 512 + c]; else if (row < 13) v = rkg[(row - 11) * 512 + c]; else if (row == 13) v = lnwg[c]; else v = lnbg[c];
          PL[i] = v; }
      __syncthreads(); }
    const LAS float* conv = PL; const LAS float* ka = PL + 9 * 512; const LAS float* rk = PL + 11 * 512; const LAS float* lnw = PL + 13 * 512; const LAS float* lnb = PL + 14 * 512;
    for (int m0 = gw; m0 < NLAT; m0 += 2 * NGW) {
        v4u raw[2][14];
        const v4u z4 = (v4u){0u, 0u, 0u, 0u};
#pragma unroll
        for (int rr = 0; rr < 2; ++rr) { const int m = min(m0 + rr * NGW, NLAT - 1);
            const int t = m & 2047; const bool first = t == 0, last = t == SEQ - 1; const size_t o = (size_t)m * 512 + c0;
            const size_t om = first ? o : o - 512, op = last ? o : o + 512;
#pragma unroll
            for (int which = 0; which < 3; ++which) { const bf16* Z = which == 0 ? ZR : (which == 1 ? ZK : ZV);
                const v4u ra = *(const GAS v4u*)(Z + om), rc_ = *(const GAS v4u*)(Z + op);
                raw[rr][3 * which] = first ? z4 : ra; raw[rr][3 * which + 1] = *(const GAS v4u*)(Z + o); raw[rr][3 * which + 2] = last ? z4 : rc_; }
            raw[rr][9] = *(const GAS v4u*)(AS0 + o); raw[rr][10] = *(const GAS v4u*)(AS1 + o); raw[rr][11] = *(const GAS v4u*)(YF + o); raw[rr][12] = *(const GAS v4u*)(YB + o); raw[rr][13] = *(const GAS v4u*)(G + o); }
#pragma unroll
        for (int rr = 0; rr < 2; ++rr) { const int m = m0 + rr * NGW; if (m >= NLAT) continue;
            const size_t o = (size_t)m * 512 + c0;
            float r[8], k[8], v[8], tmp[8];
            asm volatile("" ::: "memory");
#pragma unroll
            for (int which = 0; which < 3; ++which) { float (&dst)[8] = which == 0 ? r : (which == 1 ? k : v);
                asm volatile("" ::: "memory");
                float fa[8], fb[8], fc[8]; unpack8(raw[rr][3 * which], fa); unpack8(raw[rr][3 * which + 1], fb); unpack8(raw[rr][3 * which + 2], fc);
                const LAS float* cwp = conv + (3 * which) * 512 + c0;
#pragma unroll
                for (int j = 0; j < 8; ++j) dst[j] = cwp[j] * fa[j] + cwp[512 + j] * fb[j] + cwp[1024 + j] * fc[j]; }
            asm volatile("" ::: "memory");
            float a0[8], a1[8]; unpack8(raw[rr][9], a0); unpack8(raw[rr][10], a1);
            float s = 0.f;
#pragma unroll
            for (int j = 0; j < 8; ++j) { const float km0 = k[j] * (1.0f + (a0[j] - 1.0f) * ka[c0 + j]), km1 = k[j] * (1.0f + (a1[j] - 1.0f) * ka[512 + c0 + j]);
                s += r[j] * (km0 * rk[c0 + j] + km1 * rk[512 + c0 + j]); }
            s += __shfl_xor(s, 1); s += __shfl_xor(s, 2); s += __shfl_xor(s, 4);
            asm volatile("" ::: "memory");
            float y[8], yb[8]; unpack8(raw[rr][11], y); unpack8(raw[rr][12], yb);
            float sm = 0.f;
#pragma unroll
            for (int j = 0; j < 8; ++j) { y[j] += yb[j]; sm += y[j]; }
            sm += __shfl_xor(sm, 1); sm += __shfl_xor(sm, 2); sm += __shfl_xor(sm, 4);
            const float mean = sm * (1.f / 64.f); float sq = 0.f;
#pragma unroll
            for (int j = 0; j < 8; ++j) { y[j] -= mean; sq += y[j] * y[j]; }
            sq += __shfl_xor(sq, 1); sq += __shfl_xor(sq, 2); sq += __shfl_xor(sq, 4);
            const float rstd = __builtin_amdgcn_rsqf(sq * (1.f / 64.f) + 64e-5f);
            float gg[8]; unpack8(raw[rr][13], gg);
#pragma unroll
            for (int j = 0; j < 8; ++j) tmp[j] = (y[j] * rstd * lnw[c0 + j] + lnb[c0 + j] + s * v[j]) * gg[j];
            *(GAS v4u*)(ORW + o) = pack8(tmp); }
    }
}

struct EpiMerge {
    static constexpr bool PERM = true, AFTER_DRAIN = false;
    bf16* merged; const bf16* gates; int goff; int first;
    __device__ __forceinline__ void operator()(const f32x4 (&acc)[2][2][4][2], const Unit& u, int wr, int wc, int fr, int fq) const {
        const int row0 = u.pm * 256 + wr * 64 + fr, col0 = u.pn * 256 + wc * 32 + 8 * fq;
#pragma unroll
        for (int ai = 0; ai < 2; ++ai)
#pragma unroll
            for (int m = 0; m < 4; ++m) { const size_t row = (size_t)(row0 + ai * 128 + m * 16);
#pragma unroll
                for (int bj = 0; bj < 2; ++bj) { const int col = col0 + bj * 128;
                    float gt[8]; unpack8(*(const GAS v4u*)(gates + row * 2048 + goff + col), gt);
                    const f32x4 v0 = acc[ai][bj][m][0], v1 = acc[ai][bj][m][1];
                    float o[8] = {v0.x * gt[0], v0.y * gt[1], v0.z * gt[2], v0.w * gt[3], v1.x * gt[4], v1.y * gt[5], v1.z * gt[6], v1.w * gt[7]};
                    GAS v4u* p = (GAS v4u*)(merged + row * 1024 + col);
                    if (!first) { float pv[8]; unpack8(*p, pv);
#pragma unroll
                        for (int j = 0; j < 8; ++j) o[j] += pv[j]; }
                    *p = pack8(o); } }
    }
};
struct EpiMerge2 {
    static constexpr bool PERM = true, AFTER_DRAIN = false;
    bf16* merged; const bf16* gates;
    __device__ __forceinline__ void mid(f32x4 (&acc)[2][2][4][2], const Unit& u, int wr, int wc, int fr, int fq) const {
        const int row0 = u.pm * 256 + wr * 64 + fr, col0 = u.pn * 256 + wc * 32 + 8 * fq;
#pragma unroll
        for (int ai = 0; ai < 2; ++ai)
#pragma unroll
            for (int m = 0; m < 4; ++m) { const size_t row = (size_t)(row0 + ai * 128 + m * 16);
#pragma unroll
                for (int bj = 0; bj < 2; ++bj) { const int col = col0 + bj * 128;
                    float gr[8], ga[8]; unpack8(*(const GAS v4u*)(gates + row * 2048 + col), gr); unpack8(*(const GAS v4u*)(gates + row * 2048 + 1024 + col), ga);
                    float q[8];
#pragma unroll
                    for (int j = 0; j < 8; ++j) q[j] = gr[j] * __builtin_amdgcn_rcpf(fmaxf(ga[j], 1e-30f));
                    acc[ai][bj][m][0] *= (f32x4){q[0], q[1], q[2], q[3]}; acc[ai][bj][m][1] *= (f32x4){q[4], q[5], q[6], q[7]}; } }
    }
    __device__ __forceinline__ void operator()(const f32x4 (&acc)[2][2][4][2], const Unit& u, int wr, int wc, int fr, int fq) const {
        const int row0 = u.pm * 256 + wr * 64 + fr, col0 = u.pn * 256 + wc * 32 + 8 * fq;
#pragma unroll
        for (int ai = 0; ai < 2; ++ai)
#pragma unroll
            for (int m = 0; m < 4; ++m) { const size_t row = (size_t)(row0 + ai * 128 + m * 16);
#pragma unroll
                for (int bj = 0; bj < 2; ++bj) { const int col = col0 + bj * 128;
                    float ga[8]; unpack8(*(const GAS v4u*)(gates + row * 2048 + 1024 + col), ga);
                    const f32x4 v0 = acc[ai][bj][m][0], v1 = acc[ai][bj][m][1];
                    float o[8] = {v0.x * fmaxf(ga[0], 1e-30f), v0.y * fmaxf(ga[1], 1e-30f), v0.z * fmaxf(ga[2], 1e-30f), v0.w * fmaxf(ga[3], 1e-30f),
                                  v1.x * fmaxf(ga[4], 1e-30f), v1.y * fmaxf(ga[5], 1e-30f), v1.z * fmaxf(ga[6], 1e-30f), v1.w * fmaxf(ga[7], 1e-30f)};
                    *(GAS v4u*)(merged + row * 1024 + col) = pack8(o); } }
    }
};
struct EpiOutproj {
    static constexpr bool PERM = true, AFTER_DRAIN = false;
    bf16* delta; const float* mod;
    __device__ __forceinline__ void operator()(const f32x4 (&acc)[2][2][4][2], const Unit& u, int wr, int wc, int fr, int fq) const {
        const int row0 = u.pm * 256 + wr * 64 + fr, col0 = u.pn * 256 + wc * 32 + 8 * fq; const int b = u.pm >> 3;
        f32x4 gv[2][2];
#pragma unroll
        for (int bj = 0; bj < 2; ++bj)
#pragma unroll
            for (int n = 0; n < 2; ++n) gv[bj][n] = *(const f32x4*)(mod + (size_t)b * 6144 + 2048 + col0 + bj * 128 + 4 * n);
#pragma unroll
        for (int ai = 0; ai < 2; ++ai)
#pragma unroll
            for (int m = 0; m < 4; ++m) { const size_t off = (size_t)(row0 + ai * 128 + m * 16) * 1024 + col0;
#pragma unroll
                for (int bj = 0; bj < 2; ++bj) { const f32x4 v0 = gv[bj][0] * acc[ai][bj][m][0], v1 = gv[bj][1] * acc[ai][bj][m][1];
                    v4u w; w.x = pkbf(v0.x, v0.y); w.y = pkbf(v0.z, v0.w); w.z = pkbf(v1.x, v1.y); w.w = pkbf(v1.z, v1.w);
                    *(GAS v4u*)(delta + off + bj * 128) = w; } }
    }
};

constexpr int RW_PITCH = 2064;
__device__ __forceinline__ void p8_norm2_router(Frame& F) {
    LAS unsigned char* rhi = F.lds; LAS unsigned char* rlo = F.lds + 32 * RW_PITCH;
    const float* rw = karg_in(I_ROUTER);
    for (int i = F.tid; i < 16384; i += 512) { const int e = i & 15, k = i >> 4; const float w = rw[i]; const unsigned h = pkbf(w, 0.f) & 0xffffu; const float wl = w - __uint_as_float(h << 16);
        *(LAS bf16*)(rhi + e * RW_PITCH + 2 * k) = (bf16)h; *(LAS bf16*)(rlo + e * RW_PITCH + 2 * k) = (bf16)(pkbf(wl, 0.f) & 0xffffu); }
    for (int i = F.tid; i < 16 * 1024 / 2; i += 512) { const int e = 16 + i / 512, k2 = i % 512; *(LAS unsigned*)(rhi + e * RW_PITCH + 4 * k2) = 0u; *(LAS unsigned*)(rlo + e * RW_PITCH + 4 * k2) = 0u; }
    __syncthreads();
    const int gw = blockIdx.x * NWAVES + F.wave, NGW = F.G * NWAVES, lane = F.lane, l32 = lane & 31, hi = lane >> 5;
    const float* mod = (const float*)(F.ws + WS_MOD); bf16* H2 = (bf16*)(F.ws + WS_H2); float* AFF = (float*)(F.ws + WS_AFF);
    const float* g2 = karg_in(I_N2G); const float* Xp = karg_in(I_X); const bf16* DELTA = (const bf16*)(F.ws + WS_DELTA);
    f32x4 gv[4];
#pragma unroll
    for (int j = 0; j < 4; ++j) gv[j] = *(const f32x4*)(g2 + 4 * lane + 256 * j);
    for (int tile = gw; tile < NLAT / 32; tile += NGW) {
        const int mbase = tile * 32, b = mbase >> 11; const float* sh = mod + (size_t)b * 6144 + 3072; const float* sc = sh + 1024;
        f32x4 av[4], bv[4];
#pragma unroll
        for (int j = 0; j < 4; ++j) { av[j] = *(const f32x4*)(sc + 4 * lane + 256 * j) + 1.0f; bv[j] = *(const f32x4*)(sh + 4 * lane + 256 * j); }
#pragma unroll 1
        for (int r0 = 0; r0 < 32; r0 += 4) {
            f32x4 v[4][4];
#pragma unroll
            for (int r = 0; r < 4; ++r) { const float* xr = Xp + (size_t)(mbase + r0 + r) * DM; const bf16* dr = DELTA + (size_t)(mbase + r0 + r) * DM;
#pragma unroll
                for (int j = 0; j < 4; ++j) { const v2u d = *(const GAS v2u*)(dr + 4 * lane + 256 * j);
                    v[r][j] = *(const GAS f32x4*)(xr + 4 * lane + 256 * j) + (f32x4){bflo(d.x), bfhi(d.x), bflo(d.y), bfhi(d.y)}; } }
#pragma unroll
            for (int r = 0; r < 4; ++r) { float s = 0.f;
#pragma unroll
                for (int j = 0; j < 4; ++j) s += (v[r][j].x * v[r][j].x + v[r][j].y * v[r][j].y) + (v[r][j].z * v[r][j].z + v[r][j].w * v[r][j].w);
                const float rstd = __builtin_amdgcn_rsqf(wave_sum(s) * (1.f / DM) + 1e-6f);
#pragma unroll
                for (int j = 0; j < 4; ++j) { const f32x4 y = v[r][j] * rstd * gv[j] * av[j] + bv[j];
                    v2u o; o.x = pkbf(y.x, y.y); o.y = pkbf(y.z, y.w);
                    *(GAS v2u*)(H2 + (size_t)(mbase + r0 + r) * DM + 4 * lane + 256 * j) = o; } }
        }
        asm volatile("s_waitcnt vmcnt(0)" ::: "memory");
        f32x16 acc;
#pragma unroll
        for (int r = 0; r < 16; ++r) acc[r] = 0.f;
        const bf16* hrow = H2 + (size_t)(mbase + l32) * DM + 8 * hi;
        const LAS unsigned char* ah = rhi + l32 * RW_PITCH + 16 * hi; const LAS unsigned char* al = rlo + l32 * RW_PITCH + 16 * hi;
#pragma unroll 8
        for (int ks = 0; ks < 64; ++ks) { const bf16x8 bf = *(const GAS bf16x8*)(hrow + 16 * ks);
            const bf16x8 fh = *(const LAS bf16x8*)(ah + 32 * ks), fl = *(const LAS bf16x8*)(al + 32 * ks);
            acc = __builtin_amdgcn_mfma_f32_32x32x16_bf16(fh, bf, acc, 0, 0, 0); acc = __builtin_amdgcn_mfma_f32_32x32x16_bf16(fl, bf, acc, 0, 0, 0); }
        float mx = acc[0];
#pragma unroll
        for (int r = 1; r < 8; ++r) mx = fmaxf(mx, acc[r]);
        mx = fmaxf(mx, __shfl_xor(mx, 32));
        float pe[8], den = 0.f;
#pragma unroll
        for (int r = 0; r < 8; ++r) { pe[r] = __expf(acc[r] - mx); den += pe[r]; }
        den += __shfl_xor(den, 32);
        const float inv = 1.0f / den; const int t = (mbase & 2047) + l32;
#pragma unroll
        for (int r = 0; r < 8; ++r) { const int e = (r & 3) + 8 * (r >> 2) + 4 * hi; AFF[((size_t)b * 16 + e) * SEQ + t] = pe[r] * inv; }
    }
}

__device__ __forceinline__ int block_count(Frame& F, LAS int* wc, int slot, bool p0, bool p1, bool p2, bool p3) {
    const int c = __builtin_popcountll(__ballot(p0)) + __builtin_popcountll(__ballot(p1)) + __builtin_popcountll(__ballot(p2)) + __builtin_popcountll(__ballot(p3));
    if (F.lane == 0) wc[slot * 8 + F.wave] = c;
    __syncthreads();
    int s = 0;
#pragma unroll
    for (int w = 0; w < 8; ++w) s += wc[slot * 8 + w];
    return s;
}
__device__ __forceinline__ void p9_topk_gather(Frame& F) {
    LAS int* wc = (LAS int*)F.lds;
    LAS int* sel = (LAS int*)(F.lds + 1024);
    const float* AFF = (const float*)(F.ws + WS_AFF); int* IDX = (int*)(F.ws + WS_IDX); float* VAL = (float*)(F.ws + WS_VAL);
    const bf16* H2 = (const bf16*)(F.ws + WS_H2); bf16* XE = (bf16*)(F.ws + WS_XE); int* INV = (int*)(F.ws + WS_INV);
    const int tid = F.tid, lane = F.lane, wave = F.wave;
    for (int p = blockIdx.x; p < NB * NE; p += F.G) {
        const int b = p >> 4, e = p & 15;
        const f32x4 av = *(const GAS f32x4*)(AFF + (size_t)p * SEQ + 4 * tid);
        const unsigned u0 = __float_as_uint(av.x), u1 = __float_as_uint(av.y), u2 = __float_as_uint(av.z), u3 = __float_as_uint(av.w);
        unsigned tau = 0u; int it = 0;
        for (int bit = 30; bit >= 0; --bit, ++it) { const unsigned cand = tau | (1u << bit);
            const int cnt = block_count(F, wc, it & 1, u0 >= cand, u1 >= cand, u2 >= cand, u3 >= cand);
            if (cnt >= CAP) tau = cand; }
        const int cgt = block_count(F, wc, it & 1, u0 > tau, u1 > tau, u2 > tau, u3 > tau); ++it;
        const int need_eq = CAP - cgt;
        const int ngt = (u0 > tau) + (u1 > tau) + (u2 > tau) + (u3 > tau), neq = (u0 == tau) + (u1 == tau) + (u2 == tau) + (u3 == tau);
        int pk = ngt | (neq << 16), inc = pk;
#pragma unroll
        for (int o = 1; o < 64; o <<= 1) { const int nb = __shfl_up(inc, o); if (lane >= o) inc += nb; }
        if (lane == 63) wc[16 + wave] = inc;
        __syncthreads();
        int base = 0;
#pragma unroll
        for (int w = 0; w < 8; ++w) base += (w < wave) ? wc[16 + w] : 0;
        int ex = base + inc - pk; int gpos = ex & 0xffff, epos = ex >> 16;
        const unsigned uu[4] = {u0, u1, u2, u3}; const float ff[4] = {av.x, av.y, av.z, av.w};
#pragma unroll
        for (int j = 0; j < 4; ++j) { int slot = -1;
            if (uu[j] > tau) { slot = gpos; ++gpos; } else if (uu[j] == tau) { if (epos < need_eq) slot = cgt + epos; ++epos; }
            if (slot >= 0) { IDX[(size_t)(e * NB + b) * CAP + slot] = 4 * tid + j; VAL[(size_t)(e * NB + b) * CAP + slot] = ff[j]; sel[slot] = 4 * tid + j; }
            INV[((size_t)b * SEQ + 4 * tid + j) * 16 + e] = slot; }
        __syncthreads();
        __syncthreads();
    }
}

struct ExpertOrder {
    int G, c, upe, npn;
    __device__ void init(int G_, int c_, int npn_) { G = G_; c = c_; npn = npn_; upe = 32 * npn_; }
    __device__ bool next(int i, Unit& u) const { const long L = (long)i * G + c; if (L >= (long)NE * upe) return false;
        const int e = (int)(L / upe), rem = (int)(L % upe); u.pm = e * 32 + (rem & 31); u.pn = e * npn + (rem >> 5); return true; }
    __device__ __forceinline__ void a_ready(const Unit&) const {}
    __device__ __forceinline__ void done(const Unit&) const {}
};
struct EpiSwiglu {
    static constexpr bool PERM = true, AFTER_DRAIN = false;
    bf16* act;
    __device__ __forceinline__ void operator()(const f32x4 (&acc)[2][2][4][2], const Unit& u, int wr, int wc, int fr, int fq) const {
        const int e = u.pm >> 5, pnl = u.pn - 12 * e; const int row0 = u.pm * 256 + wr * 64 + fr, col = 128 * pnl + wc * 32 + 8 * fq;
#pragma unroll
        for (int ai = 0; ai < 2; ++ai)
#pragma unroll
            for (int m = 0; m < 4; ++m) { const f32x4 g0 = acc[ai][0][m][0], g1 = acc[ai][0][m][1], u0 = acc[ai][1][m][0], u1 = acc[ai][1][m][1];
                float o[8] = {g0.x * sigmoidf_(g0.x) * u0.x, g0.y * sigmoidf_(g0.y) * u0.y, g0.z * sigmoidf_(g0.z) * u0.z, g0.w * sigmoidf_(g0.w) * u0.w,
                              g1.x * sigmoidf_(g1.x) * u1.x, g1.y * sigmoidf_(g1.y) * u1.y, g1.z * sigmoidf_(g1.z) * u1.z, g1.w * sigmoidf_(g1.w) * u1.w};
                *(GAS v4u*)(act + (size_t)(row0 + ai * 128 + m * 16) * DFF + col) = pack8(o); }
    }
};
struct EpiDown {
    static constexpr bool PERM = true, AFTER_DRAIN = false;
    bf16* y2; const float* val;
    __device__ __forceinline__ void operator()(const f32x4 (&acc)[2][2][4][2], const Unit& u, int wr, int wc, int fr, int fq) const {
        const int e = u.pm >> 5, pnl = u.pn - 4 * e; const int srow0 = u.pm * 256 + wr * 64 + fr, col0 = pnl * 256 + wc * 32 + 8 * fq;
#pragma unroll
        for (int ai = 0; ai < 2; ++ai)
#pragma unroll
            for (int m = 0; m < 4; ++m) { const int srow = srow0 + ai * 128 + m * 16; const float vl = val[srow];
#pragma unroll
                for (int bj = 0; bj < 2; ++bj) { const f32x4 v0 = acc[ai][bj][m][0] * vl, v1 = acc[ai][bj][m][1] * vl;
                    v4u w; w.x = pkbf(v0.x, v0.y); w.y = pkbf(v0.z, v0.w); w.z = pkbf(v1.x, v1.y); w.w = pkbf(v1.z, v1.w);
                    *(GAS v4u*)(y2 + (size_t)srow * DM + col0 + bj * 128) = w; } }
    }
};
__device__ __forceinline__ void p12_combine(Frame& F, bool dostore = true) {
    const int gw = blockIdx.x * NWAVES + F.wave, NGW = F.G * NWAVES, lane = F.lane;
    const int* INV = (const int*)(F.ws + WS_INV); const bf16* Y2 = (const bf16*)(F.ws + WS_Y2); const float* mod = (const float*)(F.ws + WS_MOD);
    const float* Xp = karg_in(I_X); const bf16* DELTA = (const bf16*)(F.ws + WS_DELTA);
    for (int m0 = gw; m0 < NLAT; m0 += 2 * NGW) {
        int inv[2]; f32x4 xv[2][4];
#pragma unroll
        for (int r = 0; r < 2; ++r) { const int m = min(m0 + r * NGW, NLAT - 1);
            { const int iv = INV[(size_t)m * 16 + (lane & 15)]; inv[r] = lane < 16 ? iv : -1; const float* orow = Xp + (size_t)m * DM; const bf16* dr = DELTA + (size_t)m * DM;
                const v4u d0 = *(const GAS v4u*)(dr + 8 * lane), d1 = *(const GAS v4u*)(dr + 512 + 8 * lane);
                xv[r][0] = *(const GAS f32x4*)(orow + 8 * lane) + (f32x4){bflo(d0.x), bfhi(d0.x), bflo(d0.y), bfhi(d0.y)}; xv[r][1] = *(const GAS f32x4*)(orow + 8 * lane + 4) + (f32x4){bflo(d0.z), bfhi(d0.z), bflo(d0.w), bfhi(d0.w)};
                xv[r][2] = *(const GAS f32x4*)(orow + 512 + 8 * lane) + (f32x4){bflo(d1.x), bfhi(d1.x), bflo(d1.y), bfhi(d1.y)}; xv[r][3] = *(const GAS f32x4*)(orow + 512 + 8 * lane + 4) + (f32x4){bflo(d1.z), bfhi(d1.z), bflo(d1.w), bfhi(d1.w)}; } }
#pragma unroll
        for (int r = 0; r < 2; ++r) { const int m = m0 + r * NGW; if (m >= NLAT) continue;
            const int b = m >> 11; unsigned long long mk = __ballot(inv[r] >= 0);
            float a0[8] = {0.f, 0.f, 0.f, 0.f, 0.f, 0.f, 0.f, 0.f}, a1[8] = {0.f, 0.f, 0.f, 0.f, 0.f, 0.f, 0.f, 0.f};
            while (mk) {
                const int e = __builtin_ctzll(mk); mk &= mk - 1; const int slot = __builtin_amdgcn_readlane(inv[r], e);
                const bool two = mk != 0; int e2 = e, slot2 = slot; if (two) { e2 = __builtin_ctzll(mk); mk &= mk - 1; slot2 = __builtin_amdgcn_readlane(inv[r], e2); }
                const bf16* yr = Y2 + ((size_t)(e * NB + b) * CAP + slot) * DM; const bf16* yr2 = Y2 + ((size_t)(e2 * NB + b) * CAP + slot2) * DM;
                const v4u q0 = *(const GAS v4u*)(yr + 8 * lane), q1 = *(const GAS v4u*)(yr + 512 + 8 * lane), q2 = *(const GAS v4u*)(yr2 + 8 * lane), q3 = *(const GAS v4u*)(yr2 + 512 + 8 * lane);
                float f0[8], f1[8], f2[8], f3[8]; unpack8(q0, f0); unpack8(q1, f1); unpack8(q2, f2); unpack8(q3, f3);
                const float w2 = two ? 1.0f : 0.0f;
#pragma unroll
                for (int j = 0; j < 8; ++j) { a0[j] += f0[j] + w2 * f2[j]; a1[j] += f1[j] + w2 * f3[j]; }
            }
            float* orow = F.out + (size_t)m * DM; const float* g = mod + (size_t)b * 6144 + 5120;
            const f32x4 g0 = *(const f32x4*)(g + 8 * lane), g1 = *(const f32x4*)(g + 8 * lane + 4), g2 = *(const f32x4*)(g + 512 + 8 * lane), g3 = *(const f32x4*)(g + 512 + 8 * lane + 4);
            if (dostore) {
            *(GAS f32x4*)(orow + 8 * lane) = xv[r][0] + g0 * (f32x4){a0[0], a0[1], a0[2], a0[3]}; *(GAS f32x4*)(orow + 8 * lane + 4) = xv[r][1] + g1 * (f32x4){a0[4], a0[5], a0[6], a0[7]};
            *(GAS f32x4*)(orow + 512 + 8 * lane) = xv[r][2] + g2 * (f32x4){a1[0], a1[1], a1[2], a1[3]}; *(GAS f32x4*)(orow + 512 + 8 * lane + 4) = xv[r][3] + g3 * (f32x4){a1[4], a1[5], a1[6], a1[7]}; }
        }
    }
}

struct Args { const float* in[30]; float* out; unsigned char* ws; int ph_lo, ph_hi; };
__global__ void __launch_bounds__(NWAVES * 64, 2) mk_fwd(Args args) {
    extern __shared__ __attribute__((aligned(16))) unsigned char lds[];
    Frame F;
    F.lds = (LAS unsigned char*)lds; F.MISC = (volatile LAS unsigned*)(F.lds + MISC_OFF);
    F.tid = threadIdx.x; F.lane = F.tid & 63; F.wave = __builtin_amdgcn_readfirstlane(F.tid >> 6); F.G = gridDim.x;
    F.out = args.out; F.ws = args.ws; F.ctl = (gu32*)(args.ws + WS_CTL);
    for (int u = F.tid; u < (LDS_BYTES - LDSCTL_OFF) / 4; u += NWAVES * 64) ((LAS unsigned*)(F.lds + LDSCTL_OFF))[u] = 0u;
    __syncthreads();
    XcdBarrier bar; bar.bar = (unsigned*)(F.ctl + CW_BAR); bar.x = 0; bar.st = nullptr;
    if (N_LAUNCHES == 1) bar = xcd_barrier_post((unsigned*)(F.ctl + CW_BAR), F.MISC + 8);
#define GRID_BAR() do { if (N_LAUNCHES == 1) xcd_barrier(bar); } while (0)
    const int lo = args.ph_lo, hi = args.ph_hi;
#ifndef PH_MASK
#define PH_MASK 0x1FFF
#endif
#define IN(k) (((PH_MASK >> (k)) & 1) && lo <= (k) && (k) < hi)
#define SEAM(k) do { if (IN(k) && IN((k) + 1)) GRID_BAR(); } while (0)
    unsigned char* ws = args.ws;

    if (IN(0)) { p0_prologue(F); } SEAM(0);
    if (IN(1)) { p1_norm1(F); } SEAM(1);
    if (IN(2)) {
        pg8::Gemm g{(const bf16*)(ws + WS_H1), (const bf16*)(ws + WS_WIN), NTOK, WIN_ROWS, DM}; InprojOrder S; S.init(F.G, (int)blockIdx.x);
        EpiInproj E{(bf16*)(ws + WS_ZK), (bf16*)(ws + WS_ZV), (bf16*)(ws + WS_ZR), (bf16*)(ws + WS_Q), (bf16*)(ws + WS_KQ), (bf16*)(ws + WS_VQ), (bf16*)(ws + WS_LA), (bf16*)args.out};
        pg8::gemm_phase<EpiInproj, InprojOrder, true, true>(F.lds, g, S, E);
    } SEAM(2);
    if (IN(3)) {
        p3a_lora(F);
        p3b_attn_prep(F);
    } SEAM(3);
    if (IN(4)) { p4a_attention(F); __syncthreads(); p4b_scan(F); } SEAM(4);
    if (IN(5)) { p5_rwkv_out(F); } SEAM(5);
    if (IN(6)) {
        pg8::Gemm g{(const bf16*)(ws + WS_ORW), (const bf16*)(ws + WS_WBRR), NLAT, DM, DM, (const bf16*)(ws + WS_Q), 512}; pg8::StaticOrder S; S.init(NLAT, DM, F.G, (int)blockIdx.x);
        EpiMerge2 E{(bf16*)(ws + WS_MERGED), (const bf16*)args.out};
        pg8::gemm_phase<EpiMerge2, pg8::StaticOrder, true, true, true>(F.lds, g, S, E);
    } SEAM(6);
    if (IN(7)) {
        pg8::Gemm g{(const bf16*)(ws + WS_MERGED), (const bf16*)(ws + WS_WOUT), NLAT, DM, DM}; pg8::StaticOrder S; S.init(NLAT, DM, F.G, (int)blockIdx.x);
        EpiOutproj E{(bf16*)(ws + WS_DELTA), (const float*)(ws + WS_MOD)};
        pg8::gemm_phase<EpiOutproj, pg8::StaticOrder, true, true>(F.lds, g, S, E);
    } SEAM(7);
    if (IN(8)) { p8_norm2_router(F); } SEAM(8);
    if (IN(9)) { p9_topk_gather(F); } SEAM(9);
    if (IN(10)) {
        pg8::Gemm g{(const bf16*)(ws + WS_H2), (const bf16*)(ws + WS_WGU), NSLOT, NE * 3072, DM, nullptr, 0, (const int*)(ws + WS_IDX), (LAS int*)(F.lds + RING_BYTES)}; ExpertOrder S; S.init(F.G, (int)blockIdx.x, 12);
        EpiSwiglu E{(bf16*)(ws + WS_ACT)};
        pg8::gemm_phase<EpiSwiglu, ExpertOrder, true, true, false, true>(F.lds, g, S, E);
    } SEAM(10);
    if (IN(11)) {
        pg8::Gemm g{(const bf16*)(ws + WS_ACT), (const bf16*)(ws + WS_WD), NSLOT, NE * 1024, DFF}; ExpertOrder S; S.init(F.G, (int)blockIdx.x, 4);
        EpiDown E{(bf16*)(ws + WS_Y2), (const float*)(ws + WS_VAL)};
        pg8::gemm_phase<EpiDown, ExpertOrder, true, true>(F.lds, g, S, E);
    } SEAM(11);
    if (IN(12)) { p12_combine(F); }
#undef IN
#undef SEAM
#undef GRID_BAR
}

extern "C" void kernel_launch(void* const* d_in, const int* in_sizes, int n_in, void* d_out, int out_size, void* d_ws, size_t ws_size, hipStream_t stream) {
    static int grid = 0;
    if (grid == 0) {
        if (n_in != 30 || out_size != NLAT * DM || ws_size < WS_END) { fprintf(stderr, "kernel_launch: unexpected problem (n_in %d out %d ws %zu)\n", n_in, out_size, ws_size); grid = -1; return; }
        int dev = 0, cus = 0, per_cu = 0;
        if (hipGetDevice(&dev) != hipSuccess || hipDeviceGetAttribute(&cus, hipDeviceAttributeMultiprocessorCount, dev) != hipSuccess) { grid = -1; return; }
        if (hipFuncSetAttribute((const void*)mk_fwd, hipFuncAttributeMaxDynamicSharedMemorySize, LDS_BYTES) != hipSuccess) { fprintf(stderr, "kernel_launch: hipFuncSetAttribute failed\n"); grid = -1; return; }
        if (hipOccupancyMaxActiveBlocksPerMultiprocessor(&per_cu, (const void*)mk_fwd, NWAVES * 64, LDS_BYTES) != hipSuccess || per_cu < 1) fprintf(stderr, "kernel_launch: occupancy query says %d\n", per_cu);
        (void)hipGetLastError();
        grid = cus;
    }
    if (grid < 0) return;
    if (hipMemsetAsync((char*)d_ws + WS_CTL, 0, CTL_ZERO_BYTES, stream) != hipSuccess) return;
    Args a{};
    for (int i = 0; i < 30; ++i) a.in[i] = (const float*)d_in[i];
    a.out = (float*)d_out; a.ws = (unsigned char*)d_ws;
    if (N_LAUNCHES == 1) { a.ph_lo = 0; a.ph_hi = N_PHASES; hipLaunchKernelGGL(mk_fwd, dim3(grid), dim3(NWAVES * 64), LDS_BYTES, stream, a); }
    else for (int li = 0; li < N_PHASES; ++li) { a.ph_lo = li; a.ph_hi = li + 1; hipLaunchKernelGGL(mk_fwd, dim3(grid), dim3(NWAVES * 64), LDS_BYTES, stream, a); }
}
```

```cpp
#include <hip/hip_runtime.h>
#include <cstdio>
#include <cstdint>
#define MK_N_LAUNCHES 1
namespace pg8 {
#define PG8_LAS __attribute__((address_space(3)))
typedef unsigned short bf16_t;
typedef short bf16x8 __attribute__((ext_vector_type(8)));
typedef float f32x4 __attribute__((ext_vector_type(4)));
typedef unsigned u32x4 __attribute__((ext_vector_type(4)));
constexpr int BM = 256, BK = 64, HALF = 128, HTB = HALF * BK * 2  , STAGE_BYTES = 8 * HTB, NXCD = 8, WGM = 8;

__host__ __device__ __forceinline__ int lds_byte(int r, int c) { const int st = (r >> 4) * 2 + (c >> 5), rr = r & 15, cc = c & 31, ob = rr * 64 + cc * 2; return st * 1024 + (ob ^ (((ob >> 9) & 1) << 5)); }
__host__ __device__ __forceinline__ void stage_rc(int b, int& R, int& C) { const int st = b / 1024, sb = b % 1024, swz = sb ^ (((sb >> 9) & 1) << 5); R = (st >> 1) * 16 + swz / 64; C = (st & 1) * 32 + (swz % 64) / 2; }
__host__ __device__ __forceinline__ int perm32(int rho) { const int n = rho >> 4, i = rho & 15; return 8 * (i >> 2) + 4 * n + (i & 3); }

struct Unit { int pm, pn; };
struct Gemm { const bf16_t* A; const bf16_t* Bt; int M, N, K; const bf16_t* A2 = nullptr; int lda = 0; const int* gidx = nullptr; PG8_LAS int* glds = nullptr; };

struct StaticOrder {
    int nM, nN, nwg, G, c;
    __host__ __device__ void init(int M, int N, int G_, int c_) { nM = M / BM; nN = N / BM; nwg = nM * nN; G = G_; c = c_; }
    __host__ __device__ bool next(int i, Unit& u) const {
        const long L = (long)i * G + c; if (L >= nwg) return false;
        int wgid = (int)L; { const int q = nwg / NXCD, r = nwg % NXCD, xcd = wgid % NXCD, off = wgid / NXCD; wgid = (xcd < r ? xcd * (q + 1) : r * (q + 1) + (xcd - r) * q) + off; }
        const int nig = WGM * nN, gid = wgid / nig, fm = gid * WGM, gsz = (nM - fm) < WGM ? (nM - fm) : WGM;
        u.pm = fm + ((wgid % nig) % gsz); u.pn = (wgid % nig) / gsz; return true;
    }
    __device__ __forceinline__ void a_ready(const Unit&) const {}
    __device__ __forceinline__ void done(const Unit&) const {}
};

template <class Epi, class Sched, bool ALIGN_EPI = false, bool SP2 = false, bool SPLITA = false, bool GATHERA = false>
__device__ __forceinline__ void gemm_phase(PG8_LAS unsigned char* lds, const Gemm g, const Sched& S, const Epi& E) {
    const int tid = threadIdx.x, wid = __builtin_amdgcn_readfirstlane(tid >> 6), lane = tid & 63, wr = wid >> 2, wc = wid & 3, fr = lane & 15, fq = lane >> 4;
    const int K = g.K, nt = K / BK, lda = g.lda ? g.lda : g.K, nh = nt / 2;
    unsigned voffA[2], voffB[2];
#pragma unroll
    for (int i = 0; i < 2; ++i) { int R, C; stage_rc(tid * 16 + i * 8192, R, C); const int Rb = Epi::PERM ? ((R & ~31) + perm32(R & 31)) : R;
        voffA[i] = (unsigned)(R * lda + C) * 2u; voffB[i] = (unsigned)(Rb * K + C) * 2u; }
    const size_t kstep = (size_t)(BK * 2);
    const size_t hstep = (size_t)HALF * K * 2;
    const size_t tstep = 2 * hstep;
    const size_t hstepA = (size_t)HALF * lda * 2, tstepA = 2 * hstepA;
    const unsigned ldsw = (unsigned)wid * 1024u;
    const int aoff = lds_byte(wr * 64 + fr, fq * 8), boff = lds_byte(wc * 32 + fr, fq * 8);
#define PG8_SA(b, h) (((b) * 2 + (h)) * HTB)
#define PG8_SB(b, h) ((4 + (b) * 2 + (h)) * HTB)
#define PG8_STAGE(bufoff, gbase, voff) do { _Pragma("unroll") for (int _i = 0; _i < 2; ++_i) \
        __builtin_amdgcn_global_load_lds((const unsigned*)((const char*)(gbase) + (voff)[_i]), (PG8_LAS unsigned*)(lds + (bufoff) + ldsw + _i * 8192), 16, 0, 0); } while (0)
#define PG8_LDA(dst, b, h) do { _Pragma("unroll") for (int m = 0; m < 4; ++m) _Pragma("unroll") for (int k = 0; k < 2; ++k) dst[m][k] = *(const PG8_LAS bf16x8*)(lds + PG8_SA(b, h) + aoff + m * 2048 + k * 1024); } while (0)
#define PG8_LDB(dst, b, h) do { _Pragma("unroll") for (int n = 0; n < 2; ++n) _Pragma("unroll") for (int k = 0; k < 2; ++k) dst[n][k] = *(const PG8_LAS bf16x8*)(lds + PG8_SB(b, h) + boff + n * 2048 + k * 1024); } while (0)
#define PG8_MMA(ai, bj, At, Bt) do { __builtin_amdgcn_s_setprio(1); _Pragma("unroll") for (int m = 0; m < 4; ++m) _Pragma("unroll") for (int n = 0; n < 2; ++n) _Pragma("unroll") for (int k = 0; k < 2; ++k) \
        acc[ai][bj][m][n] = __builtin_amdgcn_mfma_f32_16x16x32_bf16(Bt[n][k], At[m][k], acc[ai][bj][m][n], 0, 0, 0); __builtin_amdgcn_s_setprio(0); } while (0)
#define PG8_WAIT_V(n) asm volatile("s_waitcnt vmcnt(" #n ")" ::: "memory")
#define PG8_WAIT_L(n) asm volatile("s_waitcnt lgkmcnt(" #n ")" ::: "memory")
#define PG8_BAR __builtin_amdgcn_s_barrier()
#define PG8_SCHED __builtin_amdgcn_sched_barrier(0)
    Unit cur, nxt; int ui = 0;
    if (!S.next(0, cur)) return;
    f32x4 acc[2][2][4][2];
#pragma unroll
    for (int a = 0; a < 2; ++a)
#pragma unroll
        for (int b = 0; b < 2; ++b)
#pragma unroll
            for (int m = 0; m < 4; ++m)
#pragma unroll
                for (int n = 0; n < 2; ++n) acc[a][b][m][n] = (f32x4){0.f, 0.f, 0.f, 0.f};
    bf16x8 At[4][2], B0[2][2], B1[2][2];
    const char* cA = (const char*)g.A + (size_t)cur.pm * tstepA; const char* cB = (const char*)g.Bt + (size_t)cur.pn * tstep;
    const char* cA2 = SPLITA ? (const char*)g.A2 + (size_t)cur.pm * tstepA : cA;
#define PG8_AADDR(tt) (SPLITA ? (((tt) < nh) ? cA + (size_t)(tt) * kstep : cA2 + (size_t)((tt) - nh) * kstep) : cA + (size_t)(tt) * kstep)
    unsigned gofc[2][2] = {{0u, 0u}, {0u, 0u}}, gofn[2][2] = {{0u, 0u}, {0u, 0u}}; int gR[2] = {0, 0}, gC[2] = {0, 0};
    if constexpr (GATHERA) {
#pragma unroll
        for (int i = 0; i < 2; ++i) { int R, C; stage_rc(tid * 16 + i * 8192, R, C); gR[i] = R; gC[i] = C; }
        if (tid < 256) g.glds[tid] = g.gidx[cur.pm * 256 + tid];
        asm volatile("s_waitcnt vmcnt(0) lgkmcnt(0)" ::: "memory"); __builtin_amdgcn_s_barrier(); asm volatile("" ::: "memory");
#pragma unroll
        for (int hh = 0; hh < 2; ++hh)
#pragma unroll
            for (int i = 0; i < 2; ++i) gofc[hh][i] = (unsigned)(((cur.pm & 31) * 2048 + g.glds[hh * 128 + gR[i]]) * lda + gC[i]) * 2u;
        cA = (const char*)g.A; cA2 = cA;
    }
#define PG8_GA(hh) (GATHERA ? gofc[hh] : voffA)
#define PG8_GN(hh) (GATHERA ? (last ? gofn[hh] : gofc[hh]) : voffA)
#define PG8_HA(x) (GATHERA ? (x) : (x) + hstepA)
    S.a_ready(cur);
    if constexpr (SP2) {
        PG8_STAGE(PG8_SB(0, 0), cB, voffB); PG8_STAGE(PG8_SB(0, 1), cB + hstep, voffB); PG8_STAGE(PG8_SA(0, 0), cA, PG8_GA(0)); PG8_STAGE(PG8_SA(0, 1), PG8_HA(cA), PG8_GA(1));
        if (wr == 1) PG8_BAR;
        PG8_WAIT_V(2); PG8_BAR;
        PG8_STAGE(PG8_SB(1, 0), cB + kstep, voffB); PG8_STAGE(PG8_SA(1, 0), cA + kstep, PG8_GA(0)); PG8_STAGE(PG8_SB(1, 1), cB + hstep + kstep, voffB);
        PG8_WAIT_V(6); PG8_BAR;
    } else {
        PG8_STAGE(PG8_SB(0, 0), cB, voffB); PG8_STAGE(PG8_SA(0, 0), cA, voffA); PG8_STAGE(PG8_SB(0, 1), cB + hstep, voffB); PG8_STAGE(PG8_SA(0, 1), cA + hstepA, voffA);
        if (wr == 1) PG8_BAR;
        PG8_WAIT_V(4); PG8_BAR;
        PG8_STAGE(PG8_SB(1, 0), cB + kstep, voffB); PG8_STAGE(PG8_SA(1, 0), cA + kstep, PG8_GA(0)); PG8_STAGE(PG8_SB(1, 1), cB + hstep + kstep, voffB);
        PG8_WAIT_V(6); PG8_BAR;
    }
    for (;;) {
        const bool has_next = S.next(ui + 1, nxt);
        const char* nA = has_next ? (const char*)g.A + (size_t)nxt.pm * tstepA : cA; const char* nB = has_next ? (const char*)g.Bt + (size_t)nxt.pn * tstep : cB;
        const char* nA2 = (SPLITA && has_next) ? (const char*)g.A2 + (size_t)nxt.pm * tstepA : cA2;
        if constexpr (GATHERA) { nA = cA;
            if (has_next) __builtin_amdgcn_global_load_lds((const unsigned*)(g.gidx + nxt.pm * 256 + (wid & 3) * 64 + lane), (PG8_LAS unsigned*)(g.glds + ((ui + 1) & 1) * 256 + (wid & 3) * 64), 4, 0, 0); }
        for (int t = 0; t < nt; t += 2) {
            const bool last = (t == nt - 2);
            const char* a1 = PG8_AADDR(t + 1);
            const char* a2 = last ? nA : PG8_AADDR(t + 2); const char* b2 = last ? nB : cB + (size_t)(t + 2) * kstep;
            const char* a3 = a2 + kstep; const char* b3 = b2 + kstep;
            if (last && has_next) S.a_ready(nxt);
            if constexpr (GATHERA) { if (last && has_next) {
#pragma unroll
                for (int hh = 0; hh < 2; ++hh)
#pragma unroll
                    for (int i = 0; i < 2; ++i) gofn[hh][i] = (unsigned)(((nxt.pm & 31) * 2048 + g.glds[((ui + 1) & 1) * 256 + hh * 128 + gR[i]]) * lda + gC[i]) * 2u; } }
            if constexpr (SPLITA) { if (t == nh) E.mid(acc, cur, wr, wc, fr, fq); }
            if constexpr (SP2) {
            PG8_LDB(B0, 0, 0); PG8_LDB(B1, 0, 1); PG8_SCHED; PG8_LDA(At, 0, 0); PG8_STAGE(PG8_SA(1, 1), PG8_HA(a1), PG8_GA(1));
            PG8_WAIT_V(8); PG8_WAIT_L(0); PG8_BAR; PG8_MMA(0, 0, At, B0); PG8_MMA(0, 1, At, B1); PG8_BAR; PG8_SCHED;
            PG8_LDA(At, 0, 1); PG8_STAGE(PG8_SB(0, 0), b2, voffB); PG8_STAGE(PG8_SB(0, 1), b2 + hstep, voffB); PG8_STAGE(PG8_SA(0, 0), a2, PG8_GN(0));
            PG8_WAIT_V(8); PG8_WAIT_L(0); PG8_BAR; PG8_MMA(1, 0, At, B0); PG8_MMA(1, 1, At, B1); PG8_BAR; PG8_SCHED;
            PG8_LDB(B0, 1, 0); PG8_LDB(B1, 1, 1); PG8_SCHED; PG8_LDA(At, 1, 0); PG8_STAGE(PG8_SA(0, 1), PG8_HA(a2), PG8_GN(1));
            PG8_WAIT_V(8); PG8_WAIT_L(0); PG8_BAR; PG8_MMA(0, 0, At, B0); PG8_MMA(0, 1, At, B1); PG8_BAR; PG8_SCHED;
            PG8_LDA(At, 1, 1); PG8_STAGE(PG8_SB(1, 0), b3, voffB); PG8_STAGE(PG8_SB(1, 1), b3 + hstep, voffB); PG8_STAGE(PG8_SA(1, 0), a3, PG8_GN(0));
            PG8_WAIT_V(8); PG8_WAIT_L(0); PG8_BAR; PG8_MMA(1, 0, At, B0); PG8_MMA(1, 1, At, B1); PG8_BAR; PG8_SCHED;
            } else {
            PG8_LDB(B0, 0, 0); PG8_SCHED; PG8_LDA(At, 0, 0); PG8_STAGE(PG8_SA(1, 1), a1 + hstepA, voffA);
            PG8_WAIT_L(8); PG8_BAR; PG8_WAIT_L(0); PG8_MMA(0, 0, At, B0); PG8_BAR; PG8_SCHED;
            PG8_LDB(B1, 0, 1); PG8_STAGE(PG8_SB(0, 0), b2, voffB);
            PG8_BAR; PG8_WAIT_L(0); PG8_MMA(0, 1, At, B1); PG8_BAR;
            PG8_LDA(At, 0, 1); PG8_STAGE(PG8_SA(0, 0), a2, voffA);
            PG8_BAR; PG8_WAIT_L(0); PG8_MMA(1, 0, At, B0); PG8_BAR; PG8_SCHED;
            PG8_STAGE(PG8_SB(0, 1), b2 + hstep, voffB);
            PG8_WAIT_V(6); PG8_BAR; PG8_MMA(1, 1, At, B1); PG8_BAR;
            PG8_LDB(B0, 1, 0); PG8_SCHED; PG8_LDA(At, 1, 0); PG8_STAGE(PG8_SA(0, 1), a2 + hstepA, voffA);
            PG8_WAIT_L(8); PG8_BAR; PG8_WAIT_L(0); PG8_MMA(0, 0, At, B0); PG8_BAR; PG8_SCHED;
            PG8_LDB(B1, 1, 1); PG8_STAGE(PG8_SB(1, 0), b3, voffB);
            PG8_BAR; PG8_WAIT_L(0); PG8_MMA(0, 1, At, B1); PG8_BAR;
            PG8_LDA(At, 1, 1); PG8_STAGE(PG8_SA(1, 0), a3, voffA);
            PG8_BAR; PG8_WAIT_L(0); PG8_MMA(1, 0, At, B0); PG8_BAR; PG8_SCHED;
            PG8_STAGE(PG8_SB(1, 1), b3 + hstep, voffB);
            PG8_WAIT_V(6); PG8_BAR; PG8_MMA(1, 1, At, B1); PG8_BAR;
            }
        }
        if constexpr (ALIGN_EPI) { if (wr == 0) PG8_BAR; }
        if constexpr (!Epi::AFTER_DRAIN) { E(acc, cur, wr, wc, fr, fq); S.done(cur); }
        if (!has_next) break;
#pragma unroll
        for (int a = 0; a < 2; ++a)
#pragma unroll
            for (int b = 0; b < 2; ++b)
#pragma unroll
                for (int m = 0; m < 4; ++m)
#pragma unroll
                    for (int n = 0; n < 2; ++n) acc[a][b][m][n] = (f32x4){0.f, 0.f, 0.f, 0.f};
        cur = nxt; cA = nA; cA2 = nA2; cB = nB; ++ui;
        if constexpr (GATHERA) {
#pragma unroll
            for (int hh = 0; hh < 2; ++hh) { gofc[hh][0] = gofn[hh][0]; gofc[hh][1] = gofn[hh][1]; } }
        if constexpr (ALIGN_EPI) { if (wr == 1) PG8_BAR; }
    }
    PG8_WAIT_V(0);
    if constexpr (!ALIGN_EPI) { if (wr == 0) PG8_BAR; }
    PG8_BAR;
    if constexpr (Epi::AFTER_DRAIN) { E.fused(acc, cur, wr, wc, fr, fq, lds, wid, lane); S.done(cur); }
#undef PG8_AADDR
#undef PG8_GA
#undef PG8_GN
#undef PG8_HA
#undef PG8_SA
#undef PG8_SB
#undef PG8_STAGE
#undef PG8_LDA
#undef PG8_LDB
#undef PG8_MMA
#undef PG8_WAIT_V
#undef PG8_WAIT_L
#undef PG8_BAR
#undef PG8_SCHED
}
}
#define GAS __attribute__((address_space(1)))
#define LAS __attribute__((address_space(3)))
typedef unsigned short bf16;
typedef unsigned v4u __attribute__((ext_vector_type(4)));
typedef float f32x4 __attribute__((ext_vector_type(4)));
typedef short bf16x8 __attribute__((ext_vector_type(8)));
typedef GAS unsigned gu32;
typedef GAS unsigned long long gu64;
#define RLX_AGENT __ATOMIC_RELAXED, __HIP_MEMORY_SCOPE_AGENT
#define LDS_WAIT() asm volatile("s_waitcnt lgkmcnt(0)" ::: "memory")
#define VM_WAIT() asm volatile("s_waitcnt vmcnt(0)" ::: "memory")
__device__ __forceinline__ unsigned long long rt() { return __builtin_amdgcn_s_memrealtime(); }
__device__ __forceinline__ unsigned f2bf(float f) { unsigned u = __builtin_bit_cast(unsigned, f); return (u + 0x7fffu + ((u >> 16) & 1u)) >> 16; }
__device__ __forceinline__ unsigned pk2(float lo, float hi) { return f2bf(lo) | (f2bf(hi) << 16); }

#define XB_TMO      128
#define XB_XCNT(j)  (256  + 64 * (j))
#define XB_XSUB(j)  (1280 + 64 * (j))
#define XB_XGEN(j)  (2304 + 64 * (j))
#define XB_TOP      3328
#define XB_TOPGEN   3392
#define XCD_BAR_WORDS 3456
#define XB_SPIN_CAP (1u << 18)

__device__ __forceinline__ unsigned xb_ld(unsigned* p)              { return __hip_atomic_load(p, __ATOMIC_RELAXED, __HIP_MEMORY_SCOPE_AGENT); }
__device__ __forceinline__ unsigned xb_add(unsigned* p, unsigned v) { return __hip_atomic_fetch_add(p, v, __ATOMIC_RELAXED, __HIP_MEMORY_SCOPE_AGENT); }
__device__ __forceinline__ unsigned xb_xcc_id() { return (unsigned)__builtin_amdgcn_s_getreg((3 << 11) | 20) & 0xFu; }
#define XB_SPIN(cond, bar) do { unsigned _sp = 0; while (cond) { __builtin_amdgcn_s_sleep(1); \
    if ((++_sp & 255u) == 0u) { if (xb_ld(&(bar)[XB_TMO])) break; if (_sp > XB_SPIN_CAP) { atomicAdd(&(bar)[XB_TMO], 1u); break; } } } } while (0)

struct XcdBarrier {
    unsigned* bar; unsigned x;
    volatile LAS unsigned* st;
};

__device__ __forceinline__ XcdBarrier xcd_barrier_post(unsigned* bar, volatile LAS unsigned* st) {
    XcdBarrier b; b.bar = bar; b.x = xb_xcc_id(); b.st = st;
    if (threadIdx.x == 0) (void)xb_add(&bar[XB_XCNT(b.x)], 1u);
    return b;
}
__device__ __forceinline__ void xcd_barrier_complete(unsigned* bar, unsigned x, unsigned& nloc, unsigned& nx) {
    const unsigned G = gridDim.x * gridDim.y * gridDim.z;
    unsigned sum, cnt, mine, sp = 0u;
    for (;;) {
        sum = 0u; cnt = 0u; mine = 0u;
#pragma unroll
        for (unsigned j = 0; j < 16; ++j) { const unsigned c = xb_ld(&bar[XB_XCNT(j)]); sum += c; cnt += (c > 0u) ? 1u : 0u; mine = (j == x) ? c : mine; }
        if (sum == G) break;
        __builtin_amdgcn_s_sleep(1);
        if ((++sp & 255u) == 0u) { if (xb_ld(&bar[XB_TMO])) break; if (sp > XB_SPIN_CAP) { atomicAdd(&bar[XB_TMO], 1u); break; } }
    }
    nloc = mine > 0u ? mine : 1u; nx = cnt > 0u ? cnt : 1u;
}

__device__ __forceinline__ void xcd_barrier(const XcdBarrier& b) {
    asm volatile("s_waitcnt vmcnt(0)" ::: "memory");
    __syncthreads();
    if (threadIdx.x == 0) {
        unsigned* bar = b.bar;
        __builtin_amdgcn_s_waitcnt(0);
        unsigned nloc = b.st[0], nx = b.st[1];
        if (nloc == 0u) { xcd_barrier_complete(bar, b.x, nloc, nx); b.st[0] = nloc; b.st[1] = nx; }
        const unsigned old = xb_add(&bar[XB_XSUB(b.x)], 1u);
        const unsigned gen = old / nloc;
        if (old + 1u == (gen + 1u) * nloc) {
            __builtin_amdgcn_fence(__ATOMIC_RELEASE, "agent");
            asm volatile("s_waitcnt vmcnt(0)" ::: "memory");
            const unsigned og = xb_add(&bar[XB_TOP], 1u);
            const unsigned tg = og / nx;
            if (og + 1u == (tg + 1u) * nx) xb_add(&bar[XB_TOPGEN], 1u);
            else XB_SPIN(xb_ld(&bar[XB_TOPGEN]) == tg, bar);
            __builtin_amdgcn_fence(__ATOMIC_ACQUIRE, "agent");
            xb_add(&bar[XB_XGEN(b.x)], 1u);
            asm volatile("s_waitcnt vmcnt(0)" ::: "memory");
        } else {
            XB_SPIN(xb_ld(&bar[XB_XGEN(b.x)]) == gen, bar);
            __builtin_amdgcn_fence(__ATOMIC_ACQUIRE, "agent");
            asm volatile("s_waitcnt vmcnt(0)" ::: "memory");
        }
    }
    __syncthreads();
}

typedef float f32x2 __attribute__((ext_vector_type(2)));
typedef float f32x16 __attribute__((ext_vector_type(16)));
typedef unsigned v2u __attribute__((ext_vector_type(2)));
typedef __bf16 bf16x2_t __attribute__((ext_vector_type(2)));
using pg8::Unit;

constexpr int NWAVES = 8;
#ifndef MK_N_LAUNCHES
#define MK_N_LAUNCHES 1
#endif
constexpr int N_PHASES = 13;
constexpr int N_LAUNCHES = MK_N_LAUNCHES;

constexpr int NB = 32, SEQ = 2048, LC = 256, DM = 1024, NLAT = NB * SEQ, NCTX = NB * LC, NTOK = NLAT + NCTX;
constexpr int NE = 16, CAP = 256, DFF = 1536, NSLOT = NE * NB * CAP;
constexpr int WIN_ROWS = 4864, LORA_N = 2560, LORA_K = 384;
constexpr int KEYS = SEQ + LC;

constexpr size_t MiB = 1u << 20, KiB = 1u << 10;
constexpr size_t WS_CTL = 0, CTL_ZERO_BYTES = 1 * MiB;
constexpr size_t WS_MOD = 1 * MiB;
constexpr size_t WS_WIN = 2 * MiB;
constexpr size_t WS_WLORA = 11 * MiB + 512 * KiB;
constexpr size_t WS_WBRR = 13 * MiB + 512 * KiB;
constexpr size_t WS_WBRA = 14 * MiB + 512 * KiB;
constexpr size_t WS_WOUT = 15 * MiB + 512 * KiB;
constexpr size_t WS_WGU = 17 * MiB + 512 * KiB;
constexpr size_t WS_WD = 113 * MiB + 512 * KiB;
constexpr size_t WS_IDX = 161 * MiB + 512 * KiB;
constexpr size_t WS_VAL = 162 * MiB;
constexpr size_t WS_ZK = 163 * MiB;
constexpr size_t WS_ZV = 235 * MiB;
constexpr size_t WS_ZR = 307 * MiB;
constexpr size_t WS_Q = 371 * MiB;
constexpr size_t WS_KQ = 435 * MiB;
constexpr size_t WS_VQ = 453 * MiB;
constexpr size_t WS_XCH = 453 * MiB;
constexpr size_t WS_YB = 959 * MiB;
constexpr size_t WS_LA = 471 * MiB;
constexpr size_t WS_H1 = 525 * MiB;
constexpr size_t WS_EW = 525 * MiB;
constexpr size_t WS_ORW = 525 * MiB;
constexpr size_t WS_AS = 669 * MiB;
constexpr size_t WS_G = 813 * MiB;
constexpr size_t WS_VT = 877 * MiB;
constexpr size_t WS_YF = 895 * MiB;
constexpr size_t WS_MERGED = 163 * MiB;
constexpr size_t WS_INV = 163 * MiB;
constexpr size_t WS_XE = 167 * MiB;
constexpr size_t WS_Y2 = 167 * MiB;
constexpr size_t WS_H2 = 167 * MiB;
constexpr size_t WS_AFF = 551 * MiB;
constexpr size_t WS_ACT = 423 * MiB;
constexpr size_t WS_DELTA = 807 * MiB;
constexpr size_t WS_END = 1023 * MiB;
constexpr int CW_BAR = 4096;

constexpr int RING_BYTES = 131072;
constexpr int LDSCTL_OFF = 147456 - 1024, MISC_OFF = LDSCTL_OFF + 320;
static_assert(33 * 1024 * 4 <= LDSCTL_OFF, "P0's silu(c) image must stay below the LDS control words");
constexpr int LDS_BYTES = 147456;

__device__ __forceinline__ unsigned pkbf(float lo, float hi) { f32x2 v = {lo, hi}; return __builtin_bit_cast(unsigned, __builtin_convertvector(v, bf16x2_t)); }
__device__ __forceinline__ float bflo(unsigned u) { return __uint_as_float(u << 16); }
__device__ __forceinline__ float bfhi(unsigned u) { return __uint_as_float(u & 0xffff0000u); }
__device__ __forceinline__ float bf1(bf16 h) { return __uint_as_float(((unsigned)h) << 16); }
__device__ __forceinline__ float sigmoidf_(float x) { return __builtin_amdgcn_rcpf(1.0f + __builtin_amdgcn_exp2f(-1.4426950408889634f * x)); }
__device__ __forceinline__ float tanhf_(float x) { return 1.0f - 2.0f * __builtin_amdgcn_rcpf(__builtin_amdgcn_exp2f(2.8853900817779268f * x) + 1.0f); }
__device__ __forceinline__ float wave_sum(float v) {
    int x = __float_as_int(v);
#define WS_DPP(ctrl, rmask) x = __float_as_int(__int_as_float(x) + __int_as_float(__builtin_amdgcn_update_dpp(0, x, ctrl, rmask, 0xf, false)))
    WS_DPP(0x111, 0xf); WS_DPP(0x112, 0xf); WS_DPP(0x114, 0xf); WS_DPP(0x118, 0xf); WS_DPP(0x142, 0xa); WS_DPP(0x143, 0xc);
#undef WS_DPP
    return __int_as_float(__builtin_amdgcn_readlane(x, 63));
}
__device__ __forceinline__ void unpack8(const v4u w, float (&f)[8]) {
    f[0] = bflo(w.x); f[1] = bfhi(w.x); f[2] = bflo(w.y); f[3] = bfhi(w.y); f[4] = bflo(w.z); f[5] = bfhi(w.z); f[6] = bflo(w.w); f[7] = bfhi(w.w);
}
__device__ __forceinline__ v4u pack8(const float (&f)[8]) { v4u w; w.x = pkbf(f[0], f[1]); w.y = pkbf(f[2], f[3]); w.z = pkbf(f[4], f[5]); w.w = pkbf(f[6], f[7]); return w; }

struct Frame {
    LAS unsigned char* lds;
    volatile LAS unsigned* MISC;
    gu32* ctl;
    int tid, lane, wave, G;
    float* out; unsigned char* ws;
};
enum { I_X = 0, I_C, I_CTX, I_CCTX, I_ADAW, I_ADAB, I_N1G, I_N2G, I_WIN, I_CONV, I_W0, I_W2, I_A0, I_A2, I_KK, I_KA, I_RK, I_G2, I_LNW, I_LNB, I_QG, I_KG, I_SINK,
       I_WBRR, I_WBRA, I_WOUT, I_ROUTER, I_EG, I_EU, I_ED };
typedef const __attribute__((address_space(4))) unsigned char* kptr_t;
__device__ __forceinline__ const float* karg_in(int i) { kptr_t kp = (kptr_t)__builtin_amdgcn_kernarg_segment_ptr(); asm volatile("" : "+s"(kp)); return *(const float* const __attribute__((address_space(4)))*)(kp + 8 * i); }

__device__ __forceinline__ void transpose_item(const float* W, int N, int k0, int n0, bf16* WT, int Kd, int drow0, LAS float* scr, int lane) {
#pragma unroll 8
    for (int i = 0; i < 32; ++i) { const int kk = 2 * i + (lane >> 5); scr[kk * 33 + (lane & 31)] = W[(size_t)(k0 + kk) * N + n0 + (lane & 31)]; }
    LDS_WAIT(); asm volatile("" ::: "memory");
    const int c = lane & 7;
#pragma unroll
    for (int j = 0; j < 4; ++j) { const int n = (lane >> 3) + 8 * j; const LAS float* s = scr + (8 * c) * 33 + n;
        v4u o; o.x = pkbf(s[0 * 33], s[1 * 33]); o.y = pkbf(s[2 * 33], s[3 * 33]); o.z = pkbf(s[4 * 33], s[5 * 33]); o.w = pkbf(s[6 * 33], s[7 * 33]);
        *(GAS v4u*)(WT + (size_t)(drow0 + n) * Kd + k0 + 8 * c) = o; }
    LDS_WAIT(); asm volatile("" ::: "memory");
}
__device__ __forceinline__ int win_dest_block(int sb) {
    if (sb < 4) return 13 + sb;
    if (sb < 8) return sb - 4;
    if (sb < 12) return sb - 4;
    if (sb == 12) return 8;
    if (sb == 13) return 9;
    if (sb == 14) return 10;
    if (sb < 19) return sb + 2;
    if (sb == 19) return 11;
    if (sb == 20) return 12;
    return sb;
}
__device__ __forceinline__ void p0_prologue(Frame& F) {
    if (blockIdx.x < 96) {
        LAS float* cs = (LAS float*)F.lds;
        const float* c = karg_in(I_C); const float* cc = karg_in(I_CCTX);
        for (int i = F.tid; i < 33 * 1024; i += 512) { const float v = i < 32 * 1024 ? c[i] : cc[i - 32 * 1024]; cs[i] = v * sigmoidf_(v); }
        __syncthreads();
        const int col = blockIdx.x * 64 + F.lane; const float* aw = karg_in(I_ADAW);
        float acc[33];
#pragma unroll
        for (int b = 0; b < 33; ++b) acc[b] = 0.f;
        const int kbeg = F.wave * 128;
        for (int k = kbeg; k < kbeg + 128; k += 4) {
            const float w0 = aw[(size_t)(k + 0) * 6144 + col], w1 = aw[(size_t)(k + 1) * 6144 + col], w2 = aw[(size_t)(k + 2) * 6144 + col], w3 = aw[(size_t)(k + 3) * 6144 + col];
#pragma unroll
            for (int b = 0; b < 33; ++b) { const f32x4 cv = *(const LAS f32x4*)(cs + b * 1024 + k); acc[b] += cv.x * w0 + cv.y * w1 + cv.z * w2 + cv.w * w3; }
        }
        __syncthreads();
        LAS float* red = (LAS float*)F.lds;
#pragma unroll
        for (int b = 0; b < 33; ++b) red[(F.wave * 33 + b) * 64 + F.lane] = acc[b];
        __syncthreads();
        float* mod = (float*)(F.ws + WS_MOD); const float* ab = karg_in(I_ADAB);
        for (int i = F.tid; i < 33 * 64; i += 512) { const int b = i >> 6, l = i & 63; float s = 0.f;
#pragma unroll
            for (int w = 0; w < 8; ++w) s += red[(w * 33 + b) * 64 + l];
            mod[(size_t)b * 6144 + blockIdx.x * 64 + l] = s + ab[blockIdx.x * 64 + l]; }
        __syncthreads();
    }
    LAS float* scr = (LAS float*)(F.lds + F.wave * 16384);
    const int gw = blockIdx.x * NWAVES + F.wave, NGW = F.G * NWAVES;
    constexpr int IT_WIN = 16 * 148, IT_G = 16 * 768, IT_BR = 256, IT_OUT = 512;
    constexpr int NITEMS = IT_WIN + 3 * IT_G + 2 * IT_BR + IT_OUT;
    bf16* WIN = (bf16*)(F.ws + WS_WIN); bf16* WGU = (bf16*)(F.ws + WS_WGU); bf16* WD = (bf16*)(F.ws + WS_WD);
    for (int it = gw; it < NITEMS; it += NGW) {
        int r = it;
        if (r < IT_WIN) { const int kb = r / 148, nb = r % 148, n0 = 32 * nb; const int db = win_dest_block(n0 >> 7);
            transpose_item(karg_in(I_WIN), 4736, 64 * kb, n0, WIN, 1024, db * 128 + (n0 & 127), scr, F.lane); continue; }
        r -= IT_WIN;
        if (r < IT_G) { const int e = r / 768, q = r % 768, kb = q / 48, nb = q % 48, n0 = 32 * nb;
            transpose_item(karg_in(I_EG) + (size_t)e * 1024 * 1536, 1536, 64 * kb, n0, WGU, 1024, e * 3072 + 256 * (n0 >> 7) + (n0 & 127), scr, F.lane); continue; }
        r -= IT_G;
        if (r < IT_G) { const int e = r / 768, q = r % 768, kb = q / 48, nb = q % 48, n0 = 32 * nb;
            transpose_item(karg_in(I_EU) + (size_t)e * 1024 * 1536, 1536, 64 * kb, n0, WGU, 1024, e * 3072 + 256 * (n0 >> 7) + 128 + (n0 & 127), scr, F.lane); continue; }
        r -= IT_G;
        if (r < IT_G) { const int e = r / 768, q = r % 768, kb = q / 32, nb = q % 32, n0 = 32 * nb;
            transpose_item(karg_in(I_ED) + (size_t)e * 1536 * 1024, 1024, 64 * kb, n0, WD, 1536, e * 1024 + n0, scr, F.lane); continue; }
        r -= IT_G;
        if (r < IT_BR) { const int kb = r / 32, nb = r % 32; transpose_item(karg_in(I_WBRR), 1024, 64 * kb, 32 * nb, (bf16*)(F.ws + WS_WBRR), 1024, 32 * nb, scr, F.lane); continue; }
        r -= IT_BR;
        if (r < IT_BR) { const int kb = r / 32, nb = r % 32; transpose_item(karg_in(I_WBRA), 1024, 64 * kb, 32 * nb, (bf16*)(F.ws + WS_WBRR) + 512, 1024, 32 * nb, scr, F.lane); continue; }
        r -= IT_BR;
        { const int kb = r / 32, nb = r % 32; transpose_item(karg_in(I_WOUT), 1024, 64 * kb, 32 * nb, (bf16*)(F.ws + WS_WOUT), 1024, 32 * nb, scr, F.lane); }
    }
    const int gt = blockIdx.x * 512 + F.tid, NGT = F.G * 512;
    for (int i = gt; i < 128 * 1024 / 8; i += NGT) *(GAS v4u*)(WIN + (size_t)4736 * 1024 + (size_t)i * 8) = (v4u){0u, 0u, 0u, 0u};
    { bf16* WL = (bf16*)(F.ws + WS_WLORA); const float* w2 = karg_in(I_W2); const float* a2 = karg_in(I_A2); const float* g2 = karg_in(I_G2);
      for (int i = gt; i < LORA_N * (LORA_K / 8); i += NGT) { const int n = i / (LORA_K / 8), k8 = (i % (LORA_K / 8)) * 8; const int rg = n >> 9, col = n & 511; float f[8];
#pragma unroll
          for (int j = 0; j < 8; ++j) { const int k = k8 + j; float v = 0.f;
              if (rg == 0) { if (k < 64) v = w2[(size_t)k * 512 + col]; }
              else if (rg == 1) { if (k >= 64 && k < 128) v = w2[(size_t)(64 + k - 64) * 512 + col]; }
              else if (rg == 2) { if (k >= 128 && k < 192) v = a2[(size_t)(k - 128) * 512 + col]; }
              else if (rg == 3) { if (k >= 192 && k < 256) v = a2[(size_t)(64 + k - 192) * 512 + col]; }
              else { if (k >= 256) v = g2[(size_t)(k - 256) * 512 + col]; }
              f[j] = v; }
          *(GAS v4u*)(WL + (size_t)n * LORA_K + k8) = pack8(f); } }
}

__device__ __forceinline__ void p1_norm1(Frame& F) {
    const int gw = blockIdx.x * NWAVES + F.wave, NGW = F.G * NWAVES;
    const float* mod = (const float*)(F.ws + WS_MOD); bf16* H1 = (bf16*)(F.ws + WS_H1);
    const float* g1 = karg_in(I_N1G); const float* Xp = karg_in(I_X); const float* CTXp = karg_in(I_CTX);
    f32x4 gv[4];
#pragma unroll
    for (int j = 0; j < 4; ++j) gv[j] = *(const f32x4*)(g1 + 4 * F.lane + 256 * j);
    for (int m0 = gw; m0 < NTOK; m0 += 4 * NGW) {
        f32x4 v[4][4]; float s[4];
#pragma unroll
        for (int r = 0; r < 4; ++r) { const int m = min(m0 + r * NGW, NTOK - 1); s[r] = 0.f;
            const float* xr = m < NLAT ? Xp + (size_t)m * DM : CTXp + (size_t)(m - NLAT) * DM;
#pragma unroll
            for (int j = 0; j < 4; ++j) v[r][j] = *(const GAS f32x4*)(xr + 4 * F.lane + 256 * j); }
#pragma unroll
        for (int r = 0; r < 4; ++r) { const int m = m0 + r * NGW;
            if (m < NTOK) {
#pragma unroll
                for (int j = 0; j < 4; ++j) s[r] += (v[r][j].x * v[r][j].x + v[r][j].y * v[r][j].y) + (v[r][j].z * v[r][j].z + v[r][j].w * v[r][j].w);
                const float rstd = __builtin_amdgcn_rsqf(wave_sum(s[r]) * (1.f / DM) + 1e-6f);
                const int mb = m < NLAT ? (m >> 11) : 32; const float* sh = mod + (size_t)mb * 6144; const float* sc = sh + 1024;
#pragma unroll
                for (int j = 0; j < 4; ++j) { const f32x4 a = *(const f32x4*)(sc + 4 * F.lane + 256 * j), bsh = *(const f32x4*)(sh + 4 * F.lane + 256 * j);
                    const f32x4 y = v[r][j] * rstd * gv[j] * (a + 1.0f) + bsh;
                    v2u o; o.x = pkbf(y.x, y.y); o.y = pkbf(y.z, y.w);
                    *(GAS v2u*)(H1 + (size_t)m * DM + 4 * F.lane + 256 * j) = o; } } }
    }
}

struct InprojOrder {
    pg8::StaticOrder so; int G, c;
    __device__ void init(int G_, int c_) { so.init(NLAT, WIN_ROWS, G_, c_); G = G_; c = c_; }
    __device__ bool next(int i, Unit& u) const {
        long L = (long)i * G + c; if (L < 4864) return so.next(i, u);
        L -= 4864; if (L >= 224) return false; u.pm = 256 + (int)(L % 32); u.pn = (int)(L / 32); return true; }
    __device__ __forceinline__ void a_ready(const Unit&) const {}
    __device__ __forceinline__ void done(const Unit&) const {}
};
struct EpiInproj {
    static constexpr bool PERM = true, AFTER_DRAIN = false;
    bf16 *zk, *zv, *zr, *q, *kq, *vq, *la, *gates;
    __device__ __forceinline__ void operator()(const f32x4 (&acc)[2][2][4][2], const Unit& u, int wr, int wc, int fr, int fq) const {
        const int row0 = u.pm * 256 + wr * 64 + fr; const bool isctx = u.pm >= 256;
#pragma unroll
        for (int bj = 0; bj < 2; ++bj) {
            const int c128 = 2 * u.pn + bj; bf16* base = nullptr; int pitch = 0, act = 0; bool ok = true;
            if (c128 < 4) { base = zk + c128 * 128; pitch = 512; }
            else if (c128 < 8) { base = zv + (c128 - 4) * 128; pitch = 512; }
            else if (c128 < 11) { base = la + (c128 - 8) * 128; pitch = 384; act = (c128 == 8) ? 1 : ((c128 == 10) ? 2 : 0); }
            else if (c128 == 11) { base = kq; pitch = 128; }
            else if (c128 == 12) { base = vq; pitch = 128; }
            else if (c128 < 17) { base = zr + (c128 - 13) * 128; pitch = 512; ok = !isctx; }
            else if (c128 < 21) { base = q + (c128 - 17) * 128; pitch = 512; ok = !isctx; }
            else if (c128 < 37) { base = gates + (c128 - 21) * 128; pitch = 2048; act = 2; ok = !isctx; }
            else ok = false;
            if (ok) {
#pragma unroll
                for (int ai = 0; ai < 2; ++ai)
#pragma unroll
                    for (int m = 0; m < 4; ++m) {
                        f32x4 v0 = acc[ai][bj][m][0], v1 = acc[ai][bj][m][1];
                        if (act == 1) { v0.x = tanhf_(v0.x); v0.y = tanhf_(v0.y); v0.z = tanhf_(v0.z); v0.w = tanhf_(v0.w); v1.x = tanhf_(v1.x); v1.y = tanhf_(v1.y); v1.z = tanhf_(v1.z); v1.w = tanhf_(v1.w); }
                        else if (act == 2) { v0.x = sigmoidf_(v0.x); v0.y = sigmoidf_(v0.y); v0.z = sigmoidf_(v0.z); v0.w = sigmoidf_(v0.w); v1.x = sigmoidf_(v1.x); v1.y = sigmoidf_(v1.y); v1.z = sigmoidf_(v1.z); v1.w = sigmoidf_(v1.w); }
                        v4u w; w.x = pkbf(v0.x, v0.y); w.y = pkbf(v0.z, v0.w); w.z = pkbf(v1.x, v1.y); w.w = pkbf(v1.z, v1.w);
                        *(GAS v4u*)(base + (size_t)(row0 + ai * 128 + m * 16) * pitch + wc * 32 + 8 * fq) = w;
                    }
            }
        }
    }
};

constexpr int LORA_LP = 144;
template <int NKS> __device__ __forceinline__ void lora_item(const bf16* LA, const bf16* WL, bf16* outp, const float* bias, float scale, int act, int tile, int rg, int kbase, int lane, LAS unsigned char* st) {
    const int l32 = lane & 31, hi = lane >> 5;
    bf16x8 xf[2][NKS];
#pragma unroll
    for (int s2 = 0; s2 < 2; ++s2)
#pragma unroll
        for (int ks = 0; ks < NKS; ++ks) xf[s2][ks] = *(const GAS bf16x8*)(LA + (size_t)(tile * 64 + s2 * 32 + l32) * LORA_K + kbase + 16 * ks + 8 * hi);
    bf16x8 wf[NKS], wn[NKS];
    { const bf16* wp = WL + (size_t)(rg * 512 + l32) * LORA_K + kbase + 8 * hi;
#pragma unroll
      for (int ks = 0; ks < NKS; ++ks) wf[ks] = *(const GAS bf16x8*)(wp + 16 * ks); }
#pragma unroll 1
    for (int np = 0; np < 8; ++np) {
#pragma unroll
        for (int nh = 0; nh < 2; ++nh) { const int nt = 2 * np + nh;
            f32x16 acc0, acc1;
#pragma unroll
            for (int r = 0; r < 16; ++r) { acc0[r] = 0.f; acc1[r] = 0.f; }
            { const int ntn = nt < 15 ? nt + 1 : 15; const bf16* wp = WL + (size_t)(rg * 512 + ntn * 32 + l32) * LORA_K + kbase + 8 * hi;
#pragma unroll
              for (int ks = 0; ks < NKS; ++ks) wn[ks] = *(const GAS bf16x8*)(wp + 16 * ks); }
#pragma unroll
            for (int ks = 0; ks < NKS; ++ks) { acc0 = __builtin_amdgcn_mfma_f32_32x32x16_bf16(wf[ks], xf[0][ks], acc0, 0, 0, 0); acc1 = __builtin_amdgcn_mfma_f32_32x32x16_bf16(wf[ks], xf[1][ks], acc1, 0, 0, 0); }
#pragma unroll
            for (int ks = 0; ks < NKS; ++ks) wf[ks] = wn[ks];
#pragma unroll
            for (int r4 = 0; r4 < 4; ++r4) { const int col = nt * 32 + 8 * r4 + 4 * hi;
                f32x4 bv = (f32x4){0.f, 0.f, 0.f, 0.f}; if (act) bv = *(const f32x4*)(bias + col);
                f32x4 v0 = (f32x4){acc0[4 * r4], acc0[4 * r4 + 1], acc0[4 * r4 + 2], acc0[4 * r4 + 3]} + bv, v1 = (f32x4){acc1[4 * r4], acc1[4 * r4 + 1], acc1[4 * r4 + 2], acc1[4 * r4 + 3]} + bv;
                if (act) { v0.x = scale * sigmoidf_(v0.x); v0.y = scale * sigmoidf_(v0.y); v0.z = scale * sigmoidf_(v0.z); v0.w = scale * sigmoidf_(v0.w);
                           v1.x = scale * sigmoidf_(v1.x); v1.y = scale * sigmoidf_(v1.y); v1.z = scale * sigmoidf_(v1.z); v1.w = scale * sigmoidf_(v1.w); }
                v2u o0, o1; o0.x = pkbf(v0.x, v0.y); o0.y = pkbf(v0.z, v0.w); o1.x = pkbf(v1.x, v1.y); o1.y = pkbf(v1.z, v1.w);
                const int lc = (32 * nh + 8 * r4 + 4 * hi) * 2;
                *(LAS v2u*)(st + l32 * LORA_LP + lc) = o0; *(LAS v2u*)(st + 32 * LORA_LP + l32 * LORA_LP + lc) = o1; }
        }
#pragma unroll
        for (int i = 0; i < 8; ++i) { const int row = 8 * i + (lane >> 3);
            const v4u w = *(const LAS v4u*)(st + row * LORA_LP + (lane & 7) * 16);
            *(GAS v4u*)(outp + (size_t)(tile * 64 + row) * 512 + np * 64 + (lane & 7) * 8) = w; }
    }
}
__device__ __forceinline__ void p3a_lora(Frame& F) {
    const bf16* LA = (const bf16*)(F.ws + WS_LA); const bf16* WL = (const bf16*)(F.ws + WS_WLORA);
    bf16* EW = (bf16*)(F.ws + WS_EW); bf16* AS = (bf16*)(F.ws + WS_AS); bf16* G = (bf16*)(F.ws + WS_G);
    const float* w0 = karg_in(I_W0); const float* a0 = karg_in(I_A0);
    const int gw = blockIdx.x * NWAVES + F.wave, NGW = F.G * NWAVES;
    LAS unsigned char* st = F.lds + 16384 + F.wave * (64 * LORA_LP);
    for (int item = gw; item < (NTOK / 64) * 5; item += NGW) {
        const int rg = item % 5, tile = item / 5;
        if (rg == 4) { if (tile < NLAT / 64) lora_item<8>(LA, WL, G, nullptr, 1.0f, 0, tile, 4, 256, F.lane, st); }
        else if (rg < 2) lora_item<4>(LA, WL, EW + (size_t)rg * NTOK * 512, w0 + rg * 512, 0.60653066f, 1, tile, rg, 64 * rg, F.lane, st);
        else lora_item<4>(LA, WL, AS + (size_t)(rg - 2) * NTOK * 512, a0 + (rg - 2) * 512, 1.0f, 1, tile, rg, 64 * rg, F.lane, st);
    }
}

__device__ __forceinline__ void p3b_attn_prep(Frame& F) {
    LAS float* tab = (LAS float*)F.lds;
    for (int i = F.tid; i < 1024; i += 512) { const int pos = i >> 4, fi = i & 15;
        const float invf = exp2f(-(float)fi * (13.287712379549449f / 16.0f));
        const float ang = (float)pos * invf; tab[2 * i] = cosf(ang); tab[2 * i + 1] = sinf(ang); }
    __syncthreads();
    const int gw = blockIdx.x * NWAVES + F.wave, NGW = F.G * NWAVES, lane = F.lane;
    {
        bf16* Q = (bf16*)(F.ws + WS_Q); const float* qg = karg_in(I_QG);
        const int sub = lane & 7; float gq[8];
#pragma unroll
        for (int j = 0; j < 8; ++j) gq[j] = qg[8 * sub + j];
        const float qscale = 0.125f * 1.4426950408889634f;
        for (int m0 = gw; m0 < NLAT; m0 += 4 * NGW) {
            v4u raw[4];
#pragma unroll
            for (int r = 0; r < 4; ++r) { const int m = min(m0 + r * NGW, NLAT - 1); raw[r] = *(const GAS v4u*)(Q + (size_t)m * 512 + 8 * lane); }
#pragma unroll
            for (int r = 0; r < 4; ++r) { const int m = m0 + r * NGW; if (m >= NLAT) continue;
                const int t = m & 2047; GAS v4u* p = (GAS v4u*)(Q + (size_t)m * 512 + 8 * lane);
                float y[8]; unpack8(raw[r], y); float ss = 0.f;
#pragma unroll
                for (int j = 0; j < 8; ++j) ss += y[j] * y[j];
                ss += __shfl_xor(ss, 1); ss += __shfl_xor(ss, 2); ss += __shfl_xor(ss, 4);
                const float rstd = __builtin_amdgcn_rsqf(ss * (1.f / 64.f) + 1e-6f);
                const int pos = (sub < 4) ? (t >> 6) : (t & 63); const bool second = (sub & 2) != 0; float o[8];
#pragma unroll
                for (int j = 0; j < 8; ++j) { y[j] = y[j] * rstd * gq[j]; }
#pragma unroll
                for (int j = 0; j < 8; ++j) { const float yp = __shfl_xor(y[j], 2); const int fi = 8 * (sub & 1) + j; const float cs = tab[(pos * 16 + fi) * 2], sn = tab[(pos * 16 + fi) * 2 + 1];
                    o[j] = (second ? (yp * sn + y[j] * cs) : (y[j] * cs - yp * sn)) * qscale; }
                *p = pack8(o); }
        }
    }
    {
        bf16* KQ = (bf16*)(F.ws + WS_KQ); const float* kg = karg_in(I_KG);
        const int l32 = lane & 31; const float g0 = kg[2 * l32], g1 = kg[2 * l32 + 1];
        for (int m0 = gw; m0 < NTOK; m0 += 4 * NGW) {
            unsigned raw[4];
#pragma unroll
            for (int r = 0; r < 4; ++r) { const int m = min(m0 + r * NGW, NTOK - 1); raw[r] = *(const GAS unsigned*)(KQ + (size_t)m * 128 + 2 * lane); }
#pragma unroll
            for (int r = 0; r < 4; ++r) { const int m = m0 + r * NGW; if (m >= NTOK) continue;
                GAS unsigned* p = (GAS unsigned*)(KQ + (size_t)m * 128 + 2 * lane); const unsigned w = raw[r];
                float y0 = bflo(w), y1 = bfhi(w); float ss = y0 * y0 + y1 * y1;
                ss += __shfl_xor(ss, 1); ss += __shfl_xor(ss, 2); ss += __shfl_xor(ss, 4); ss += __shfl_xor(ss, 8); ss += __shfl_xor(ss, 16);
                const float rstd = __builtin_amdgcn_rsqf(ss * (1.f / 64.f) + 1e-6f);
                y0 = y0 * rstd * g0; y1 = y1 * rstd * g1;
                const float p0 = __shfl_xor(y0, 8), p1 = __shfl_xor(y1, 8);
                if (m < NLAT) { const int t = m & 2047; const int pos = (l32 < 16) ? (t >> 6) : (t & 63); const bool second = (l32 & 8) != 0; const int fi0 = (2 * l32) & 15;
                    const float c0 = tab[(pos * 16 + fi0) * 2], s0 = tab[(pos * 16 + fi0) * 2 + 1], c1 = tab[(pos * 16 + fi0 + 1) * 2], s1 = tab[(pos * 16 + fi0 + 1) * 2 + 1];
                    const float o0 = second ? (p0 * s0 + y0 * c0) : (y0 * c0 - p0 * s0), o1 = second ? (p1 * s1 + y1 * c1) : (y1 * c1 - p1 * s1);
                    y0 = o0; y1 = o1; }
                *p = pkbf(y0, y1); }
        }
    }
    {
        const bf16* VQ = (const bf16*)(F.ws + WS_VQ); bf16* VT = (bf16*)(F.ws + WS_VT);
        const int gt = blockIdx.x * 512 + F.tid, NGT = F.G * 512;
        for (int i = gt; i < NB * 2 * (KEYS / 8) * 64; i += NGT) { const int d = i & 63, kg8 = (i >> 6) % (KEYS / 8), bh = (i >> 6) / (KEYS / 8), b = bh >> 1, hk = bh & 1;
            float f[8];
#pragma unroll
            for (int j = 0; j < 8; ++j) { const int key = kg8 * 8 + j; const size_t row = key < SEQ ? (size_t)b * SEQ + key : (size_t)NLAT + b * LC + (key - SEQ); f[j] = bf1(VQ[row * 128 + hk * 64 + d]); }
            *(GAS v4u*)(VT + ((size_t)bh * 64 + d) * KEYS + kg8 * 8) = pack8(f); }
    }
}

__device__ __forceinline__ int key_perm(int i) { const int r = 4 * (i >> 3) + (i & 3), hi = (i >> 2) & 1; return 8 * hi + r + (r >= 8 ? 8 : 0); }
__device__ __forceinline__ void attn_tile(const bf16x8 (&kf)[4], const bf16x8 (&vf)[4], const bf16x8 (&qf)[4], f32x16& o0, f32x16& o1, float& mrun, float& lrun, int mask, int l32, int hi) {
    f32x16 s;
#pragma unroll
    for (int r = 0; r < 16; ++r) s[r] = 0.f;
#pragma unroll
    for (int ks = 0; ks < 4; ++ks) s = __builtin_amdgcn_mfma_f32_32x32x16_bf16(kf[ks], qf[ks], s, 0, 0, 0);
    if (mask) {
#pragma unroll
        for (int r = 0; r < 16; ++r) { const int kk = 8 * hi + r + (r >= 8 ? 8 : 0); const bool ok = (mask == 1) ? (kk >= l32) : (kk <= l32); s[r] = ok ? s[r] : -1e30f; }
    }
    float mx = s[0];
#pragma unroll
    for (int r = 1; r < 16; ++r) mx = fmaxf(mx, s[r]);
    mx = fmaxf(mx, __shfl_xor(mx, 32));
    const float mnew = fmaxf(mrun, mx), alpha = __builtin_amdgcn_exp2f(mrun - mnew);
    float ps = 0.f; float p[16];
#pragma unroll
    for (int r = 0; r < 16; ++r) { p[r] = __builtin_amdgcn_exp2f(s[r] - mnew); ps += p[r]; }
    lrun = lrun * alpha + ps; mrun = mnew;
#pragma unroll
    for (int r = 0; r < 16; ++r) { o0[r] *= alpha; o1[r] *= alpha; }
    v4u pa, pb; pa.x = pkbf(p[0], p[1]); pa.y = pkbf(p[2], p[3]); pa.z = pkbf(p[4], p[5]); pa.w = pkbf(p[6], p[7]);
    pb.x = pkbf(p[8], p[9]); pb.y = pkbf(p[10], p[11]); pb.z = pkbf(p[12], p[13]); pb.w = pkbf(p[14], p[15]);
    const bf16x8 pa8 = __builtin_bit_cast(bf16x8, pa), pb8 = __builtin_bit_cast(bf16x8, pb);
    o0 = __builtin_amdgcn_mfma_f32_32x32x16_bf16(vf[0], pa8, o0, 0, 0, 0);
    o0 = __builtin_amdgcn_mfma_f32_32x32x16_bf16(vf[1], pb8, o0, 0, 0, 0);
    o1 = __builtin_amdgcn_mfma_f32_32x32x16_bf16(vf[2], pa8, o1, 0, 0, 0);
    o1 = __builtin_amdgcn_mfma_f32_32x32x16_bf16(vf[3], pb8, o1, 0, 0, 0);
}
constexpr int AT_KP = 144, AT_VP = 80, AT_KB = 32 * AT_KP, AT_VB = 64 * AT_VP, AT_BUF = AT_KB + AT_VB;
__device__ __forceinline__ void p4a_attention(Frame& F, bool dostore = true) {
    bf16* Q = (bf16*)(F.ws + WS_Q); const bf16* KQ = (const bf16*)(F.ws + WS_KQ); const bf16* VT = (const bf16*)(F.ws + WS_VT);
    const float* sink = karg_in(I_SINK);
    const int tid = F.tid, lane = F.lane, l32 = lane & 31, hi = lane >> 5;
    const int kperm = key_perm(l32);
    LAS unsigned char* lb = F.lds;
    const bool kpart = tid < 256; const int tt = tid & 255;
    const int skey = tt >> 3, skc = tt & 7, sd = tt >> 2, svc = tt & 3;
    const int sdst = kpart ? (skey * AT_KP + skc * 16) : (AT_KB + sd * AT_VP + svc * 16);
    for (int unit = blockIdx.x; unit < NB * 2 * 16; unit += F.G) {
        const int b = unit >> 5, hk = (unit >> 4) & 1, qb = unit & 15;
        const int g = F.wave >> 1, half = F.wave & 1, h = hk * 4 + g;
        const float sink2 = sink[h] * 1.4426950408889634f;
        const int tq0 = qb * 128 + half * 64;
        const size_t qrow = (size_t)b * SEQ + tq0 + l32;
        bf16x8 qf0[4], qf1[4];
#pragma unroll
        for (int ks = 0; ks < 4; ++ks) { qf0[ks] = *(const GAS bf16x8*)(Q + qrow * 512 + h * 64 + 16 * ks + 8 * hi); qf1[ks] = *(const GAS bf16x8*)(Q + (qrow + 32) * 512 + h * 64 + 16 * ks + 8 * hi); }
        float m0 = sink2, m1 = sink2, l0 = hi == 0 ? 1.0f : 0.0f, l1 = l0;
        f32x16 oa0, oa1, ob0, ob1;
#pragma unroll
        for (int r = 0; r < 16; ++r) { oa0[r] = 0.f; oa1[r] = 0.f; ob0[r] = 0.f; ob1[r] = 0.f; }
        const bf16* vsrc0 = VT + ((size_t)(b * 2 + hk) * 64 + sd) * KEYS + 8 * svc;
        const bf16* ksrc0 = KQ + (size_t)skey * 128 + hk * 64 + 8 * skc;
#define AT_SRC(s_, ptr_) do { int key0_; size_t krow_; if ((s_) < 8) { key0_ = SEQ + 32 * (s_); krow_ = (size_t)NLAT + b * LC + 32 * (s_); } \
            else { int kp_ = qb * 128 - 128 + 32 * ((s_) - 8); kp_ = (kp_ >= 0 && kp_ < SEQ) ? kp_ : 0; key0_ = kp_; krow_ = (size_t)b * SEQ + kp_; } \
            ptr_ = kpart ? (ksrc0 + krow_ * 128) : (vsrc0 + key0_); } while (0)
        v4u stg;
        { const bf16* sp; AT_SRC(0, sp); stg = *(const GAS v4u*)sp; }
        __syncthreads();
        *(LAS v4u*)(lb + sdst) = stg;
        __syncthreads();
#pragma unroll 1
        for (int s = 0; s < 20; ++s) {
            if (s + 1 < 20) { const bf16* sp; AT_SRC(s + 1, sp); stg = *(const GAS v4u*)sp; }
            const LAS unsigned char* kb_ = lb + (s & 1) * AT_BUF; const LAS unsigned char* vb_ = kb_ + AT_KB;
            bool use0, use1; int mk0 = 0, mk1 = 0;
            if (s < 8) { use0 = true; use1 = true; }
            else { const int j = s - 8, kp0 = qb * 128 - 128 + 32 * j, bi = j - 2 * half; const bool inr = kp0 >= 0 && kp0 < SEQ;
                use0 = inr && bi >= 0 && bi <= 8; use1 = inr && bi >= 1 && bi <= 9; mk0 = bi == 0 ? 1 : (bi == 8 ? 2 : 0); mk1 = bi == 1 ? 1 : (bi == 9 ? 2 : 0); }
            if (use0 || use1) {
                bf16x8 kf[4], vf[4];
#pragma unroll
                for (int ks = 0; ks < 4; ++ks) kf[ks] = *(const LAS bf16x8*)(kb_ + kperm * AT_KP + 32 * ks + 16 * hi);
                vf[0] = *(const LAS bf16x8*)(vb_ + l32 * AT_VP + 16 * hi); vf[1] = *(const LAS bf16x8*)(vb_ + l32 * AT_VP + 32 + 16 * hi);
                vf[2] = *(const LAS bf16x8*)(vb_ + (32 + l32) * AT_VP + 16 * hi); vf[3] = *(const LAS bf16x8*)(vb_ + (32 + l32) * AT_VP + 32 + 16 * hi);
                if (use0) attn_tile(kf, vf, qf0, oa0, oa1, m0, l0, mk0, l32, hi);
                if (use1) attn_tile(kf, vf, qf1, ob0, ob1, m1, l1, mk1, l32, hi);
            }
            if (s + 1 < 20) *(LAS v4u*)(lb + ((s + 1) & 1) * AT_BUF + sdst) = stg;
            __syncthreads();
        }
#undef AT_SRC
#pragma unroll
        for (int qi = 0; qi < 2; ++qi) {
            const float lr = qi ? l1 : l0; const float ltot = lr + __shfl_xor(lr, 32), inv = 1.0f / ltot;
            const f32x16& o0 = qi ? ob0 : oa0; const f32x16& o1 = qi ? ob1 : oa1;
            bf16* op = Q + (qrow + 32 * qi) * 512 + h * 64 + 4 * hi;
#pragma unroll
            for (int r4 = 0; r4 < 4; ++r4) {
                v2u w0; w0.x = pkbf(o0[4 * r4] * inv, o0[4 * r4 + 1] * inv); w0.y = pkbf(o0[4 * r4 + 2] * inv, o0[4 * r4 + 3] * inv);
                v2u w1; w1.x = pkbf(o1[4 * r4] * inv, o1[4 * r4 + 1] * inv); w1.y = pkbf(o1[4 * r4 + 2] * inv, o1[4 * r4 + 3] * inv);
                if (dostore) { *(GAS v2u*)(op + 8 * r4) = w0; *(GAS v2u*)(op + 32 + 8 * r4) = w1; }
            }
        }
    }
}

constexpr int SC_C = 32, SC_NCH = (LC + SEQ) / SC_C;
constexpr int SC_RP = 3;
constexpr int SC_ROUNDS = SC_NCH / SC_RP;
constexpr int SC_TASK_BYTES = 24576;
constexpr int SC_SLOT_BYTES = 2 * SC_RP * SC_TASK_BYTES;
constexpr int SC_PITCH = 144;
constexpr int SC_PLDS = 4 * 32 * SC_PITCH + 256;
__device__ __forceinline__ int launder(int v) { asm volatile("" : "+v"(v)); return v; }
__device__ __forceinline__ int crow_(int r, int hi) { return (r & 3) + 8 * (r >> 2) + 4 * hi; }
__device__ __forceinline__ bf16x8 packacc(const f32x16& x, int s) {
    v4u p; p.x = pkbf(x[8 * s], x[8 * s + 1]); p.y = pkbf(x[8 * s + 2], x[8 * s + 3]); p.z = pkbf(x[8 * s + 4], x[8 * s + 5]); p.w = pkbf(x[8 * s + 6], x[8 * s + 7]);
    return __builtin_bit_cast(bf16x8, p); }
#define MF(a, b, c) __builtin_amdgcn_mfma_f32_32x32x16_bf16((a), (b), (c), 0, 0, 0)
__device__ __forceinline__ f32x16 zero16() { f32x16 z;
#pragma unroll
    for (int r = 0; r < 16; ++r) z[r] = 0.f;
    return z; }
__device__ __forceinline__ void st_acc_bf16(unsigned char* p, const f32x16& x) {
    v4u a, b; a.x = pkbf(x[0], x[1]); a.y = pkbf(x[2], x[3]); a.z = pkbf(x[4], x[5]); a.w = pkbf(x[6], x[7]); b.x = pkbf(x[8], x[9]); b.y = pkbf(x[10], x[11]); b.z = pkbf(x[12], x[13]); b.w = pkbf(x[14], x[15]);
    *(GAS v4u*)p = a; *(GAS v4u*)(p + 16) = b; }
__device__ __forceinline__ f32x16 ld_acc_bf16(const unsigned char* p) {
    const v4u a = *(const GAS v4u*)p, b = *(const GAS v4u*)(p + 16); f32x16 x;
    x[0] = bflo(a.x); x[1] = bfhi(a.x); x[2] = bflo(a.y); x[3] = bfhi(a.y); x[4] = bflo(a.z); x[5] = bfhi(a.z); x[6] = bflo(a.w); x[7] = bfhi(a.w);
    x[8] = bflo(b.x); x[9] = bfhi(b.x); x[10] = bflo(b.y); x[11] = bfhi(b.y); x[12] = bflo(b.z); x[13] = bfhi(b.z); x[14] = bflo(b.w); x[15] = bfhi(b.w); return x; }

__device__ __forceinline__ void chan_to_frags(const unsigned (&pp)[16], int hi, bf16x8 (&fr)[2][2]) {
    unsigned mine[8], recv[8];
#pragma unroll
    for (int q = 0; q < 8; ++q) { const int plo = (q >> 1) * 4 + (q & 1), phi = plo + 2;
        mine[q] = hi ? pp[phi] : pp[plo]; const unsigned snd = hi ? pp[plo] : pp[phi]; recv[q] = (unsigned)__shfl_xor((int)snd, 32); }
#pragma unroll
    for (int s2 = 0; s2 < 2; ++s2) { v4u t0, t1;
        t0.x = hi ? recv[4 * s2] : mine[4 * s2]; t0.y = hi ? recv[4 * s2 + 1] : mine[4 * s2 + 1]; t0.z = hi ? recv[4 * s2 + 2] : mine[4 * s2 + 2]; t0.w = hi ? recv[4 * s2 + 3] : mine[4 * s2 + 3];
        t1.x = hi ? mine[4 * s2] : recv[4 * s2]; t1.y = hi ? mine[4 * s2 + 1] : recv[4 * s2 + 1]; t1.z = hi ? mine[4 * s2 + 2] : recv[4 * s2 + 2]; t1.w = hi ? mine[4 * s2 + 3] : recv[4 * s2 + 3];
        fr[0][s2] = __builtin_bit_cast(bf16x8, t0); fr[1][s2] = __builtin_bit_cast(bf16x8, t1); }
}
__device__ __forceinline__ void scan_produce(unsigned char* ws, int b, int h, int dir, int chunk, LAS unsigned char* pl, unsigned char* xo, int lane_in, const float* conv, const float* kkpp, const float* kapp) {
    int lane = launder(lane_in);
    float cw[9]; float kkp, kap;
    { const int colc = h * 64 + lane;
#pragma unroll
      for (int j = 0; j < 3; ++j) { cw[j] = conv[j * 1536 + colc]; cw[3 + j] = conv[j * 1536 + 512 + colc]; cw[6 + j] = conv[j * 1536 + 1024 + colc]; }
      kkp = kkpp[dir * 512 + colc]; kap = kapp[dir * 512 + colc]; }
    const bf16* ZK = (const bf16*)(ws + WS_ZK); const bf16* ZV = (const bf16*)(ws + WS_ZV); const bf16* ZR = (const bf16*)(ws + WS_ZR);
    const bf16* EW = (const bf16*)(ws + WS_EW) + (size_t)dir * NTOK * 512; const bf16* AS = (const bf16*)(ws + WS_AS) + (size_t)dir * NTOK * 512;
    int l32 = lane & 31, hi = lane >> 5; const int col = h * 64 + lane;
    const bool lat = chunk >= LC / SC_C; const int len = lat ? SEQ : LC, n0 = lat ? chunk * SC_C - LC : chunk * SC_C;
    const int rowbase = lat ? b * SEQ : NLAT + b * LC;
    LAS unsigned char* mA = pl; LAS unsigned char* mB = pl + 32 * SC_PITCH; LAS unsigned char* mK = pl + 64 * SC_PITCH; LAS unsigned char* mR = pl + 96 * SC_PITCH;
    LAS float* pcs = (LAS float*)(pl + 128 * SC_PITCH);
    unsigned pa[16], pb[16], pk[16], pv[16]; float P = 1.0f;
    const float latf = lat ? 1.0f : 0.0f;
    const float cwr_m = latf * (dir ? cw[2] : cw[0]), cwr_c = latf * cw[1], cwr_p = latf * (dir ? cw[0] : cw[2]), cwk_m = dir ? cw[5] : cw[3], cwk_p = dir ? cw[3] : cw[5], cwv_m = dir ? cw[8] : cw[6], cwv_p = dir ? cw[6] : cw[8];
    const int tk0 = dir ? (len - 1 - n0) : n0, tstep = dir ? -1 : 1;
    const unsigned ob0 = ((unsigned)(rowbase + tk0) * 512u + (unsigned)col) * 2u;
    const long ostepb = (long)tstep * 1024;
    const bool vm1 = n0 > 0, vp32 = n0 + SC_C < len;
    const char* ZKc = (const char*)ZK; const char* ZVc = (const char*)ZV; const char* ZRc = lat ? (const char*)ZR : (const char*)ZK;
    const char* EWc = (const char*)EW; const char* ASc = (const char*)AS;
#define SC_LD(base, j) (*(const GAS bf16*)((base) + (long)(j) * ostepb + ob0))
    const long jm1 = vm1 ? -1 : 0;
    float km = bf1(SC_LD(ZKc, jm1)), kc = bf1(SC_LD(ZKc, 0)), vm = bf1(SC_LD(ZVc, jm1)), vc = bf1(SC_LD(ZVc, 0)), rm = bf1(SC_LD(ZRc, jm1)), rc = bf1(SC_LD(ZRc, 0));
    km = vm1 ? km : 0.f; vm = vm1 ? vm : 0.f; rm = vm1 ? rm : 0.f;
    bf16 gk[2][8], gv[2][8], gr[2][8], ge[2][8], ga[2][8];
#define SC_LOADG(g, bu) do { _Pragma("unroll") for (int jj = 0; jj < 8; ++jj) { const int j = 8 * (g) + jj; \
        const bool vn = (j + 1 < SC_C) || vp32; const long jn = vn ? (j + 1) : j; const bf16 tk_ = SC_LD(ZKc, jn), tv_ = SC_LD(ZVc, jn), tr_ = SC_LD(ZRc, jn); \
        gk[bu][jj] = vn ? tk_ : (bf16)0; gv[bu][jj] = vn ? tv_ : (bf16)0; gr[bu][jj] = vn ? tr_ : (bf16)0; \
        ge[bu][jj] = SC_LD(EWc, j); ga[bu][jj] = SC_LD(ASc, j); } } while (0)
    SC_LOADG(0, 0);
    asm volatile("" ::: "memory");
#pragma unroll
    for (int g = 0; g < 4; ++g) {
        if (g < 3) SC_LOADG(g + 1, (g + 1) & 1);
#pragma unroll
        for (int jj = 0; jj < 8; jj += 2) {
            float va[2], vb[2], vk[2], vv[2];
#pragma unroll
            for (int u = 0; u < 2; ++u) {
                const int i = 8 * g + jj + u;
                const float kp = bf1(gk[g & 1][jj + u]), vp = bf1(gv[g & 1][jj + u]), rp = bf1(gr[g & 1][jj + u]);
                const float k = cwk_m * km + cw[4] * kc + cwk_p * kp, v = cwv_m * vm + cw[7] * vc + cwv_p * vp, r = cwr_m * rm + cwr_c * rc + cwr_p * rp;
                km = kc; kc = kp; vm = vc; vc = vp; rm = rc; rc = rp;
                const float a = bf1(ga[g & 1][jj + u]), ew = bf1(ge[g & 1][jj + u]), w = __expf(-ew);
                const float kkv = k * kkp, ss = wave_sum(kkv * kkv), kk = kkv * __builtin_amdgcn_rsqf(fmaxf(ss, 1e-24f));
                const float kmod = k * (1.0f + (a - 1.0f) * kap);
                const float Pprev = P; P *= w; const float invP = __builtin_amdgcn_rcpf(P);
                const float at = -kk * Pprev, bt = kk * a * invP, kt = kmod * invP, rt = r * P;
                *(LAS bf16*)(mA + i * SC_PITCH + 2 * lane) = (bf16)(pkbf(at, 0.f) & 0xffffu); *(LAS bf16*)(mB + i * SC_PITCH + 2 * lane) = (bf16)(pkbf(bt, 0.f) & 0xffffu);
                *(LAS bf16*)(mK + i * SC_PITCH + 2 * lane) = (bf16)(pkbf(kt, 0.f) & 0xffffu); *(LAS bf16*)(mR + i * SC_PITCH + 2 * lane) = (bf16)(pkbf(rt, 0.f) & 0xffffu);
                va[u] = at; vb[u] = bt; vk[u] = kt; vv[u] = v;
            }
            const int p = 4 * g + (jj >> 1);
            pa[p] = pkbf(va[0], va[1]); pb[p] = pkbf(vb[0], vb[1]); pk[p] = pkbf(vk[0], vk[1]); pv[p] = pkbf(vv[0], vv[1]);
        }
        asm volatile("" ::: "memory");
    }
#undef SC_LOADG
#undef SC_LD
    pcs[lane] = P;
    const float pc_o = __shfl_xor(P, 32); const float pcn0 = hi ? pc_o : P, pcn1 = hi ? P : pc_o;
    bf16x8 fA[2][2], fB[2][2], fK[2][2], fV[2][2];
    chan_to_frags(pa, hi, fA); chan_to_frags(pb, hi, fB); chan_to_frags(pk, hi, fK); chan_to_frags(pv, hi, fV);
    LDS_WAIT(); asm volatile("" ::: "memory");
    __builtin_amdgcn_sched_barrier(0);
    lane = launder(lane_in); l32 = lane & 31; hi = lane >> 5;
    f32x16 X = zero16(), XT = zero16(), LakT = zero16(), MrbT = zero16(), MrkT = zero16();
    const int roff = l32 * SC_PITCH + 16 * hi;
#pragma unroll
    for (int ks = 0; ks < 4; ++ks) {
        const bf16x8 ga = *(const LAS bf16x8*)(mA + roff + 32 * ks), gb = *(const LAS bf16x8*)(mB + roff + 32 * ks), gk = *(const LAS bf16x8*)(mK + roff + 32 * ks), gr = *(const LAS bf16x8*)(mR + roff + 32 * ks);
        X = MF(ga, gb, X); XT = MF(gb, ga, XT); LakT = MF(gk, ga, LakT); MrbT = MF(gb, gr, MrbT); MrkT = MF(gk, gr, MrkT);
    }
    f32x16 TmT;
#pragma unroll
    for (int r = 0; r < 16; ++r) { const int row = crow_(r, hi);
        X[r] = (l32 < row) ? X[r] : 0.f; XT[r] = (row < l32) ? XT[r] : 0.f; LakT[r] = (row < l32) ? LakT[r] : 0.f;
        MrbT[r] = (row <= l32) ? MrbT[r] : 0.f; MrkT[r] = (row <= l32) ? MrkT[r] : 0.f; TmT[r] = XT[r] + ((row == l32) ? 1.0f : 0.f); }
    const bf16x8 la0 = packacc(LakT, 0), la1 = packacc(LakT, 1), rb0 = packacc(MrbT, 0), rb1 = packacc(MrbT, 1), rk0 = packacc(MrkT, 0), rk1 = packacc(MrkT, 1);
    __builtin_amdgcn_sched_barrier(0);
#pragma unroll
    for (int it = 0; it < 4; ++it) {
        const bf16x8 x0 = packacc(X, 0), x1 = packacc(X, 1), y0 = packacc(XT, 0), y1 = packacc(XT, 1), t0 = packacc(TmT, 0), t1 = packacc(TmT, 1);
        f32x16 Xn = zero16(), XnT = zero16();
        Xn = MF(y0, x0, Xn); Xn = MF(y1, x1, Xn); XnT = MF(x0, y0, XnT); XnT = MF(x1, y1, XnT);
        const bf16x8 n0 = packacc(Xn, 0), n1 = packacc(Xn, 1);
        TmT = MF(n0, t0, TmT); TmT = MF(n1, t1, TmT);
        X = Xn; XT = XnT;
    }
    __builtin_amdgcn_sched_barrier(0);
    const bf16x8 tt0 = packacc(TmT, 0), tt1 = packacc(TmT, 1);
    f32x16 W[2], Ut[2];
#pragma unroll
    for (int ct = 0; ct < 2; ++ct) { f32x16 w = zero16(); w = MF(tt0, fA[ct][0], w); w = MF(tt1, fA[ct][1], w); W[ct] = w;
        f32x16 x1 = zero16(); x1 = MF(la0, fV[ct][0], x1); x1 = MF(la1, fV[ct][1], x1);
        f32x16 u = zero16(); u = MF(tt0, packacc(x1, 0), u); u = MF(tt1, packacc(x1, 1), u); Ut[ct] = u; }
    bf16x8 fW[2][2], fU[2][2];
#pragma unroll
    for (int ct = 0; ct < 2; ++ct) { fW[ct][0] = packacc(W[ct], 0); fW[ct][1] = packacc(W[ct], 1); fU[ct][0] = packacc(Ut[ct], 0); fU[ct][1] = packacc(Ut[ct], 1); }
    __builtin_amdgcn_sched_barrier(0);
    lane = launder(lane_in); l32 = lane & 31; hi = lane >> 5;
#pragma unroll
    for (int kt = 0; kt < 2; ++kt) { f32x16 acc;
#pragma unroll
        for (int r4 = 0; r4 < 4; ++r4) { const v2u rr = *(const LAS v2u*)(mR + l32 * SC_PITCH + 2 * (32 * kt + 8 * r4 + 4 * hi));
            acc[4 * r4] = bflo(rr.x); acc[4 * r4 + 1] = bfhi(rr.x); acc[4 * r4 + 2] = bflo(rr.y); acc[4 * r4 + 3] = bfhi(rr.y); }
        acc = MF(fW[kt][0], rb0, acc); acc = MF(fW[kt][1], rb1, acc);
        *(GAS bf16x8*)(xo + 16384 + (kt * 2 + 0) * 1024 + lane * 16) = packacc(acc, 0); *(GAS bf16x8*)(xo + 16384 + (kt * 2 + 1) * 1024 + lane * 16) = packacc(acc, 1); }
#pragma unroll
    for (int vt = 0; vt < 2; ++vt) { f32x16 acc = zero16();
        acc = MF(rb0, fU[vt][0], acc); acc = MF(rb1, fU[vt][1], acc); acc = MF(rk0, fV[vt][0], acc); acc = MF(rk1, fV[vt][1], acc);
        st_acc_bf16(xo + 20480 + vt * 2048 + lane * 32, acc); }
    __builtin_amdgcn_sched_barrier(0);
    lane = launder(lane_in); l32 = lane & 31; hi = lane >> 5;
#pragma unroll
    for (int kt = 0; kt < 2; ++kt)
#pragma unroll
        for (int nt = 0; nt < 2; ++nt) { f32x16 acc = zero16(); acc = MF(fW[kt][0], fB[nt][0], acc); acc = MF(fW[kt][1], fB[nt][1], acc);
            const float pc = nt ? pcn1 : pcn0;
#pragma unroll
            for (int r = 0; r < 16; ++r) acc[r] = (acc[r] + ((kt == nt && crow_(r, hi) == l32) ? 1.0f : 0.f)) * pc;
            *(GAS bf16x8*)(xo + ((kt * 2 + nt) * 2 + 0) * 1024 + lane * 16) = packacc(acc, 0); *(GAS bf16x8*)(xo + ((kt * 2 + nt) * 2 + 1) * 1024 + lane * 16) = packacc(acc, 1); }
    __builtin_amdgcn_sched_barrier(0);
    lane = launder(lane_in); l32 = lane & 31; hi = lane >> 5;
#pragma unroll
    for (int kt = 0; kt < 2; ++kt)
#pragma unroll
        for (int vt = 0; vt < 2; ++vt) { f32x16 acc = zero16();
            acc = MF(fB[kt][0], fU[vt][0], acc); acc = MF(fB[kt][1], fU[vt][1], acc); acc = MF(fK[kt][0], fV[vt][0], acc); acc = MF(fK[kt][1], fV[vt][1], acc);
#pragma unroll
            for (int r4 = 0; r4 < 4; ++r4) { const f32x4 pr = *(const LAS f32x4*)(pcs + 32 * kt + 8 * r4 + 4 * hi);
                acc[4 * r4] *= pr.x; acc[4 * r4 + 1] *= pr.y; acc[4 * r4 + 2] *= pr.z; acc[4 * r4 + 3] *= pr.w; }
            st_acc_bf16(xo + 8192 + (kt * 2 + vt) * 2048 + lane * 32, acc); }
    LDS_WAIT();
}
__device__ __forceinline__ void scan_consume(unsigned char* ws, int b, int h, int dir, int chunk, const unsigned char* xi, int lane, f32x16 (&H)[2][2]) {
    const int l32 = lane & 31, hi = lane >> 5;
    bf16x8 hb[2][2][2];
#pragma unroll
    for (int kt = 0; kt < 2; ++kt)
#pragma unroll
        for (int vt = 0; vt < 2; ++vt) { hb[kt][vt][0] = packacc(H[kt][vt], 0); hb[kt][vt][1] = packacc(H[kt][vt], 1); }
    if (chunk >= LC / SC_C) {
        bf16x8 rf[2][2];
#pragma unroll
        for (int kt = 0; kt < 2; ++kt)
#pragma unroll
            for (int s2 = 0; s2 < 2; ++s2) rf[kt][s2] = *(const GAS bf16x8*)(xi + 16384 + (kt * 2 + s2) * 1024 + lane * 16);
        bf16* Y = (bf16*)(ws + (dir ? WS_YB : WS_YF)); const int n0 = chunk * SC_C - LC;
#pragma unroll
        for (int vt = 0; vt < 2; ++vt) { f32x16 acc = ld_acc_bf16(xi + 20480 + vt * 2048 + lane * 32);
#pragma unroll
            for (int kt = 0; kt < 2; ++kt) { acc = MF(rf[kt][0], hb[kt][vt][0], acc); acc = MF(rf[kt][1], hb[kt][vt][1], acc); }
#pragma unroll
            for (int r = 0; r < 16; ++r) { const int i = crow_(r, hi), tk = dir ? (SEQ - 1 - (n0 + i)) : (n0 + i);
                Y[((size_t)b * SEQ + tk) * 512 + h * 64 + 32 * vt + l32] = (bf16)(pkbf(acc[r], 0.f) & 0xffffu); } }
    }
    f32x16 Hn[2][2];
#pragma unroll
    for (int nt = 0; nt < 2; ++nt)
#pragma unroll
        for (int vt = 0; vt < 2; ++vt) Hn[nt][vt] = ld_acc_bf16(xi + 8192 + (nt * 2 + vt) * 2048 + lane * 32);
#pragma unroll
    for (int kt = 0; kt < 2; ++kt)
#pragma unroll
        for (int nt = 0; nt < 2; ++nt) { const bf16x8 g0 = *(const GAS bf16x8*)(xi + ((kt * 2 + nt) * 2 + 0) * 1024 + lane * 16), g1 = *(const GAS bf16x8*)(xi + ((kt * 2 + nt) * 2 + 1) * 1024 + lane * 16);
#pragma unroll
            for (int vt = 0; vt < 2; ++vt) { Hn[nt][vt] = MF(g0, hb[kt][vt][0], Hn[nt][vt]); Hn[nt][vt] = MF(g1, hb[kt][vt][1], Hn[nt][vt]); } }
#pragma unroll
    for (int nt = 0; nt < 2; ++nt)
#pragma unroll
        for (int vt = 0; vt < 2; ++vt) H[nt][vt] = Hn[nt][vt];
}
__device__ __forceinline__ void p4b_scan(Frame& F) {
    const int wave = F.wave, lane = F.lane;
    const bool is_cons = wave < 2; const int pw = wave - 2;
    unsigned char* xch = F.ws + WS_XCH + (size_t)blockIdx.x * (2 * SC_SLOT_BYTES);
    LAS unsigned char* pl = F.lds + (is_cons ? 0 : pw) * SC_PLDS;
    for (int task = blockIdx.x; task < NB * 8; task += F.G) {
        const int b = task >> 3, h = task & 7; const int pdir = is_cons ? wave : pw / SC_RP, pci = is_cons ? 0 : pw % SC_RP;
        const float* conv = karg_in(I_CONV); const float* kkpp = karg_in(I_KK); const float* kapp = karg_in(I_KA);
#define SC_SYNC() do { asm volatile("s_waitcnt vmcnt(0) lgkmcnt(0)" ::: "memory"); __builtin_amdgcn_s_barrier(); asm volatile("" ::: "memory"); } while (0)
        if (is_cons) {
            f32x16 H[2][2];
#pragma unroll
            for (int i = 0; i < 2; ++i)
#pragma unroll
                for (int j = 0; j < 2; ++j) H[i][j] = zero16();
#pragma unroll 1
            for (int q = -1; q < SC_ROUNDS; ++q) {
                if (q >= 0) { __builtin_amdgcn_fence(__ATOMIC_ACQUIRE, "agent");
#pragma unroll 1
                    for (int i = 0; i < SC_RP; ++i) scan_consume(F.ws, b, h, wave, q * SC_RP + i, xch + (size_t)(q & 1) * SC_SLOT_BYTES + (size_t)(wave * SC_RP + i) * SC_TASK_BYTES, lane, H); }
                SC_SYNC();
            }
        } else {
#pragma unroll 1
            for (int q = -1; q < SC_ROUNDS; ++q) {
                if (q + 1 < SC_ROUNDS) scan_produce(F.ws, b, h, pdir, (q + 1) * SC_RP + pci, pl, xch + (size_t)((q + 1) & 1) * SC_SLOT_BYTES + (size_t)(pdir * SC_RP + pci) * SC_TASK_BYTES, lane, conv, kkpp, kapp);
                SC_SYNC();
            }
        }
#undef SC_SYNC
    }
}
#undef MF

__device__ __forceinline__ void p5_rwkv_out(Frame& F) {
    const int gw = blockIdx.x * NWAVES + F.wave, NGW = F.G * NWAVES, lane = F.lane, c0 = 8 * lane;
    const bf16* ZK = (const bf16*)(F.ws + WS_ZK); const bf16* ZV = (const bf16*)(F.ws + WS_ZV); const bf16* ZR = (const bf16*)(F.ws + WS_ZR);
    const bf16* AS0 = (const bf16*)(F.ws + WS_AS); const bf16* AS1 = AS0 + (size_t)NTOK * 512;
    const bf16* YF = (const bf16*)(F.ws + WS_YF); const bf16* YB = (const bf16*)(F.ws + WS_YB); const bf16* G = (const bf16*)(F.ws + WS_G);
    bf16* ORW = (bf16*)(F.ws + WS_ORW);
    LAS float* PL = (LAS float*)F.lds;
    { const float* convg = karg_in(I_CONV); const float* kag = karg_in(I_KA); const float* rkg = karg_in(I_RK); const float* lnwg = karg_in(I_LNW); const float* lnbg = karg_in(I_LNB);
      for (int i = F.tid; i < 15 * 512; i += 512) { const int row = i >> 9, c = i & 511; float v;
          if (row < 9) v = convg[(row % 3) * 1536 + (row / 3) * 512 + c]; else if (row < 11) v = kag[(row - 9) * 512 + c]; else if (row < 13) v = rkg[(row - 11) * 512 + c]; else if (row == 13) v = lnwg[c]; else v = lnbg[c];
          PL[i] = v; }
      __syncthreads(); }
    const LAS float* conv = PL; const LAS float* ka = PL + 9 * 512; const LAS float* rk = PL + 11 * 512; const LAS float* lnw = PL + 13 * 512; const LAS float* lnb = PL + 14 * 512;
    for (int m0 = gw; m0 < NLAT; m0 += 2 * NGW) {
        v4u raw[2][14];
        const v4u z4 = (v4u){0u, 0u, 0u, 0u};
#pragma unroll
        for (int rr = 0; rr < 2; ++rr) { const int m = min(m0 + rr * NGW, NLAT - 1);
            const int t = m & 2047; const bool first = t == 0, last = t == SEQ - 1; const size_t o = (size_t)m * 512 + c0;
            const size_t om = first ? o : o - 512, op = last ? o : o + 512;
#pragma unroll
            for (int which = 0; which < 3; ++which) { const bf16* Z = which == 0 ? ZR : (which == 1 ? ZK : ZV);
                const v4u ra = *(const GAS v4u*)(Z + om), rc_ = *(const GAS v4u*)(Z + op);
                raw[rr][3 * which] = first ? z4 : ra; raw[rr][3 * which + 1] = *(const GAS v4u*)(Z + o); raw[rr][3 * which + 2] = last ? z4 : rc_; }
            raw[rr][9] = *(const GAS v4u*)(AS0 + o); raw[rr][10] = *(const GAS v4u*)(AS1 + o); raw[rr][11] = *(const GAS v4u*)(YF + o); raw[rr][12] = *(const GAS v4u*)(YB + o); raw[rr][13] = *(const GAS v4u*)(G + o); }
#pragma unroll
        for (int rr = 0; rr < 2; ++rr) { const int m = m0 + rr * NGW; if (m >= NLAT) continue;
            const size_t o = (size_t)m * 512 + c0;
            float r[8], k[8], v[8], tmp[8];
            asm volatile("" ::: "memory");
#pragma unroll
            for (int which = 0; which < 3; ++which) { float (&dst)[8] = which == 0 ? r : (which == 1 ? k : v);
                asm volatile("" ::: "memory");
                float fa[8], fb[8], fc[8]; unpack8(raw[rr][3 * which], fa); unpack8(raw[rr][3 * which + 1], fb); unpack8(raw[rr][3 * which + 2], fc);
                const LAS float* cwp = conv + (3 * which) * 512 + c0;
#pragma unroll
                for (int j = 0; j < 8; ++j) dst[j] = cwp[j] * fa[j] + cwp[512 + j] * fb[j] + cwp[1024 + j] * fc[j]; }
            asm volatile("" ::: "memory");
            float a0[8], a1[8]; unpack8(raw[rr][9], a0); unpack8(raw[rr][10], a1);
            float s = 0.f;
#pragma unroll
            for (int j = 0; j < 8; ++j) { const float km0 = k[j] * (1.0f + (a0[j] - 1.0f) * ka[c0 + j]), km1 = k[j] * (1.0f + (a1[j] - 1.0f) * ka[512 + c0 + j]);
                s += r[j] * (km0 * rk[c0 + j] + km1 * rk[512 + c0 + j]); }
            s += __shfl_xor(s, 1); s += __shfl_xor(s, 2); s += __shfl_xor(s, 4);
            asm volatile("" ::: "memory");
            float y[8], yb[8]; unpack8(raw[rr][11], y); unpack8(raw[rr][12], yb);
            float sm = 0.f;
#pragma unroll
            for (int j = 0; j < 8; ++j) { y[j] += yb[j]; sm += y[j]; }
            sm += __shfl_xor(sm, 1); sm += __shfl_xor(sm, 2); sm += __shfl_xor(sm, 4);
            const float mean = sm * (1.f / 64.f); float sq = 0.f;
#pragma unroll
            for (int j = 0; j < 8; ++j) { y[j] -= mean; sq += y[j] * y[j]; }
            sq += __shfl_xor(sq, 1); sq += __shfl_xor(sq, 2); sq += __shfl_xor(sq, 4);
            const float rstd = __builtin_amdgcn_rsqf(sq * (1.f / 64.f) + 64e-5f);
            float gg[8]; unpack8(raw[rr][13], gg);
#pragma unroll
            for (int j = 0; j < 8; ++j) tmp[j] = (y[j] * rstd * lnw[c0 + j] + lnb[c0 + j] + s * v[j]) * gg[j];
            *(GAS v4u*)(ORW + o) = pack8(tmp); }
    }
}

struct EpiMerge {
    static constexpr bool PERM = true, AFTER_DRAIN = false;
    bf16* merged; const bf16* gates; int goff; int first;
    __device__ __forceinline__ void operator()(const f32x4 (&acc)[2][2][4][2], const Unit& u, int wr, int wc, int fr, int fq) const {
        const int row0 = u.pm * 256 + wr * 64 + fr, col0 = u.pn * 256 + wc * 32 + 8 * fq;
#pragma unroll
        for (int ai = 0; ai < 2; ++ai)
#pragma unroll
            for (int m = 0; m < 4; ++m) { const size_t row = (size_t)(row0 + ai * 128 + m * 16);
#pragma unroll
                for (int bj = 0; bj < 2; ++bj) { const int col = col0 + bj * 128;
                    float gt[8]; unpack8(*(const GAS v4u*)(gates + row * 2048 + goff + col), gt);
                    const f32x4 v0 = acc[ai][bj][m][0], v1 = acc[ai][bj][m][1];
                    float o[8] = {v0.x * gt[0], v0.y * gt[1], v0.z * gt[2], v0.w * gt[3], v1.x * gt[4], v1.y * gt[5], v1.z * gt[6], v1.w * gt[7]};
                    GAS v4u* p = (GAS v4u*)(merged + row * 1024 + col);
                    if (!first) { float pv[8]; unpack8(*p, pv);
#pragma unroll
                        for (int j = 0; j < 8; ++j) o[j] += pv[j]; }
                    *p = pack8(o); } }
    }
};
struct EpiMerge2 {
    static constexpr bool PERM = true, AFTER_DRAIN = false;
    bf16* merged; const bf16* gates;
    __device__ __forceinline__ void mid(f32x4 (&acc)[2][2][4][2], const Unit& u, int wr, int wc, int fr, int fq) const {
        const int row0 = u.pm * 256 + wr * 64 + fr, col0 = u.pn * 256 + wc * 32 + 8 * fq;
#pragma unroll
        for (int ai = 0; ai < 2; ++ai)
#pragma unroll
            for (int m = 0; m < 4; ++m) { const size_t row = (size_t)(row0 + ai * 128 + m * 16);
#pragma unroll
                for (int bj = 0; bj < 2; ++bj) { const int col = col0 + bj * 128;
                    float gr[8], ga[8]; unpack8(*(const GAS v4u*)(gates + row * 2048 + col), gr); unpack8(*(const GAS v4u*)(gates + row * 2048 + 1024 + col), ga);
                    float q[8];
#pragma unroll
                    for (int j = 0; j < 8; ++j) q[j] = gr[j] * __builtin_amdgcn_rcpf(fmaxf(ga[j], 1e-30f));
                    acc[ai][bj][m][0] *= (f32x4){q[0], q[1], q[2], q[3]}; acc[ai][bj][m][1] *= (f32x4){q[4], q[5], q[6], q[7]}; } }
    }
    __device__ __forceinline__ void operator()(const f32x4 (&acc)[2][2][4][2], const Unit& u, int wr, int wc, int fr, int fq) const {
        const int row0 = u.pm * 256 + wr * 64 + fr, col0 = u.pn * 256 + wc * 32 + 8 * fq;
#pragma unroll
        for (int ai = 0; ai < 2; ++ai)
#pragma unroll
            for (int m = 0; m < 4; ++m) { const size_t row = (size_t)(row0 + ai * 128 + m * 16);
#pragma unroll
                for (int bj = 0; bj < 2; ++bj) { const int col = col0 + bj * 128;
                    float ga[8]; unpack8(*(const GAS v4u*)(gates + row * 2048 + 1024 + col), ga);
                    const f32x4 v0 = acc[ai][bj][m][0], v1 = acc[ai][bj][m][1];
                    float o[8] = {v0.x * fmaxf(ga[0], 1e-30f), v0.y * fmaxf(ga[1], 1e-30f), v0.z * fmaxf(ga[2], 1e-30f), v0.w * fmaxf(ga[3], 1e-30f),
                                  v1.x * fmaxf(ga[4], 1e-30f), v1.y * fmaxf(ga[5], 1e-30f), v1.z * fmaxf(ga[6], 1e-30f), v1.w * fmaxf(ga[7], 1e-30f)};
                    *(GAS v4u*)(merged + row * 1024 + col) = pack8(o); } }
    }
};
struct EpiOutproj {
    static constexpr bool PERM = true, AFTER_DRAIN = false;
    bf16* delta; const float* mod;
    __device__ __forceinline__ void operator()(const f32x4 (&acc)[2][2][4][2], const Unit& u, int wr, int wc, int fr, int fq) const {
        const int row0 = u.pm * 256 + wr * 64 + fr, col0 = u.pn * 256 + wc * 32 + 8 * fq; const int b = u.pm >> 3;
        f32x4 gv[2][2];
#pragma unroll
        for (int bj = 0; bj < 2; ++bj)
#pragma unroll
            for (int n = 0; n < 2; ++n) gv[bj][n] = *(const f32x4*)(mod + (size_t)b * 6144 + 2048 + col0 + bj * 128 + 4 * n);
#pragma unroll
        for (int ai = 0; ai < 2; ++ai)
#pragma unroll
            for (int m = 0; m < 4; ++m) { const size_t off = (size_t)(row0 + ai * 128 + m * 16) * 1024 + col0;
#pragma unroll
                for (int bj = 0; bj < 2; ++bj) { const f32x4 v0 = gv[bj][0] * acc[ai][bj][m][0], v1 = gv[bj][1] * acc[ai][bj][m][1];
                    v4u w; w.x = pkbf(v0.x, v0.y); w.y = pkbf(v0.z, v0.w); w.z = pkbf(v1.x, v1.y); w.w = pkbf(v1.z, v1.w);
                    *(GAS v4u*)(delta + off + bj * 128) = w; } }
    }
};

constexpr int RW_PITCH = 2064;
__device__ __forceinline__ void p8_norm2_router(Frame& F) {
    LAS unsigned char* rhi = F.lds; LAS unsigned char* rlo = F.lds + 32 * RW_PITCH;
    const float* rw = karg_in(I_ROUTER);
    for (int i = F.tid; i < 16384; i += 512) { const int e = i & 15, k = i >> 4; const float w = rw[i]; const unsigned h = pkbf(w, 0.f) & 0xffffu; const float wl = w - __uint_as_float(h << 16);
        *(LAS bf16*)(rhi + e * RW_PITCH + 2 * k) = (bf16)h; *(LAS bf16*)(rlo + e * RW_PITCH + 2 * k) = (bf16)(pkbf(wl, 0.f) & 0xffffu); }
    for (int i = F.tid; i < 16 * 1024 / 2; i += 512) { const int e = 16 + i / 512, k2 = i % 512; *(LAS unsigned*)(rhi + e * RW_PITCH + 4 * k2) = 0u; *(LAS unsigned*)(rlo + e * RW_PITCH + 4 * k2) = 0u; }
    __syncthreads();
    const int gw = blockIdx.x * NWAVES + F.wave, NGW = F.G * NWAVES, lane = F.lane, l32 = lane & 31, hi = lane >> 5;
    const float* mod = (const float*)(F.ws + WS_MOD); bf16* H2 = (bf16*)(F.ws + WS_H2); float* AFF = (float*)(F.ws + WS_AFF);
    const float* g2 = karg_in(I_N2G); const float* Xp = karg_in(I_X); const bf16* DELTA = (const bf16*)(F.ws + WS_DELTA);
    f32x4 gv[4];
#pragma unroll
    for (int j = 0; j < 4; ++j) gv[j] = *(const f32x4*)(g2 + 4 * lane + 256 * j);
    for (int tile = gw; tile < NLAT / 32; tile += NGW) {
        const int mbase = tile * 32, b = mbase >> 11; const float* sh = mod + (size_t)b * 6144 + 3072; const float* sc = sh + 1024;
        f32x4 av[4], bv[4];
#pragma unroll
        for (int j = 0; j < 4; ++j) { av[j] = *(const f32x4*)(sc + 4 * lane + 256 * j) + 1.0f; bv[j] = *(const f32x4*)(sh + 4 * lane + 256 * j); }
#pragma unroll 1
        for (int r0 = 0; r0 < 32; r0 += 4) {
            f32x4 v[4][4];
#pragma unroll
            for (int r = 0; r < 4; ++r) { const float* xr = Xp + (size_t)(mbase + r0 + r) * DM; const bf16* dr = DELTA + (size_t)(mbase + r0 + r) * DM;
#pragma unroll
                for (int j = 0; j < 4; ++j) { const v2u d = *(const GAS v2u*)(dr + 4 * lane + 256 * j);
                    v[r][j] = *(const GAS f32x4*)(xr + 4 * lane + 256 * j) + (f32x4){bflo(d.x), bfhi(d.x), bflo(d.y), bfhi(d.y)}; } }
#pragma unroll
            for (int r = 0; r < 4; ++r) { float s = 0.f;
#pragma unroll
                for (int j = 0; j < 4; ++j) s += (v[r][j].x * v[r][j].x + v[r][j].y * v[r][j].y) + (v[r][j].z * v[r][j].z + v[r][j].w * v[r][j].w);
                const float rstd = __builtin_amdgcn_rsqf(wave_sum(s) * (1.f / DM) + 1e-6f);
#pragma unroll
                for (int j = 0; j < 4; ++j) { const f32x4 y = v[r][j] * rstd * gv[j] * av[j] + bv[j];
                    v2u o; o.x = pkbf(y.x, y.y); o.y = pkbf(y.z, y.w);
                    *(GAS v2u*)(H2 + (size_t)(mbase + r0 + r) * DM + 4 * lane + 256 * j) = o; } }
        }
        asm volatile("s_waitcnt vmcnt(0)" ::: "memory");
        f32x16 acc;
#pragma unroll
        for (int r = 0; r < 16; ++r) acc[r] = 0.f;
        const bf16* hrow = H2 + (size_t)(mbase + l32) * DM + 8 * hi;
        const LAS unsigned char* ah = rhi + l32 * RW_PITCH + 16 * hi; const LAS unsigned char* al = rlo + l32 * RW_PITCH + 16 * hi;
#pragma unroll 8
        for (int ks = 0; ks < 64; ++ks) { const bf16x8 bf = *(const GAS bf16x8*)(hrow + 16 * ks);
            const bf16x8 fh = *(const LAS bf16x8*)(ah + 32 * ks), fl = *(const LAS bf16x8*)(al + 32 * ks);
            acc = __builtin_amdgcn_mfma_f32_32x32x16_bf16(fh, bf, acc, 0, 0, 0); acc = __builtin_amdgcn_mfma_f32_32x32x16_bf16(fl, bf, acc, 0, 0, 0); }
        float mx = acc[0];
#pragma unroll
        for (int r = 1; r < 8; ++r) mx = fmaxf(mx, acc[r]);
        mx = fmaxf(mx, __shfl_xor(mx, 32));
        float pe[8], den = 0.f;
#pragma unroll
        for (int r = 0; r < 8; ++r) { pe[r] = __expf(acc[r] - mx); den += pe[r]; }
        den += __shfl_xor(den, 32);
        const float inv = 1.0f / den; const int t = (mbase & 2047) + l32;
#pragma unroll
        for (int r = 0; r < 8; ++r) { const int e = (r & 3) + 8 * (r >> 2) + 4 * hi; AFF[((size_t)b * 16 + e) * SEQ + t] = pe[r] * inv; }
    }
}

__device__ __forceinline__ int block_count(Frame& F, LAS int* wc, int slot, bool p0, bool p1, bool p2, bool p3) {
    const int c = __builtin_popcountll(__ballot(p0)) + __builtin_popcountll(__ballot(p1)) + __builtin_popcountll(__ballot(p2)) + __builtin_popcountll(__ballot(p3));
    if (F.lane == 0) wc[slot * 8 + F.wave] = c;
    __syncthreads();
    int s = 0;
#pragma unroll
    for (int w = 0; w < 8; ++w) s += wc[slot * 8 + w];
    return s;
}
__device__ __forceinline__ void p9_topk_gather(Frame& F) {
    LAS int* wc = (LAS int*)F.lds;
    LAS int* sel = (LAS int*)(F.lds + 1024);
    const float* AFF = (const float*)(F.ws + WS_AFF); int* IDX = (int*)(F.ws + WS_IDX); float* VAL = (float*)(F.ws + WS_VAL);
    const bf16* H2 = (const bf16*)(F.ws + WS_H2); bf16* XE = (bf16*)(F.ws + WS_XE); int* INV = (int*)(F.ws + WS_INV);
    const int tid = F.tid, lane = F.lane, wave = F.wave;
    for (int p = blockIdx.x; p < NB * NE; p += F.G) {
        const int b = p >> 4, e = p & 15;
        const f32x4 av = *(const GAS f32x4*)(AFF + (size_t)p * SEQ + 4 * tid);
        const unsigned u0 = __float_as_uint(av.x), u1 = __float_as_uint(av.y), u2 = __float_as_uint(av.z), u3 = __float_as_uint(av.w);
        unsigned tau = 0u; int it = 0;
        for (int bit = 30; bit >= 0; --bit, ++it) { const unsigned cand = tau | (1u << bit);
            const int cnt = block_count(F, wc, it & 1, u0 >= cand, u1 >= cand, u2 >= cand, u3 >= cand);
            if (cnt >= CAP) tau = cand; }
        const int cgt = block_count(F, wc, it & 1, u0 > tau, u1 > tau, u2 > tau, u3 > tau); ++it;
        const int need_eq = CAP - cgt;
        const int ngt = (u0 > tau) + (u1 > tau) + (u2 > tau) + (u3 > tau), neq = (u0 == tau) + (u1 == tau) + (u2 == tau) + (u3 == tau);
        int pk = ngt | (neq << 16), inc = pk;
#pragma unroll
        for (int o = 1; o < 64; o <<= 1) { const int nb = __shfl_up(inc, o); if (lane >= o) inc += nb; }
        if (lane == 63) wc[16 + wave] = inc;
        __syncthreads();
        int base = 0;
#pragma unroll
        for (int w = 0; w < 8; ++w) base += (w < wave) ? wc[16 + w] : 0;
        int ex = base + inc - pk; int gpos = ex & 0xffff, epos = ex >> 16;
        const unsigned uu[4] = {u0, u1, u2, u3}; const float ff[4] = {av.x, av.y, av.z, av.w};
#pragma unroll
        for (int j = 0; j < 4; ++j) { int slot = -1;
            if (uu[j] > tau) { slot = gpos; ++gpos; } else if (uu[j] == tau) { if (epos < need_eq) slot = cgt + epos; ++epos; }
            if (slot >= 0) { IDX[(size_t)(e * NB + b) * CAP + slot] = 4 * tid + j; VAL[(size_t)(e * NB + b) * CAP + slot] = ff[j]; sel[slot] = 4 * tid + j; }
            INV[((size_t)b * SEQ + 4 * tid + j) * 16 + e] = slot; }
        __syncthreads();
        __syncthreads();
    }
}

struct ExpertOrder {
    int G, c, upe, npn;
    __device__ void init(int G_, int c_, int npn_) { G = G_; c = c_; npn = npn_; upe = 32 * npn_; }
    __device__ bool next(int i, Unit& u) const { const unsigned L = (unsigned)i * (unsigned)G + (unsigned)c; if (L >= (unsigned)(NE * upe)) return false;
        const unsigned e = L / (unsigned)upe, rem = L - e * (unsigned)upe; u.pm = (int)(e * 32u + (rem & 31u)); u.pn = (int)(e * (unsigned)npn + (rem >> 5)); return true; }
    __device__ __forceinline__ void a_ready(const Unit&) const {}
    __device__ __forceinline__ void done(const Unit&) const {}
};
struct EpiSwiglu {
    static constexpr bool PERM = true, AFTER_DRAIN = false;
    bf16* act;
    __device__ __forceinline__ void operator()(const f32x4 (&acc)[2][2][4][2], const Unit& u, int wr, int wc, int fr, int fq) const {
        const int e = u.pm >> 5, pnl = u.pn - 12 * e; const int row0 = u.pm * 256 + wr * 64 + fr, col = 128 * pnl + wc * 32 + 8 * fq;
#pragma unroll
        for (int ai = 0; ai < 2; ++ai)
#pragma unroll
            for (int m = 0; m < 4; ++m) { const f32x4 g0 = acc[ai][0][m][0], g1 = acc[ai][0][m][1], u0 = acc[ai][1][m][0], u1 = acc[ai][1][m][1];
                float o[8] = {g0.x * sigmoidf_(g0.x) * u0.x, g0.y * sigmoidf_(g0.y) * u0.y, g0.z * sigmoidf_(g0.z) * u0.z, g0.w * sigmoidf_(g0.w) * u0.w,
                              g1.x * sigmoidf_(g1.x) * u1.x, g1.y * sigmoidf_(g1.y) * u1.y, g1.z * sigmoidf_(g1.z) * u1.z, g1.w * sigmoidf_(g1.w) * u1.w};
                *(GAS v4u*)(act + (size_t)(row0 + ai * 128 + m * 16) * DFF + col) = pack8(o); }
    }
};
struct EpiDown {
    static constexpr bool PERM = true, AFTER_DRAIN = false;
    bf16* y2; const float* val;
    __device__ __forceinline__ void operator()(const f32x4 (&acc)[2][2][4][2], const Unit& u, int wr, int wc, int fr, int fq) const {
        const int e = u.pm >> 5, pnl = u.pn - 4 * e; const int srow0 = u.pm * 256 + wr * 64 + fr, col0 = pnl * 256 + wc * 32 + 8 * fq;
#pragma unroll
        for (int ai = 0; ai < 2; ++ai)
#pragma unroll
            for (int m = 0; m < 4; ++m) { const int srow = srow0 + ai * 128 + m * 16; const float vl = val[srow];
#pragma unroll
                for (int bj = 0; bj < 2; ++bj) { const f32x4 v0 = acc[ai][bj][m][0] * vl, v1 = acc[ai][bj][m][1] * vl;
                    v4u w; w.x = pkbf(v0.x, v0.y); w.y = pkbf(v0.z, v0.w); w.z = pkbf(v1.x, v1.y); w.w = pkbf(v1.z, v1.w);
                    *(GAS v4u*)(y2 + (size_t)srow * DM + col0 + bj * 128) = w; } }
    }
};
__device__ __forceinline__ void p12_combine(Frame& F, bool dostore = true) {
    const int gw = blockIdx.x * NWAVES + F.wave, NGW = F.G * NWAVES, lane = F.lane;
    const int* INV = (const int*)(F.ws + WS_INV); const bf16* Y2 = (const bf16*)(F.ws + WS_Y2); const float* mod = (const float*)(F.ws + WS_MOD);
    const float* Xp = karg_in(I_X); const bf16* DELTA = (const bf16*)(F.ws + WS_DELTA);
    for (int m0 = gw; m0 < NLAT; m0 += 2 * NGW) {
        int inv[2]; f32x4 xv[2][4];
#pragma unroll
        for (int r = 0; r < 2; ++r) { const int m = min(m0 + r * NGW, NLAT - 1);
            { const int iv = INV[(size_t)m * 16 + (lane & 15)]; inv[r] = lane < 16 ? iv : -1; const float* orow = Xp + (size_t)m * DM; const bf16* dr = DELTA + (size_t)m * DM;
                const v4u d0 = *(const GAS v4u*)(dr + 8 * lane), d1 = *(const GAS v4u*)(dr + 512 + 8 * lane);
                xv[r][0] = *(const GAS f32x4*)(orow + 8 * lane) + (f32x4){bflo(d0.x), bfhi(d0.x), bflo(d0.y), bfhi(d0.y)}; xv[r][1] = *(const GAS f32x4*)(orow + 8 * lane + 4) + (f32x4){bflo(d0.z), bfhi(d0.z), bflo(d0.w), bfhi(d0.w)};
                xv[r][2] = *(const GAS f32x4*)(orow + 512 + 8 * lane) + (f32x4){bflo(d1.x), bfhi(d1.x), bflo(d1.y), bfhi(d1.y)}; xv[r][3] = *(const GAS f32x4*)(orow + 512 + 8 * lane + 4) + (f32x4){bflo(d1.z), bfhi(d1.z), bflo(d1.w), bfhi(d1.w)}; } }
#pragma unroll
        for (int r = 0; r < 2; ++r) { const int m = m0 + r * NGW; if (m >= NLAT) continue;
            const int b = m >> 11; unsigned long long mk = __ballot(inv[r] >= 0);
            float a0[8] = {0.f, 0.f, 0.f, 0.f, 0.f, 0.f, 0.f, 0.f}, a1[8] = {0.f, 0.f, 0.f, 0.f, 0.f, 0.f, 0.f, 0.f};
            while (mk) {
                const int e = __builtin_ctzll(mk); mk &= mk - 1; const int slot = __builtin_amdgcn_readlane(inv[r], e);
                const bool two = mk != 0; int e2 = e, slot2 = slot; if (two) { e2 = __builtin_ctzll(mk); mk &= mk - 1; slot2 = __builtin_amdgcn_readlane(inv[r], e2); }
                const bf16* yr = Y2 + ((size_t)(e * NB + b) * CAP + slot) * DM; const bf16* yr2 = Y2 + ((size_t)(e2 * NB + b) * CAP + slot2) * DM;
                const v4u q0 = *(const GAS v4u*)(yr + 8 * lane), q1 = *(const GAS v4u*)(yr + 512 + 8 * lane), q2 = *(const GAS v4u*)(yr2 + 8 * lane), q3 = *(const GAS v4u*)(yr2 + 512 + 8 * lane);
                float f0[8], f1[8], f2[8], f3[8]; unpack8(q0, f0); unpack8(q1, f1); unpack8(q2, f2); unpack8(q3, f3);
                const float w2 = two ? 1.0f : 0.0f;
#pragma unroll
                for (int j = 0; j < 8; ++j) { a0[j] += f0[j] + w2 * f2[j]; a1[j] += f1[j] + w2 * f3[j]; }
            }
            float* orow = F.out + (size_t)m * DM; const float* g = mod + (size_t)b * 6144 + 5120;
            const f32x4 g0 = *(const f32x4*)(g + 8 * lane), g1 = *(const f32x4*)(g + 8 * lane + 4), g2 = *(const f32x4*)(g + 512 + 8 * lane), g3 = *(const f32x4*)(g + 512 + 8 * lane + 4);
            if (dostore) {
            *(GAS f32x4*)(orow + 8 * lane) = xv[r][0] + g0 * (f32x4){a0[0], a0[1], a0[2], a0[3]}; *(GAS f32x4*)(orow + 8 * lane + 4) = xv[r][1] + g1 * (f32x4){a0[4], a0[5], a0[6], a0[7]};
            *(GAS f32x4*)(orow + 512 + 8 * lane) = xv[r][2] + g2 * (f32x4){a1[0], a1[1], a1[2], a1[3]}; *(GAS f32x4*)(orow + 512 + 8 * lane + 4) = xv[r][3] + g3 * (f32x4){a1[4], a1[5], a1[6], a1[7]}; }
        }
    }
}

struct Args { const float* in[30]; float* out; unsigned char* ws; int ph_lo, ph_hi; };
__global__ void __launch_bounds__(NWAVES * 64, 2) mk_fwd(Args args) {
    extern __shared__ __attribute__((aligned(16))) unsigned char lds[];
    Frame F;
    F.lds = (LAS unsigned char*)lds; F.MISC = (volatile LAS unsigned*)(F.lds + MISC_OFF);
    F.tid = threadIdx.x; F.lane = F.tid & 63; F.wave = __builtin_amdgcn_readfirstlane(F.tid >> 6); F.G = gridDim.x;
    F.out = args.out; F.ws = args.ws; F.ctl = (gu32*)(args.ws + WS_CTL);
    for (int u = F.tid; u < (LDS_BYTES - LDSCTL_OFF) / 4; u += NWAVES * 64) ((LAS unsigned*)(F.lds + LDSCTL_OFF))[u] = 0u;
    __syncthreads();
    XcdBarrier bar; bar.bar = (unsigned*)(F.ctl + CW_BAR); bar.x = 0; bar.st = nullptr;
    if (N_LAUNCHES == 1) bar = xcd_barrier_post((unsigned*)(F.ctl + CW_BAR), F.MISC + 8);
#define GRID_BAR() do { if (N_LAUNCHES == 1) xcd_barrier(bar); } while (0)
    const int lo = args.ph_lo, hi = args.ph_hi;
#ifndef PH_MASK
#define PH_MASK 0x1FFF
#endif
#define IN(k) (((PH_MASK >> (k)) & 1) && lo <= (k) && (k) < hi)
#define SEAM(k) do { if (IN(k) && IN((k) + 1)) GRID_BAR(); } while (0)
    unsigned char* ws = args.ws;

    if (IN(0)) { p0_prologue(F); } SEAM(0);
    if (IN(1)) { p1_norm1(F); } SEAM(1);
    if (IN(2)) {
        pg8::Gemm g{(const bf16*)(ws + WS_H1), (const bf16*)(ws + WS_WIN), NTOK, WIN_ROWS, DM}; InprojOrder S; S.init(F.G, (int)blockIdx.x);
        EpiInproj E{(bf16*)(ws + WS_ZK), (bf16*)(ws + WS_ZV), (bf16*)(ws + WS_ZR), (bf16*)(ws + WS_Q), (bf16*)(ws + WS_KQ), (bf16*)(ws + WS_VQ), (bf16*)(ws + WS_LA), (bf16*)args.out};
        pg8::gemm_phase<EpiInproj, InprojOrder, true, true>(F.lds, g, S, E);
    } SEAM(2);
    if (IN(3)) {
        p3a_lora(F);
        p3b_attn_prep(F);
    } SEAM(3);
    if (IN(4)) { p4a_attention(F); __syncthreads(); p4b_scan(F); } SEAM(4);
    if (IN(5)) { p5_rwkv_out(F); } SEAM(5);
    if (IN(6)) {
        pg8::Gemm g{(const bf16*)(ws + WS_ORW), (const bf16*)(ws + WS_WBRR), NLAT, DM, DM, (const bf16*)(ws + WS_Q), 512}; pg8::StaticOrder S; S.init(NLAT, DM, F.G, (int)blockIdx.x);
        EpiMerge2 E{(bf16*)(ws + WS_MERGED), (const bf16*)args.out};
        pg8::gemm_phase<EpiMerge2, pg8::StaticOrder, true, true, true>(F.lds, g, S, E);
    } SEAM(6);
    if (IN(7)) {
        pg8::Gemm g{(const bf16*)(ws + WS_MERGED), (const bf16*)(ws + WS_WOUT), NLAT, DM, DM}; pg8::StaticOrder S; S.init(NLAT, DM, F.G, (int)blockIdx.x);
        EpiOutproj E{(bf16*)(ws + WS_DELTA), (const float*)(ws + WS_MOD)};
        pg8::gemm_phase<EpiOutproj, pg8::StaticOrder, true, true>(F.lds, g, S, E);
    } SEAM(7);
    if (IN(8)) { p8_norm2_router(F); } SEAM(8);
    if (IN(9)) { p9_topk_gather(F); } SEAM(9);
    if (IN(10)) {
        pg8::Gemm g{(const bf16*)(ws + WS_H2), (const bf16*)(ws + WS_WGU), NSLOT, NE * 3072, DM, nullptr, 0, (const int*)(ws + WS_IDX), (LAS int*)(F.lds + RING_BYTES)}; ExpertOrder S; S.init(F.G, (int)blockIdx.x, 12);
        EpiSwiglu E{(bf16*)(ws + WS_ACT)};
        pg8::gemm_phase<EpiSwiglu, ExpertOrder, true, true, false, true>(F.lds, g, S, E);
    } SEAM(10);
    if (IN(11)) {
        pg8::Gemm g{(const bf16*)(ws + WS_ACT), (const bf16*)(ws + WS_WD), NSLOT, NE * 1024, DFF}; ExpertOrder S; S.init(F.G, (int)blockIdx.x, 4);
        EpiDown E{(bf16*)(ws + WS_Y2), (const float*)(ws + WS_VAL)};
        pg8::gemm_phase<EpiDown, ExpertOrder, true, true>(F.lds, g, S, E);
    } SEAM(11);
    if (IN(12)) { p12_combine(F); }
#undef IN
#undef SEAM
#undef GRID_BAR
}

extern "C" void kernel_launch(void* const* d_in, const int* in_sizes, int n_in, void* d_out, int out_size, void* d_ws, size_t ws_size, hipStream_t stream) {
    static int grid = 0;
    if (grid == 0) {
        if (n_in != 30 || out_size != NLAT * DM || ws_size < WS_END) { fprintf(stderr, "kernel_launch: unexpected problem (n_in %d out %d ws %zu)\n", n_in, out_size, ws_size); grid = -1; return; }
        int dev = 0, cus = 0, per_cu = 0;
        if (hipGetDevice(&dev) != hipSuccess || hipDeviceGetAttribute(&cus, hipDeviceAttributeMultiprocessorCount, dev) != hipSuccess) { grid = -1; return; }
        if (hipFuncSetAttribute((const void*)mk_fwd, hipFuncAttributeMaxDynamicSharedMemorySize, LDS_BYTES) != hipSuccess) { fprintf(stderr, "kernel_launch: hipFuncSetAttribute failed\n"); grid = -1; return; }
        if (hipOccupancyMaxActiveBlocksPerMultiprocessor(&per_cu, (const void*)mk_fwd, NWAVES * 64, LDS_BYTES) != hipSuccess || per_cu < 1) fprintf(stderr, "kernel_launch: occupancy query says %d\n", per_cu);
        (void)hipGetLastError();
        grid = cus;
    }
    if (grid < 0) return;
    if (hipMemsetAsync((char*)d_ws + WS_CTL, 0, CTL_ZERO_BYTES, stream) != hipSuccess) return;
    Args a{};
    for (int i = 0; i < 30; ++i) a.in[i] = (const float*)d_in[i];
    a.out = (float*)d_out; a.ws = (unsigned char*)d_ws;
    if (N_LAUNCHES == 1) { a.ph_lo = 0; a.ph_hi = N_PHASES; hipLaunchKernelGGL(mk_fwd, dim3(grid), dim3(NWAVES * 64), LDS_BYTES, stream, a); }
    else for (int li = 0; li < N_PHASES; ++li) { a.ph_lo = li; a.ph_hi = li + 1; hipLaunchKernelGGL(mk_fwd, dim3(grid), dim3(NWAVES * 64), LDS_BYTES, stream, a); }
}
```

```cpp
#include <hip/hip_runtime.h>
#include <cstdio>
#include <cstdint>
#define MK_N_LAUNCHES 1
namespace pg8 {
#define PG8_LAS __attribute__((address_space(3)))
typedef unsigned short bf16_t;
typedef short bf16x8 __attribute__((ext_vector_type(8)));
typedef float f32x4 __attribute__((ext_vector_type(4)));
typedef unsigned u32x4 __attribute__((ext_vector_type(4)));
constexpr int BM = 256, BK = 64, HALF = 128, HTB = HALF * BK * 2  , STAGE_BYTES = 8 * HTB, NXCD = 8, WGM = 8;

__host__ __device__ __forceinline__ int lds_byte(int r, int c) { const int st = (r >> 4) * 2 + (c >> 5), rr = r & 15, cc = c & 31, ob = rr * 64 + cc * 2; return st * 1024 + (ob ^ (((ob >> 9) & 1) << 5)); }
__host__ __device__ __forceinline__ void stage_rc(int b, int& R, int& C) { const int st = b / 1024, sb = b % 1024, swz = sb ^ (((sb >> 9) & 1) << 5); R = (st >> 1) * 16 + swz / 64; C = (st & 1) * 32 + (swz % 64) / 2; }
__host__ __device__ __forceinline__ int perm32(int rho) { const int n = rho >> 4, i = rho & 15; return 8 * (i >> 2) + 4 * n + (i & 3); }

struct Unit { int pm, pn; };
struct Gemm { const bf16_t* A; const bf16_t* Bt; int M, N, K; const bf16_t* A2 = nullptr; int lda = 0; const int* gidx = nullptr; PG8_LAS int* glds = nullptr; };

struct StaticOrder {
    int nM, nN, nwg, G, c;
    __host__ __device__ void init(int M, int N, int G_, int c_) { nM = M / BM; nN = N / BM; nwg = nM * nN; G = G_; c = c_; }
    __host__ __device__ bool next(int i, Unit& u) const {
        const long L = (long)i * G + c; if (L >= nwg) return false;
        int wgid = (int)L; { const int q = nwg / NXCD, r = nwg % NXCD, xcd = wgid % NXCD, off = wgid / NXCD; wgid = (xcd < r ? xcd * (q + 1) : r * (q + 1) + (xcd - r) * q) + off; }
        const int nig = WGM * nN, gid = wgid / nig, fm = gid * WGM, gsz = (nM - fm) < WGM ? (nM - fm) : WGM;
        u.pm = fm + ((wgid % nig) % gsz); u.pn = (wgid % nig) / gsz; return true;
    }
    __device__ __forceinline__ void a_ready(const Unit&) const {}
    __device__ __forceinline__ void done(const Unit&) const {}
};

template <class Epi, class Sched, bool ALIGN_EPI = false, bool SP2 = false, bool SPLITA = false, bool GATHERA = false>
__device__ __forceinline__ void gemm_phase(PG8_LAS unsigned char* lds, const Gemm g, const Sched& S, const Epi& E) {
    const int tid = threadIdx.x, wid = __builtin_amdgcn_readfirstlane(tid >> 6), lane = tid & 63, wr = wid >> 2, wc = wid & 3, fr = lane & 15, fq = lane >> 4;
    const int K = g.K, nt = K / BK, lda = g.lda ? g.lda : g.K, nh = nt / 2;
    unsigned voffA[2], voffB[2];
#pragma unroll
    for (int i = 0; i < 2; ++i) { int R, C; stage_rc(tid * 16 + i * 8192, R, C); const int Rb = Epi::PERM ? ((R & ~31) + perm32(R & 31)) : R;
        voffA[i] = (unsigned)(R * lda + C) * 2u; voffB[i] = (unsigned)(Rb * K + C) * 2u; }
    const size_t kstep = (size_t)(BK * 2);
    const size_t hstep = (size_t)HALF * K * 2;
    const size_t tstep = 2 * hstep;
    const size_t hstepA = (size_t)HALF * lda * 2, tstepA = 2 * hstepA;
    const unsigned ldsw = (unsigned)wid * 1024u;
    const int aoff = lds_byte(wr * 64 + fr, fq * 8), boff = lds_byte(wc * 32 + fr, fq * 8);
#define PG8_SA(b, h) (((b) * 2 + (h)) * HTB)
#define PG8_SB(b, h) ((4 + (b) * 2 + (h)) * HTB)
#define PG8_STAGE(bufoff, gbase, voff) do { _Pragma("unroll") for (int _i = 0; _i < 2; ++_i) \
        __builtin_amdgcn_global_load_lds((const unsigned*)((const char*)(gbase) + (voff)[_i]), (PG8_LAS unsigned*)(lds + (bufoff) + ldsw + _i * 8192), 16, 0, 0); } while (0)
#define PG8_LDA(dst, b, h) do { _Pragma("unroll") for (int m = 0; m < 4; ++m) _Pragma("unroll") for (int k = 0; k < 2; ++k) dst[m][k] = *(const PG8_LAS bf16x8*)(lds + PG8_SA(b, h) + aoff + m * 2048 + k * 1024); } while (0)
#define PG8_LDB(dst, b, h) do { _Pragma("unroll") for (int n = 0; n < 2; ++n) _Pragma("unroll") for (int k = 0; k < 2; ++k) dst[n][k] = *(const PG8_LAS bf16x8*)(lds + PG8_SB(b, h) + boff + n * 2048 + k * 1024); } while (0)
#define PG8_MMA(ai, bj, At, Bt) do { __builtin_amdgcn_s_setprio(1); _Pragma("unroll") for (int m = 0; m < 4; ++m) _Pragma("unroll") for (int n = 0; n < 2; ++n) _Pragma("unroll") for (int k = 0; k < 2; ++k) \
        acc[ai][bj][m][n] = __builtin_amdgcn_mfma_f32_16x16x32_bf16(Bt[n][k], At[m][k], acc[ai][bj][m][n], 0, 0, 0); __builtin_amdgcn_s_setprio(0); } while (0)
#define PG8_WAIT_V(n) asm volatile("s_waitcnt vmcnt(" #n ")" ::: "memory")
#define PG8_WAIT_L(n) asm volatile("s_waitcnt lgkmcnt(" #n ")" ::: "memory")
#define PG8_BAR __builtin_amdgcn_s_barrier()
#define PG8_SCHED __builtin_amdgcn_sched_barrier(0)
    Unit cur, nxt; int ui = 0;
    if (!S.next(0, cur)) return;
    f32x4 acc[2][2][4][2];
#pragma unroll
    for (int a = 0; a < 2; ++a)
#pragma unroll
        for (int b = 0; b < 2; ++b)
#pragma unroll
            for (int m = 0; m < 4; ++m)
#pragma unroll
                for (int n = 0; n < 2; ++n) acc[a][b][m][n] = (f32x4){0.f, 0.f, 0.f, 0.f};
    bf16x8 At[4][2], B0[2][2], B1[2][2];
    const char* cA = (const char*)g.A + (size_t)cur.pm * tstepA; const char* cB = (const char*)g.Bt + (size_t)cur.pn * tstep;
    const char* cA2 = SPLITA ? (const char*)g.A2 + (size_t)cur.pm * tstepA : cA;
#define PG8_AADDR(tt) (SPLITA ? (((tt) < nh) ? cA + (size_t)(tt) * kstep : cA2 + (size_t)((tt) - nh) * kstep) : cA + (size_t)(tt) * kstep)
    unsigned gofc[2][2] = {{0u, 0u}, {0u, 0u}}, gofn[2][2] = {{0u, 0u}, {0u, 0u}}; int gR[2] = {0, 0}, gC[2] = {0, 0};
    if constexpr (GATHERA) {
#pragma unroll
        for (int i = 0; i < 2; ++i) { int R, C; stage_rc(tid * 16 + i * 8192, R, C); gR[i] = R; gC[i] = C; }
        if (tid < 256) g.glds[tid] = g.gidx[cur.pm * 256 + tid];
        asm volatile("s_waitcnt vmcnt(0) lgkmcnt(0)" ::: "memory"); __builtin_amdgcn_s_barrier(); asm volatile("" ::: "memory");
#pragma unroll
        for (int hh = 0; hh < 2; ++hh)
#pragma unroll
            for (int i = 0; i < 2; ++i) gofc[hh][i] = (unsigned)(((cur.pm & 31) * 2048 + g.glds[hh * 128 + gR[i]]) * lda + gC[i]) * 2u;
        cA = (const char*)g.A; cA2 = cA;
    }
#define PG8_GA(hh) (GATHERA ? gofc[hh] : voffA)
#define PG8_GN(hh) (GATHERA ? (last ? gofn[hh] : gofc[hh]) : voffA)
#define PG8_HA(x) (GATHERA ? (x) : (x) + hstepA)
    S.a_ready(cur);
    if constexpr (SP2) {
        PG8_STAGE(PG8_SB(0, 0), cB, voffB); PG8_STAGE(PG8_SB(0, 1), cB + hstep, voffB); PG8_STAGE(PG8_SA(0, 0), cA, PG8_GA(0)); PG8_STAGE(PG8_SA(0, 1), PG8_HA(cA), PG8_GA(1));
        if (wr == 1) PG8_BAR;
        PG8_WAIT_V(2); PG8_BAR;
        PG8_STAGE(PG8_SB(1, 0), cB + kstep, voffB); PG8_STAGE(PG8_SA(1, 0), cA + kstep, PG8_GA(0)); PG8_STAGE(PG8_SB(1, 1), cB + hstep + kstep, voffB);
        PG8_WAIT_V(6); PG8_BAR;
    } else {
        PG8_STAGE(PG8_SB(0, 0), cB, voffB); PG8_STAGE(PG8_SA(0, 0), cA, voffA); PG8_STAGE(PG8_SB(0, 1), cB + hstep, voffB); PG8_STAGE(PG8_SA(0, 1), cA + hstepA, voffA);
        if (wr == 1) PG8_BAR;
        PG8_WAIT_V(4); PG8_BAR;
        PG8_STAGE(PG8_SB(1, 0), cB + kstep, voffB); PG8_STAGE(PG8_SA(1, 0), cA + kstep, PG8_GA(0)); PG8_STAGE(PG8_SB(1, 1), cB + hstep + kstep, voffB);
        PG8_WAIT_V(6); PG8_BAR;
    }
    for (;;) {
        const bool has_next = S.next(ui + 1, nxt);
        const char* nA = has_next ? (const char*)g.A + (size_t)nxt.pm * tstepA : cA; const char* nB = has_next ? (const char*)g.Bt + (size_t)nxt.pn * tstep : cB;
        const char* nA2 = (SPLITA && has_next) ? (const char*)g.A2 + (size_t)nxt.pm * tstepA : cA2;
        if constexpr (GATHERA) { nA = cA;
            if (has_next) __builtin_amdgcn_global_load_lds((const unsigned*)(g.gidx + nxt.pm * 256 + (wid & 3) * 64 + lane), (PG8_LAS unsigned*)(g.glds + ((ui + 1) & 1) * 256 + (wid & 3) * 64), 4, 0, 0); }
        for (int t = 0; t < nt; t += 2) {
            const bool last = (t == nt - 2);
            const char* a1 = PG8_AADDR(t + 1);
            const char* a2 = last ? nA : PG8_AADDR(t + 2); const char* b2 = last ? nB : cB + (size_t)(t + 2) * kstep;
            const char* a3 = a2 + kstep; const char* b3 = b2 + kstep;
            if (last && has_next) S.a_ready(nxt);
            if constexpr (GATHERA) { if (last && has_next) {
#pragma unroll
                for (int hh = 0; hh < 2; ++hh)
#pragma unroll
                    for (int i = 0; i < 2; ++i) gofn[hh][i] = (unsigned)(((nxt.pm & 31) * 2048 + g.glds[((ui + 1) & 1) * 256 + hh * 128 + gR[i]]) * lda + gC[i]) * 2u; } }
            if constexpr (SPLITA) { if (t == nh) E.mid(acc, cur, wr, wc, fr, fq); }
            if constexpr (SP2) {
            PG8_LDB(B0, 0, 0); PG8_LDB(B1, 0, 1); PG8_SCHED; PG8_LDA(At, 0, 0); PG8_STAGE(PG8_SA(1, 1), PG8_HA(a1), PG8_GA(1));
            PG8_WAIT_V(8); PG8_WAIT_L(0); PG8_BAR; PG8_MMA(0, 0, At, B0); PG8_MMA(0, 1, At, B1); PG8_BAR; PG8_SCHED;
            PG8_LDA(At, 0, 1); PG8_STAGE(PG8_SB(0, 0), b2, voffB); PG8_STAGE(PG8_SB(0, 1), b2 + hstep, voffB); PG8_STAGE(PG8_SA(0, 0), a2, PG8_GN(0));
            PG8_WAIT_V(8); PG8_WAIT_L(0); PG8_BAR; PG8_MMA(1, 0, At, B0); PG8_MMA(1, 1, At, B1); PG8_BAR; PG8_SCHED;
            PG8_LDB(B0, 1, 0); PG8_LDB(B1, 1, 1); PG8_SCHED; PG8_LDA(At, 1, 0); PG8_STAGE(PG8_SA(0, 1), PG8_HA(a2), PG8_GN(1));
            PG8_WAIT_V(8); PG8_WAIT_L(0); PG8_BAR; PG8_MMA(0, 0, At, B0); PG8_MMA(0, 1, At, B1); PG8_BAR; PG8_SCHED;
            PG8_LDA(At, 1, 1); PG8_STAGE(PG8_SB(1, 0), b3, voffB); PG8_STAGE(PG8_SB(1, 1), b3 + hstep, voffB); PG8_STAGE(PG8_SA(1, 0), a3, PG8_GN(0));
            PG8_WAIT_V(8); PG8_WAIT_L(0); PG8_BAR; PG8_MMA(1, 0, At, B0); PG8_MMA(1, 1, At, B1); PG8_BAR; PG8_SCHED;
            } else {
            PG8_LDB(B0, 0, 0); PG8_SCHED; PG8_LDA(At, 0, 0); PG8_STAGE(PG8_SA(1, 1), a1 + hstepA, voffA);
            PG8_WAIT_L(8); PG8_BAR; PG8_WAIT_L(0); PG8_MMA(0, 0, At, B0); PG8_BAR; PG8_SCHED;
            PG8_LDB(B1, 0, 1); PG8_STAGE(PG8_SB(0, 0), b2, voffB);
            PG8_BAR; PG8_WAIT_L(0); PG8_MMA(0, 1, At, B1); PG8_BAR;
            PG8_LDA(At, 0, 1); PG8_STAGE(PG8_SA(0, 0), a2, voffA);
            PG8_BAR; PG8_WAIT_L(0); PG8_MMA(1, 0, At, B0); PG8_BAR; PG8_SCHED;
            PG8_STAGE(PG8_SB(0, 1), b2 + hstep, voffB);
            PG8_WAIT_V(6); PG8_BAR; PG8_MMA(1, 1, At, B1); PG8_BAR;
            PG8_LDB(B0, 1, 0); PG8_SCHED; PG8_LDA(At, 1, 0); PG8_STAGE(PG8_SA(0, 1), a2 + hstepA, voffA);
            PG8_WAIT_L(8); PG8_BAR; PG8_WAIT_L(0); PG8_MMA(0, 0, At, B0); PG8_BAR; PG8_SCHED;
            PG8_LDB(B1, 1, 1); PG8_STAGE(PG8_SB(1, 0), b3, voffB);
            PG8_BAR; PG8_WAIT_L(0); PG8_MMA(0, 1, At, B1); PG8_BAR;
            PG8_LDA(At, 1, 1); PG8_STAGE(PG8_SA(1, 0), a3, voffA);
            PG8_BAR; PG8_WAIT_L(0); PG8_MMA(1, 0, At, B0); PG8_BAR; PG8_SCHED;
            PG8_STAGE(PG8_SB(1, 1), b3 + hstep, voffB);
            PG8_WAIT_V(6); PG8_BAR; PG8_MMA(1, 1, At, B1); PG8_BAR;
            }
        }
        if constexpr (ALIGN_EPI) { if (wr == 0) PG8_BAR; }
        if constexpr (!Epi::AFTER_DRAIN) { E(acc, cur, wr, wc, fr, fq); S.done(cur); }
        if (!has_next) break;
#pragma unroll
        for (int a = 0; a < 2; ++a)
#pragma unroll
            for (int b = 0; b < 2; ++b)
#pragma unroll
                for (int m = 0; m < 4; ++m)
#pragma unroll
                    for (int n = 0; n < 2; ++n) acc[a][b][m][n] = (f32x4){0.f, 0.f, 0.f, 0.f};
        cur = nxt; cA = nA; cA2 = nA2; cB = nB; ++ui;
        if constexpr (GATHERA) {
#pragma unroll
            for (int hh = 0; hh < 2; ++hh) { gofc[hh][0] = gofn[hh][0]; gofc[hh][1] = gofn[hh][1]; } }
        if constexpr (ALIGN_EPI) { if (wr == 1) PG8_BAR; }
    }
    PG8_WAIT_V(0);
    if constexpr (!ALIGN_EPI) { if (wr == 0) PG8_BAR; }
    PG8_BAR;
    if constexpr (Epi::AFTER_DRAIN) { E.fused(acc, cur, wr, wc, fr, fq, lds, wid, lane); S.done(cur); }
#undef PG8_AADDR
#undef PG8_GA
#undef PG8_GN
#undef PG8_HA
#undef PG8_SA
#undef PG8_SB
#undef PG8_STAGE
#undef PG8_LDA
#undef PG8_LDB
#undef PG8_MMA
#undef PG8_WAIT_V
#undef PG8_WAIT_L
#undef PG8_BAR
#undef PG8_SCHED
}
}
#define GAS __attribute__((address_space(1)))
#define LAS __attribute__((address_space(3)))
typedef unsigned short bf16;
typedef unsigned v4u __attribute__((ext_vector_type(4)));
typedef float f32x4 __attribute__((ext_vector_type(4)));
typedef short bf16x8 __attribute__((ext_vector_type(8)));
typedef GAS unsigned gu32;
typedef GAS unsigned long long gu64;
#define RLX_AGENT __ATOMIC_RELAXED, __HIP_MEMORY_SCOPE_AGENT
#define LDS_WAIT() asm volatile("s_waitcnt lgkmcnt(0)" ::: "memory")
#define VM_WAIT() asm volatile("s_waitcnt vmcnt(0)" ::: "memory")
__device__ __forceinline__ unsigned long long rt() { return __builtin_amdgcn_s_memrealtime(); }
__device__ __forceinline__ unsigned f2bf(float f) { unsigned u = __builtin_bit_cast(unsigned, f); return (u + 0x7fffu + ((u >> 16) & 1u)) >> 16; }
__device__ __forceinline__ unsigned pk2(float lo, float hi) { return f2bf(lo) | (f2bf(hi) << 16); }

#define XB_TMO      128
#define XB_XCNT(j)  (256  + 64 * (j))
#define XB_XSUB(j)  (1280 + 64 * (j))
#define XB_XGEN(j)  (2304 + 64 * (j))
#define XB_TOP      3328
#define XB_TOPGEN   3392
#define XCD_BAR_WORDS 3456
#define XB_SPIN_CAP (1u << 18)

__device__ __forceinline__ unsigned xb_ld(unsigned* p)              { return __hip_atomic_load(p, __ATOMIC_RELAXED, __HIP_MEMORY_SCOPE_AGENT); }
__device__ __forceinline__ unsigned xb_add(unsigned* p, unsigned v) { return __hip_atomic_fetch_add(p, v, __ATOMIC_RELAXED, __HIP_MEMORY_SCOPE_AGENT); }
__device__ __forceinline__ unsigned xb_xcc_id() { return (unsigned)__builtin_amdgcn_s_getreg((3 << 11) | 20) & 0xFu; }
#define XB_SPIN(cond, bar) do { unsigned _sp = 0; while (cond) { __builtin_amdgcn_s_sleep(1); \
    if ((++_sp & 255u) == 0u) { if (xb_ld(&(bar)[XB_TMO])) break; if (_sp > XB_SPIN_CAP) { atomicAdd(&(bar)[XB_TMO], 1u); break; } } } } while (0)

struct XcdBarrier {
    unsigned* bar; unsigned x;
    volatile LAS unsigned* st;
};

__device__ __forceinline__ XcdBarrier xcd_barrier_post(unsigned* bar, volatile LAS unsigned* st) {
    XcdBarrier b; b.bar = bar; b.x = xb_xcc_id(); b.st = st;
    if (threadIdx.x == 0) (void)xb_add(&bar[XB_XCNT(b.x)], 1u);
    return b;
}
__device__ __forceinline__ void xcd_barrier_complete(unsigned* bar, unsigned x, unsigned& nloc, unsigned& nx) {
    const unsigned G = gridDim.x * gridDim.y * gridDim.z;
    unsigned sum, cnt, mine, sp = 0u;
    for (;;) {
        sum = 0u; cnt = 0u; mine = 0u;
#pragma unroll
        for (unsigned j = 0; j < 16; ++j) { const unsigned c = xb_ld(&bar[XB_XCNT(j)]); sum += c; cnt += (c > 0u) ? 1u : 0u; mine = (j == x) ? c : mine; }
        if (sum == G) break;
        __builtin_amdgcn_s_sleep(1);
        if ((++sp & 255u) == 0u) { if (xb_ld(&bar[XB_TMO])) break; if (sp > XB_SPIN_CAP) { atomicAdd(&bar[XB_TMO], 1u); break; } }
    }
    nloc = mine > 0u ? mine : 1u; nx = cnt > 0u ? cnt : 1u;
}

__device__ __forceinline__ void xcd_barrier(const XcdBarrier& b) {
    asm volatile("s_waitcnt vmcnt(0)" ::: "memory");
    __syncthreads();
    if (threadIdx.x == 0) {
        unsigned* bar = b.bar;
        __builtin_amdgcn_s_waitcnt(0);
        unsigned nloc = b.st[0], nx = b.st[1];
        if (nloc == 0u) { xcd_barrier_complete(bar, b.x, nloc, nx); b.st[0] = nloc; b.st[1] = nx; }
        const unsigned old = xb_add(&bar[XB_XSUB(b.x)], 1u);
        const unsigned gen = old / nloc;
        if (old + 1u == (gen + 1u) * nloc) {
            __builtin_amdgcn_fence(__ATOMIC_RELEASE, "agent");
            asm volatile("s_waitcnt vmcnt(0)" ::: "memory");
            const unsigned og = xb_add(&bar[XB_TOP], 1u);
            const unsigned tg = og / nx;
            if (og + 1u == (tg + 1u) * nx) xb_add(&bar[XB_TOPGEN], 1u);
            else XB_SPIN(xb_ld(&bar[XB_TOPGEN]) == tg, bar);
            __builtin_amdgcn_fence(__ATOMIC_ACQUIRE, "agent");
            xb_add(&bar[XB_XGEN(b.x)], 1u);
            asm volatile("s_waitcnt vmcnt(0)" ::: "memory");
        } else {
            XB_SPIN(xb_ld(&bar[XB_XGEN(b.x)]) == gen, bar);
            __builtin_amdgcn_fence(__ATOMIC_ACQUIRE, "agent");
            asm volatile("s_waitcnt vmcnt(0)" ::: "memory");
        }
    }
    __syncthreads();
}

typedef float f32x2 __attribute__((ext_vector_type(2)));
typedef float f32x16 __attribute__((ext_vector_type(16)));
typedef unsigned v2u __attribute__((ext_vector_type(2)));
typedef __bf16 bf16x2_t __attribute__((ext_vector_type(2)));
using pg8::Unit;

constexpr int NWAVES = 8;
#ifndef MK_N_LAUNCHES
#define MK_N_LAUNCHES 1
#endif
constexpr int N_PHASES = 13;
constexpr int N_LAUNCHES = MK_N_LAUNCHES;

constexpr int NB = 32, SEQ = 2048, LC = 256, DM = 1024, NLAT = NB * SEQ, NCTX = NB * LC, NTOK = NLAT + NCTX;
constexpr int NE = 16, CAP = 256, DFF = 1536, NSLOT = NE * NB * CAP;
constexpr int WIN_ROWS = 4864, LORA_N = 2560, LORA_K = 384;
constexpr int KEYS = SEQ + LC;

constexpr size_t MiB = 1u << 20, KiB = 1u << 10;
constexpr size_t WS_CTL = 0, CTL_ZERO_BYTES = 1 * MiB;
constexpr size_t WS_MOD = 1 * MiB;
constexpr size_t WS_WIN = 2 * MiB;
constexpr size_t WS_WLORA = 11 * MiB + 512 * KiB;
constexpr size_t WS_WBRR = 13 * MiB + 512 * KiB;
constexpr size_t WS_WBRA = 14 * MiB + 512 * KiB;
constexpr size_t WS_WOUT = 15 * MiB + 512 * KiB;
constexpr size_t WS_WGU = 17 * MiB + 512 * KiB;
constexpr size_t WS_WD = 113 * MiB + 512 * KiB;
constexpr size_t WS_IDX = 161 * MiB + 512 * KiB;
constexpr size_t WS_VAL = 162 * MiB;
constexpr size_t WS_ZK = 163 * MiB;
constexpr size_t WS_ZV = 235 * MiB;
constexpr size_t WS_ZR = 307 * MiB;
constexpr size_t WS_Q = 371 * MiB;
constexpr size_t WS_KQ = 435 * MiB;
constexpr size_t WS_VQ = 453 * MiB;
constexpr size_t WS_XCH = 453 * MiB;
constexpr size_t WS_YB = 959 * MiB;
constexpr size_t WS_LA = 471 * MiB;
constexpr size_t WS_H1 = 525 * MiB;
constexpr size_t WS_EW = 525 * MiB;
constexpr size_t WS_ORW = 525 * MiB;
constexpr size_t WS_AS = 669 * MiB;
constexpr size_t WS_G = 813 * MiB;
constexpr size_t WS_VT = 877 * MiB;
constexpr size_t WS_YF = 895 * MiB;
constexpr size_t WS_MERGED = 163 * MiB;
constexpr size_t WS_INV = 163 * MiB;
constexpr size_t WS_XE = 167 * MiB;
constexpr size_t WS_Y2 = 167 * MiB;
constexpr size_t WS_H2 = 167 * MiB;
constexpr size_t WS_AFF = 551 * MiB;
constexpr size_t WS_ACT = 423 * MiB;
constexpr size_t WS_DELTA = 807 * MiB;
constexpr size_t WS_END = 1023 * MiB;
constexpr int CW_BAR = 4096;

constexpr int RING_BYTES = 131072;
constexpr int LDSCTL_OFF = 147456 - 1024, MISC_OFF = LDSCTL_OFF + 320;
static_assert(33 * 1024 * 4 <= LDSCTL_OFF, "P0's silu(c) image must stay below the LDS control words");
constexpr int LDS_BYTES = 147456;

__device__ __forceinline__ unsigned pkbf(float lo, float hi) { f32x2 v = {lo, hi}; return __builtin_bit_cast(unsigned, __builtin_convertvector(v, bf16x2_t)); }
__device__ __forceinline__ float bflo(unsigned u) { return __uint_as_float(u << 16); }
__device__ __forceinline__ float bfhi(unsigned u) { return __uint_as_float(u & 0xffff0000u); }
__device__ __forceinline__ float bf1(bf16 h) { return __uint_as_float(((unsigned)h) << 16); }
__device__ __forceinline__ float sigmoidf_(float x) { return __builtin_amdgcn_rcpf(1.0f + __builtin_amdgcn_exp2f(-1.4426950408889634f * x)); }
__device__ __forceinline__ float tanhf_(float x) { return 1.0f - 2.0f * __builtin_amdgcn_rcpf(__builtin_amdgcn_exp2f(2.8853900817779268f * x) + 1.0f); }
__device__ __forceinline__ float wave_sum(float v) {
    int x = __float_as_int(v);
#define WS_DPP(ctrl, rmask) x = __float_as_int(__int_as_float(x) + __int_as_float(__builtin_amdgcn_update_dpp(0, x, ctrl, rmask, 0xf, false)))
    WS_DPP(0x111, 0xf); WS_DPP(0x112, 0xf); WS_DPP(0x114, 0xf); WS_DPP(0x118, 0xf); WS_DPP(0x142, 0xa); WS_DPP(0x143, 0xc);
#undef WS_DPP
    return __int_as_float(__builtin_amdgcn_readlane(x, 63));
}
__device__ __forceinline__ void unpack8(const v4u w, float (&f)[8]) {
    f[0] = bflo(w.x); f[1] = bfhi(w.x); f[2] = bflo(w.y); f[3] = bfhi(w.y); f[4] = bflo(w.z); f[5] = bfhi(w.z); f[6] = bflo(w.w); f[7] = bfhi(w.w);
}
__device__ __forceinline__ v4u pack8(const float (&f)[8]) { v4u w; w.x = pkbf(f[0], f[1]); w.y = pkbf(f[2], f[3]); w.z = pkbf(f[4], f[5]); w.w = pkbf(f[6], f[7]); return w; }

struct Frame {
    LAS unsigned char* lds;
    volatile LAS unsigned* MISC;
    gu32* ctl;
    int tid, lane, wave, G;
    float* out; unsigned char* ws;
};
enum { I_X = 0, I_C, I_CTX, I_CCTX, I_ADAW, I_ADAB, I_N1G, I_N2G, I_WIN, I_CONV, I_W0, I_W2, I_A0, I_A2, I_KK, I_KA, I_RK, I_G2, I_LNW, I_LNB, I_QG, I_KG, I_SINK,
       I_WBRR, I_WBRA, I_WOUT, I_ROUTER, I_EG, I_EU, I_ED };
typedef const __attribute__((address_space(4))) unsigned char* kptr_t;
__device__ __forceinline__ const float* karg_in(int i) { kptr_t kp = (kptr_t)__builtin_amdgcn_kernarg_segment_ptr(); asm volatile("" : "+s"(kp)); return *(const float* const __attribute__((address_space(4)))*)(kp + 8 * i); }

__device__ __forceinline__ void transpose_item(const float* W, int N, int k0, int n0, bf16* WT, int Kd, int drow0, LAS float* scr, int lane) {
#pragma unroll 8
    for (int i = 0; i < 32; ++i) { const int kk = 2 * i + (lane >> 5); scr[kk * 33 + (lane & 31)] = W[(size_t)(k0 + kk) * N + n0 + (lane & 31)]; }
    LDS_WAIT(); asm volatile("" ::: "memory");
    const int c = lane & 7;
#pragma unroll
    for (int j = 0; j < 4; ++j) { const int n = (lane >> 3) + 8 * j; const LAS float* s = scr + (8 * c) * 33 + n;
        v4u o; o.x = pkbf(s[0 * 33], s[1 * 33]); o.y = pkbf(s[2 * 33], s[3 * 33]); o.z = pkbf(s[4 * 33], s[5 * 33]); o.w = pkbf(s[6 * 33], s[7 * 33]);
        *(GAS v4u*)(WT + (size_t)(drow0 + n) * Kd + k0 + 8 * c) = o; }
    LDS_WAIT(); asm volatile("" ::: "memory");
}
__device__ __forceinline__ int win_dest_block(int sb) {
    if (sb < 4) return 13 + sb;
    if (sb < 8) return sb - 4;
    if (sb < 12) return sb - 4;
    if (sb == 12) return 8;
    if (sb == 13) return 9;
    if (sb == 14) return 10;
    if (sb < 19) return sb + 2;
    if (sb == 19) return 11;
    if (sb == 20) return 12;
    return sb;
}
__device__ __forceinline__ void p0_prologue(Frame& F) {
    if (blockIdx.x < 96) {
        LAS float* cs = (LAS float*)F.lds;
        const float* c = karg_in(I_C); const float* cc = karg_in(I_CCTX);
        for (int i = F.tid; i < 33 * 1024; i += 512) { const float v = i < 32 * 1024 ? c[i] : cc[i - 32 * 1024]; cs[i] = v * sigmoidf_(v); }
        __syncthreads();
        const int col = blockIdx.x * 64 + F.lane; const float* aw = karg_in(I_ADAW);
        float acc[33];
#pragma unroll
        for (int b = 0; b < 33; ++b) acc[b] = 0.f;
        const int kbeg = F.wave * 128;
        for (int k = kbeg; k < kbeg + 128; k += 4) {
            const float w0 = aw[(size_t)(k + 0) * 6144 + col], w1 = aw[(size_t)(k + 1) * 6144 + col], w2 = aw[(size_t)(k + 2) * 6144 + col], w3 = aw[(size_t)(k + 3) * 6144 + col];
#pragma unroll
            for (int b = 0; b < 33; ++b) { const f32x4 cv = *(const LAS f32x4*)(cs + b * 1024 + k); acc[b] += cv.x * w0 + cv.y * w1 + cv.z * w2 + cv.w * w3; }
        }
        __syncthreads();
        LAS float* red = (LAS float*)F.lds;
#pragma unroll
        for (int b = 0; b < 33; ++b) red[(F.wave * 33 + b) * 64 + F.lane] = acc[b];
        __syncthreads();
        float* mod = (float*)(F.ws + WS_MOD); const float* ab = karg_in(I_ADAB);
        for (int i = F.tid; i < 33 * 64; i += 512) { const int b = i >> 6, l = i & 63; float s = 0.f;
#pragma unroll
            for (int w = 0; w < 8; ++w) s += red[(w * 33 + b) * 64 + l];
            mod[(size_t)b * 6144 + blockIdx.x * 64 + l] = s + ab[blockIdx.x * 64 + l]; }
        __syncthreads();
    }
    LAS float* scr = (LAS float*)(F.lds + F.wave * 16384);
    const int gw = blockIdx.x * NWAVES + F.wave, NGW = F.G * NWAVES;
    constexpr int IT_WIN = 16 * 148, IT_G = 16 * 768, IT_BR = 256, IT_OUT = 512;
    constexpr int NITEMS = IT_WIN + 3 * IT_G + 2 * IT_BR + IT_OUT;
    bf16* WIN = (bf16*)(F.ws + WS_WIN); bf16* WGU = (bf16*)(F.ws + WS_WGU); bf16* WD = (bf16*)(F.ws + WS_WD);
    for (int it = gw; it < NITEMS; it += NGW) {
        int r = it;
        if (r < IT_WIN) { const int kb = r / 148, nb = r % 148, n0 = 32 * nb; const int db = win_dest_block(n0 >> 7);
            transpose_item(karg_in(I_WIN), 4736, 64 * kb, n0, WIN, 1024, db * 128 + (n0 & 127), scr, F.lane); continue; }
        r -= IT_WIN;
        if (r < IT_G) { const int e = r / 768, q = r % 768, kb = q / 48, nb = q % 48, n0 = 32 * nb;
            transpose_item(karg_in(I_EG) + (size_t)e * 1024 * 1536, 1536, 64 * kb, n0, WGU, 1024, e * 3072 + 256 * (n0 >> 7) + (n0 & 127), scr, F.lane); continue; }
        r -= IT_G;
        if (r < IT_G) { const int e = r / 768, q = r % 768, kb = q / 48, nb = q % 48, n0 = 32 * nb;
            transpose_item(karg_in(I_EU) + (size_t)e * 1024 * 1536, 1536, 64 * kb, n0, WGU, 1024, e * 3072 + 256 * (n0 >> 7) + 128 + (n0 & 127), scr, F.lane); continue; }
        r -= IT_G;
        if (r < IT_G) { const int e = r / 768, q = r % 768, kb = q / 32, nb = q % 32, n0 = 32 * nb;
            transpose_item(karg_in(I_ED) + (size_t)e * 1536 * 1024, 1024, 64 * kb, n0, WD, 1536, e * 1024 + n0, scr, F.lane); continue; }
        r -= IT_G;
        if (r < IT_BR) { const int kb = r / 32, nb = r % 32; transpose_item(karg_in(I_WBRR), 1024, 64 * kb, 32 * nb, (bf16*)(F.ws + WS_WBRR), 1024, 32 * nb, scr, F.lane); continue; }
        r -= IT_BR;
        if (r < IT_BR) { const int kb = r / 32, nb = r % 32; transpose_item(karg_in(I_WBRA), 1024, 64 * kb, 32 * nb, (bf16*)(F.ws + WS_WBRR) + 512, 1024, 32 * nb, scr, F.lane); continue; }
        r -= IT_BR;
        { const int kb = r / 32, nb = r % 32; transpose_item(karg_in(I_WOUT), 1024, 64 * kb, 32 * nb, (bf16*)(F.ws + WS_WOUT), 1024, 32 * nb, scr, F.lane); }
    }
    const int gt = blockIdx.x * 512 + F.tid, NGT = F.G * 512;
    for (int i = gt; i < 128 * 1024 / 8; i += NGT) *(GAS v4u*)(WIN + (size_t)4736 * 1024 + (size_t)i * 8) = (v4u){0u, 0u, 0u, 0u};
    { bf16* WL = (bf16*)(F.ws + WS_WLORA); const float* w2 = karg_in(I_W2); const float* a2 = karg_in(I_A2); const float* g2 = karg_in(I_G2);
      for (int i = gt; i < LORA_N * (LORA_K / 8); i += NGT) { const int n = i / (LORA_K / 8), k8 = (i % (LORA_K / 8)) * 8; const int rg = n >> 9, col = n & 511; float f[8];
#pragma unroll
          for (int j = 0; j < 8; ++j) { const int k = k8 + j; float v = 0.f;
              if (rg == 0) { if (k < 64) v = w2[(size_t)k * 512 + col]; }
              else if (rg == 1) { if (k >= 64 && k < 128) v = w2[(size_t)(64 + k - 64) * 512 + col]; }
              else if (rg == 2) { if (k >= 128 && k < 192) v = a2[(size_t)(k - 128) * 512 + col]; }
              else if (rg == 3) { if (k >= 192 && k < 256) v = a2[(size_t)(64 + k - 192) * 512 + col]; }
              else { if (k >= 256) v = g2[(size_t)(k - 256) * 512 + col]; }
              f[j] = v; }
          *(GAS v4u*)(WL + (size_t)n * LORA_K + k8) = pack8(f); } }
}

__device__ __forceinline__ void p1_norm1(Frame& F) {
    const int gw = blockIdx.x * NWAVES + F.wave, NGW = F.G * NWAVES;
    const float* mod = (const float*)(F.ws + WS_MOD); bf16* H1 = (bf16*)(F.ws + WS_H1);
    const float* g1 = karg_in(I_N1G); const float* Xp = karg_in(I_X); const float* CTXp = karg_in(I_CTX);
    f32x4 gv[4];
#pragma unroll
    for (int j = 0; j < 4; ++j) gv[j] = *(const f32x4*)(g1 + 4 * F.lane + 256 * j);
    for (int m0 = gw; m0 < NTOK; m0 += 4 * NGW) {
        f32x4 v[4][4]; float s[4];
#pragma unroll
        for (int r = 0; r < 4; ++r) { const int m = min(m0 + r * NGW, NTOK - 1); s[r] = 0.f;
            const float* xr = m < NLAT ? Xp + (size_t)m * DM : CTXp + (size_t)(m - NLAT) * DM;
#pragma unroll
            for (int j = 0; j < 4; ++j) v[r][j] = *(const GAS f32x4*)(xr + 4 * F.lane + 256 * j); }
#pragma unroll
        for (int r = 0; r < 4; ++r) { const int m = m0 + r * NGW;
            if (m < NTOK) {
#pragma unroll
                for (int j = 0; j < 4; ++j) s[r] += (v[r][j].x * v[r][j].x + v[r][j].y * v[r][j].y) + (v[r][j].z * v[r][j].z + v[r][j].w * v[r][j].w);
                const float rstd = __builtin_amdgcn_rsqf(wave_sum(s[r]) * (1.f / DM) + 1e-6f);
                const int mb = m < NLAT ? (m >> 11) : 32; const float* sh = mod + (size_t)mb * 6144; const float* sc = sh + 1024;
#pragma unroll
                for (int j = 0; j < 4; ++j) { const f32x4 a = *(const f32x4*)(sc + 4 * F.lane + 256 * j), bsh = *(const f32x4*)(sh + 4 * F.lane + 256 * j);
                    const f32x4 y = v[r][j] * rstd * gv[j] * (a + 1.0f) + bsh;
                    v2u o; o.x = pkbf(y.x, y.y); o.y = pkbf(y.z, y.w);
                    *(GAS v2u*)(H1 + (size_t)m * DM + 4 * F.lane + 256 * j) = o; } } }
    }
}

struct InprojOrder {
    pg8::StaticOrder so; int G, c;
    __device__ void init(int G_, int c_) { so.init(NLAT, WIN_ROWS, G_, c_); G = G_; c = c_; }
    __device__ bool next(int i, Unit& u) const {
        long L = (long)i * G + c; if (L < 4864) return so.next(i, u);
        L -= 4864; if (L >= 224) return false; u.pm = 256 + (int)(L % 32); u.pn = (int)(L / 32); return true; }
    __device__ __forceinline__ void a_ready(const Unit&) const {}
    __device__ __forceinline__ void done(const Unit&) const {}
};
struct EpiInproj {
    static constexpr bool PERM = true, AFTER_DRAIN = false;
    bf16 *zk, *zv, *zr, *q, *kq, *vq, *la, *gates;
    __device__ __forceinline__ void operator()(const f32x4 (&acc)[2][2][4][2], const Unit& u, int wr, int wc, int fr, int fq) const {
        const int row0 = u.pm * 256 + wr * 64 + fr; const bool isctx = u.pm >= 256;
#pragma unroll
        for (int bj = 0; bj < 2; ++bj) {
            const int c128 = 2 * u.pn + bj; bf16* base = nullptr; int pitch = 0, act = 0; bool ok = true;
            if (c128 < 4) { base = zk + c128 * 128; pitch = 512; }
            else if (c128 < 8) { base = zv + (c128 - 4) * 128; pitch = 512; }
            else if (c128 < 11) { base = la + (c128 - 8) * 128; pitch = 384; act = (c128 == 8) ? 1 : ((c128 == 10) ? 2 : 0); }
            else if (c128 == 11) { base = kq; pitch = 128; }
            else if (c128 == 12) { base = vq; pitch = 128; }
            else if (c128 < 17) { base = zr + (c128 - 13) * 128; pitch = 512; ok = !isctx; }
            else if (c128 < 21) { base = q + (c128 - 17) * 128; pitch = 512; ok = !isctx; }
            else if (c128 < 37) { base = gates + (c128 - 21) * 128; pitch = 2048; act = 2; ok = !isctx; }
            else ok = false;
            if (ok) {
#pragma unroll
                for (int ai = 0; ai < 2; ++ai)
#pragma unroll
                    for (int m = 0; m < 4; ++m) {
                        f32x4 v0 = acc[ai][bj][m][0], v1 = acc[ai][bj][m][1];
                        if (act == 1) { v0.x = tanhf_(v0.x); v0.y = tanhf_(v0.y); v0.z = tanhf_(v0.z); v0.w = tanhf_(v0.w); v1.x = tanhf_(v1.x); v1.y = tanhf_(v1.y); v1.z = tanhf_(v1.z); v1.w = tanhf_(v1.w); }
                        else if (act == 2) { v0.x = sigmoidf_(v0.x); v0.y = sigmoidf_(v0.y); v0.z = sigmoidf_(v0.z); v0.w = sigmoidf_(v0.w); v1.x = sigmoidf_(v1.x); v1.y = sigmoidf_(v1.y); v1.z = sigmoidf_(v1.z); v1.w = sigmoidf_(v1.w); }
                        v4u w; w.x = pkbf(v0.x, v0.y); w.y = pkbf(v0.z, v0.w); w.z = pkbf(v1.x, v1.y); w.w = pkbf(v1.z, v1.w);
                        *(GAS v4u*)(base + (size_t)(row0 + ai * 128 + m * 16) * pitch + wc * 32 + 8 * fq) = w;
                    }
            }
        }
    }
};

constexpr int LORA_LP = 144;
template <int NKS> __device__ __forceinline__ void lora_item(const bf16* LA, const bf16* WL, bf16* outp, const float* bias, float scale, int act, int tile, int rg, int kbase, int lane, LAS unsigned char* st) {
    const int l32 = lane & 31, hi = lane >> 5;
    bf16x8 xf[2][NKS];
#pragma unroll
    for (int s2 = 0; s2 < 2; ++s2)
#pragma unroll
        for (int ks = 0; ks < NKS; ++ks) xf[s2][ks] = *(const GAS bf16x8*)(LA + (size_t)(tile * 64 + s2 * 32 + l32) * LORA_K + kbase + 16 * ks + 8 * hi);
    bf16x8 wf[NKS], wn[NKS];
    { const bf16* wp = WL + (size_t)(rg * 512 + l32) * LORA_K + kbase + 8 * hi;
#pragma unroll
      for (int ks = 0; ks < NKS; ++ks) wf[ks] = *(const GAS bf16x8*)(wp + 16 * ks); }
#pragma unroll 1
    for (int np = 0; np < 8; ++np) {
#pragma unroll
        for (int nh = 0; nh < 2; ++nh) { const int nt = 2 * np + nh;
            f32x16 acc0, acc1;
#pragma unroll
            for (int r = 0; r < 16; ++r) { acc0[r] = 0.f; acc1[r] = 0.f; }
            { const int ntn = nt < 15 ? nt + 1 : 15; const bf16* wp = WL + (size_t)(rg * 512 + ntn * 32 + l32) * LORA_K + kbase + 8 * hi;
#pragma unroll
              for (int ks = 0; ks < NKS; ++ks) wn[ks] = *(const GAS bf16x8*)(wp + 16 * ks); }
#pragma unroll
            for (int ks = 0; ks < NKS; ++ks) { acc0 = __builtin_amdgcn_mfma_f32_32x32x16_bf16(wf[ks], xf[0][ks], acc0, 0, 0, 0); acc1 = __builtin_amdgcn_mfma_f32_32x32x16_bf16(wf[ks], xf[1][ks], acc1, 0, 0, 0); }
#pragma unroll
            for (int ks = 0; ks < NKS; ++ks) wf[ks] = wn[ks];
#pragma unroll
            for (int r4 = 0; r4 < 4; ++r4) { const int col = nt * 32 + 8 * r4 + 4 * hi;
                f32x4 bv = (f32x4){0.f, 0.f, 0.f, 0.f}; if (act) bv = *(const f32x4*)(bias + col);
                f32x4 v0 = (f32x4){acc0[4 * r4], acc0[4 * r4 + 1], acc0[4 * r4 + 2], acc0[4 * r4 + 3]} + bv, v1 = (f32x4){acc1[4 * r4], acc1[4 * r4 + 1], acc1[4 * r4 + 2], acc1[4 * r4 + 3]} + bv;
                if (act) { v0.x = scale * sigmoidf_(v0.x); v0.y = scale * sigmoidf_(v0.y); v0.z = scale * sigmoidf_(v0.z); v0.w = scale * sigmoidf_(v0.w);
                           v1.x = scale * sigmoidf_(v1.x); v1.y = scale * sigmoidf_(v1.y); v1.z = scale * sigmoidf_(v1.z); v1.w = scale * sigmoidf_(v1.w); }
                v2u o0, o1; o0.x = pkbf(v0.x, v0.y); o0.y = pkbf(v0.z, v0.w); o1.x = pkbf(v1.x, v1.y); o1.y = pkbf(v1.z, v1.w);
                const int lc = (32 * nh + 8 * r4 + 4 * hi) * 2;
                *(LAS v2u*)(st + l32 * LORA_LP + lc) = o0; *(LAS v2u*)(st + 32 * LORA_LP + l32 * LORA_LP + lc) = o1; }
        }
#pragma unroll
        for (int i = 0; i < 8; ++i) { const int row = 8 * i + (lane >> 3);
            const v4u w = *(const LAS v4u*)(st + row * LORA_LP + (lane & 7) * 16);
            *(GAS v4u*)(outp + (size_t)(tile * 64 + row) * 512 + np * 64 + (lane & 7) * 8) = w; }
    }
}
__device__ __forceinline__ void p3a_lora(Frame& F) {
    const bf16* LA = (const bf16*)(F.ws + WS_LA); const bf16* WL = (const bf16*)(F.ws + WS_WLORA);
    bf16* EW = (bf16*)(F.ws + WS_EW); bf16* AS = (bf16*)(F.ws + WS_AS); bf16* G = (bf16*)(F.ws + WS_G);
    const float* w0 = karg_in(I_W0); const float* a0 = karg_in(I_A0);
    const int gw = blockIdx.x * NWAVES + F.wave, NGW = F.G * NWAVES;
    LAS unsigned char* st = F.lds + 16384 + F.wave * (64 * LORA_LP);
    for (int item = gw; item < (NTOK / 64) * 5; item += NGW) {
        const int rg = item % 5, tile = item / 5;
        if (rg == 4) { if (tile < NLAT / 64) lora_item<8>(LA, WL, G, nullptr, 1.0f, 0, tile, 4, 256, F.lane, st); }
        else if (rg < 2) lora_item<4>(LA, WL, EW + (size_t)rg * NTOK * 512, w0 + rg * 512, 0.60653066f, 1, tile, rg, 64 * rg, F.lane, st);
        else lora_item<4>(LA, WL, AS + (size_t)(rg - 2) * NTOK * 512, a0 + (rg - 2) * 512, 1.0f, 1, tile, rg, 64 * rg, F.lane, st);
    }
}

__device__ __forceinline__ void p3b_attn_prep(Frame& F) {
    LAS float* tab = (LAS float*)F.lds;
    for (int i = F.tid; i < 1024; i += 512) { const int pos = i >> 4, fi = i & 15;
        const float invf = exp2f(-(float)fi * (13.287712379549449f / 16.0f));
        const float ang = (float)pos * invf; tab[2 * i] = cosf(ang); tab[2 * i + 1] = sinf(ang); }
    __syncthreads();
    const int gw = blockIdx.x * NWAVES + F.wave, NGW = F.G * NWAVES, lane = F.lane;
    {
        bf16* Q = (bf16*)(F.ws + WS_Q); const float* qg = karg_in(I_QG);
        const int sub = lane & 7; float gq[8];
#pragma unroll
        for (int j = 0; j < 8; ++j) gq[j] = qg[8 * sub + j];
        const float qscale = 0.125f * 1.4426950408889634f;
        for (int m0 = gw; m0 < NLAT; m0 += 4 * NGW) {
            v4u raw[4];
#pragma unroll
            for (int r = 0; r < 4; ++r) { const int m = min(m0 + r * NGW, NLAT - 1); raw[r] = *(const GAS v4u*)(Q + (size_t)m * 512 + 8 * lane); }
#pragma unroll
            for (int r = 0; r < 4; ++r) { const int m = m0 + r * NGW; if (m >= NLAT) continue;
                const int t = m & 2047; GAS v4u* p = (GAS v4u*)(Q + (size_t)m * 512 + 8 * lane);
                float y[8]; unpack8(raw[r], y); float ss = 0.f;
#pragma unroll
                for (int j = 0; j < 8; ++j) ss += y[j] * y[j];
                ss += __shfl_xor(ss, 1); ss += __shfl_xor(ss, 2); ss += __shfl_xor(ss, 4);
                const float rstd = __builtin_amdgcn_rsqf(ss * (1.f / 64.f) + 1e-6f);
                const int pos = (sub < 4) ? (t >> 6) : (t & 63); const bool second = (sub & 2) != 0; float o[8];
#pragma unroll
                for (int j = 0; j < 8; ++j) { y[j] = y[j] * rstd * gq[j]; }
#pragma unroll
                for (int j = 0; j < 8; ++j) { const float yp = __shfl_xor(y[j], 2); const int fi = 8 * (sub & 1) + j; const float cs = tab[(pos * 16 + fi) * 2], sn = tab[(pos * 16 + fi) * 2 + 1];
                    o[j] = (second ? (yp * sn + y[j] * cs) : (y[j] * cs - yp * sn)) * qscale; }
                *p = pack8(o); }
        }
    }
    {
        bf16* KQ = (bf16*)(F.ws + WS_KQ); const float* kg = karg_in(I_KG);
        const int l32 = lane & 31; const float g0 = kg[2 * l32], g1 = kg[2 * l32 + 1];
        for (int m0 = gw; m0 < NTOK; m0 += 4 * NGW) {
            unsigned raw[4];
#pragma unroll
            for (int r = 0; r < 4; ++r) { const int m = min(m0 + r * NGW, NTOK - 1); raw[r] = *(const GAS unsigned*)(KQ + (size_t)m * 128 + 2 * lane); }
#pragma unroll
            for (int r = 0; r < 4; ++r) { const int m = m0 + r * NGW; if (m >= NTOK) continue;
                GAS unsigned* p = (GAS unsigned*)(KQ + (size_t)m * 128 + 2 * lane); const unsigned w = raw[r];
                float y0 = bflo(w), y1 = bfhi(w); float ss = y0 * y0 + y1 * y1;
                ss += __shfl_xor(ss, 1); ss += __shfl_xor(ss, 2); ss += __shfl_xor(ss, 4); ss += __shfl_xor(ss, 8); ss += __shfl_xor(ss, 16);
                const float rstd = __builtin_amdgcn_rsqf(ss * (1.f / 64.f) + 1e-6f);
                y0 = y0 * rstd * g0; y1 = y1 * rstd * g1;
                const float p0 = __shfl_xor(y0, 8), p1 = __shfl_xor(y1, 8);
                if (m < NLAT) { const int t = m & 2047; const int pos = (l32 < 16) ? (t >> 6) : (t & 63); const bool second = (l32 & 8) != 0; const int fi0 = (2 * l32) & 15;
                    const float c0 = tab[(pos * 16 + fi0) * 2], s0 = tab[(pos * 16 + fi0) * 2 + 1], c1 = tab[(pos * 16 + fi0 + 1) * 2], s1 = tab[(pos * 16 + fi0 + 1) * 2 + 1];
                    const float o0 = second ? (p0 * s0 + y0 * c0) : (y0 * c0 - p0 * s0), o1 = second ? (p1 * s1 + y1 * c1) : (y1 * c1 - p1 * s1);
                    y0 = o0; y1 = o1; }
                *p = pkbf(y0, y1); }
        }
    }
    {
        const bf16* VQ = (const bf16*)(F.ws + WS_VQ); bf16* VT = (bf16*)(F.ws + WS_VT);
        const int gt = blockIdx.x * 512 + F.tid, NGT = F.G * 512;
        for (int i = gt; i < NB * 2 * (KEYS / 8) * 64; i += NGT) { const int d = i & 63, kg8 = (i >> 6) % (KEYS / 8), bh = (i >> 6) / (KEYS / 8), b = bh >> 1, hk = bh & 1;
            float f[8];
#pragma unroll
            for (int j = 0; j < 8; ++j) { const int key = kg8 * 8 + j; const size_t row = key < SEQ ? (size_t)b * SEQ + key : (size_t)NLAT + b * LC + (key - SEQ); f[j] = bf1(VQ[row * 128 + hk * 64 + d]); }
            *(GAS v4u*)(VT + ((size_t)bh * 64 + d) * KEYS + kg8 * 8) = pack8(f); }
    }
}

__device__ __forceinline__ int key_perm(int i) { const int r = 4 * (i >> 3) + (i & 3), hi = (i >> 2) & 1; return 8 * hi + r + (r >= 8 ? 8 : 0); }
__device__ __forceinline__ void attn_tile(const bf16x8 (&kf)[4], const bf16x8 (&vf)[4], const bf16x8 (&qf)[4], f32x16& o0, f32x16& o1, float& mrun, float& lrun, int mask, int l32, int hi) {
    f32x16 s;
#pragma unroll
    for (int r = 0; r < 16; ++r) s[r] = 0.f;
#pragma unroll
    for (int ks = 0; ks < 4; ++ks) s = __builtin_amdgcn_mfma_f32_32x32x16_bf16(kf[ks], qf[ks], s, 0, 0, 0);
    if (mask) {
#pragma unroll
        for (int r = 0; r < 16; ++r) { const int kk = 8 * hi + r + (r >= 8 ? 8 : 0); const bool ok = (mask == 1) ? (kk >= l32) : (kk <= l32); s[r] = ok ? s[r] : -1e30f; }
    }
    float mx = s[0];
#pragma unroll
    for (int r = 1; r < 16; ++r) mx = fmaxf(mx, s[r]);
    mx = fmaxf(mx, __shfl_xor(mx, 32));
    const float mnew = fmaxf(mrun, mx), alpha = __builtin_amdgcn_exp2f(mrun - mnew);
    float ps = 0.f; float p[16];
#pragma unroll
    for (int r = 0; r < 16; ++r) { p[r] = __builtin_amdgcn_exp2f(s[r] - mnew); ps += p[r]; }
    lrun = lrun * alpha + ps; mrun = mnew;
#pragma unroll
    for (int r = 0; r < 16; ++r) { o0[r] *= alpha; o1[r] *= alpha; }
    v4u pa, pb; pa.x = pkbf(p[0], p[1]); pa.y = pkbf(p[2], p[3]); pa.z = pkbf(p[4], p[5]); pa.w = pkbf(p[6], p[7]);
    pb.x = pkbf(p[8], p[9]); pb.y = pkbf(p[10], p[11]); pb.z = pkbf(p[12], p[13]); pb.w = pkbf(p[14], p[15]);
    const bf16x8 pa8 = __builtin_bit_cast(bf16x8, pa), pb8 = __builtin_bit_cast(bf16x8, pb);
    o0 = __builtin_amdgcn_mfma_f32_32x32x16_bf16(vf[0], pa8, o0, 0, 0, 0);
    o0 = __builtin_amdgcn_mfma_f32_32x32x16_bf16(vf[1], pb8, o0, 0, 0, 0);
    o1 = __builtin_amdgcn_mfma_f32_32x32x16_bf16(vf[2], pa8, o1, 0, 0, 0);
    o1 = __builtin_amdgcn_mfma_f32_32x32x16_bf16(vf[3], pb8, o1, 0, 0, 0);
}
constexpr int AT_KP = 144, AT_VP = 80, AT_KB = 32 * AT_KP, AT_VB = 64 * AT_VP, AT_BUF = AT_KB + AT_VB;
__device__ __forceinline__ void p4a_attention(Frame& F, bool dostore = true) {
    bf16* Q = (bf16*)(F.ws + WS_Q); const bf16* KQ = (const bf16*)(F.ws + WS_KQ); const bf16* VT = (const bf16*)(F.ws + WS_VT);
    const float* sink = karg_in(I_SINK);
    const int tid = F.tid, lane = F.lane, l32 = lane & 31, hi = lane >> 5;
    const int kperm = key_perm(l32);
    LAS unsigned char* lb = F.lds;
    const bool kpart = tid < 256; const int tt = tid & 255;
    const int skey = tt >> 3, skc = tt & 7, sd = tt >> 2, svc = tt & 3;
    const int sdst = kpart ? (skey * AT_KP + skc * 16) : (AT_KB + sd * AT_VP + svc * 16);
    for (int unit = blockIdx.x; unit < NB * 2 * 16; unit += F.G) {
        const int b = unit >> 5, hk = (unit >> 4) & 1, qb = unit & 15;
        const int g = F.wave >> 1, half = F.wave & 1, h = hk * 4 + g;
        const float sink2 = sink[h] * 1.4426950408889634f;
        const int tq0 = qb * 128 + half * 64;
        const size_t qrow = (size_t)b * SEQ + tq0 + l32;
        bf16x8 qf0[4], qf1[4];
#pragma unroll
        for (int ks = 0; ks < 4; ++ks) { qf0[ks] = *(const GAS bf16x8*)(Q + qrow * 512 + h * 64 + 16 * ks + 8 * hi); qf1[ks] = *(const GAS bf16x8*)(Q + (qrow + 32) * 512 + h * 64 + 16 * ks + 8 * hi); }
        float m0 = sink2, m1 = sink2, l0 = hi == 0 ? 1.0f : 0.0f, l1 = l0;
        f32x16 oa0, oa1, ob0, ob1;
#pragma unroll
        for (int r = 0; r < 16; ++r) { oa0[r] = 0.f; oa1[r] = 0.f; ob0[r] = 0.f; ob1[r] = 0.f; }
        const bf16* vsrc0 = VT + ((size_t)(b * 2 + hk) * 64 + sd) * KEYS + 8 * svc;
        const bf16* ksrc0 = KQ + (size_t)skey * 128 + hk * 64 + 8 * skc;
#define AT_SRC(s_, ptr_) do { int key0_; size_t krow_; if ((s_) < 8) { key0_ = SEQ + 32 * (s_); krow_ = (size_t)NLAT + b * LC + 32 * (s_); } \
            else { int kp_ = qb * 128 - 128 + 32 * ((s_) - 8); kp_ = (kp_ >= 0 && kp_ < SEQ) ? kp_ : 0; key0_ = kp_; krow_ = (size_t)b * SEQ + kp_; } \
            ptr_ = kpart ? (ksrc0 + krow_ * 128) : (vsrc0 + key0_); } while (0)
        v4u stg;
        { const bf16* sp; AT_SRC(0, sp); stg = *(const GAS v4u*)sp; }
        __syncthreads();
        *(LAS v4u*)(lb + sdst) = stg;
        __syncthreads();
#pragma unroll 1
        for (int s = 0; s < 20; ++s) {
            if (s + 1 < 20) { const bf16* sp; AT_SRC(s + 1, sp); stg = *(const GAS v4u*)sp; }
            const LAS unsigned char* kb_ = lb + (s & 1) * AT_BUF; const LAS unsigned char* vb_ = kb_ + AT_KB;
            bool use0, use1; int mk0 = 0, mk1 = 0;
            if (s < 8) { use0 = true; use1 = true; }
            else { const int j = s - 8, kp0 = qb * 128 - 128 + 32 * j, bi = j - 2 * half; const bool inr = kp0 >= 0 && kp0 < SEQ;
                use0 = inr && bi >= 0 && bi <= 8; use1 = inr && bi >= 1 && bi <= 9; mk0 = bi == 0 ? 1 : (bi == 8 ? 2 : 0); mk1 = bi == 1 ? 1 : (bi == 9 ? 2 : 0); }
            if (use0 || use1) {
                bf16x8 kf[4], vf[4];
#pragma unroll
                for (int ks = 0; ks < 4; ++ks) kf[ks] = *(const LAS bf16x8*)(kb_ + kperm * AT_KP + 32 * ks + 16 * hi);
                vf[0] = *(const LAS bf16x8*)(vb_ + l32 * AT_VP + 16 * hi); vf[1] = *(const LAS bf16x8*)(vb_ + l32 * AT_VP + 32 + 16 * hi);
                vf[2] = *(const LAS bf16x8*)(vb_ + (32 + l32) * AT_VP + 16 * hi); vf[3] = *(const LAS bf16x8*)(vb_ + (32 + l32) * AT_VP + 32 + 16 * hi);
                if (use0) attn_tile(kf, vf, qf0, oa0, oa1, m0, l0, mk0, l32, hi);
                if (use1) attn_tile(kf, vf, qf1, ob0, ob1, m1, l1, mk1, l32, hi);
            }
            if (s + 1 < 20) *(LAS v4u*)(lb + ((s + 1) & 1) * AT_BUF + sdst) = stg;
            __syncthreads();
        }
#undef AT_SRC
#pragma unroll
        for (int qi = 0; qi < 2; ++qi) {
            const float lr = qi ? l1 : l0; const float ltot = lr + __shfl_xor(lr, 32), inv = 1.0f / ltot;
            const f32x16& o0 = qi ? ob0 : oa0; const f32x16& o1 = qi ? ob1 : oa1;
            bf16* op = Q + (qrow + 32 * qi) * 512 + h * 64 + 4 * hi;
#pragma unroll
            for (int r4 = 0; r4 < 4; ++r4) {
                v2u w0; w0.x = pkbf(o0[4 * r4] * inv, o0[4 * r4 + 1] * inv); w0.y = pkbf(o0[4 * r4 + 2] * inv, o0[4 * r4 + 3] * inv);
                v2u w1; w1.x = pkbf(o1[4 * r4] * inv, o1[4 * r4 + 1] * inv); w1.y = pkbf(o1[4 * r4 + 2] * inv, o1[4 * r4 + 3] * inv);
                if (dostore) { *(GAS v2u*)(op + 8 * r4) = w0; *(GAS v2u*)(op + 32 + 8 * r4) = w1; }
            }
        }
    }
}

constexpr int SC_C = 32, SC_NCH = (LC + SEQ) / SC_C;
constexpr int SC_RP = 3;
constexpr int SC_ROUNDS = SC_NCH / SC_RP;
constexpr int SC_TASK_BYTES = 24576;
constexpr int SC_SLOT_BYTES = 2 * SC_RP * SC_TASK_BYTES;
constexpr int SC_PITCH = 144;
constexpr int SC_PLDS = 4 * 32 * SC_PITCH + 256;
__device__ __forceinline__ int launder(int v) { asm volatile("" : "+v"(v)); return v; }
__device__ __forceinline__ int crow_(int r, int hi) { return (r & 3) + 8 * (r >> 2) + 4 * hi; }
__device__ __forceinline__ bf16x8 packacc(const f32x16& x, int s) {
    v4u p; p.x = pkbf(x[8 * s], x[8 * s + 1]); p.y = pkbf(x[8 * s + 2], x[8 * s + 3]); p.z = pkbf(x[8 * s + 4], x[8 * s + 5]); p.w = pkbf(x[8 * s + 6], x[8 * s + 7]);
    return __builtin_bit_cast(bf16x8, p); }
#define MF(a, b, c) __builtin_amdgcn_mfma_f32_32x32x16_bf16((a), (b), (c), 0, 0, 0)
__device__ __forceinline__ f32x16 zero16() { f32x16 z;
#pragma unroll
    for (int r = 0; r < 16; ++r) z[r] = 0.f;
    return z; }
__device__ __forceinline__ void st_acc_bf16(unsigned char* p, const f32x16& x) {
    v4u a, b; a.x = pkbf(x[0], x[1]); a.y = pkbf(x[2], x[3]); a.z = pkbf(x[4], x[5]); a.w = pkbf(x[6], x[7]); b.x = pkbf(x[8], x[9]); b.y = pkbf(x[10], x[11]); b.z = pkbf(x[12], x[13]); b.w = pkbf(x[14], x[15]);
    *(GAS v4u*)p = a; *(GAS v4u*)(p + 16) = b; }
__device__ __forceinline__ f32x16 ld_acc_bf16(const unsigned char* p) {
    const v4u a = *(const GAS v4u*)p, b = *(const GAS v4u*)(p + 16); f32x16 x;
    x[0] = bflo(a.x); x[1] = bfhi(a.x); x[2] = bflo(a.y); x[3] = bfhi(a.y); x[4] = bflo(a.z); x[5] = bfhi(a.z); x[6] = bflo(a.w); x[7] = bfhi(a.w);
    x[8] = bflo(b.x); x[9] = bfhi(b.x); x[10] = bflo(b.y); x[11] = bfhi(b.y); x[12] = bflo(b.z); x[13] = bfhi(b.z); x[14] = bflo(b.w); x[15] = bfhi(b.w); return x; }

__device__ __forceinline__ void chan_to_frags(const unsigned (&pp)[16], int, bf16x8 (&fr)[2][2]) {
    unsigned t0[8], t1[8];
#pragma unroll
    for (int q = 0; q < 8; ++q) { const int plo = (q >> 1) * 4 + (q & 1), phi = plo + 2;
        const auto r = __builtin_amdgcn_permlane32_swap(pp[plo], pp[phi], false, false); t0[q] = r[0]; t1[q] = r[1]; }
#pragma unroll
    for (int s2 = 0; s2 < 2; ++s2) { v4u a, b2; a.x = t0[4 * s2]; a.y = t0[4 * s2 + 1]; a.z = t0[4 * s2 + 2]; a.w = t0[4 * s2 + 3]; b2.x = t1[4 * s2]; b2.y = t1[4 * s2 + 1]; b2.z = t1[4 * s2 + 2]; b2.w = t1[4 * s2 + 3];
        fr[0][s2] = __builtin_bit_cast(bf16x8, a); fr[1][s2] = __builtin_bit_cast(bf16x8, b2); }
}
struct ScanPre { float cw[9], kkp, kap; bf16 km, kc, vm, vc, rm, rc; bf16 gk[8], gv[8], gr[8], ge[8], ga[8]; };
constexpr int SC_PRE_LOADS = 11 + 6 + 40;
__device__ __forceinline__ void scan_prefetch(unsigned char* ws, int b, int h, int dir, int chunk, int lane, const float* conv, const float* kkpp, const float* kapp, ScanPre& pf) {
    const bool lat = chunk >= LC / SC_C; const int len = lat ? SEQ : LC, n0 = lat ? chunk * SC_C - LC : chunk * SC_C;
    const int rowbase = lat ? b * SEQ : NLAT + b * LC, col = h * 64 + lane;
    const int tk0 = dir ? (len - 1 - n0) : n0, tstep = dir ? -1 : 1;
    const unsigned ob0 = ((unsigned)(rowbase + tk0) * 512u + (unsigned)col) * 2u; const long ostepb = (long)tstep * 1024;
    const bool vm1 = n0 > 0;
    const char* ZKc = (const char*)(ws + WS_ZK); const char* ZVc = (const char*)(ws + WS_ZV); const char* ZRc = lat ? (const char*)(ws + WS_ZR) : ZKc;
    const char* EWc = (const char*)(ws + WS_EW) + (size_t)dir * NTOK * 1024; const char* ASc = (const char*)(ws + WS_AS) + (size_t)dir * NTOK * 1024;
#pragma unroll
    for (int j = 0; j < 3; ++j) { pf.cw[j] = conv[j * 1536 + col]; pf.cw[3 + j] = conv[j * 1536 + 512 + col]; pf.cw[6 + j] = conv[j * 1536 + 1024 + col]; }
    pf.kkp = kkpp[dir * 512 + col]; pf.kap = kapp[dir * 512 + col];
#define SC_LD(base, j) (*(const GAS bf16*)((base) + (long)(j) * ostepb + ob0))
    const long jm1 = vm1 ? -1 : 0;
    pf.km = SC_LD(ZKc, jm1); pf.kc = SC_LD(ZKc, 0); pf.vm = SC_LD(ZVc, jm1); pf.vc = SC_LD(ZVc, 0); pf.rm = SC_LD(ZRc, jm1); pf.rc = SC_LD(ZRc, 0);
#pragma unroll
    for (int jj = 0; jj < 8; ++jj) { pf.gk[jj] = SC_LD(ZKc, jj + 1); pf.gv[jj] = SC_LD(ZVc, jj + 1); pf.gr[jj] = SC_LD(ZRc, jj + 1); pf.ge[jj] = SC_LD(EWc, jj); pf.ga[jj] = SC_LD(ASc, jj); }
#undef SC_LD
}
__device__ __forceinline__ void scan_produce(unsigned char* ws, int b, int h, int dir, int chunk, LAS unsigned char* pl, unsigned char* xo, int lane_in, const float* conv, const float* kkpp, const float* kapp, ScanPre& pf) {
    int lane = launder(lane_in);
    float cw[9]; float kkp = pf.kkp, kap = pf.kap;
#pragma unroll
    for (int j = 0; j < 9; ++j) cw[j] = pf.cw[j];
    const bf16* ZK = (const bf16*)(ws + WS_ZK); const bf16* ZV = (const bf16*)(ws + WS_ZV); const bf16* ZR = (const bf16*)(ws + WS_ZR);
    const bf16* EW = (const bf16*)(ws + WS_EW) + (size_t)dir * NTOK * 512; const bf16* AS = (const bf16*)(ws + WS_AS) + (size_t)dir * NTOK * 512;
    int l32 = lane & 31, hi = lane >> 5; const int col = h * 64 + lane;
    const bool lat = chunk >= LC / SC_C; const int len = lat ? SEQ : LC, n0 = lat ? chunk * SC_C - LC : chunk * SC_C;
    const int rowbase = lat ? b * SEQ : NLAT + b * LC;
    LAS unsigned char* mA = pl; LAS unsigned char* mB = pl + 32 * SC_PITCH; LAS unsigned char* mK = pl + 64 * SC_PITCH; LAS unsigned char* mR = pl + 96 * SC_PITCH;
    LAS float* pcs = (LAS float*)(pl + 128 * SC_PITCH);
    unsigned pa[16], pb[16], pk[16], pv[16]; float P = 1.0f;
    const float latf = lat ? 1.0f : 0.0f;
    const float cwr_m = latf * (dir ? cw[2] : cw[0]), cwr_c = latf * cw[1], cwr_p = latf * (dir ? cw[0] : cw[2]), cwk_m = dir ? cw[5] : cw[3], cwk_p = dir ? cw[3] : cw[5], cwv_m = dir ? cw[8] : cw[6], cwv_p = dir ? cw[6] : cw[8];
    const int tk0 = dir ? (len - 1 - n0) : n0, tstep = dir ? -1 : 1;
    const unsigned ob0 = ((unsigned)(rowbase + tk0) * 512u + (unsigned)col) * 2u;
    const long ostepb = (long)tstep * 1024;
    const bool vm1 = n0 > 0, vp32 = n0 + SC_C < len;
    const char* ZKc = (const char*)ZK; const char* ZVc = (const char*)ZV; const char* ZRc = lat ? (const char*)ZR : (const char*)ZK;
    const char* EWc = (const char*)EW; const char* ASc = (const char*)AS;
#define SC_LD(base, j) (*(const GAS bf16*)((base) + (long)(j) * ostepb + ob0))
    float km = bf1(pf.km), kc = bf1(pf.kc), vm = bf1(pf.vm), vc = bf1(pf.vc), rm = bf1(pf.rm), rc = bf1(pf.rc);
    km = vm1 ? km : 0.f; vm = vm1 ? vm : 0.f; rm = vm1 ? rm : 0.f;
    bf16 rk[16], rv[16], rr[16], re[16], ra[16];
#define SC_LOADSTEP(j, sl) do { const bool vn = ((j) + 1 < SC_C) || vp32; const long jn = vn ? ((j) + 1) : (j); const bf16 tk_ = SC_LD(ZKc, jn), tv_ = SC_LD(ZVc, jn), tr_ = SC_LD(ZRc, jn); \
        rk[sl] = vn ? tk_ : (bf16)0; rv[sl] = vn ? tv_ : (bf16)0; rr[sl] = vn ? tr_ : (bf16)0; re[sl] = SC_LD(EWc, (j)); ra[sl] = SC_LD(ASc, (j)); } while (0)
#pragma unroll
    for (int jj = 0; jj < 8; ++jj) { rk[jj] = pf.gk[jj]; rv[jj] = pf.gv[jj]; rr[jj] = pf.gr[jj]; re[jj] = pf.ge[jj]; ra[jj] = pf.ga[jj]; }
#pragma unroll
    for (int jj = 8; jj < 16; ++jj) SC_LOADSTEP(jj, jj);
    asm volatile("" ::: "memory");
#pragma unroll
    for (int p = 0; p < 16; ++p) {
        bf16 ck[2], cv[2], cr[2], ce[2], ca[2];
#pragma unroll
        for (int u = 0; u < 2; ++u) { const int sl = (2 * p + u) & 15; ck[u] = rk[sl]; cv[u] = rv[sl]; cr[u] = rr[sl]; ce[u] = re[sl]; ca[u] = ra[sl]; }
        if (2 * p + 16 < SC_C) { SC_LOADSTEP(2 * p + 16, (2 * p) & 15); SC_LOADSTEP(2 * p + 17, (2 * p + 1) & 15); }
        float va[2], vb[2], vk[2], vv[2], vr[2];
#pragma unroll
        for (int u = 0; u < 2; ++u) {
            const float kp = bf1(ck[u]), vp = bf1(cv[u]), rp = bf1(cr[u]);
            const float k = cwk_m * km + cw[4] * kc + cwk_p * kp, v = cwv_m * vm + cw[7] * vc + cwv_p * vp, r = cwr_m * rm + cwr_c * rc + cwr_p * rp;
            km = kc; kc = kp; vm = vc; vc = vp; rm = rc; rc = rp;
            const float a = bf1(ca[u]), ew = bf1(ce[u]), w = __expf(-ew);
            const float kkv = k * kkp, ss = wave_sum(kkv * kkv), kk = kkv * __builtin_amdgcn_rsqf(fmaxf(ss, 1e-24f));
            const float kmod = k * (1.0f + (a - 1.0f) * kap);
            const float Pprev = P; P *= w; const float invP = __builtin_amdgcn_rcpf(P);
            const float at = -kk * Pprev, bt = kk * a * invP, kt = kmod * invP, rt = r * P;
            va[u] = at; vb[u] = bt; vk[u] = kt; vv[u] = v; vr[u] = rt;
        }
        pa[p] = pkbf(va[0], va[1]); pb[p] = pkbf(vb[0], vb[1]); pk[p] = pkbf(vk[0], vk[1]); pv[p] = pkbf(vv[0], vv[1]); const unsigned prt = pkbf(vr[0], vr[1]);
        { const int i0 = 2 * p;
          *(LAS bf16*)(mA + i0 * SC_PITCH + 2 * lane) = (bf16)(pa[p] & 0xffffu); *(LAS bf16*)(mA + (i0 + 1) * SC_PITCH + 2 * lane) = (bf16)(pa[p] >> 16);
          *(LAS bf16*)(mB + i0 * SC_PITCH + 2 * lane) = (bf16)(pb[p] & 0xffffu); *(LAS bf16*)(mB + (i0 + 1) * SC_PITCH + 2 * lane) = (bf16)(pb[p] >> 16);
          *(LAS bf16*)(mK + i0 * SC_PITCH + 2 * lane) = (bf16)(pk[p] & 0xffffu); *(LAS bf16*)(mK + (i0 + 1) * SC_PITCH + 2 * lane) = (bf16)(pk[p] >> 16);
          *(LAS bf16*)(mR + i0 * SC_PITCH + 2 * lane) = (bf16)(prt & 0xffffu); *(LAS bf16*)(mR + (i0 + 1) * SC_PITCH + 2 * lane) = (bf16)(prt >> 16); }
        if ((p & 3) == 3) asm volatile("" ::: "memory");
    }
#undef SC_LOADSTEP
#undef SC_LD
    pcs[lane] = P;
    const float pc_o = __shfl_xor(P, 32); const float pcn0 = hi ? pc_o : P, pcn1 = hi ? P : pc_o;
    bf16x8 fA[2][2], fB[2][2], fK[2][2], fV[2][2];
    chan_to_frags(pa, hi, fA); chan_to_frags(pb, hi, fB); chan_to_frags(pk, hi, fK); chan_to_frags(pv, hi, fV);
    LDS_WAIT(); asm volatile("" ::: "memory");
    __builtin_amdgcn_sched_barrier(0);
    lane = launder(lane_in); l32 = lane & 31; hi = lane >> 5;
    f32x16 X = zero16(), XT = zero16(), LakT = zero16(), MrbT = zero16(), MrkT = zero16();
    const int roff = l32 * SC_PITCH + 16 * hi;
#pragma unroll
    for (int ks = 0; ks < 4; ++ks) {
        const bf16x8 ga = *(const LAS bf16x8*)(mA + roff + 32 * ks), gb = *(const LAS bf16x8*)(mB + roff + 32 * ks), gk = *(const LAS bf16x8*)(mK + roff + 32 * ks), gr = *(const LAS bf16x8*)(mR + roff + 32 * ks);
        X = MF(ga, gb, X); XT = MF(gb, ga, XT); LakT = MF(gk, ga, LakT); MrbT = MF(gb, gr, MrbT); MrkT = MF(gk, gr, MrkT);
    }
    f32x16 TmT;
#pragma unroll
    for (int r = 0; r < 16; ++r) { const int row = crow_(r, hi);
        X[r] = (l32 < row) ? X[r] : 0.f; XT[r] = (row < l32) ? XT[r] : 0.f; LakT[r] = (row < l32) ? LakT[r] : 0.f;
        MrbT[r] = (row <= l32) ? MrbT[r] : 0.f; MrkT[r] = (row <= l32) ? MrkT[r] : 0.f; TmT[r] = XT[r] + ((row == l32) ? 1.0f : 0.f); }
    const bf16x8 la0 = packacc(LakT, 0), la1 = packacc(LakT, 1), rb0 = packacc(MrbT, 0), rb1 = packacc(MrbT, 1), rk0 = packacc(MrkT, 0), rk1 = packacc(MrkT, 1);
    __builtin_amdgcn_sched_barrier(0);
#pragma unroll
    for (int it = 0; it < 4; ++it) {
        const bf16x8 x0 = packacc(X, 0), x1 = packacc(X, 1), y0 = packacc(XT, 0), y1 = packacc(XT, 1), t0 = packacc(TmT, 0), t1 = packacc(TmT, 1);
        f32x16 Xn = zero16(), XnT = zero16();
        Xn = MF(y0, x0, Xn); Xn = MF(y1, x1, Xn); XnT = MF(x0, y0, XnT); XnT = MF(x1, y1, XnT);
        const bf16x8 n0 = packacc(Xn, 0), n1 = packacc(Xn, 1);
        TmT = MF(n0, t0, TmT); TmT = MF(n1, t1, TmT);
        X = Xn; XT = XnT;
    }
    __builtin_amdgcn_sched_barrier(0);
    const bf16x8 tt0 = packacc(TmT, 0), tt1 = packacc(TmT, 1);
    f32x16 W[2], Ut[2];
#pragma unroll
    for (int ct = 0; ct < 2; ++ct) { f32x16 w = zero16(); w = MF(tt0, fA[ct][0], w); w = MF(tt1, fA[ct][1], w); W[ct] = w;
        f32x16 x1 = zero16(); x1 = MF(la0, fV[ct][0], x1); x1 = MF(la1, fV[ct][1], x1);
        f32x16 u = zero16(); u = MF(tt0, packacc(x1, 0), u); u = MF(tt1, packacc(x1, 1), u); Ut[ct] = u; }
    bf16x8 fW[2][2], fU[2][2];
#pragma unroll
    for (int ct = 0; ct < 2; ++ct) { fW[ct][0] = packacc(W[ct], 0); fW[ct][1] = packacc(W[ct], 1); fU[ct][0] = packacc(Ut[ct], 0); fU[ct][1] = packacc(Ut[ct], 1); }
    __builtin_amdgcn_sched_barrier(0);
    lane = launder(lane_in); l32 = lane & 31; hi = lane >> 5;
#pragma unroll
    for (int kt = 0; kt < 2; ++kt) { f32x16 acc;
#pragma unroll
        for (int r4 = 0; r4 < 4; ++r4) { const v2u rr = *(const LAS v2u*)(mR + l32 * SC_PITCH + 2 * (32 * kt + 8 * r4 + 4 * hi));
            acc[4 * r4] = bflo(rr.x); acc[4 * r4 + 1] = bfhi(rr.x); acc[4 * r4 + 2] = bflo(rr.y); acc[4 * r4 + 3] = bfhi(rr.y); }
        acc = MF(fW[kt][0], rb0, acc); acc = MF(fW[kt][1], rb1, acc);
        *(GAS bf16x8*)(xo + 16384 + (kt * 2 + 0) * 1024 + lane * 16) = packacc(acc, 0); *(GAS bf16x8*)(xo + 16384 + (kt * 2 + 1) * 1024 + lane * 16) = packacc(acc, 1); }
#pragma unroll
    for (int vt = 0; vt < 2; ++vt) { f32x16 acc = zero16();
        acc = MF(rb0, fU[vt][0], acc); acc = MF(rb1, fU[vt][1], acc); acc = MF(rk0, fV[vt][0], acc); acc = MF(rk1, fV[vt][1], acc);
        st_acc_bf16(xo + 20480 + vt * 2048 + lane * 32, acc); }
    __builtin_amdgcn_sched_barrier(0);
    lane = launder(lane_in); l32 = lane & 31; hi = lane >> 5;
#pragma unroll
    for (int kt = 0; kt < 2; ++kt)
#pragma unroll
        for (int nt = 0; nt < 2; ++nt) { f32x16 acc = zero16(); acc = MF(fW[kt][0], fB[nt][0], acc); acc = MF(fW[kt][1], fB[nt][1], acc);
            const float pc = nt ? pcn1 : pcn0;
#pragma unroll
            for (int r = 0; r < 16; ++r) acc[r] = (acc[r] + ((kt == nt && crow_(r, hi) == l32) ? 1.0f : 0.f)) * pc;
            *(GAS bf16x8*)(xo + ((kt * 2 + nt) * 2 + 0) * 1024 + lane * 16) = packacc(acc, 0); *(GAS bf16x8*)(xo + ((kt * 2 + nt) * 2 + 1) * 1024 + lane * 16) = packacc(acc, 1); }
    __builtin_amdgcn_sched_barrier(0);
    lane = launder(lane_in); l32 = lane & 31; hi = lane >> 5;
#pragma unroll
    for (int kt = 0; kt < 2; ++kt)
#pragma unroll
        for (int vt = 0; vt < 2; ++vt) { f32x16 acc = zero16();
            acc = MF(fB[kt][0], fU[vt][0], acc); acc = MF(fB[kt][1], fU[vt][1], acc); acc = MF(fK[kt][0], fV[vt][0], acc); acc = MF(fK[kt][1], fV[vt][1], acc);
#pragma unroll
            for (int r4 = 0; r4 < 4; ++r4) { const f32x4 pr = *(const LAS f32x4*)(pcs + 32 * kt + 8 * r4 + 4 * hi);
                acc[4 * r4] *= pr.x; acc[4 * r4 + 1] *= pr.y; acc[4 * r4 + 2] *= pr.z; acc[4 * r4 + 3] *= pr.w; }
            st_acc_bf16(xo + 8192 + (kt * 2 + vt) * 2048 + lane * 32, acc); }
    LDS_WAIT();
    __builtin_amdgcn_sched_barrier(0); asm volatile("" ::: "memory");
    scan_prefetch(ws, b, h, dir, (chunk + SC_RP < SC_NCH) ? chunk + SC_RP : chunk, launder(lane_in), conv, kkpp, kapp, pf);
    __builtin_amdgcn_sched_barrier(0); asm volatile("" ::: "memory");
}
__device__ __forceinline__ void scan_consume(unsigned char* ws, int b, int h, int dir, int chunk, const unsigned char* xi, int lane, f32x16 (&H)[2][2]) {
    const int l32 = lane & 31, hi = lane >> 5;
    bf16x8 hb[2][2][2];
#pragma unroll
    for (int kt = 0; kt < 2; ++kt)
#pragma unroll
        for (int vt = 0; vt < 2; ++vt) { hb[kt][vt][0] = packacc(H[kt][vt], 0); hb[kt][vt][1] = packacc(H[kt][vt], 1); }
    if (chunk >= LC / SC_C) {
        bf16x8 rf[2][2];
#pragma unroll
        for (int kt = 0; kt < 2; ++kt)
#pragma unroll
            for (int s2 = 0; s2 < 2; ++s2) rf[kt][s2] = *(const GAS bf16x8*)(xi + 16384 + (kt * 2 + s2) * 1024 + lane * 16);
        bf16* Y = (bf16*)(ws + (dir ? WS_YB : WS_YF)); const int n0 = chunk * SC_C - LC;
#pragma unroll
        for (int vt = 0; vt < 2; ++vt) { f32x16 acc = ld_acc_bf16(xi + 20480 + vt * 2048 + lane * 32);
#pragma unroll
            for (int kt = 0; kt < 2; ++kt) { acc = MF(rf[kt][0], hb[kt][vt][0], acc); acc = MF(rf[kt][1], hb[kt][vt][1], acc); }
#pragma unroll
            for (int r = 0; r < 16; ++r) { const int i = crow_(r, hi), tk = dir ? (SEQ - 1 - (n0 + i)) : (n0 + i);
                Y[((size_t)b * SEQ + tk) * 512 + h * 64 + 32 * vt + l32] = (bf16)(pkbf(acc[r], 0.f) & 0xffffu); } }
    }
    f32x16 Hn[2][2];
#pragma unroll
    for (int nt = 0; nt < 2; ++nt)
#pragma unroll
        for (int vt = 0; vt < 2; ++vt) Hn[nt][vt] = ld_acc_bf16(xi + 8192 + (nt * 2 + vt) * 2048 + lane * 32);
#pragma unroll
    for (int kt = 0; kt < 2; ++kt)
#pragma unroll
        for (int nt = 0; nt < 2; ++nt) { const bf16x8 g0 = *(const GAS bf16x8*)(xi + ((kt * 2 + nt) * 2 + 0) * 1024 + lane * 16), g1 = *(const GAS bf16x8*)(xi + ((kt * 2 + nt) * 2 + 1) * 1024 + lane * 16);
#pragma unroll
            for (int vt = 0; vt < 2; ++vt) { Hn[nt][vt] = MF(g0, hb[kt][vt][0], Hn[nt][vt]); Hn[nt][vt] = MF(g1, hb[kt][vt][1], Hn[nt][vt]); } }
#pragma unroll
    for (int nt = 0; nt < 2; ++nt)
#pragma unroll
        for (int vt = 0; vt < 2; ++vt) H[nt][vt] = Hn[nt][vt];
}
__device__ __forceinline__ void p4b_scan(Frame& F) {
    const int wave = F.wave, lane = F.lane;
    const bool is_cons = wave < 2; const int pw = wave - 2;
    unsigned char* xch = F.ws + WS_XCH + (size_t)blockIdx.x * (2 * SC_SLOT_BYTES);
    LAS unsigned char* pl = F.lds + (is_cons ? 0 : pw) * SC_PLDS;
    for (int task = blockIdx.x; task < NB * 8; task += F.G) {
        const int b = task >> 3, h = task & 7; const int pdir = is_cons ? wave : pw / SC_RP, pci = is_cons ? 0 : pw % SC_RP;
        const float* conv = karg_in(I_CONV); const float* kkpp = karg_in(I_KK); const float* kapp = karg_in(I_KA);
#define SC_SYNC() do { asm volatile("s_waitcnt vmcnt(0) lgkmcnt(0)" ::: "memory"); __builtin_amdgcn_s_barrier(); asm volatile("" ::: "memory"); } while (0)
        if (is_cons) {
            f32x16 H[2][2];
#pragma unroll
            for (int i = 0; i < 2; ++i)
#pragma unroll
                for (int j = 0; j < 2; ++j) H[i][j] = zero16();
#pragma unroll 1
            for (int q = -1; q < SC_ROUNDS; ++q) {
                if (q >= 0) { __builtin_amdgcn_fence(__ATOMIC_ACQUIRE, "agent");
#pragma unroll 1
                    for (int i = 0; i < SC_RP; ++i) scan_consume(F.ws, b, h, wave, q * SC_RP + i, xch + (size_t)(q & 1) * SC_SLOT_BYTES + (size_t)(wave * SC_RP + i) * SC_TASK_BYTES, lane, H); }
                SC_SYNC();
            }
        } else {
            ScanPre pf; scan_prefetch(F.ws, b, h, pdir, pci, lane, conv, kkpp, kapp, pf);
#pragma unroll 1
            for (int q = -1; q < SC_ROUNDS; ++q) {
                if (q + 1 < SC_ROUNDS) { scan_produce(F.ws, b, h, pdir, (q + 1) * SC_RP + pci, pl, xch + (size_t)((q + 1) & 1) * SC_SLOT_BYTES + (size_t)(pdir * SC_RP + pci) * SC_TASK_BYTES, lane, conv, kkpp, kapp, pf);
                    asm volatile("s_waitcnt vmcnt(%0) lgkmcnt(0)" :: "n"(SC_PRE_LOADS) : "memory"); __builtin_amdgcn_s_barrier(); asm volatile("" ::: "memory"); }
                else SC_SYNC();
            }
        }
#undef SC_SYNC
    }
}
#undef MF

__device__ __forceinline__ void p5_rwkv_out(Frame& F) {
    const int gw = blockIdx.x * NWAVES + F.wave, NGW = F.G * NWAVES, lane = F.lane, c0 = 8 * lane;
    const bf16* ZK = (const bf16*)(F.ws + WS_ZK); const bf16* ZV = (const bf16*)(F.ws + WS_ZV); const bf16* ZR = (const bf16*)(F.ws + WS_ZR);
    const bf16* AS0 = (const bf16*)(F.ws + WS_AS); const bf16* AS1 = AS0 + (size_t)NTOK * 512;
    const bf16* YF = (const bf16*)(F.ws + WS_YF); const bf16* YB = (const bf16*)(F.ws + WS_YB); const bf16* G = (const bf16*)(F.ws + WS_G);
    bf16* ORW = (bf16*)(F.ws + WS_ORW);
    LAS float* PL = (LAS float*)F.lds;
    { const float* convg = karg_in(I_CONV); const float* kag = karg_in(I_KA); const float* rkg = karg_in(I_RK); const float* lnwg = karg_in(I_LNW); const float* lnbg = karg_in(I_LNB);
      for (int i = F.tid; i < 15 * 512; i += 512) { const int row = i >> 9, c = i & 511; float v;
          if (row < 9) v = convg[(row % 3) * 1536 + (row / 3) * 512 + c]; else if (row < 11) v = kag[(row - 9) * 512 + c]; else if (row < 13) v = rkg[(row - 11) * 512 + c]; else if (row == 13) v = lnwg[c]; else v = lnbg[c];
          PL[i] = v; }
      __syncthreads(); }
    const LAS float* conv = PL; const LAS float* ka = PL + 9 * 512; const LAS float* rk = PL + 11 * 512; const LAS float* lnw = PL + 13 * 512; const LAS float* lnb = PL + 14 * 512;
    for (int m0 = gw; m0 < NLAT; m0 += 2 * NGW) {
        v4u raw[2][14];
        const v4u z4 = (v4u){0u, 0u, 0u, 0u};
#pragma unroll
        for (int rr = 0; rr < 2; ++rr) { const int m = min(m0 + rr * NGW, NLAT - 1);
            const int t = m & 2047; const bool first = t == 0, last = t == SEQ - 1; const size_t o = (size_t)m * 512 + c0;
            const size_t om = first ? o : o - 512, op = last ? o : o + 512;
#pragma unroll
            for (int which = 0; which < 3; ++which) { const bf16* Z = which == 0 ? ZR : (which == 1 ? ZK : ZV);
                const v4u ra = *(const GAS v4u*)(Z + om), rc_ = *(const GAS v4u*)(Z + op);
                raw[rr][3 * which] = first ? z4 : ra; raw[rr][3 * which + 1] = *(const GAS v4u*)(Z + o); raw[rr][3 * which + 2] = last ? z4 : rc_; }
            raw[rr][9] = *(const GAS v4u*)(AS0 + o); raw[rr][10] = *(const GAS v4u*)(AS1 + o); raw[rr][11] = *(const GAS v4u*)(YF + o); raw[rr][12] = *(const GAS v4u*)(YB + o); raw[rr][13] = *(const GAS v4u*)(G + o); }
#pragma unroll
        for (int rr = 0; rr < 2; ++rr) { const int m = m0 + rr * NGW; if (m >= NLAT) continue;
            const size_t o = (size_t)m * 512 + c0;
            float r[8], k[8], v[8], tmp[8];
            asm volatile("" ::: "memory");
#pragma unroll
            for (int which = 0; which < 3; ++which) { float (&dst)[8] = which == 0 ? r : (which == 1 ? k : v);
                asm volatile("" ::: "memory");
                float fa[8], fb[8], fc[8]; unpack8(raw[rr][3 * which], fa); unpack8(raw[rr][3 * which + 1], fb); unpack8(raw[rr][3 * which + 2], fc);
                const LAS float* cwp = conv + (3 * which) * 512 + c0;
#pragma unroll
                for (int j = 0; j < 8; ++j) dst[j] = cwp[j] * fa[j] + cwp[512 + j] * fb[j] + cwp[1024 + j] * fc[j]; }
            asm volatile("" ::: "memory");
            float a0[8], a1[8]; unpack8(raw[rr][9], a0); unpack8(raw[rr][10], a1);
            float s = 0.f;
#pragma unroll
            for (int j = 0; j < 8; ++j) { const float km0 = k[j] * (1.0f + (a0[j] - 1.0f) * ka[c0 + j]), km1 = k[j] * (1.0f + (a1[j] - 1.0f) * ka[512 + c0 + j]);
                s += r[j] * (km0 * rk[c0 + j] + km1 * rk[512 + c0 + j]); }
            s += __shfl_xor(s, 1); s += __shfl_xor(s, 2); s += __shfl_xor(s, 4);
            asm volatile("" ::: "memory");
            float y[8], yb[8]; unpack8(raw[rr][11], y); unpack8(raw[rr][12], yb);
            float sm = 0.f;
#pragma unroll
            for (int j = 0; j < 8; ++j) { y[j] += yb[j]; sm += y[j]; }
            sm += __shfl_xor(sm, 1); sm += __shfl_xor(sm, 2); sm += __shfl_xor(sm, 4);
            const float mean = sm * (1.f / 64.f); float sq = 0.f;
#pragma unroll
            for (int j = 0; j < 8; ++j) { y[j] -= mean; sq += y[j] * y[j]; }
            sq += __shfl_xor(sq, 1); sq += __shfl_xor(sq, 2); sq += __shfl_xor(sq, 4);
            const float rstd = __builtin_amdgcn_rsqf(sq * (1.f / 64.f) + 64e-5f);
            float gg[8]; unpack8(raw[rr][13], gg);
#pragma unroll
            for (int j = 0; j < 8; ++j) tmp[j] = (y[j] * rstd * lnw[c0 + j] + lnb[c0 + j] + s * v[j]) * gg[j];
            *(GAS v4u*)(ORW + o) = pack8(tmp); }
    }
}

struct EpiMerge {
    static constexpr bool PERM = true, AFTER_DRAIN = false;
    bf16* merged; const bf16* gates; int goff; int first;
    __device__ __forceinline__ void operator()(const f32x4 (&acc)[2][2][4][2], const Unit& u, int wr, int wc, int fr, int fq) const {
        const int row0 = u.pm * 256 + wr * 64 + fr, col0 = u.pn * 256 + wc * 32 + 8 * fq;
#pragma unroll
        for (int ai = 0; ai < 2; ++ai)
#pragma unroll
            for (int m = 0; m < 4; ++m) { const size_t row = (size_t)(row0 + ai * 128 + m * 16);
#pragma unroll
                for (int bj = 0; bj < 2; ++bj) { const int col = col0 + bj * 128;
                    float gt[8]; unpack8(*(const GAS v4u*)(gates + row * 2048 + goff + col), gt);
                    const f32x4 v0 = acc[ai][bj][m][0], v1 = acc[ai][bj][m][1];
                    float o[8] = {v0.x * gt[0], v0.y * gt[1], v0.z * gt[2], v0.w * gt[3], v1.x * gt[4], v1.y * gt[5], v1.z * gt[6], v1.w * gt[7]};
                    GAS v4u* p = (GAS v4u*)(merged + row * 1024 + col);
                    if (!first) { float pv[8]; unpack8(*p, pv);
#pragma unroll
                        for (int j = 0; j < 8; ++j) o[j] += pv[j]; }
                    *p = pack8(o); } }
    }
};
struct EpiMerge2 {
    static constexpr bool PERM = true, AFTER_DRAIN = false;
    bf16* merged; const bf16* gates;
    __device__ __forceinline__ void mid(f32x4 (&acc)[2][2][4][2], const Unit& u, int wr, int wc, int fr, int fq) const {
        const int row0 = u.pm * 256 + wr * 64 + fr, col0 = u.pn * 256 + wc * 32 + 8 * fq;
#pragma unroll
        for (int ai = 0; ai < 2; ++ai)
#pragma unroll
            for (int m = 0; m < 4; ++m) { const size_t row = (size_t)(row0 + ai * 128 + m * 16);
#pragma unroll
                for (int bj = 0; bj < 2; ++bj) { const int col = col0 + bj * 128;
                    float gr[8], ga[8]; unpack8(*(const GAS v4u*)(gates + row * 2048 + col), gr); unpack8(*(const GAS v4u*)(gates + row * 2048 + 1024 + col), ga);
                    float q[8];
#pragma unroll
                    for (int j = 0; j < 8; ++j) q[j] = gr[j] * __builtin_amdgcn_rcpf(fmaxf(ga[j], 1e-30f));
                    acc[ai][bj][m][0] *= (f32x4){q[0], q[1], q[2], q[3]}; acc[ai][bj][m][1] *= (f32x4){q[4], q[5], q[6], q[7]}; } }
    }
    __device__ __forceinline__ void operator()(const f32x4 (&acc)[2][2][4][2], const Unit& u, int wr, int wc, int fr, int fq) const {
        const int row0 = u.pm * 256 + wr * 64 + fr, col0 = u.pn * 256 + wc * 32 + 8 * fq;
#pragma unroll
        for (int ai = 0; ai < 2; ++ai)
#pragma unroll
            for (int m = 0; m < 4; ++m) { const size_t row = (size_t)(row0 + ai * 128 + m * 16);
#pragma unroll
                for (int bj = 0; bj < 2; ++bj) { const int col = col0 + bj * 128;
                    float ga[8]; unpack8(*(const GAS v4u*)(gates + row * 2048 + 1024 + col), ga);
                    const f32x4 v0 = acc[ai][bj][m][0], v1 = acc[ai][bj][m][1];
                    float o[8] = {v0.x * fmaxf(ga[0], 1e-30f), v0.y * fmaxf(ga[1], 1e-30f), v0.z * fmaxf(ga[2], 1e-30f), v0.w * fmaxf(ga[3], 1e-30f),
                                  v1.x * fmaxf(ga[4], 1e-30f), v1.y * fmaxf(ga[5], 1e-30f), v1.z * fmaxf(ga[6], 1e-30f), v1.w * fmaxf(ga[7], 1e-30f)};
                    *(GAS v4u*)(merged + row * 1024 + col) = pack8(o); } }
    }
};
struct EpiOutproj {
    static constexpr bool PERM = true, AFTER_DRAIN = false;
    bf16* delta; const float* mod;
    __device__ __forceinline__ void operator()(const f32x4 (&acc)[2][2][4][2], const Unit& u, int wr, int wc, int fr, int fq) const {
        const int row0 = u.pm * 256 + wr * 64 + fr, col0 = u.pn * 256 + wc * 32 + 8 * fq; const int b = u.pm >> 3;
        f32x4 gv[2][2];
#pragma unroll
        for (int bj = 0; bj < 2; ++bj)
#pragma unroll
            for (int n = 0; n < 2; ++n) gv[bj][n] = *(const f32x4*)(mod + (size_t)b * 6144 + 2048 + col0 + bj * 128 + 4 * n);
#pragma unroll
        for (int ai = 0; ai < 2; ++ai)
#pragma unroll
            for (int m = 0; m < 4; ++m) { const size_t off = (size_t)(row0 + ai * 128 + m * 16) * 1024 + col0;
#pragma unroll
                for (int bj = 0; bj < 2; ++bj) { const f32x4 v0 = gv[bj][0] * acc[ai][bj][m][0], v1 = gv[bj][1] * acc[ai][bj][m][1];
                    v4u w; w.x = pkbf(v0.x, v0.y); w.y = pkbf(v0.z, v0.w); w.z = pkbf(v1.x, v1.y); w.w = pkbf(v1.z, v1.w);
                    *(GAS v4u*)(delta + off + bj * 128) = w; } }
    }
};

constexpr int RW_PITCH = 2064;
__device__ __forceinline__ void p8_norm2_router(Frame& F) {
    LAS unsigned char* rhi = F.lds; LAS unsigned char* rlo = F.lds + 32 * RW_PITCH;
    const float* rw = karg_in(I_ROUTER);
    for (int i = F.tid; i < 16384; i += 512) { const int e = i & 15, k = i >> 4; const float w = rw[i]; const unsigned h = pkbf(w, 0.f) & 0xffffu; const float wl = w - __uint_as_float(h << 16);
        *(LAS bf16*)(rhi + e * RW_PITCH + 2 * k) = (bf16)h; *(LAS bf16*)(rlo + e * RW_PITCH + 2 * k) = (bf16)(pkbf(wl, 0.f) & 0xffffu); }
    for (int i = F.tid; i < 16 * 1024 / 2; i += 512) { const int e = 16 + i / 512, k2 = i % 512; *(LAS unsigned*)(rhi + e * RW_PITCH + 4 * k2) = 0u; *(LAS unsigned*)(rlo + e * RW_PITCH + 4 * k2) = 0u; }
    __syncthreads();
    const int gw = blockIdx.x * NWAVES + F.wave, NGW = F.G * NWAVES, lane = F.lane, l32 = lane & 31, hi = lane >> 5;
    const float* mod = (const float*)(F.ws + WS_MOD); bf16* H2 = (bf16*)(F.ws + WS_H2); float* AFF = (float*)(F.ws + WS_AFF);
    const float* g2 = karg_in(I_N2G); const float* Xp = karg_in(I_X); const bf16* DELTA = (const bf16*)(F.ws + WS_DELTA);
    f32x4 gv[4];
#pragma unroll
    for (int j = 0; j < 4; ++j) gv[j] = *(const f32x4*)(g2 + 4 * lane + 256 * j);
    for (int tile = gw; tile < NLAT / 32; tile += NGW) {
        const int mbase = tile * 32, b = mbase >> 11; const float* sh = mod + (size_t)b * 6144 + 3072; const float* sc = sh + 1024;
        f32x4 av[4], bv[4];
#pragma unroll
        for (int j = 0; j < 4; ++j) { av[j] = *(const f32x4*)(sc + 4 * lane + 256 * j) + 1.0f; bv[j] = *(const f32x4*)(sh + 4 * lane + 256 * j); }
#pragma unroll 1
        for (int r0 = 0; r0 < 32; r0 += 4) {
            f32x4 v[4][4];
#pragma unroll
            for (int r = 0; r < 4; ++r) { const float* xr = Xp + (size_t)(mbase + r0 + r) * DM; const bf16* dr = DELTA + (size_t)(mbase + r0 + r) * DM;
#pragma unroll
                for (int j = 0; j < 4; ++j) { const v2u d = *(const GAS v2u*)(dr + 4 * lane + 256 * j);
                    v[r][j] = *(const GAS f32x4*)(xr + 4 * lane + 256 * j) + (f32x4){bflo(d.x), bfhi(d.x), bflo(d.y), bfhi(d.y)}; } }
#pragma unroll
            for (int r = 0; r < 4; ++r) { float s = 0.f;
#pragma unroll
                for (int j = 0; j < 4; ++j) s += (v[r][j].x * v[r][j].x + v[r][j].y * v[r][j].y) + (v[r][j].z * v[r][j].z + v[r][j].w * v[r][j].w);
                const float rstd = __builtin_amdgcn_rsqf(wave_sum(s) * (1.f / DM) + 1e-6f);
#pragma unroll
                for (int j = 0; j < 4; ++j) { const f32x4 y = v[r][j] * rstd * gv[j] * av[j] + bv[j];
                    v2u o; o.x = pkbf(y.x, y.y); o.y = pkbf(y.z, y.w);
                    *(GAS v2u*)(H2 + (size_t)(mbase + r0 + r) * DM + 4 * lane + 256 * j) = o; } }
        }
        asm volatile("s_waitcnt vmcnt(0)" ::: "memory");
        f32x16 acc;
#pragma unroll
        for (int r = 0; r < 16; ++r) acc[r] = 0.f;
        const bf16* hrow = H2 + (size_t)(mbase + l32) * DM + 8 * hi;
        const LAS unsigned char* ah = rhi + l32 * RW_PITCH + 16 * hi; const LAS unsigned char* al = rlo + l32 * RW_PITCH + 16 * hi;
#pragma unroll 8
        for (int ks = 0; ks < 64; ++ks) { const bf16x8 bf = *(const GAS bf16x8*)(hrow + 16 * ks);
            const bf16x8 fh = *(const LAS bf16x8*)(ah + 32 * ks), fl = *(const LAS bf16x8*)(al + 32 * ks);
            acc = __builtin_amdgcn_mfma_f32_32x32x16_bf16(fh, bf, acc, 0, 0, 0); acc = __builtin_amdgcn_mfma_f32_32x32x16_bf16(fl, bf, acc, 0, 0, 0); }
        float mx = acc[0];
#pragma unroll
        for (int r = 1; r < 8; ++r) mx = fmaxf(mx, acc[r]);
        mx = fmaxf(mx, __shfl_xor(mx, 32));
        float pe[8], den = 0.f;
#pragma unroll
        for (int r = 0; r < 8; ++r) { pe[r] = __expf(acc[r] - mx); den += pe[r]; }
        den += __shfl_xor(den, 32);
        const float inv = 1.0f / den; const int t = (mbase & 2047) + l32;
#pragma unroll
        for (int r = 0; r < 8; ++r) { const int e = (r & 3) + 8 * (r >> 2) + 4 * hi; AFF[((size_t)b * 16 + e) * SEQ + t] = pe[r] * inv; }
    }
}

__device__ __forceinline__ int block_count(Frame& F, LAS int* wc, int slot, bool p0, bool p1, bool p2, bool p3) {
    const int c = __builtin_popcountll(__ballot(p0)) + __builtin_popcountll(__ballot(p1)) + __builtin_popcountll(__ballot(p2)) + __builtin_popcountll(__ballot(p3));
    if (F.lane == 0) wc[slot * 8 + F.wave] = c;
    __syncthreads();
    int s = 0;
#pragma unroll
    for (int w = 0; w < 8; ++w) s += wc[slot * 8 + w];
    return s;
}
__device__ __forceinline__ void p9_topk_gather(Frame& F) {
    LAS int* wc = (LAS int*)F.lds;
    LAS int* sel = (LAS int*)(F.lds + 1024);
    const float* AFF = (const float*)(F.ws + WS_AFF); int* IDX = (int*)(F.ws + WS_IDX); float* VAL = (float*)(F.ws + WS_VAL);
    const bf16* H2 = (const bf16*)(F.ws + WS_H2); bf16* XE = (bf16*)(F.ws + WS_XE); int* INV = (int*)(F.ws + WS_INV);
    const int tid = F.tid, lane = F.lane, wave = F.wave;
    for (int p = blockIdx.x; p < NB * NE; p += F.G) {
        const int b = p >> 4, e = p & 15;
        const f32x4 av = *(const GAS f32x4*)(AFF + (size_t)p * SEQ + 4 * tid);
        const unsigned u0 = __float_as_uint(av.x), u1 = __float_as_uint(av.y), u2 = __float_as_uint(av.z), u3 = __float_as_uint(av.w);
        unsigned tau = 0u; int it = 0;
        for (int bit = 30; bit >= 0; --bit, ++it) { const unsigned cand = tau | (1u << bit);
            const int cnt = block_count(F, wc, it & 1, u0 >= cand, u1 >= cand, u2 >= cand, u3 >= cand);
            if (cnt >= CAP) tau = cand; }
        const int cgt = block_count(F, wc, it & 1, u0 > tau, u1 > tau, u2 > tau, u3 > tau); ++it;
        const int need_eq = CAP - cgt;
        const int ngt = (u0 > tau) + (u1 > tau) + (u2 > tau) + (u3 > tau), neq = (u0 == tau) + (u1 == tau) + (u2 == tau) + (u3 == tau);
        int pk = ngt | (neq << 16), inc = pk;
#pragma unroll
        for (int o = 1; o < 64; o <<= 1) { const int nb = __shfl_up(inc, o); if (lane >= o) inc += nb; }
        if (lane == 63) wc[16 + wave] = inc;
        __syncthreads();
        int base = 0;
#pragma unroll
        for (int w = 0; w < 8; ++w) base += (w < wave) ? wc[16 + w] : 0;
        int ex = base + inc - pk; int gpos = ex & 0xffff, epos = ex >> 16;
        const unsigned uu[4] = {u0, u1, u2, u3}; const float ff[4] = {av.x, av.y, av.z, av.w};
#pragma unroll
        for (int j = 0; j < 4; ++j) { int slot = -1;
            if (uu[j] > tau) { slot = gpos; ++gpos; } else if (uu[j] == tau) { if (epos < need_eq) slot = cgt + epos; ++epos; }
            if (slot >= 0) { IDX[(size_t)(e * NB + b) * CAP + slot] = 4 * tid + j; VAL[(size_t)(e * NB + b) * CAP + slot] = ff[j]; sel[slot] = 4 * tid + j; }
            INV[((size_t)b * SEQ + 4 * tid + j) * 16 + e] = slot; }
        __syncthreads();
        __syncthreads();
    }
}

struct ExpertOrder {
    int G, c, upe, npn;
    __device__ void init(int G_, int c_, int npn_) { G = G_; c = c_; npn = npn_; upe = 32 * npn_; }
    __device__ bool next(int i, Unit& u) const { const unsigned L = (unsigned)i * (unsigned)G + (unsigned)c; if (L >= (unsigned)(NE * upe)) return false;
        const unsigned e = L / (unsigned)upe, rem = L - e * (unsigned)upe; u.pm = (int)(e * 32u + (rem & 31u)); u.pn = (int)(e * (unsigned)npn + (rem >> 5)); return true; }
    __device__ __forceinline__ void a_ready(const Unit&) const {}
    __device__ __forceinline__ void done(const Unit&) const {}
};
struct EpiSwiglu {
    static constexpr bool PERM = true, AFTER_DRAIN = false;
    bf16* act;
    __device__ __forceinline__ void operator()(const f32x4 (&acc)[2][2][4][2], const Unit& u, int wr, int wc, int fr, int fq) const {
        const int e = u.pm >> 5, pnl = u.pn - 12 * e; const int row0 = u.pm * 256 + wr * 64 + fr, col = 128 * pnl + wc * 32 + 8 * fq;
#pragma unroll
        for (int ai = 0; ai < 2; ++ai)
#pragma unroll
            for (int m = 0; m < 4; ++m) { const f32x4 g0 = acc[ai][0][m][0], g1 = acc[ai][0][m][1], u0 = acc[ai][1][m][0], u1 = acc[ai][1][m][1];
                float o[8] = {g0.x * sigmoidf_(g0.x) * u0.x, g0.y * sigmoidf_(g0.y) * u0.y, g0.z * sigmoidf_(g0.z) * u0.z, g0.w * sigmoidf_(g0.w) * u0.w,
                              g1.x * sigmoidf_(g1.x) * u1.x, g1.y * sigmoidf_(g1.y) * u1.y, g1.z * sigmoidf_(g1.z) * u1.z, g1.w * sigmoidf_(g1.w) * u1.w};
                *(GAS v4u*)(act + (size_t)(row0 + ai * 128 + m * 16) * DFF + col) = pack8(o); }
    }
};
struct EpiDown {
    static constexpr bool PERM = true, AFTER_DRAIN = false;
    bf16* y2; const float* val;
    __device__ __forceinline__ void operator()(const f32x4 (&acc)[2][2][4][2], const Unit& u, int wr, int wc, int fr, int fq) const {
        const int e = u.pm >> 5, pnl = u.pn - 4 * e; const int srow0 = u.pm * 256 + wr * 64 + fr, col0 = pnl * 256 + wc * 32 + 8 * fq;
#pragma unroll
        for (int ai = 0; ai < 2; ++ai)
#pragma unroll
            for (int m = 0; m < 4; ++m) { const int srow = srow0 + ai * 128 + m * 16; const float vl = val[srow];
#pragma unroll
                for (int bj = 0; bj < 2; ++bj) { const f32x4 v0 = acc[ai][bj][m][0] * vl, v1 = acc[ai][bj][m][1] * vl;
                    v4u w; w.x = pkbf(v0.x, v0.y); w.y = pkbf(v0.z, v0.w); w.z = pkbf(v1.x, v1.y); w.w = pkbf(v1.z, v1.w);
                    *(GAS v4u*)(y2 + (size_t)srow * DM + col0 + bj * 128) = w; } }
    }
};
__device__ __forceinline__ void p12_combine(Frame& F, bool dostore = true) {
    const int gw = blockIdx.x * NWAVES + F.wave, NGW = F.G * NWAVES, lane = F.lane;
    const int* INV = (const int*)(F.ws + WS_INV); const bf16* Y2 = (const bf16*)(F.ws + WS_Y2); const float* mod = (const float*)(F.ws + WS_MOD);
    const float* Xp = karg_in(I_X); const bf16* DELTA = (const bf16*)(F.ws + WS_DELTA);
    for (int m0 = gw; m0 < NLAT; m0 += 2 * NGW) {
        int inv[2]; f32x4 xv[2][4];
#pragma unroll
        for (int r = 0; r < 2; ++r) { const int m = min(m0 + r * NGW, NLAT - 1);
            { const int iv = INV[(size_t)m * 16 + (lane & 15)]; inv[r] = lane < 16 ? iv : -1; const float* orow = Xp + (size_t)m * DM; const bf16* dr = DELTA + (size_t)m * DM;
                const v4u d0 = *(const GAS v4u*)(dr + 8 * lane), d1 = *(const GAS v4u*)(dr + 512 + 8 * lane);
                xv[r][0] = *(const GAS f32x4*)(orow + 8 * lane) + (f32x4){bflo(d0.x), bfhi(d0.x), bflo(d0.y), bfhi(d0.y)}; xv[r][1] = *(const GAS f32x4*)(orow + 8 * lane + 4) + (f32x4){bflo(d0.z), bfhi(d0.z), bflo(d0.w), bfhi(d0.w)};
                xv[r][2] = *(const GAS f32x4*)(orow + 512 + 8 * lane) + (f32x4){bflo(d1.x), bfhi(d1.x), bflo(d1.y), bfhi(d1.y)}; xv[r][3] = *(const GAS f32x4*)(orow + 512 + 8 * lane + 4) + (f32x4){bflo(d1.z), bfhi(d1.z), bflo(d1.w), bfhi(d1.w)}; } }
#pragma unroll
        for (int r = 0; r < 2; ++r) { const int m = m0 + r * NGW; if (m >= NLAT) continue;
            const int b = m >> 11; unsigned long long mk = __ballot(inv[r] >= 0);
            float a0[8] = {0.f, 0.f, 0.f, 0.f, 0.f, 0.f, 0.f, 0.f}, a1[8] = {0.f, 0.f, 0.f, 0.f, 0.f, 0.f, 0.f, 0.f};
            while (mk) {
                const int e = __builtin_ctzll(mk); mk &= mk - 1; const int slot = __builtin_amdgcn_readlane(inv[r], e);
                const bool two = mk != 0; int e2 = e, slot2 = slot; if (two) { e2 = __builtin_ctzll(mk); mk &= mk - 1; slot2 = __builtin_amdgcn_readlane(inv[r], e2); }
                const bf16* yr = Y2 + ((size_t)(e * NB + b) * CAP + slot) * DM; const bf16* yr2 = Y2 + ((size_t)(e2 * NB + b) * CAP + slot2) * DM;
                const v4u q0 = *(const GAS v4u*)(yr + 8 * lane), q1 = *(const GAS v4u*)(yr + 512 + 8 * lane), q2 = *(const GAS v4u*)(yr2 + 8 * lane), q3 = *(const GAS v4u*)(yr2 + 512 + 8 * lane);
                float f0[8], f1[8], f2[8], f3[8]; unpack8(q0, f0); unpack8(q1, f1); unpack8(q2, f2); unpack8(q3, f3);
                const float w2 = two ? 1.0f : 0.0f;
#pragma unroll
                for (int j = 0; j < 8; ++j) { a0[j] += f0[j] + w2 * f2[j]; a1[j] += f1[j] + w2 * f3[j]; }
            }
            float* orow = F.out + (size_t)m * DM; const float* g = mod + (size_t)b * 6144 + 5120;
            const f32x4 g0 = *(const f32x4*)(g + 8 * lane), g1 = *(const f32x4*)(g + 8 * lane + 4), g2 = *(const f32x4*)(g + 512 + 8 * lane), g3 = *(const f32x4*)(g + 512 + 8 * lane + 4);
            if (dostore) {
            *(GAS f32x4*)(orow + 8 * lane) = xv[r][0] + g0 * (f32x4){a0[0], a0[1], a0[2], a0[3]}; *(GAS f32x4*)(orow + 8 * lane + 4) = xv[r][1] + g1 * (f32x4){a0[4], a0[5], a0[6], a0[7]};
            *(GAS f32x4*)(orow + 512 + 8 * lane) = xv[r][2] + g2 * (f32x4){a1[0], a1[1], a1[2], a1[3]}; *(GAS f32x4*)(orow + 512 + 8 * lane + 4) = xv[r][3] + g3 * (f32x4){a1[4], a1[5], a1[6], a1[7]}; }
        }
    }
}

struct Args { const float* in[30]; float* out; unsigned char* ws; int ph_lo, ph_hi; };
__global__ void __launch_bounds__(NWAVES * 64, 2) mk_fwd(Args args) {
    extern __shared__ __attribute__((aligned(16))) unsigned char lds[];
    Frame F;
    F.lds = (LAS unsigned char*)lds; F.MISC = (volatile LAS unsigned*)(F.lds + MISC_OFF);
    F.tid = threadIdx.x; F.lane = F.tid & 63; F.wave = __builtin_amdgcn_readfirstlane(F.tid >> 6); F.G = gridDim.x;
    F.out = args.out; F.ws = args.ws; F.ctl = (gu32*)(args.ws + WS_CTL);
    for (int u = F.tid; u < (LDS_BYTES - LDSCTL_OFF) / 4; u += NWAVES * 64) ((LAS unsigned*)(F.lds + LDSCTL_OFF))[u] = 0u;
    __syncthreads();
    XcdBarrier bar; bar.bar = (unsigned*)(F.ctl + CW_BAR); bar.x = 0; bar.st = nullptr;
    if (N_LAUNCHES == 1) bar = xcd_barrier_post((unsigned*)(F.ctl + CW_BAR), F.MISC + 8);
#define GRID_BAR() do { if (N_LAUNCHES == 1) xcd_barrier(bar); } while (0)
    const int lo = args.ph_lo, hi = args.ph_hi;
#ifndef PH_MASK
#define PH_MASK 0x1FFF
#endif
#define IN(k) (((PH_MASK >> (k)) & 1) && lo <= (k) && (k) < hi)
#define SEAM(k) do { if (IN(k) && IN((k) + 1)) GRID_BAR(); } while (0)
    unsigned char* ws = args.ws;

    if (IN(0)) { p0_prologue(F); } SEAM(0);
    if (IN(1)) { p1_norm1(F); } SEAM(1);
    if (IN(2)) {
        pg8::Gemm g{(const bf16*)(ws + WS_H1), (const bf16*)(ws + WS_WIN), NTOK, WIN_ROWS, DM}; InprojOrder S; S.init(F.G, (int)blockIdx.x);
        EpiInproj E{(bf16*)(ws + WS_ZK), (bf16*)(ws + WS_ZV), (bf16*)(ws + WS_ZR), (bf16*)(ws + WS_Q), (bf16*)(ws + WS_KQ), (bf16*)(ws + WS_VQ), (bf16*)(ws + WS_LA), (bf16*)args.out};
        pg8::gemm_phase<EpiInproj, InprojOrder, true, true>(F.lds, g, S, E);
    } SEAM(2);
    if (IN(3)) {
        p3a_lora(F);
        p3b_attn_prep(F);
    } SEAM(3);
    if (IN(4)) { p4a_attention(F); __syncthreads(); p4b_scan(F); } SEAM(4);
    if (IN(5)) { p5_rwkv_out(F); } SEAM(5);
    if (IN(6)) {
        pg8::Gemm g{(const bf16*)(ws + WS_ORW), (const bf16*)(ws + WS_WBRR), NLAT, DM, DM, (const bf16*)(ws + WS_Q), 512}; pg8::StaticOrder S; S.init(NLAT, DM, F.G, (int)blockIdx.x);
        EpiMerge2 E{(bf16*)(ws + WS_MERGED), (const bf16*)args.out};
        pg8::gemm_phase<EpiMerge2, pg8::StaticOrder, true, true, true>(F.lds, g, S, E);
    } SEAM(6);
    if (IN(7)) {
        pg8::Gemm g{(const bf16*)(ws + WS_MERGED), (const bf16*)(ws + WS_WOUT), NLAT, DM, DM}; pg8::StaticOrder S; S.init(NLAT, DM, F.G, (int)blockIdx.x);
        EpiOutproj E{(bf16*)(ws + WS_DELTA), (const float*)(ws + WS_MOD)};
        pg8::gemm_phase<EpiOutproj, pg8::StaticOrder, true, true>(F.lds, g, S, E);
    } SEAM(7);
    if (IN(8)) { p8_norm2_router(F); } SEAM(8);
    if (IN(9)) { p9_topk_gather(F); } SEAM(9);
    if (IN(10)) {
        pg8::Gemm g{(const bf16*)(ws + WS_H2), (const bf16*)(ws + WS_WGU), NSLOT, NE * 3072, DM, nullptr, 0, (const int*)(ws + WS_IDX), (LAS int*)(F.lds + RING_BYTES)}; ExpertOrder S; S.init(F.G, (int)blockIdx.x, 12);
        EpiSwiglu E{(bf16*)(ws + WS_ACT)};
        pg8::gemm_phase<EpiSwiglu, ExpertOrder, true, true, false, true>(F.lds, g, S, E);
    } SEAM(10);
    if (IN(11)) {
        pg8::Gemm g{(const bf16*)(ws + WS_ACT), (const bf16*)(ws + WS_WD), NSLOT, NE * 1024, DFF}; ExpertOrder S; S.init(F.G, (int)blockIdx.x, 4);
        EpiDown E{(bf16*)(ws + WS_Y2), (const float*)(ws + WS_VAL)};
        pg8::gemm_phase<EpiDown, ExpertOrder, true, true>(F.lds, g, S, E);
    } SEAM(11);
    if (IN(12)) { p12_combine(F); }
#undef IN
#undef SEAM
#undef GRID_BAR
}

extern "C" void kernel_launch(void* const* d_in, const int* in_sizes, int n_in, void* d_out, int out_size, void* d_ws, size_t ws_size, hipStream_t stream) {
    static int grid = 0;
    if (grid == 0) {
        if (n_in != 30 || out_size != NLAT * DM || ws_size < WS_END) { fprintf(stderr, "kernel_launch: unexpected problem (n_in %d out %d ws %zu)\n", n_in, out_size, ws_size); grid = -1; return; }
        int dev = 0, cus = 0, per_cu = 0;
        if (hipGetDevice(&dev) != hipSuccess || hipDeviceGetAttribute(&cus, hipDeviceAttributeMultiprocessorCount, dev) != hipSuccess) { grid = -1; return; }
        if (hipFuncSetAttribute((const void*)mk_fwd, hipFuncAttributeMaxDynamicSharedMemorySize, LDS_BYTES) != hipSuccess) { fprintf(stderr, "kernel_launch: hipFuncSetAttribute failed\n"); grid = -1; return; }
        if (hipOccupancyMaxActiveBlocksPerMultiprocessor(&per_cu, (const void*)mk_fwd, NWAVES * 64, LDS_BYTES) != hipSuccess || per_cu < 1) fprintf(stderr, "kernel_launch: occupancy query says %d\n", per_cu);
        (void)hipGetLastError();
        grid = cus;
    }
    if (grid < 0) return;
    if (hipMemsetAsync((char*)d_ws + WS_CTL, 0, CTL_ZERO_BYTES, stream) != hipSuccess) return;
    Args a{};
    for (int i = 0; i < 30; ++i) a.in[i] = (const float*)d_in[i];
    a.out = (float*)d_out; a.ws = (unsigned char*)d_ws;
    if (N_LAUNCHES == 1) { a.ph_lo = 0; a.ph_hi = N_PHASES; hipLaunchKernelGGL(mk_fwd, dim3(grid), dim3(NWAVES * 64), LDS_BYTES, stream, a); }
    else for (int li = 0; li < N_PHASES; ++li) { a.ph_lo = li; a.ph_hi = li + 1; hipLaunchKernelGGL(mk_fwd, dim3(grid), dim3(NWAVES * 64), LDS_BYTES, stream, a); }
}
```

```cpp
#include <hip/hip_runtime.h>
#include <cstdio>
#include <cstdint>
#define MK_N_LAUNCHES 1
namespace pg8 {
#define PG8_LAS __attribute__((address_space(3)))
typedef unsigned short bf16_t;
typedef short bf16x8 __attribute__((ext_vector_type(8)));
typedef float f32x4 __attribute__((ext_vector_type(4)));
typedef unsigned u32x4 __attribute__((ext_vector_type(4)));
typedef int i32x4 __attribute__((ext_vector_type(4)));
typedef int i32x8 __attribute__((ext_vector_type(8)));
constexpr int BM = 256, BK = 64, HALF = 128, HTB = HALF * BK * 2  , STAGE_BYTES = 8 * HTB, NXCD = 8, WGM = 8;

__host__ __device__ __forceinline__ int lds_byte(int r, int c) { const int st = (r >> 4) * 2 + (c >> 5), rr = r & 15, cc = c & 31, ob = rr * 64 + cc * 2; return st * 1024 + (ob ^ (((ob >> 9) & 1) << 5)); }
__host__ __device__ __forceinline__ void stage_rc(int b, int& R, int& C) { const int st = b / 1024, sb = b % 1024, swz = sb ^ (((sb >> 9) & 1) << 5); R = (st >> 1) * 16 + swz / 64; C = (st & 1) * 32 + (swz % 64) / 2; }
__host__ __device__ __forceinline__ int perm32(int rho) { const int n = rho >> 4, i = rho & 15; return 8 * (i >> 2) + 4 * n + (i & 3); }

struct Unit { int pm, pn; };
struct Gemm { const bf16_t* A; const bf16_t* Bt; int M, N, K; const bf16_t* A2 = nullptr; int lda = 0; const int* gidx = nullptr; PG8_LAS int* glds = nullptr; };

struct StaticOrder {
    int nM, nN, nwg, G, c;
    __host__ __device__ void init(int M, int N, int G_, int c_) { nM = M / BM; nN = N / BM; nwg = nM * nN; G = G_; c = c_; }
    __host__ __device__ bool next(int i, Unit& u) const {
        const long L = (long)i * G + c; if (L >= nwg) return false;
        int wgid = (int)L; { const int q = nwg / NXCD, r = nwg % NXCD, xcd = wgid % NXCD, off = wgid / NXCD; wgid = (xcd < r ? xcd * (q + 1) : r * (q + 1) + (xcd - r) * q) + off; }
        const int nig = WGM * nN, gid = wgid / nig, fm = gid * WGM, gsz = (nM - fm) < WGM ? (nM - fm) : WGM;
        u.pm = fm + ((wgid % nig) % gsz); u.pn = (wgid % nig) / gsz; return true;
    }
    __device__ __forceinline__ void a_ready(const Unit&) const {}
    __device__ __forceinline__ void done(const Unit&) const {}
};

template <class Epi, class Sched, bool ALIGN_EPI = false, bool SP2 = false, bool SPLITA = false, bool GATHERA = false, bool FP8 = false>
__device__ __forceinline__ void gemm_phase(PG8_LAS unsigned char* lds, const Gemm g, const Sched& S, const Epi& E) {
    const int tid = threadIdx.x, wid = __builtin_amdgcn_readfirstlane(tid >> 6), lane = tid & 63, wr = wid >> 2, wc = wid & 3, fr = lane & 15, fq = lane >> 4;
    const int K = g.K, nt = K / BK, lda = g.lda ? g.lda : g.K, nh = nt / 2;
    unsigned voffA[2], voffB[2];
#pragma unroll
    for (int i = 0; i < 2; ++i) { int R, C; stage_rc(tid * 16 + i * 8192, R, C); const int Rb = Epi::PERM ? ((R & ~31) + perm32(R & 31)) : R;
        voffA[i] = (unsigned)(R * lda + C) * 2u; voffB[i] = (unsigned)(Rb * K + C) * 2u; }
    const size_t kstep = (size_t)(BK * 2);
    const size_t hstep = (size_t)HALF * K * 2;
    const size_t tstep = 2 * hstep;
    const size_t hstepA = (size_t)HALF * lda * 2, tstepA = 2 * hstepA;
    const unsigned ldsw = (unsigned)wid * 1024u;
    const int aoff = lds_byte(wr * 64 + fr, fq * 8), boff = lds_byte(wc * 32 + fr, fq * 8);
#define PG8_SA(b, h) (((b) * 2 + (h)) * HTB)
#define PG8_SB(b, h) ((4 + (b) * 2 + (h)) * HTB)
#define PG8_STAGE(bufoff, gbase, voff) do { _Pragma("unroll") for (int _i = 0; _i < 2; ++_i) \
        __builtin_amdgcn_global_load_lds((const unsigned*)((const char*)(gbase) + (voff)[_i]), (PG8_LAS unsigned*)(lds + (bufoff) + ldsw + _i * 8192), 16, 0, 0); } while (0)
#define PG8_LD32(off) __builtin_shufflevector(*(const PG8_LAS i32x4*)(lds + (off)), *(const PG8_LAS i32x4*)(lds + (off) + 1024), 0, 1, 2, 3, 4, 5, 6, 7)
#define PG8_LDA(dst, b, h) do { if constexpr (FP8) { _Pragma("unroll") for (int m = 0; m < 4; ++m) dst##8[m] = PG8_LD32(PG8_SA(b, h) + aoff + m * 2048); } else { \
        _Pragma("unroll") for (int m = 0; m < 4; ++m) _Pragma("unroll") for (int k = 0; k < 2; ++k) dst[m][k] = *(const PG8_LAS bf16x8*)(lds + PG8_SA(b, h) + aoff + m * 2048 + k * 1024); } } while (0)
#define PG8_LDB(dst, b, h) do { if constexpr (FP8) { _Pragma("unroll") for (int n = 0; n < 2; ++n) dst##8[n] = PG8_LD32(PG8_SB(b, h) + boff + n * 2048); } else { \
        _Pragma("unroll") for (int n = 0; n < 2; ++n) _Pragma("unroll") for (int k = 0; k < 2; ++k) dst[n][k] = *(const PG8_LAS bf16x8*)(lds + PG8_SB(b, h) + boff + n * 2048 + k * 1024); } } while (0)
#define PG8_MMA(ai, bj, At, Bt) do { __builtin_amdgcn_s_setprio(1); if constexpr (FP8) { _Pragma("unroll") for (int m = 0; m < 4; ++m) _Pragma("unroll") for (int n = 0; n < 2; ++n) \
        asm volatile("v_mfma_f32_16x16x128_f8f6f4 %0, %1, %2, %0" : "+v"(acc[ai][bj][m][n]) : "v"(Bt##8[n]), "v"(At##8[m])); } else { \
        _Pragma("unroll") for (int m = 0; m < 4; ++m) _Pragma("unroll") for (int n = 0; n < 2; ++n) _Pragma("unroll") for (int k = 0; k < 2; ++k) \
        acc[ai][bj][m][n] = __builtin_amdgcn_mfma_f32_16x16x32_bf16(Bt[n][k], At[m][k], acc[ai][bj][m][n], 0, 0, 0); } __builtin_amdgcn_s_setprio(0); } while (0)
#define PG8_WAIT_V(n) asm volatile("s_waitcnt vmcnt(" #n ")" ::: "memory")
#define PG8_WAIT_L(n) asm volatile("s_waitcnt lgkmcnt(" #n ")" ::: "memory")
#define PG8_BAR __builtin_amdgcn_s_barrier()
#define PG8_SCHED __builtin_amdgcn_sched_barrier(0)
    Unit cur, nxt; int ui = 0;
    if (!S.next(0, cur)) return;
    f32x4 acc[2][2][4][2];
#pragma unroll
    for (int a = 0; a < 2; ++a)
#pragma unroll
        for (int b = 0; b < 2; ++b)
#pragma unroll
            for (int m = 0; m < 4; ++m)
#pragma unroll
                for (int n = 0; n < 2; ++n) acc[a][b][m][n] = (f32x4){0.f, 0.f, 0.f, 0.f};
    bf16x8 At[4][2], B0[2][2], B1[2][2]; i32x8 At8[4], B08[2], B18[2];
    const char* cA = (const char*)g.A + (size_t)cur.pm * tstepA; const char* cB = (const char*)g.Bt + (size_t)cur.pn * tstep;
    const char* cA2 = SPLITA ? (const char*)g.A2 + (size_t)cur.pm * tstepA : cA;
#define PG8_AADDR(tt) (SPLITA ? (((tt) < nh) ? cA + (size_t)(tt) * kstep : cA2 + (size_t)((tt) - nh) * kstep) : cA + (size_t)(tt) * kstep)
    unsigned gofc[2][2] = {{0u, 0u}, {0u, 0u}}, gofn[2][2] = {{0u, 0u}, {0u, 0u}}; int gR[2] = {0, 0}, gC[2] = {0, 0};
    if constexpr (GATHERA) {
#pragma unroll
        for (int i = 0; i < 2; ++i) { int R, C; stage_rc(tid * 16 + i * 8192, R, C); gR[i] = R; gC[i] = C; }
        if (tid < 256) g.glds[tid] = g.gidx[cur.pm * 256 + tid];
        asm volatile("s_waitcnt vmcnt(0) lgkmcnt(0)" ::: "memory"); __builtin_amdgcn_s_barrier(); asm volatile("" ::: "memory");
#pragma unroll
        for (int hh = 0; hh < 2; ++hh)
#pragma unroll
            for (int i = 0; i < 2; ++i) gofc[hh][i] = (unsigned)(((cur.pm & 31) * 2048 + g.glds[hh * 128 + gR[i]]) * lda + gC[i]) * 2u;
        cA = (const char*)g.A; cA2 = cA;
    }
#define PG8_GA(hh) (GATHERA ? gofc[hh] : voffA)
#define PG8_GN(hh) (GATHERA ? (last ? gofn[hh] : gofc[hh]) : voffA)
#define PG8_HA(x) (GATHERA ? (x) : (x) + hstepA)
    S.a_ready(cur);
    if constexpr (SP2) {
        PG8_STAGE(PG8_SB(0, 0), cB, voffB); PG8_STAGE(PG8_SB(0, 1), cB + hstep, voffB); PG8_STAGE(PG8_SA(0, 0), cA, PG8_GA(0)); PG8_STAGE(PG8_SA(0, 1), PG8_HA(cA), PG8_GA(1));
        if (wr == 1) PG8_BAR;
        PG8_WAIT_V(2); PG8_BAR;
        PG8_STAGE(PG8_SB(1, 0), cB + kstep, voffB); PG8_STAGE(PG8_SA(1, 0), cA + kstep, PG8_GA(0)); PG8_STAGE(PG8_SB(1, 1), cB + hstep + kstep, voffB);
        PG8_WAIT_V(6); PG8_BAR;
    } else {
        PG8_STAGE(PG8_SB(0, 0), cB, voffB); PG8_STAGE(PG8_SA(0, 0), cA, voffA); PG8_STAGE(PG8_SB(0, 1), cB + hstep, voffB); PG8_STAGE(PG8_SA(0, 1), cA + hstepA, voffA);
        if (wr == 1) PG8_BAR;
        PG8_WAIT_V(4); PG8_BAR;
        PG8_STAGE(PG8_SB(1, 0), cB + kstep, voffB); PG8_STAGE(PG8_SA(1, 0), cA + kstep, PG8_GA(0)); PG8_STAGE(PG8_SB(1, 1), cB + hstep + kstep, voffB);
        PG8_WAIT_V(6); PG8_BAR;
    }
    for (;;) {
        const bool has_next = S.next(ui + 1, nxt);
        const char* nA = has_next ? (const char*)g.A + (size_t)nxt.pm * tstepA : cA; const char* nB = has_next ? (const char*)g.Bt + (size_t)nxt.pn * tstep : cB;
        const char* nA2 = (SPLITA && has_next) ? (const char*)g.A2 + (size_t)nxt.pm * tstepA : cA2;
        if constexpr (GATHERA) { nA = cA;
            if (has_next) __builtin_amdgcn_global_load_lds((const unsigned*)(g.gidx + nxt.pm * 256 + (wid & 3) * 64 + lane), (PG8_LAS unsigned*)(g.glds + ((ui + 1) & 1) * 256 + (wid & 3) * 64), 4, 0, 0); }
        for (int t = 0; t < nt; t += 2) {
            const bool last = (t == nt - 2);
            const char* a1 = PG8_AADDR(t + 1);
            const char* a2 = last ? nA : PG8_AADDR(t + 2); const char* b2 = last ? nB : cB + (size_t)(t + 2) * kstep;
            const char* a3 = a2 + kstep; const char* b3 = b2 + kstep;
            if (last && has_next) S.a_ready(nxt);
            if constexpr (GATHERA) { if (last && has_next) {
#pragma unroll
                for (int hh = 0; hh < 2; ++hh)
#pragma unroll
                    for (int i = 0; i < 2; ++i) gofn[hh][i] = (unsigned)(((nxt.pm & 31) * 2048 + g.glds[((ui + 1) & 1) * 256 + hh * 128 + gR[i]]) * lda + gC[i]) * 2u; } }
            if constexpr (SPLITA) { if (t == nh) E.mid(acc, cur, wr, wc, fr, fq); }
            if constexpr (SP2) {
            PG8_LDB(B0, 0, 0); PG8_LDB(B1, 0, 1); PG8_SCHED; PG8_LDA(At, 0, 0); PG8_STAGE(PG8_SA(1, 1), PG8_HA(a1), PG8_GA(1));
            PG8_WAIT_V(8); PG8_WAIT_L(0); PG8_BAR; PG8_MMA(0, 0, At, B0); PG8_MMA(0, 1, At, B1); PG8_BAR; PG8_SCHED;
            PG8_LDA(At, 0, 1); PG8_STAGE(PG8_SB(0, 0), b2, voffB); PG8_STAGE(PG8_SB(0, 1), b2 + hstep, voffB); PG8_STAGE(PG8_SA(0, 0), a2, PG8_GN(0));
            PG8_WAIT_V(8); PG8_WAIT_L(0); PG8_BAR; PG8_MMA(1, 0, At, B0); PG8_MMA(1, 1, At, B1); PG8_BAR; PG8_SCHED;
            PG8_LDB(B0, 1, 0); PG8_LDB(B1, 1, 1); PG8_SCHED; PG8_LDA(At, 1, 0); PG8_STAGE(PG8_SA(0, 1), PG8_HA(a2), PG8_GN(1));
            PG8_WAIT_V(8); PG8_WAIT_L(0); PG8_BAR; PG8_MMA(0, 0, At, B0); PG8_MMA(0, 1, At, B1); PG8_BAR; PG8_SCHED;
            PG8_LDA(At, 1, 1); PG8_STAGE(PG8_SB(1, 0), b3, voffB); PG8_STAGE(PG8_SB(1, 1), b3 + hstep, voffB); PG8_STAGE(PG8_SA(1, 0), a3, PG8_GN(0));
            PG8_WAIT_V(8); PG8_WAIT_L(0); PG8_BAR; PG8_MMA(1, 0, At, B0); PG8_MMA(1, 1, At, B1); PG8_BAR; PG8_SCHED;
            } else {
            PG8_LDB(B0, 0, 0); PG8_SCHED; PG8_LDA(At, 0, 0); PG8_STAGE(PG8_SA(1, 1), a1 + hstepA, voffA);
            PG8_WAIT_L(8); PG8_BAR; PG8_WAIT_L(0); PG8_MMA(0, 0, At, B0); PG8_BAR; PG8_SCHED;
            PG8_LDB(B1, 0, 1); PG8_STAGE(PG8_SB(0, 0), b2, voffB);
            PG8_BAR; PG8_WAIT_L(0); PG8_MMA(0, 1, At, B1); PG8_BAR;
            PG8_LDA(At, 0, 1); PG8_STAGE(PG8_SA(0, 0), a2, voffA);
            PG8_BAR; PG8_WAIT_L(0); PG8_MMA(1, 0, At, B0); PG8_BAR; PG8_SCHED;
            PG8_STAGE(PG8_SB(0, 1), b2 + hstep, voffB);
            PG8_WAIT_V(6); PG8_BAR; PG8_MMA(1, 1, At, B1); PG8_BAR;
            PG8_LDB(B0, 1, 0); PG8_SCHED; PG8_LDA(At, 1, 0); PG8_STAGE(PG8_SA(0, 1), a2 + hstepA, voffA);
            PG8_WAIT_L(8); PG8_BAR; PG8_WAIT_L(0); PG8_MMA(0, 0, At, B0); PG8_BAR; PG8_SCHED;
            PG8_LDB(B1, 1, 1); PG8_STAGE(PG8_SB(1, 0), b3, voffB);
            PG8_BAR; PG8_WAIT_L(0); PG8_MMA(0, 1, At, B1); PG8_BAR;
            PG8_LDA(At, 1, 1); PG8_STAGE(PG8_SA(1, 0), a3, voffA);
            PG8_BAR; PG8_WAIT_L(0); PG8_MMA(1, 0, At, B0); PG8_BAR; PG8_SCHED;
            PG8_STAGE(PG8_SB(1, 1), b3 + hstep, voffB);
            PG8_WAIT_V(6); PG8_BAR; PG8_MMA(1, 1, At, B1); PG8_BAR;
            }
        }
        if constexpr (FP8) asm volatile("s_nop 15\n\ts_nop 15" ::: "memory");
        if constexpr (ALIGN_EPI) { if (wr == 0) PG8_BAR; }
        if constexpr (!Epi::AFTER_DRAIN) { E(acc, cur, wr, wc, fr, fq); S.done(cur); }
        if (!has_next) break;
#pragma unroll
        for (int a = 0; a < 2; ++a)
#pragma unroll
            for (int b = 0; b < 2; ++b)
#pragma unroll
                for (int m = 0; m < 4; ++m)
#pragma unroll
                    for (int n = 0; n < 2; ++n) acc[a][b][m][n] = (f32x4){0.f, 0.f, 0.f, 0.f};
        cur = nxt; cA = nA; cA2 = nA2; cB = nB; ++ui;
        if constexpr (GATHERA) {
#pragma unroll
            for (int hh = 0; hh < 2; ++hh) { gofc[hh][0] = gofn[hh][0]; gofc[hh][1] = gofn[hh][1]; } }
        if constexpr (ALIGN_EPI) { if (wr == 1) PG8_BAR; }
    }
    PG8_WAIT_V(0);
    if constexpr (!ALIGN_EPI) { if (wr == 0) PG8_BAR; }
    PG8_BAR;
    if constexpr (Epi::AFTER_DRAIN) { E.fused(acc, cur, wr, wc, fr, fq, lds, wid, lane); S.done(cur); }
#undef PG8_AADDR
#undef PG8_GA
#undef PG8_GN
#undef PG8_HA
#undef PG8_SA
#undef PG8_SB
#undef PG8_STAGE
#undef PG8_LDA
#undef PG8_LDB
#undef PG8_MMA
#undef PG8_LD32
#undef PG8_WAIT_V
#undef PG8_WAIT_L
#undef PG8_BAR
#undef PG8_SCHED
}
}
#define GAS __attribute__((address_space(1)))
#define LAS __attribute__((address_space(3)))
typedef unsigned short bf16;
typedef unsigned v4u __attribute__((ext_vector_type(4)));
typedef float f32x4 __attribute__((ext_vector_type(4)));
typedef short bf16x8 __attribute__((ext_vector_type(8)));
typedef GAS unsigned gu32;
typedef GAS unsigned long long gu64;
#define RLX_AGENT __ATOMIC_RELAXED, __HIP_MEMORY_SCOPE_AGENT
#define LDS_WAIT() asm volatile("s_waitcnt lgkmcnt(0)" ::: "memory")
#define VM_WAIT() asm volatile("s_waitcnt vmcnt(0)" ::: "memory")
__device__ __forceinline__ unsigned long long rt() { return __builtin_amdgcn_s_memrealtime(); }
__device__ __forceinline__ unsigned f2bf(float f) { unsigned u = __builtin_bit_cast(unsigned, f); return (u + 0x7fffu + ((u >> 16) & 1u)) >> 16; }
__device__ __forceinline__ unsigned pk2(float lo, float hi) { return f2bf(lo) | (f2bf(hi) << 16); }

#define XB_TMO      128
#define XB_XCNT(j)  (256  + 64 * (j))
#define XB_XSUB(j)  (1280 + 64 * (j))
#define XB_XGEN(j)  (2304 + 64 * (j))
#define XB_TOP      3328
#define XB_TOPGEN   3392
#define XCD_BAR_WORDS 3456
#define XB_SPIN_CAP (1u << 18)

__device__ __forceinline__ unsigned xb_ld(unsigned* p)              { return __hip_atomic_load(p, __ATOMIC_RELAXED, __HIP_MEMORY_SCOPE_AGENT); }
__device__ __forceinline__ unsigned xb_add(unsigned* p, unsigned v) { return __hip_atomic_fetch_add(p, v, __ATOMIC_RELAXED, __HIP_MEMORY_SCOPE_AGENT); }
__device__ __forceinline__ unsigned xb_xcc_id() { return (unsigned)__builtin_amdgcn_s_getreg((3 << 11) | 20) & 0xFu; }
#define XB_SPIN(cond, bar) do { unsigned _sp = 0; while (cond) { __builtin_amdgcn_s_sleep(1); \
    if ((++_sp & 255u) == 0u) { if (xb_ld(&(bar)[XB_TMO])) break; if (_sp > XB_SPIN_CAP) { atomicAdd(&(bar)[XB_TMO], 1u); break; } } } } while (0)

struct XcdBarrier {
    unsigned* bar; unsigned x;
    volatile LAS unsigned* st;
};

__device__ __forceinline__ XcdBarrier xcd_barrier_post(unsigned* bar, volatile LAS unsigned* st) {
    XcdBarrier b; b.bar = bar; b.x = xb_xcc_id(); b.st = st;
    if (threadIdx.x == 0) (void)xb_add(&bar[XB_XCNT(b.x)], 1u);
    return b;
}
__device__ __forceinline__ void xcd_barrier_complete(unsigned* bar, unsigned x, unsigned& nloc, unsigned& nx) {
    const unsigned G = gridDim.x * gridDim.y * gridDim.z;
    unsigned sum, cnt, mine, sp = 0u;
    for (;;) {
        sum = 0u; cnt = 0u; mine = 0u;
#pragma unroll
        for (unsigned j = 0; j < 16; ++j) { const unsigned c = xb_ld(&bar[XB_XCNT(j)]); sum += c; cnt += (c > 0u) ? 1u : 0u; mine = (j == x) ? c : mine; }
        if (sum == G) break;
        __builtin_amdgcn_s_sleep(1);
        if ((++sp & 255u) == 0u) { if (xb_ld(&bar[XB_TMO])) break; if (sp > XB_SPIN_CAP) { atomicAdd(&bar[XB_TMO], 1u); break; } }
    }
    nloc = mine > 0u ? mine : 1u; nx = cnt > 0u ? cnt : 1u;
}

__device__ __forceinline__ void xcd_barrier(const XcdBarrier& b) {
    asm volatile("s_waitcnt vmcnt(0)" ::: "memory");
    __syncthreads();
    if (threadIdx.x == 0) {
        unsigned* bar = b.bar;
        __builtin_amdgcn_s_waitcnt(0);
        unsigned nloc = b.st[0], nx = b.st[1];
        if (nloc == 0u) { xcd_barrier_complete(bar, b.x, nloc, nx); b.st[0] = nloc; b.st[1] = nx; }
        const unsigned old = xb_add(&bar[XB_XSUB(b.x)], 1u);
        const unsigned gen = old / nloc;
        if (old + 1u == (gen + 1u) * nloc) {
            __builtin_amdgcn_fence(__ATOMIC_RELEASE, "agent");
            asm volatile("s_waitcnt vmcnt(0)" ::: "memory");
            const unsigned og = xb_add(&bar[XB_TOP], 1u);
            const unsigned tg = og / nx;
            if (og + 1u == (tg + 1u) * nx) xb_add(&bar[XB_TOPGEN], 1u);
            else XB_SPIN(xb_ld(&bar[XB_TOPGEN]) == tg, bar);
            __builtin_amdgcn_fence(__ATOMIC_ACQUIRE, "agent");
            xb_add(&bar[XB_XGEN(b.x)], 1u);
            asm volatile("s_waitcnt vmcnt(0)" ::: "memory");
        } else {
            XB_SPIN(xb_ld(&bar[XB_XGEN(b.x)]) == gen, bar);
            __builtin_amdgcn_fence(__ATOMIC_ACQUIRE, "agent");
            asm volatile("s_waitcnt vmcnt(0)" ::: "memory");
        }
    }
    __syncthreads();
}

typedef float f32x2 __attribute__((ext_vector_type(2)));
typedef float f32x16 __attribute__((ext_vector_type(16)));
typedef unsigned v2u __attribute__((ext_vector_type(2)));
typedef __bf16 bf16x2_t __attribute__((ext_vector_type(2)));
using pg8::Unit;

constexpr int NWAVES = 8;
#ifndef MK_N_LAUNCHES
#define MK_N_LAUNCHES 1
#endif
constexpr int N_PHASES = 13;
constexpr int N_LAUNCHES = MK_N_LAUNCHES;

constexpr int NB = 32, SEQ = 2048, LC = 256, DM = 1024, NLAT = NB * SEQ, NCTX = NB * LC, NTOK = NLAT + NCTX;
constexpr int NE = 16, CAP = 256, DFF = 1536, NSLOT = NE * NB * CAP;
constexpr int WIN_ROWS = 4864, LORA_N = 2560, LORA_K = 384;
constexpr int KEYS = SEQ + LC;

constexpr size_t MiB = 1u << 20, KiB = 1u << 10;
constexpr size_t WS_CTL = 0, CTL_ZERO_BYTES = 1 * MiB;
constexpr size_t WS_MOD = 1 * MiB;
constexpr size_t WS_WIN = 2 * MiB;
constexpr size_t WS_WLORA = 11 * MiB + 512 * KiB;
constexpr size_t WS_WBRR = 13 * MiB + 512 * KiB;
constexpr size_t WS_WBRA = 14 * MiB + 512 * KiB;
constexpr size_t WS_WOUT = 15 * MiB + 512 * KiB;
constexpr size_t WS_WGU = 17 * MiB + 512 * KiB;
constexpr size_t WS_WD = 113 * MiB + 512 * KiB;
constexpr size_t WS_IDX = 161 * MiB + 512 * KiB;
constexpr size_t WS_VAL = 162 * MiB;
constexpr size_t WS_ZK = 163 * MiB;
constexpr size_t WS_ZV = 235 * MiB;
constexpr size_t WS_ZR = 307 * MiB;
constexpr size_t WS_Q = 371 * MiB;
constexpr size_t WS_KQ = 435 * MiB;
constexpr size_t WS_VQ = 453 * MiB;
constexpr size_t WS_XCH = 453 * MiB;
constexpr size_t WS_YB = 959 * MiB;
constexpr size_t WS_LA = 471 * MiB;
constexpr size_t WS_H1 = 525 * MiB;
constexpr size_t WS_EW = 525 * MiB;
constexpr size_t WS_ORW = 525 * MiB;
constexpr size_t WS_AS = 669 * MiB;
constexpr size_t WS_G = 813 * MiB;
constexpr size_t WS_VT = 877 * MiB;
constexpr size_t WS_YF = 895 * MiB;
constexpr size_t WS_MERGED = 163 * MiB;
constexpr size_t WS_INV = 163 * MiB;
constexpr size_t WS_XE = 167 * MiB;
constexpr size_t WS_Y2 = 167 * MiB;
constexpr size_t WS_H2 = 167 * MiB;
constexpr size_t WS_AFF = 551 * MiB;
constexpr size_t WS_ACT = 423 * MiB;
constexpr size_t WS_H2Q = 700 * MiB;
constexpr float W_SCALE = 32.0f, ACT_SCALE = 8.0f;
constexpr size_t WS_DELTA = 807 * MiB;
constexpr size_t WS_END = 1023 * MiB;
constexpr int CW_BAR = 4096;

constexpr int RING_BYTES = 131072;
constexpr int LDSCTL_OFF = 147456 - 1024, MISC_OFF = LDSCTL_OFF + 320;
static_assert(33 * 1024 * 4 <= LDSCTL_OFF, "P0's silu(c) image must stay below the LDS control words");
constexpr int LDS_BYTES = 147456;

__device__ __forceinline__ unsigned pkbf(float lo, float hi) { f32x2 v = {lo, hi}; return __builtin_bit_cast(unsigned, __builtin_convertvector(v, bf16x2_t)); }
__device__ __forceinline__ unsigned pk4f8(float a, float b, float c, float d) {
    a = __builtin_amdgcn_fmed3f(a, -448.f, 448.f); b = __builtin_amdgcn_fmed3f(b, -448.f, 448.f); c = __builtin_amdgcn_fmed3f(c, -448.f, 448.f); d = __builtin_amdgcn_fmed3f(d, -448.f, 448.f);
    int r = __builtin_amdgcn_cvt_pk_fp8_f32(a, b, 0, false); r = __builtin_amdgcn_cvt_pk_fp8_f32(c, d, r, true); return (unsigned)r; }
__device__ __forceinline__ float bflo(unsigned u) { return __uint_as_float(u << 16); }
__device__ __forceinline__ float bfhi(unsigned u) { return __uint_as_float(u & 0xffff0000u); }
__device__ __forceinline__ float bf1(bf16 h) { return __uint_as_float(((unsigned)h) << 16); }
__device__ __forceinline__ float sigmoidf_(float x) { return __builtin_amdgcn_rcpf(1.0f + __builtin_amdgcn_exp2f(-1.4426950408889634f * x)); }
__device__ __forceinline__ float tanhf_(float x) { return 1.0f - 2.0f * __builtin_amdgcn_rcpf(__builtin_amdgcn_exp2f(2.8853900817779268f * x) + 1.0f); }
__device__ __forceinline__ float wave_sum(float v) {
    int x = __float_as_int(v);
#define WS_DPP(ctrl, rmask) x = __float_as_int(__int_as_float(x) + __int_as_float(__builtin_amdgcn_update_dpp(0, x, ctrl, rmask, 0xf, false)))
    WS_DPP(0x111, 0xf); WS_DPP(0x112, 0xf); WS_DPP(0x114, 0xf); WS_DPP(0x118, 0xf); WS_DPP(0x142, 0xa); WS_DPP(0x143, 0xc);
#undef WS_DPP
    return __int_as_float(__builtin_amdgcn_readlane(x, 63));
}
__device__ __forceinline__ void unpack8(const v4u w, float (&f)[8]) {
    f[0] = bflo(w.x); f[1] = bfhi(w.x); f[2] = bflo(w.y); f[3] = bfhi(w.y); f[4] = bflo(w.z); f[5] = bfhi(w.z); f[6] = bflo(w.w); f[7] = bfhi(w.w);
}
__device__ __forceinline__ v4u pack8(const float (&f)[8]) { v4u w; w.x = pkbf(f[0], f[1]); w.y = pkbf(f[2], f[3]); w.z = pkbf(f[4], f[5]); w.w = pkbf(f[6], f[7]); return w; }

struct Frame {
    LAS unsigned char* lds;
    volatile LAS unsigned* MISC;
    gu32* ctl;
    int tid, lane, wave, G;
    float* out; unsigned char* ws;
};
enum { I_X = 0, I_C, I_CTX, I_CCTX, I_ADAW, I_ADAB, I_N1G, I_N2G, I_WIN, I_CONV, I_W0, I_W2, I_A0, I_A2, I_KK, I_KA, I_RK, I_G2, I_LNW, I_LNB, I_QG, I_KG, I_SINK,
       I_WBRR, I_WBRA, I_WOUT, I_ROUTER, I_EG, I_EU, I_ED };
typedef const __attribute__((address_space(4))) unsigned char* kptr_t;
__device__ __forceinline__ const float* karg_in(int i) { kptr_t kp = (kptr_t)__builtin_amdgcn_kernarg_segment_ptr(); asm volatile("" : "+s"(kp)); return *(const float* const __attribute__((address_space(4)))*)(kp + 8 * i); }

__device__ __forceinline__ void transpose_item(const float* W, int N, int k0, int n0, bf16* WT, int Kd, int drow0, LAS float* scr, int lane) {
#pragma unroll 8
    for (int i = 0; i < 32; ++i) { const int kk = 2 * i + (lane >> 5); scr[kk * 33 + (lane & 31)] = W[(size_t)(k0 + kk) * N + n0 + (lane & 31)]; }
    LDS_WAIT(); asm volatile("" ::: "memory");
    const int c = lane & 7;
#pragma unroll
    for (int j = 0; j < 4; ++j) { const int n = (lane >> 3) + 8 * j; const LAS float* s = scr + (8 * c) * 33 + n;
        v4u o; o.x = pkbf(s[0 * 33], s[1 * 33]); o.y = pkbf(s[2 * 33], s[3 * 33]); o.z = pkbf(s[4 * 33], s[5 * 33]); o.w = pkbf(s[6 * 33], s[7 * 33]);
        *(GAS v4u*)(WT + (size_t)(drow0 + n) * Kd + k0 + 8 * c) = o; }
    LDS_WAIT(); asm volatile("" ::: "memory");
}
__device__ __forceinline__ void transpose_item_f8(const float* W, int N, int k0, int n0, unsigned char* WT, int Kd, int drow0, LAS float* scr, int lane, float scale) {
#pragma unroll 8
    for (int i = 0; i < 32; ++i) { const int kk = 2 * i + (lane >> 5); scr[kk * 33 + (lane & 31)] = W[(size_t)(k0 + kk) * N + n0 + (lane & 31)]; }
    LDS_WAIT(); asm volatile("" ::: "memory");
    const int c = lane & 7;
#pragma unroll
    for (int j = 0; j < 4; ++j) { const int n = (lane >> 3) + 8 * j; const LAS float* s = scr + (8 * c) * 33 + n;
        v2u o; o.x = pk4f8(s[0 * 33] * scale, s[1 * 33] * scale, s[2 * 33] * scale, s[3 * 33] * scale); o.y = pk4f8(s[4 * 33] * scale, s[5 * 33] * scale, s[6 * 33] * scale, s[7 * 33] * scale);
        *(GAS v2u*)(WT + (size_t)(drow0 + n) * Kd + k0 + 8 * c) = o; }
    LDS_WAIT(); asm volatile("" ::: "memory");
}
__device__ __forceinline__ int win_dest_block(int sb) {
    if (sb < 4) return 13 + sb;
    if (sb < 8) return sb - 4;
    if (sb < 12) return sb - 4;
    if (sb == 12) return 8;
    if (sb == 13) return 9;
    if (sb == 14) return 10;
    if (sb < 19) return sb + 2;
    if (sb == 19) return 11;
    if (sb == 20) return 12;
    return sb;
}
__device__ __forceinline__ void p0_prologue(Frame& F) {
    if (blockIdx.x < 96) {
        LAS float* cs = (LAS float*)F.lds;
        const float* c = karg_in(I_C); const float* cc = karg_in(I_CCTX);
        for (int i = F.tid; i < 33 * 1024; i += 512) { const float v = i < 32 * 1024 ? c[i] : cc[i - 32 * 1024]; cs[i] = v * sigmoidf_(v); }
        __syncthreads();
        const int col = blockIdx.x * 64 + F.lane; const float* aw = karg_in(I_ADAW);
        float acc[33];
#pragma unroll
        for (int b = 0; b < 33; ++b) acc[b] = 0.f;
        const int kbeg = F.wave * 128;
        for (int k = kbeg; k < kbeg + 128; k += 4) {
            const float w0 = aw[(size_t)(k + 0) * 6144 + col], w1 = aw[(size_t)(k + 1) * 6144 + col], w2 = aw[(size_t)(k + 2) * 6144 + col], w3 = aw[(size_t)(k + 3) * 6144 + col];
#pragma unroll
            for (int b = 0; b < 33; ++b) { const f32x4 cv = *(const LAS f32x4*)(cs + b * 1024 + k); acc[b] += cv.x * w0 + cv.y * w1 + cv.z * w2 + cv.w * w3; }
        }
        __syncthreads();
        LAS float* red = (LAS float*)F.lds;
#pragma unroll
        for (int b = 0; b < 33; ++b) red[(F.wave * 33 + b) * 64 + F.lane] = acc[b];
        __syncthreads();
        float* mod = (float*)(F.ws + WS_MOD); const float* ab = karg_in(I_ADAB);
        for (int i = F.tid; i < 33 * 64; i += 512) { const int b = i >> 6, l = i & 63; float s = 0.f;
#pragma unroll
            for (int w = 0; w < 8; ++w) s += red[(w * 33 + b) * 64 + l];
            mod[(size_t)b * 6144 + blockIdx.x * 64 + l] = s + ab[blockIdx.x * 64 + l]; }
        __syncthreads();
    }
    LAS float* scr = (LAS float*)(F.lds + F.wave * 16384);
    const int gw = blockIdx.x * NWAVES + F.wave, NGW = F.G * NWAVES;
    constexpr int IT_WIN = 16 * 148, IT_G = 16 * 768, IT_BR = 256, IT_OUT = 512;
    constexpr int NITEMS = IT_WIN + 3 * IT_G + 2 * IT_BR + IT_OUT;
    bf16* WIN = (bf16*)(F.ws + WS_WIN); unsigned char* WGU = F.ws + WS_WGU; unsigned char* WD = F.ws + WS_WD;
    for (int it = gw; it < NITEMS; it += NGW) {
        int r = it;
        if (r < IT_WIN) { const int kb = r / 148, nb = r % 148, n0 = 32 * nb; const int db = win_dest_block(n0 >> 7);
            transpose_item(karg_in(I_WIN), 4736, 64 * kb, n0, WIN, 1024, db * 128 + (n0 & 127), scr, F.lane); continue; }
        r -= IT_WIN;
        if (r < IT_G) { const int e = r / 768, q = r % 768, kb = q / 48, nb = q % 48, n0 = 32 * nb;
            transpose_item_f8(karg_in(I_EG) + (size_t)e * 1024 * 1536, 1536, 64 * kb, n0, WGU, 1024, e * 3072 + 256 * (n0 >> 7) + (n0 & 127), scr, F.lane, W_SCALE); continue; }
        r -= IT_G;
        if (r < IT_G) { const int e = r / 768, q = r % 768, kb = q / 48, nb = q % 48, n0 = 32 * nb;
            transpose_item_f8(karg_in(I_EU) + (size_t)e * 1024 * 1536, 1536, 64 * kb, n0, WGU, 1024, e * 3072 + 256 * (n0 >> 7) + 128 + (n0 & 127), scr, F.lane, W_SCALE); continue; }
        r -= IT_G;
        if (r < IT_G) { const int e = r / 768, q = r % 768, kb = q / 32, nb = q % 32, n0 = 32 * nb;
            transpose_item_f8(karg_in(I_ED) + (size_t)e * 1536 * 1024, 1024, 64 * kb, n0, WD, 1536, e * 1024 + n0, scr, F.lane, W_SCALE); continue; }
        r -= IT_G;
        if (r < IT_BR) { const int kb = r / 32, nb = r % 32; transpose_item(karg_in(I_WBRR), 1024, 64 * kb, 32 * nb, (bf16*)(F.ws + WS_WBRR), 1024, 32 * nb, scr, F.lane); continue; }
        r -= IT_BR;
        if (r < IT_BR) { const int kb = r / 32, nb = r % 32; transpose_item(karg_in(I_WBRA), 1024, 64 * kb, 32 * nb, (bf16*)(F.ws + WS_WBRR) + 512, 1024, 32 * nb, scr, F.lane); continue; }
        r -= IT_BR;
        { const int kb = r / 32, nb = r % 32; transpose_item(karg_in(I_WOUT), 1024, 64 * kb, 32 * nb, (bf16*)(F.ws + WS_WOUT), 1024, 32 * nb, scr, F.lane); }
    }
    const int gt = blockIdx.x * 512 + F.tid, NGT = F.G * 512;
    for (int i = gt; i < 128 * 1024 / 8; i += NGT) *(GAS v4u*)(WIN + (size_t)4736 * 1024 + (size_t)i * 8) = (v4u){0u, 0u, 0u, 0u};
    { bf16* WL = (bf16*)(F.ws + WS_WLORA); const float* w2 = karg_in(I_W2); const float* a2 = karg_in(I_A2); const float* g2 = karg_in(I_G2);
      for (int i = gt; i < LORA_N * (LORA_K / 8); i += NGT) { const int n = i / (LORA_K / 8), k8 = (i % (LORA_K / 8)) * 8; const int rg = n >> 9, col = n & 511; float f[8];
#pragma unroll
          for (int j = 0; j < 8; ++j) { const int k = k8 + j; float v = 0.f;
              if (rg == 0) { if (k < 64) v = w2[(size_t)k * 512 + col]; }
              else if (rg == 1) { if (k >= 64 && k < 128) v = w2[(size_t)(64 + k - 64) * 512 + col]; }
              else if (rg == 2) { if (k >= 128 && k < 192) v = a2[(size_t)(k - 128) * 512 + col]; }
              else if (rg == 3) { if (k >= 192 && k < 256) v = a2[(size_t)(64 + k - 192) * 512 + col]; }
              else { if (k >= 256) v = g2[(size_t)(k - 256) * 512 + col]; }
              f[j] = v; }
          *(GAS v4u*)(WL + (size_t)n * LORA_K + k8) = pack8(f); } }
}

__device__ __forceinline__ void p1_norm1(Frame& F) {
    const int gw = blockIdx.x * NWAVES + F.wave, NGW = F.G * NWAVES;
    const float* mod = (const float*)(F.ws + WS_MOD); bf16* H1 = (bf16*)(F.ws + WS_H1);
    const float* g1 = karg_in(I_N1G); const float* Xp = karg_in(I_X); const float* CTXp = karg_in(I_CTX);
    f32x4 gv[4];
#pragma unroll
    for (int j = 0; j < 4; ++j) gv[j] = *(const f32x4*)(g1 + 4 * F.lane + 256 * j);
    for (int m0 = gw; m0 < NTOK; m0 += 4 * NGW) {
        f32x4 v[4][4]; float s[4];
#pragma unroll
        for (int r = 0; r < 4; ++r) { const int m = min(m0 + r * NGW, NTOK - 1); s[r] = 0.f;
            const float* xr = m < NLAT ? Xp + (size_t)m * DM : CTXp + (size_t)(m - NLAT) * DM;
#pragma unroll
            for (int j = 0; j < 4; ++j) v[r][j] = *(const GAS f32x4*)(xr + 4 * F.lane + 256 * j); }
#pragma unroll
        for (int r = 0; r < 4; ++r) { const int m = m0 + r * NGW;
            if (m < NTOK) {
#pragma unroll
                for (int j = 0; j < 4; ++j) s[r] += (v[r][j].x * v[r][j].x + v[r][j].y * v[r][j].y) + (v[r][j].z * v[r][j].z + v[r][j].w * v[r][j].w);
                const float rstd = __builtin_amdgcn_rsqf(wave_sum(s[r]) * (1.f / DM) + 1e-6f);
                const int mb = m < NLAT ? (m >> 11) : 32; const float* sh = mod + (size_t)mb * 6144; const float* sc = sh + 1024;
#pragma unroll
                for (int j = 0; j < 4; ++j) { const f32x4 a = *(const f32x4*)(sc + 4 * F.lane + 256 * j), bsh = *(const f32x4*)(sh + 4 * F.lane + 256 * j);
                    const f32x4 y = v[r][j] * rstd * gv[j] * (a + 1.0f) + bsh;
                    v2u o; o.x = pkbf(y.x, y.y); o.y = pkbf(y.z, y.w);
                    *(GAS v2u*)(H1 + (size_t)m * DM + 4 * F.lane + 256 * j) = o; } } }
    }
}

struct InprojOrder {
    pg8::StaticOrder so; int G, c;
    __device__ void init(int G_, int c_) { so.init(NLAT, WIN_ROWS, G_, c_); G = G_; c = c_; }
    __device__ bool next(int i, Unit& u) const {
        long L = (long)i * G + c; if (L < 4864) return so.next(i, u);
        L -= 4864; if (L >= 224) return false; u.pm = 256 + (int)(L % 32); u.pn = (int)(L / 32); return true; }
    __device__ __forceinline__ void a_ready(const Unit&) const {}
    __device__ __forceinline__ void done(const Unit&) const {}
};
struct EpiInproj {
    static constexpr bool PERM = true, AFTER_DRAIN = false;
    bf16 *zk, *zv, *zr, *q, *kq, *vq, *la, *gates;
    __device__ __forceinline__ void operator()(const f32x4 (&acc)[2][2][4][2], const Unit& u, int wr, int wc, int fr, int fq) const {
        const int row0 = u.pm * 256 + wr * 64 + fr; const bool isctx = u.pm >= 256;
#pragma unroll
        for (int bj = 0; bj < 2; ++bj) {
            const int c128 = 2 * u.pn + bj; bf16* base = nullptr; int pitch = 0, act = 0; bool ok = true;
            if (c128 < 4) { base = zk + c128 * 128; pitch = 512; }
            else if (c128 < 8) { base = zv + (c128 - 4) * 128; pitch = 512; }
            else if (c128 < 11) { base = la + (c128 - 8) * 128; pitch = 384; act = (c128 == 8) ? 1 : ((c128 == 10) ? 2 : 0); }
            else if (c128 == 11) { base = kq; pitch = 128; }
            else if (c128 == 12) { base = vq; pitch = 128; }
            else if (c128 < 17) { base = zr + (c128 - 13) * 128; pitch = 512; ok = !isctx; }
            else if (c128 < 21) { base = q + (c128 - 17) * 128; pitch = 512; ok = !isctx; }
            else if (c128 < 37) { base = gates + (c128 - 21) * 128; pitch = 2048; act = 2; ok = !isctx; }
            else ok = false;
            if (ok) {
#pragma unroll
                for (int ai = 0; ai < 2; ++ai)
#pragma unroll
                    for (int m = 0; m < 4; ++m) {
                        f32x4 v0 = acc[ai][bj][m][0], v1 = acc[ai][bj][m][1];
                        if (act == 1) { v0.x = tanhf_(v0.x); v0.y = tanhf_(v0.y); v0.z = tanhf_(v0.z); v0.w = tanhf_(v0.w); v1.x = tanhf_(v1.x); v1.y = tanhf_(v1.y); v1.z = tanhf_(v1.z); v1.w = tanhf_(v1.w); }
                        else if (act == 2) { v0.x = sigmoidf_(v0.x); v0.y = sigmoidf_(v0.y); v0.z = sigmoidf_(v0.z); v0.w = sigmoidf_(v0.w); v1.x = sigmoidf_(v1.x); v1.y = sigmoidf_(v1.y); v1.z = sigmoidf_(v1.z); v1.w = sigmoidf_(v1.w); }
                        v4u w; w.x = pkbf(v0.x, v0.y); w.y = pkbf(v0.z, v0.w); w.z = pkbf(v1.x, v1.y); w.w = pkbf(v1.z, v1.w);
                        *(GAS v4u*)(base + (size_t)(row0 + ai * 128 + m * 16) * pitch + wc * 32 + 8 * fq) = w;
                    }
            }
        }
    }
};

constexpr int LORA_LP = 144;
template <int NKS> __device__ __forceinline__ void lora_item(const bf16* LA, const bf16* WL, bf16* outp, const float* bias, float scale, int act, int tile, int rg, int kbase, int lane, LAS unsigned char* st) {
    const int l32 = lane & 31, hi = lane >> 5;
    bf16x8 xf[2][NKS];
#pragma unroll
    for (int s2 = 0; s2 < 2; ++s2)
#pragma unroll
        for (int ks = 0; ks < NKS; ++ks) xf[s2][ks] = *(const GAS bf16x8*)(LA + (size_t)(tile * 64 + s2 * 32 + l32) * LORA_K + kbase + 16 * ks + 8 * hi);
    bf16x8 wf[NKS], wn[NKS];
    { const bf16* wp = WL + (size_t)(rg * 512 + l32) * LORA_K + kbase + 8 * hi;
#pragma unroll
      for (int ks = 0; ks < NKS; ++ks) wf[ks] = *(const GAS bf16x8*)(wp + 16 * ks); }
#pragma unroll 1
    for (int np = 0; np < 8; ++np) {
#pragma unroll
        for (int nh = 0; nh < 2; ++nh) { const int nt = 2 * np + nh;
            f32x16 acc0, acc1;
#pragma unroll
            for (int r = 0; r < 16; ++r) { acc0[r] = 0.f; acc1[r] = 0.f; }
            { const int ntn = nt < 15 ? nt + 1 : 15; const bf16* wp = WL + (size_t)(rg * 512 + ntn * 32 + l32) * LORA_K + kbase + 8 * hi;
#pragma unroll
              for (int ks = 0; ks < NKS; ++ks) wn[ks] = *(const GAS bf16x8*)(wp + 16 * ks); }
#pragma unroll
            for (int ks = 0; ks < NKS; ++ks) { acc0 = __builtin_amdgcn_mfma_f32_32x32x16_bf16(wf[ks], xf[0][ks], acc0, 0, 0, 0); acc1 = __builtin_amdgcn_mfma_f32_32x32x16_bf16(wf[ks], xf[1][ks], acc1, 0, 0, 0); }
#pragma unroll
            for (int ks = 0; ks < NKS; ++ks) wf[ks] = wn[ks];
#pragma unroll
            for (int r4 = 0; r4 < 4; ++r4) { const int col = nt * 32 + 8 * r4 + 4 * hi;
                f32x4 bv = (f32x4){0.f, 0.f, 0.f, 0.f}; if (act) bv = *(const f32x4*)(bias + col);
                f32x4 v0 = (f32x4){acc0[4 * r4], acc0[4 * r4 + 1], acc0[4 * r4 + 2], acc0[4 * r4 + 3]} + bv, v1 = (f32x4){acc1[4 * r4], acc1[4 * r4 + 1], acc1[4 * r4 + 2], acc1[4 * r4 + 3]} + bv;
                if (act) { v0.x = scale * sigmoidf_(v0.x); v0.y = scale * sigmoidf_(v0.y); v0.z = scale * sigmoidf_(v0.z); v0.w = scale * sigmoidf_(v0.w);
                           v1.x = scale * sigmoidf_(v1.x); v1.y = scale * sigmoidf_(v1.y); v1.z = scale * sigmoidf_(v1.z); v1.w = scale * sigmoidf_(v1.w); }
                v2u o0, o1; o0.x = pkbf(v0.x, v0.y); o0.y = pkbf(v0.z, v0.w); o1.x = pkbf(v1.x, v1.y); o1.y = pkbf(v1.z, v1.w);
                const int lc = (32 * nh + 8 * r4 + 4 * hi) * 2;
                *(LAS v2u*)(st + l32 * LORA_LP + lc) = o0; *(LAS v2u*)(st + 32 * LORA_LP + l32 * LORA_LP + lc) = o1; }
        }
#pragma unroll
        for (int i = 0; i < 8; ++i) { const int row = 8 * i + (lane >> 3);
            const v4u w = *(const LAS v4u*)(st + row * LORA_LP + (lane & 7) * 16);
            *(GAS v4u*)(outp + (size_t)(tile * 64 + row) * 512 + np * 64 + (lane & 7) * 8) = w; }
    }
}
__device__ __forceinline__ void p3a_lora(Frame& F) {
    const bf16* LA = (const bf16*)(F.ws + WS_LA); const bf16* WL = (const bf16*)(F.ws + WS_WLORA);
    bf16* EW = (bf16*)(F.ws + WS_EW); bf16* AS = (bf16*)(F.ws + WS_AS); bf16* G = (bf16*)(F.ws + WS_G);
    const float* w0 = karg_in(I_W0); const float* a0 = karg_in(I_A0);
    const int gw = blockIdx.x * NWAVES + F.wave, NGW = F.G * NWAVES;
    LAS unsigned char* st = F.lds + 16384 + F.wave * (64 * LORA_LP);
    for (int item = gw; item < (NTOK / 64) * 5; item += NGW) {
        const int rg = item % 5, tile = item / 5;
        if (rg == 4) { if (tile < NLAT / 64) lora_item<8>(LA, WL, G, nullptr, 1.0f, 0, tile, 4, 256, F.lane, st); }
        else if (rg < 2) lora_item<4>(LA, WL, EW + (size_t)rg * NTOK * 512, w0 + rg * 512, 0.60653066f, 1, tile, rg, 64 * rg, F.lane, st);
        else lora_item<4>(LA, WL, AS + (size_t)(rg - 2) * NTOK * 512, a0 + (rg - 2) * 512, 1.0f, 1, tile, rg, 64 * rg, F.lane, st);
    }
}

__device__ __forceinline__ void p3b_attn_prep(Frame& F) {
    LAS float* tab = (LAS float*)F.lds;
    for (int i = F.tid; i < 1024; i += 512) { const int pos = i >> 4, fi = i & 15;
        const float invf = exp2f(-(float)fi * (13.287712379549449f / 16.0f));
        const float ang = (float)pos * invf; tab[2 * i] = cosf(ang); tab[2 * i + 1] = sinf(ang); }
    __syncthreads();
    const int gw = blockIdx.x * NWAVES + F.wave, NGW = F.G * NWAVES, lane = F.lane;
    {
        bf16* Q = (bf16*)(F.ws + WS_Q); const float* qg = karg_in(I_QG);
        const int sub = lane & 7; float gq[8];
#pragma unroll
        for (int j = 0; j < 8; ++j) gq[j] = qg[8 * sub + j];
        const float qscale = 0.125f * 1.4426950408889634f;
        for (int m0 = gw; m0 < NLAT; m0 += 4 * NGW) {
            v4u raw[4];
#pragma unroll
            for (int r = 0; r < 4; ++r) { const int m = min(m0 + r * NGW, NLAT - 1); raw[r] = *(const GAS v4u*)(Q + (size_t)m * 512 + 8 * lane); }
#pragma unroll
            for (int r = 0; r < 4; ++r) { const int m = m0 + r * NGW; if (m >= NLAT) continue;
                const int t = m & 2047; GAS v4u* p = (GAS v4u*)(Q + (size_t)m * 512 + 8 * lane);
                float y[8]; unpack8(raw[r], y); float ss = 0.f;
#pragma unroll
                for (int j = 0; j < 8; ++j) ss += y[j] * y[j];
                ss += __shfl_xor(ss, 1); ss += __shfl_xor(ss, 2); ss += __shfl_xor(ss, 4);
                const float rstd = __builtin_amdgcn_rsqf(ss * (1.f / 64.f) + 1e-6f);
                const int pos = (sub < 4) ? (t >> 6) : (t & 63); const bool second = (sub & 2) != 0; float o[8];
#pragma unroll
                for (int j = 0; j < 8; ++j) { y[j] = y[j] * rstd * gq[j]; }
#pragma unroll
                for (int j = 0; j < 8; ++j) { const float yp = __shfl_xor(y[j], 2); const int fi = 8 * (sub & 1) + j; const float cs = tab[(pos * 16 + fi) * 2], sn = tab[(pos * 16 + fi) * 2 + 1];
                    o[j] = (second ? (yp * sn + y[j] * cs) : (y[j] * cs - yp * sn)) * qscale; }
                *p = pack8(o); }
        }
    }
    {
        bf16* KQ = (bf16*)(F.ws + WS_KQ); const float* kg = karg_in(I_KG);
        const int l32 = lane & 31; const float g0 = kg[2 * l32], g1 = kg[2 * l32 + 1];
        for (int m0 = gw; m0 < NTOK; m0 += 4 * NGW) {
            unsigned raw[4];
#pragma unroll
            for (int r = 0; r < 4; ++r) { const int m = min(m0 + r * NGW, NTOK - 1); raw[r] = *(const GAS unsigned*)(KQ + (size_t)m * 128 + 2 * lane); }
#pragma unroll
            for (int r = 0; r < 4; ++r) { const int m = m0 + r * NGW; if (m >= NTOK) continue;
                GAS unsigned* p = (GAS unsigned*)(KQ + (size_t)m * 128 + 2 * lane); const unsigned w = raw[r];
                float y0 = bflo(w), y1 = bfhi(w); float ss = y0 * y0 + y1 * y1;
                ss += __shfl_xor(ss, 1); ss += __shfl_xor(ss, 2); ss += __shfl_xor(ss, 4); ss += __shfl_xor(ss, 8); ss += __shfl_xor(ss, 16);
                const float rstd = __builtin_amdgcn_rsqf(ss * (1.f / 64.f) + 1e-6f);
                y0 = y0 * rstd * g0; y1 = y1 * rstd * g1;
                const float p0 = __shfl_xor(y0, 8), p1 = __shfl_xor(y1, 8);
                if (m < NLAT) { const int t = m & 2047; const int pos = (l32 < 16) ? (t >> 6) : (t & 63); const bool second = (l32 & 8) != 0; const int fi0 = (2 * l32) & 15;
                    const float c0 = tab[(pos * 16 + fi0) * 2], s0 = tab[(pos * 16 + fi0) * 2 + 1], c1 = tab[(pos * 16 + fi0 + 1) * 2], s1 = tab[(pos * 16 + fi0 + 1) * 2 + 1];
                    const float o0 = second ? (p0 * s0 + y0 * c0) : (y0 * c0 - p0 * s0), o1 = second ? (p1 * s1 + y1 * c1) : (y1 * c1 - p1 * s1);
                    y0 = o0; y1 = o1; }
                *p = pkbf(y0, y1); }
        }
    }
    {
        const bf16* VQ = (const bf16*)(F.ws + WS_VQ); bf16* VT = (bf16*)(F.ws + WS_VT);
        const int gt = blockIdx.x * 512 + F.tid, NGT = F.G * 512;
        for (int i = gt; i < NB * 2 * (KEYS / 8) * 64; i += NGT) { const int d = i & 63, kg8 = (i >> 6) % (KEYS / 8), bh = (i >> 6) / (KEYS / 8), b = bh >> 1, hk = bh & 1;
            float f[8];
#pragma unroll
            for (int j = 0; j < 8; ++j) { const int key = kg8 * 8 + j; const size_t row = key < SEQ ? (size_t)b * SEQ + key : (size_t)NLAT + b * LC + (key - SEQ); f[j] = bf1(VQ[row * 128 + hk * 64 + d]); }
            *(GAS v4u*)(VT + ((size_t)bh * 64 + d) * KEYS + kg8 * 8) = pack8(f); }
    }
}

__device__ __forceinline__ int key_perm(int i) { const int r = 4 * (i >> 3) + (i & 3), hi = (i >> 2) & 1; return 8 * hi + r + (r >= 8 ? 8 : 0); }
__device__ __forceinline__ void attn_tile(const bf16x8 (&kf)[4], const bf16x8 (&vf)[4], const bf16x8 (&qf)[4], f32x16& o0, f32x16& o1, float& mrun, float& lrun, int mask, int l32, int hi) {
    f32x16 s;
#pragma unroll
    for (int r = 0; r < 16; ++r) s[r] = 0.f;
#pragma unroll
    for (int ks = 0; ks < 4; ++ks) s = __builtin_amdgcn_mfma_f32_32x32x16_bf16(kf[ks], qf[ks], s, 0, 0, 0);
    if (mask) {
#pragma unroll
        for (int r = 0; r < 16; ++r) { const int kk = 8 * hi + r + (r >= 8 ? 8 : 0); const bool ok = (mask == 1) ? (kk >= l32) : (kk <= l32); s[r] = ok ? s[r] : -1e30f; }
    }
    float mx = s[0];
#pragma unroll
    for (int r = 1; r < 16; ++r) mx = fmaxf(mx, s[r]);
    mx = fmaxf(mx, __shfl_xor(mx, 32));
    const float mnew = fmaxf(mrun, mx), alpha = __builtin_amdgcn_exp2f(mrun - mnew);
    float ps = 0.f; float p[16];
#pragma unroll
    for (int r = 0; r < 16; ++r) { p[r] = __builtin_amdgcn_exp2f(s[r] - mnew); ps += p[r]; }
    lrun = lrun * alpha + ps; mrun = mnew;
#pragma unroll
    for (int r = 0; r < 16; ++r) { o0[r] *= alpha; o1[r] *= alpha; }
    v4u pa, pb; pa.x = pkbf(p[0], p[1]); pa.y = pkbf(p[2], p[3]); pa.z = pkbf(p[4], p[5]); pa.w = pkbf(p[6], p[7]);
    pb.x = pkbf(p[8], p[9]); pb.y = pkbf(p[10], p[11]); pb.z = pkbf(p[12], p[13]); pb.w = pkbf(p[14], p[15]);
    const bf16x8 pa8 = __builtin_bit_cast(bf16x8, pa), pb8 = __builtin_bit_cast(bf16x8, pb);
    o0 = __builtin_amdgcn_mfma_f32_32x32x16_bf16(vf[0], pa8, o0, 0, 0, 0);
    o0 = __builtin_amdgcn_mfma_f32_32x32x16_bf16(vf[1], pb8, o0, 0, 0, 0);
    o1 = __builtin_amdgcn_mfma_f32_32x32x16_bf16(vf[2], pa8, o1, 0, 0, 0);
    o1 = __builtin_amdgcn_mfma_f32_32x32x16_bf16(vf[3], pb8, o1, 0, 0, 0);
}
constexpr int AT_KP = 144, AT_VP = 80, AT_KB = 32 * AT_KP, AT_VB = 64 * AT_VP, AT_BUF = AT_KB + AT_VB;
__device__ __forceinline__ void p4a_attention(Frame& F, bool dostore = true) {
    bf16* Q = (bf16*)(F.ws + WS_Q); const bf16* KQ = (const bf16*)(F.ws + WS_KQ); const bf16* VT = (const bf16*)(F.ws + WS_VT);
    const float* sink = karg_in(I_SINK);
    const int tid = F.tid, lane = F.lane, l32 = lane & 31, hi = lane >> 5;
    const int kperm = key_perm(l32);
    LAS unsigned char* lb = F.lds;
    const bool kpart = tid < 256; const int tt = tid & 255;
    const int skey = tt >> 3, skc = tt & 7, sd = tt >> 2, svc = tt & 3;
    const int sdst = kpart ? (skey * AT_KP + skc * 16) : (AT_KB + sd * AT_VP + svc * 16);
    for (int unit = blockIdx.x; unit < NB * 2 * 16; unit += F.G) {
        const int b = unit >> 5, hk = (unit >> 4) & 1, qb = unit & 15;
        const int g = F.wave >> 1, half = F.wave & 1, h = hk * 4 + g;
        const float sink2 = sink[h] * 1.4426950408889634f;
        const int tq0 = qb * 128 + half * 64;
        const size_t qrow = (size_t)b * SEQ + tq0 + l32;
        bf16x8 qf0[4], qf1[4];
#pragma unroll
        for (int ks = 0; ks < 4; ++ks) { qf0[ks] = *(const GAS bf16x8*)(Q + qrow * 512 + h * 64 + 16 * ks + 8 * hi); qf1[ks] = *(const GAS bf16x8*)(Q + (qrow + 32) * 512 + h * 64 + 16 * ks + 8 * hi); }
        float m0 = sink2, m1 = sink2, l0 = hi == 0 ? 1.0f : 0.0f, l1 = l0;
        f32x16 oa0, oa1, ob0, ob1;
#pragma unroll
        for (int r = 0; r < 16; ++r) { oa0[r] = 0.f; oa1[r] = 0.f; ob0[r] = 0.f; ob1[r] = 0.f; }
        const bf16* vsrc0 = VT + ((size_t)(b * 2 + hk) * 64 + sd) * KEYS + 8 * svc;
        const bf16* ksrc0 = KQ + (size_t)skey * 128 + hk * 64 + 8 * skc;
#define AT_SRC(s_, ptr_) do { int key0_; size_t krow_; if ((s_) < 8) { key0_ = SEQ + 32 * (s_); krow_ = (size_t)NLAT + b * LC + 32 * (s_); } \
            else { int kp_ = qb * 128 - 128 + 32 * ((s_) - 8); kp_ = (kp_ >= 0 && kp_ < SEQ) ? kp_ : 0; key0_ = kp_; krow_ = (size_t)b * SEQ + kp_; } \
            ptr_ = kpart ? (ksrc0 + krow_ * 128) : (vsrc0 + key0_); } while (0)
        v4u stg;
        { const bf16* sp; AT_SRC(0, sp); stg = *(const GAS v4u*)sp; }
        __syncthreads();
        *(LAS v4u*)(lb + sdst) = stg;
        __syncthreads();
#pragma unroll 1
        for (int s = 0; s < 20; ++s) {
            if (s + 1 < 20) { const bf16* sp; AT_SRC(s + 1, sp); stg = *(const GAS v4u*)sp; }
            const LAS unsigned char* kb_ = lb + (s & 1) * AT_BUF; const LAS unsigned char* vb_ = kb_ + AT_KB;
            bool use0, use1; int mk0 = 0, mk1 = 0;
            if (s < 8) { use0 = true; use1 = true; }
            else { const int j = s - 8, kp0 = qb * 128 - 128 + 32 * j, bi = j - 2 * half; const bool inr = kp0 >= 0 && kp0 < SEQ;
                use0 = inr && bi >= 0 && bi <= 8; use1 = inr && bi >= 1 && bi <= 9; mk0 = bi == 0 ? 1 : (bi == 8 ? 2 : 0); mk1 = bi == 1 ? 1 : (bi == 9 ? 2 : 0); }
            if (use0 || use1) {
                bf16x8 kf[4], vf[4];
#pragma unroll
                for (int ks = 0; ks < 4; ++ks) kf[ks] = *(const LAS bf16x8*)(kb_ + kperm * AT_KP + 32 * ks + 16 * hi);
                vf[0] = *(const LAS bf16x8*)(vb_ + l32 * AT_VP + 16 * hi); vf[1] = *(const LAS bf16x8*)(vb_ + l32 * AT_VP + 32 + 16 * hi);
                vf[2] = *(const LAS bf16x8*)(vb_ + (32 + l32) * AT_VP + 16 * hi); vf[3] = *(const LAS bf16x8*)(vb_ + (32 + l32) * AT_VP + 32 + 16 * hi);
                if (use0) attn_tile(kf, vf, qf0, oa0, oa1, m0, l0, mk0, l32, hi);
                if (use1) attn_tile(kf, vf, qf1, ob0, ob1, m1, l1, mk1, l32, hi);
            }
            if (s + 1 < 20) *(LAS v4u*)(lb + ((s + 1) & 1) * AT_BUF + sdst) = stg;
            __syncthreads();
        }
#undef AT_SRC
#pragma unroll
        for (int qi = 0; qi < 2; ++qi) {
            const float lr = qi ? l1 : l0; const float ltot = lr + __shfl_xor(lr, 32), inv = 1.0f / ltot;
            const f32x16& o0 = qi ? ob0 : oa0; const f32x16& o1 = qi ? ob1 : oa1;
            bf16* op = Q + (qrow + 32 * qi) * 512 + h * 64 + 4 * hi;
#pragma unroll
            for (int r4 = 0; r4 < 4; ++r4) {
                v2u w0; w0.x = pkbf(o0[4 * r4] * inv, o0[4 * r4 + 1] * inv); w0.y = pkbf(o0[4 * r4 + 2] * inv, o0[4 * r4 + 3] * inv);
                v2u w1; w1.x = pkbf(o1[4 * r4] * inv, o1[4 * r4 + 1] * inv); w1.y = pkbf(o1[4 * r4 + 2] * inv, o1[4 * r4 + 3] * inv);
                if (dostore) { *(GAS v2u*)(op + 8 * r4) = w0; *(GAS v2u*)(op + 32 + 8 * r4) = w1; }
            }
        }
    }
}

constexpr int SC_C = 32, SC_NCH = (LC + SEQ) / SC_C;
constexpr int SC_RP = 3;
constexpr int SC_ROUNDS = SC_NCH / SC_RP;
constexpr int SC_TASK_BYTES = 24576;
constexpr int SC_SLOT_BYTES = 2 * SC_RP * SC_TASK_BYTES;
constexpr int SC_PITCH = 144;
constexpr int SC_PLDS = 4 * 32 * SC_PITCH + 256;
__device__ __forceinline__ int launder(int v) { asm volatile("" : "+v"(v)); return v; }
__device__ __forceinline__ int crow_(int r, int hi) { return (r & 3) + 8 * (r >> 2) + 4 * hi; }
__device__ __forceinline__ bf16x8 packacc(const f32x16& x, int s) {
    v4u p; p.x = pkbf(x[8 * s], x[8 * s + 1]); p.y = pkbf(x[8 * s + 2], x[8 * s + 3]); p.z = pkbf(x[8 * s + 4], x[8 * s + 5]); p.w = pkbf(x[8 * s + 6], x[8 * s + 7]);
    return __builtin_bit_cast(bf16x8, p); }
#define MF(a, b, c) __builtin_amdgcn_mfma_f32_32x32x16_bf16((a), (b), (c), 0, 0, 0)
__device__ __forceinline__ f32x16 zero16() { f32x16 z;
#pragma unroll
    for (int r = 0; r < 16; ++r) z[r] = 0.f;
    return z; }
__device__ __forceinline__ void st_acc_bf16(unsigned char* p, const f32x16& x) {
    v4u a, b; a.x = pkbf(x[0], x[1]); a.y = pkbf(x[2], x[3]); a.z = pkbf(x[4], x[5]); a.w = pkbf(x[6], x[7]); b.x = pkbf(x[8], x[9]); b.y = pkbf(x[10], x[11]); b.z = pkbf(x[12], x[13]); b.w = pkbf(x[14], x[15]);
    *(GAS v4u*)p = a; *(GAS v4u*)(p + 16) = b; }
__device__ __forceinline__ f32x16 ld_acc_bf16(const unsigned char* p) {
    const v4u a = *(const GAS v4u*)p, b = *(const GAS v4u*)(p + 16); f32x16 x;
    x[0] = bflo(a.x); x[1] = bfhi(a.x); x[2] = bflo(a.y); x[3] = bfhi(a.y); x[4] = bflo(a.z); x[5] = bfhi(a.z); x[6] = bflo(a.w); x[7] = bfhi(a.w);
    x[8] = bflo(b.x); x[9] = bfhi(b.x); x[10] = bflo(b.y); x[11] = bfhi(b.y); x[12] = bflo(b.z); x[13] = bfhi(b.z); x[14] = bflo(b.w); x[15] = bfhi(b.w); return x; }

__device__ __forceinline__ void chan_to_frags(const unsigned (&pp)[16], int, bf16x8 (&fr)[2][2]) {
    unsigned t0[8], t1[8];
#pragma unroll
    for (int q = 0; q < 8; ++q) { const int plo = (q >> 1) * 4 + (q & 1), phi = plo + 2;
        const auto r = __builtin_amdgcn_permlane32_swap(pp[plo], pp[phi], false, false); t0[q] = r[0]; t1[q] = r[1]; }
#pragma unroll
    for (int s2 = 0; s2 < 2; ++s2) { v4u a, b2; a.x = t0[4 * s2]; a.y = t0[4 * s2 + 1]; a.z = t0[4 * s2 + 2]; a.w = t0[4 * s2 + 3]; b2.x = t1[4 * s2]; b2.y = t1[4 * s2 + 1]; b2.z = t1[4 * s2 + 2]; b2.w = t1[4 * s2 + 3];
        fr[0][s2] = __builtin_bit_cast(bf16x8, a); fr[1][s2] = __builtin_bit_cast(bf16x8, b2); }
}
struct ScanPre { float cw[9], kkp, kap; bf16 km, kc, vm, vc, rm, rc; bf16 gk[8], gv[8], gr[8], ge[8], ga[8]; };
constexpr int SC_PRE_LOADS = 11 + 6 + 40;
__device__ __forceinline__ void scan_prefetch(unsigned char* ws, int b, int h, int dir, int chunk, int lane, const float* conv, const float* kkpp, const float* kapp, ScanPre& pf) {
    const bool lat = chunk >= LC / SC_C; const int len = lat ? SEQ : LC, n0 = lat ? chunk * SC_C - LC : chunk * SC_C;
    const int rowbase = lat ? b * SEQ : NLAT + b * LC, col = h * 64 + lane;
    const int tk0 = dir ? (len - 1 - n0) : n0, tstep = dir ? -1 : 1;
    const unsigned ob0 = ((unsigned)(rowbase + tk0) * 512u + (unsigned)col) * 2u; const long ostepb = (long)tstep * 1024;
    const bool vm1 = n0 > 0;
    const char* ZKc = (const char*)(ws + WS_ZK); const char* ZVc = (const char*)(ws + WS_ZV); const char* ZRc = lat ? (const char*)(ws + WS_ZR) : ZKc;
    const char* EWc = (const char*)(ws + WS_EW) + (size_t)dir * NTOK * 1024; const char* ASc = (const char*)(ws + WS_AS) + (size_t)dir * NTOK * 1024;
#pragma unroll
    for (int j = 0; j < 3; ++j) { pf.cw[j] = conv[j * 1536 + col]; pf.cw[3 + j] = conv[j * 1536 + 512 + col]; pf.cw[6 + j] = conv[j * 1536 + 1024 + col]; }
    pf.kkp = kkpp[dir * 512 + col]; pf.kap = kapp[dir * 512 + col];
#define SC_LD(base, j) (*(const GAS bf16*)((base) + (long)(j) * ostepb + ob0))
    const long jm1 = vm1 ? -1 : 0;
    pf.km = SC_LD(ZKc, jm1); pf.kc = SC_LD(ZKc, 0); pf.vm = SC_LD(ZVc, jm1); pf.vc = SC_LD(ZVc, 0); pf.rm = SC_LD(ZRc, jm1); pf.rc = SC_LD(ZRc, 0);
#pragma unroll
    for (int jj = 0; jj < 8; ++jj) { pf.gk[jj] = SC_LD(ZKc, jj + 1); pf.gv[jj] = SC_LD(ZVc, jj + 1); pf.gr[jj] = SC_LD(ZRc, jj + 1); pf.ge[jj] = SC_LD(EWc, jj); pf.ga[jj] = SC_LD(ASc, jj); }
#undef SC_LD
}
__device__ __forceinline__ void scan_produce(unsigned char* ws, int b, int h, int dir, int chunk, LAS unsigned char* pl, unsigned char* xo, int lane_in, const float* conv, const float* kkpp, const float* kapp, ScanPre& pf) {
    int lane = launder(lane_in);
    float cw[9]; float kkp = pf.kkp, kap = pf.kap;
#pragma unroll
    for (int j = 0; j < 9; ++j) cw[j] = pf.cw[j];
    const bf16* ZK = (const bf16*)(ws + WS_ZK); const bf16* ZV = (const bf16*)(ws + WS_ZV); const bf16* ZR = (const bf16*)(ws + WS_ZR);
    const bf16* EW = (const bf16*)(ws + WS_EW) + (size_t)dir * NTOK * 512; const bf16* AS = (const bf16*)(ws + WS_AS) + (size_t)dir * NTOK * 512;
    int l32 = lane & 31, hi = lane >> 5; const int col = h * 64 + lane;
    const bool lat = chunk >= LC / SC_C; const int len = lat ? SEQ : LC, n0 = lat ? chunk * SC_C - LC : chunk * SC_C;
    const int rowbase = lat ? b * SEQ : NLAT + b * LC;
    LAS unsigned char* mA = pl; LAS unsigned char* mB = pl + 32 * SC_PITCH; LAS unsigned char* mK = pl + 64 * SC_PITCH; LAS unsigned char* mR = pl + 96 * SC_PITCH;
    LAS float* pcs = (LAS float*)(pl + 128 * SC_PITCH);
    unsigned pa[16], pb[16], pk[16], pv[16]; float P = 1.0f;
    const float latf = lat ? 1.0f : 0.0f;
    const float cwr_m = latf * (dir ? cw[2] : cw[0]), cwr_c = latf * cw[1], cwr_p = latf * (dir ? cw[0] : cw[2]), cwk_m = dir ? cw[5] : cw[3], cwk_p = dir ? cw[3] : cw[5], cwv_m = dir ? cw[8] : cw[6], cwv_p = dir ? cw[6] : cw[8];
    const int tk0 = dir ? (len - 1 - n0) : n0, tstep = dir ? -1 : 1;
    const unsigned ob0 = ((unsigned)(rowbase + tk0) * 512u + (unsigned)col) * 2u;
    const long ostepb = (long)tstep * 1024;
    const bool vm1 = n0 > 0, vp32 = n0 + SC_C < len;
    const char* ZKc = (const char*)ZK; const char* ZVc = (const char*)ZV; const char* ZRc = lat ? (const char*)ZR : (const char*)ZK;
    const char* EWc = (const char*)EW; const char* ASc = (const char*)AS;
#define SC_LD(base, j) (*(const GAS bf16*)((base) + (long)(j) * ostepb + ob0))
    float km = bf1(pf.km), kc = bf1(pf.kc), vm = bf1(pf.vm), vc = bf1(pf.vc), rm = bf1(pf.rm), rc = bf1(pf.rc);
    km = vm1 ? km : 0.f; vm = vm1 ? vm : 0.f; rm = vm1 ? rm : 0.f;
    bf16 rk[16], rv[16], rr[16], re[16], ra[16];
#define SC_LOADSTEP(j, sl) do { const bool vn = ((j) + 1 < SC_C) || vp32; const long jn = vn ? ((j) + 1) : (j); const bf16 tk_ = SC_LD(ZKc, jn), tv_ = SC_LD(ZVc, jn), tr_ = SC_LD(ZRc, jn); \
        rk[sl] = vn ? tk_ : (bf16)0; rv[sl] = vn ? tv_ : (bf16)0; rr[sl] = vn ? tr_ : (bf16)0; re[sl] = SC_LD(EWc, (j)); ra[sl] = SC_LD(ASc, (j)); } while (0)
#pragma unroll
    for (int jj = 0; jj < 8; ++jj) { rk[jj] = pf.gk[jj]; rv[jj] = pf.gv[jj]; rr[jj] = pf.gr[jj]; re[jj] = pf.ge[jj]; ra[jj] = pf.ga[jj]; }
#pragma unroll
    for (int jj = 8; jj < 16; ++jj) SC_LOADSTEP(jj, jj);
    asm volatile("" ::: "memory");
#pragma unroll
    for (int p = 0; p < 16; ++p) {
        bf16 ck[2], cv[2], cr[2], ce[2], ca[2];
#pragma unroll
        for (int u = 0; u < 2; ++u) { const int sl = (2 * p + u) & 15; ck[u] = rk[sl]; cv[u] = rv[sl]; cr[u] = rr[sl]; ce[u] = re[sl]; ca[u] = ra[sl]; }
        if (2 * p + 16 < SC_C) { SC_LOADSTEP(2 * p + 16, (2 * p) & 15); SC_LOADSTEP(2 * p + 17, (2 * p + 1) & 15); }
        float va[2], vb[2], vk[2], vv[2], vr[2];
#pragma unroll
        for (int u = 0; u < 2; ++u) {
            const float kp = bf1(ck[u]), vp = bf1(cv[u]), rp = bf1(cr[u]);
            const float k = cwk_m * km + cw[4] * kc + cwk_p * kp, v = cwv_m * vm + cw[7] * vc + cwv_p * vp, r = cwr_m * rm + cwr_c * rc + cwr_p * rp;
            km = kc; kc = kp; vm = vc; vc = vp; rm = rc; rc = rp;
            const float a = bf1(ca[u]), ew = bf1(ce[u]), w = __expf(-ew);
            const float kkv = k * kkp, ss = wave_sum(kkv * kkv), kk = kkv * __builtin_amdgcn_rsqf(fmaxf(ss, 1e-24f));
            const float kmod = k * (1.0f + (a - 1.0f) * kap);
            const float Pprev = P; P *= w; const float invP = __builtin_amdgcn_rcpf(P);
            const float at = -kk * Pprev, bt = kk * a * invP, kt = kmod * invP, rt = r * P;
            va[u] = at; vb[u] = bt; vk[u] = kt; vv[u] = v; vr[u] = rt;
        }
        pa[p] = pkbf(va[0], va[1]); pb[p] = pkbf(vb[0], vb[1]); pk[p] = pkbf(vk[0], vk[1]); pv[p] = pkbf(vv[0], vv[1]); const unsigned prt = pkbf(vr[0], vr[1]);
        { const int i0 = 2 * p;
          *(LAS bf16*)(mA + i0 * SC_PITCH + 2 * lane) = (bf16)(pa[p] & 0xffffu); *(LAS bf16*)(mA + (i0 + 1) * SC_PITCH + 2 * lane) = (bf16)(pa[p] >> 16);
          *(LAS bf16*)(mB + i0 * SC_PITCH + 2 * lane) = (bf16)(pb[p] & 0xffffu); *(LAS bf16*)(mB + (i0 + 1) * SC_PITCH + 2 * lane) = (bf16)(pb[p] >> 16);
          *(LAS bf16*)(mK + i0 * SC_PITCH + 2 * lane) = (bf16)(pk[p] & 0xffffu); *(LAS bf16*)(mK + (i0 + 1) * SC_PITCH + 2 * lane) = (bf16)(pk[p] >> 16);
          *(LAS bf16*)(mR + i0 * SC_PITCH + 2 * lane) = (bf16)(prt & 0xffffu); *(LAS bf16*)(mR + (i0 + 1) * SC_PITCH + 2 * lane) = (bf16)(prt >> 16); }
        if ((p & 3) == 3) asm volatile("" ::: "memory");
    }
#undef SC_LOADSTEP
#undef SC_LD
    pcs[lane] = P;
    const float pc_o = __shfl_xor(P, 32); const float pcn0 = hi ? pc_o : P, pcn1 = hi ? P : pc_o;
    bf16x8 fA[2][2], fB[2][2], fK[2][2], fV[2][2];
    chan_to_frags(pa, hi, fA); chan_to_frags(pb, hi, fB); chan_to_frags(pk, hi, fK); chan_to_frags(pv, hi, fV);
    LDS_WAIT(); asm volatile("" ::: "memory");
    __builtin_amdgcn_sched_barrier(0);
    lane = launder(lane_in); l32 = lane & 31; hi = lane >> 5;
    f32x16 X = zero16(), XT = zero16(), LakT = zero16(), MrbT = zero16(), MrkT = zero16();
    const int roff = l32 * SC_PITCH + 16 * hi;
#pragma unroll
    for (int ks = 0; ks < 4; ++ks) {
        const bf16x8 ga = *(const LAS bf16x8*)(mA + roff + 32 * ks), gb = *(const LAS bf16x8*)(mB + roff + 32 * ks), gk = *(const LAS bf16x8*)(mK + roff + 32 * ks), gr = *(const LAS bf16x8*)(mR + roff + 32 * ks);
        X = MF(ga, gb, X); XT = MF(gb, ga, XT); LakT = MF(gk, ga, LakT); MrbT = MF(gb, gr, MrbT); MrkT = MF(gk, gr, MrkT);
    }
    f32x16 TmT;
#pragma unroll
    for (int r = 0; r < 16; ++r) { const int row = crow_(r, hi);
        X[r] = (l32 < row) ? X[r] : 0.f; XT[r] = (row < l32) ? XT[r] : 0.f; LakT[r] = (row < l32) ? LakT[r] : 0.f;
        MrbT[r] = (row <= l32) ? MrbT[r] : 0.f; MrkT[r] = (row <= l32) ? MrkT[r] : 0.f; TmT[r] = XT[r] + ((row == l32) ? 1.0f : 0.f); }
    const bf16x8 la0 = packacc(LakT, 0), la1 = packacc(LakT, 1), rb0 = packacc(MrbT, 0), rb1 = packacc(MrbT, 1), rk0 = packacc(MrkT, 0), rk1 = packacc(MrkT, 1);
    __builtin_amdgcn_sched_barrier(0);
#pragma unroll
    for (int it = 0; it < 4; ++it) {
        const bf16x8 x0 = packacc(X, 0), x1 = packacc(X, 1), y0 = packacc(XT, 0), y1 = packacc(XT, 1), t0 = packacc(TmT, 0), t1 = packacc(TmT, 1);
        f32x16 Xn = zero16(), XnT = zero16();
        Xn = MF(y0, x0, Xn); Xn = MF(y1, x1, Xn); XnT = MF(x0, y0, XnT); XnT = MF(x1, y1, XnT);
        const bf16x8 n0 = packacc(Xn, 0), n1 = packacc(Xn, 1);
        TmT = MF(n0, t0, TmT); TmT = MF(n1, t1, TmT);
        X = Xn; XT = XnT;
    }
    __builtin_amdgcn_sched_barrier(0);
    const bf16x8 tt0 = packacc(TmT, 0), tt1 = packacc(TmT, 1);
    f32x16 W[2], Ut[2];
#pragma unroll
    for (int ct = 0; ct < 2; ++ct) { f32x16 w = zero16(); w = MF(tt0, fA[ct][0], w); w = MF(tt1, fA[ct][1], w); W[ct] = w;
        f32x16 x1 = zero16(); x1 = MF(la0, fV[ct][0], x1); x1 = MF(la1, fV[ct][1], x1);
        f32x16 u = zero16(); u = MF(tt0, packacc(x1, 0), u); u = MF(tt1, packacc(x1, 1), u); Ut[ct] = u; }
    bf16x8 fW[2][2], fU[2][2];
#pragma unroll
    for (int ct = 0; ct < 2; ++ct) { fW[ct][0] = packacc(W[ct], 0); fW[ct][1] = packacc(W[ct], 1); fU[ct][0] = packacc(Ut[ct], 0); fU[ct][1] = packacc(Ut[ct], 1); }
    __builtin_amdgcn_sched_barrier(0);
    lane = launder(lane_in); l32 = lane & 31; hi = lane >> 5;
#pragma unroll
    for (int kt = 0; kt < 2; ++kt) { f32x16 acc;
#pragma unroll
        for (int r4 = 0; r4 < 4; ++r4) { const v2u rr = *(const LAS v2u*)(mR + l32 * SC_PITCH + 2 * (32 * kt + 8 * r4 + 4 * hi));
            acc[4 * r4] = bflo(rr.x); acc[4 * r4 + 1] = bfhi(rr.x); acc[4 * r4 + 2] = bflo(rr.y); acc[4 * r4 + 3] = bfhi(rr.y); }
        acc = MF(fW[kt][0], rb0, acc); acc = MF(fW[kt][1], rb1, acc);
        *(GAS bf16x8*)(xo + 16384 + (kt * 2 + 0) * 1024 + lane * 16) = packacc(acc, 0); *(GAS bf16x8*)(xo + 16384 + (kt * 2 + 1) * 1024 + lane * 16) = packacc(acc, 1); }
#pragma unroll
    for (int vt = 0; vt < 2; ++vt) { f32x16 acc = zero16();
        acc = MF(rb0, fU[vt][0], acc); acc = MF(rb1, fU[vt][1], acc); acc = MF(rk0, fV[vt][0], acc); acc = MF(rk1, fV[vt][1], acc);
        st_acc_bf16(xo + 20480 + vt * 2048 + lane * 32, acc); }
    __builtin_amdgcn_sched_barrier(0);
    lane = launder(lane_in); l32 = lane & 31; hi = lane >> 5;
#pragma unroll
    for (int kt = 0; kt < 2; ++kt)
#pragma unroll
        for (int nt = 0; nt < 2; ++nt) { f32x16 acc = zero16(); acc = MF(fW[kt][0], fB[nt][0], acc); acc = MF(fW[kt][1], fB[nt][1], acc);
            const float pc = nt ? pcn1 : pcn0;
#pragma unroll
            for (int r = 0; r < 16; ++r) acc[r] = (acc[r] + ((kt == nt && crow_(r, hi) == l32) ? 1.0f : 0.f)) * pc;
            *(GAS bf16x8*)(xo + ((kt * 2 + nt) * 2 + 0) * 1024 + lane * 16) = packacc(acc, 0); *(GAS bf16x8*)(xo + ((kt * 2 + nt) * 2 + 1) * 1024 + lane * 16) = packacc(acc, 1); }
    __builtin_amdgcn_sched_barrier(0);
    lane = launder(lane_in); l32 = lane & 31; hi = lane >> 5;
#pragma unroll
    for (int kt = 0; kt < 2; ++kt)
#pragma unroll
        for (int vt = 0; vt < 2; ++vt) { f32x16 acc = zero16();
            acc = MF(fB[kt][0], fU[vt][0], acc); acc = MF(fB[kt][1], fU[vt][1], acc); acc = MF(fK[kt][0], fV[vt][0], acc); acc = MF(fK[kt][1], fV[vt][1], acc);
#pragma unroll
            for (int r4 = 0; r4 < 4; ++r4) { const f32x4 pr = *(const LAS f32x4*)(pcs + 32 * kt + 8 * r4 + 4 * hi);
                acc[4 * r4] *= pr.x; acc[4 * r4 + 1] *= pr.y; acc[4 * r4 + 2] *= pr.z; acc[4 * r4 + 3] *= pr.w; }
            st_acc_bf16(xo + 8192 + (kt * 2 + vt) * 2048 + lane * 32, acc); }
    LDS_WAIT();
    __builtin_amdgcn_sched_barrier(0); asm volatile("" ::: "memory");
    scan_prefetch(ws, b, h, dir, (chunk + SC_RP < SC_NCH) ? chunk + SC_RP : chunk, launder(lane_in), conv, kkpp, kapp, pf);
    __builtin_amdgcn_sched_barrier(0); asm volatile("" ::: "memory");
}
__device__ __forceinline__ void scan_consume(unsigned char* ws, int b, int h, int dir, int chunk, const unsigned char* xi, int lane, f32x16 (&H)[2][2]) {
    const int l32 = lane & 31, hi = lane >> 5;
    bf16x8 hb[2][2][2];
#pragma unroll
    for (int kt = 0; kt < 2; ++kt)
#pragma unroll
        for (int vt = 0; vt < 2; ++vt) { hb[kt][vt][0] = packacc(H[kt][vt], 0); hb[kt][vt][1] = packacc(H[kt][vt], 1); }
    if (chunk >= LC / SC_C) {
        bf16x8 rf[2][2];
#pragma unroll
        for (int kt = 0; kt < 2; ++kt)
#pragma unroll
            for (int s2 = 0; s2 < 2; ++s2) rf[kt][s2] = *(const GAS bf16x8*)(xi + 16384 + (kt * 2 + s2) * 1024 + lane * 16);
        bf16* Y = (bf16*)(ws + (dir ? WS_YB : WS_YF)); const int n0 = chunk * SC_C - LC;
#pragma unroll
        for (int vt = 0; vt < 2; ++vt) { f32x16 acc = ld_acc_bf16(xi + 20480 + vt * 2048 + lane * 32);
#pragma unroll
            for (int kt = 0; kt < 2; ++kt) { acc = MF(rf[kt][0], hb[kt][vt][0], acc); acc = MF(rf[kt][1], hb[kt][vt][1], acc); }
#pragma unroll
            for (int r = 0; r < 16; ++r) { const int i = crow_(r, hi), tk = dir ? (SEQ - 1 - (n0 + i)) : (n0 + i);
                Y[((size_t)b * SEQ + tk) * 512 + h * 64 + 32 * vt + l32] = (bf16)(pkbf(acc[r], 0.f) & 0xffffu); } }
    }
    f32x16 Hn[2][2];
#pragma unroll
    for (int nt = 0; nt < 2; ++nt)
#pragma unroll
        for (int vt = 0; vt < 2; ++vt) Hn[nt][vt] = ld_acc_bf16(xi + 8192 + (nt * 2 + vt) * 2048 + lane * 32);
#pragma unroll
    for (int kt = 0; kt < 2; ++kt)
#pragma unroll
        for (int nt = 0; nt < 2; ++nt) { const bf16x8 g0 = *(const GAS bf16x8*)(xi + ((kt * 2 + nt) * 2 + 0) * 1024 + lane * 16), g1 = *(const GAS bf16x8*)(xi + ((kt * 2 + nt) * 2 + 1) * 1024 + lane * 16);
#pragma unroll
            for (int vt = 0; vt < 2; ++vt) { Hn[nt][vt] = MF(g0, hb[kt][vt][0], Hn[nt][vt]); Hn[nt][vt] = MF(g1, hb[kt][vt][1], Hn[nt][vt]); } }
#pragma unroll
    for (int nt = 0; nt < 2; ++nt)
#pragma unroll
        for (int vt = 0; vt < 2; ++vt) H[nt][vt] = Hn[nt][vt];
}
__device__ __forceinline__ void p4b_scan(Frame& F) {
    const int wave = F.wave, lane = F.lane;
    const bool is_cons = wave < 2; const int pw = wave - 2;
    unsigned char* xch = F.ws + WS_XCH + (size_t)blockIdx.x * (2 * SC_SLOT_BYTES);
    LAS unsigned char* pl = F.lds + (is_cons ? 0 : pw) * SC_PLDS;
    for (int task = blockIdx.x; task < NB * 8; task += F.G) {
        const int b = task >> 3, h = task & 7; const int pdir = is_cons ? wave : pw / SC_RP, pci = is_cons ? 0 : pw % SC_RP;
        const float* conv = karg_in(I_CONV); const float* kkpp = karg_in(I_KK); const float* kapp = karg_in(I_KA);
#define SC_SYNC() do { asm volatile("s_waitcnt vmcnt(0) lgkmcnt(0)" ::: "memory"); __builtin_amdgcn_s_barrier(); asm volatile("" ::: "memory"); } while (0)
        if (is_cons) {
            f32x16 H[2][2];
#pragma unroll
            for (int i = 0; i < 2; ++i)
#pragma unroll
                for (int j = 0; j < 2; ++j) H[i][j] = zero16();
#pragma unroll 1
            for (int q = -1; q < SC_ROUNDS; ++q) {
                if (q >= 0) { __builtin_amdgcn_fence(__ATOMIC_ACQUIRE, "agent");
#pragma unroll 1
                    for (int i = 0; i < SC_RP; ++i) scan_consume(F.ws, b, h, wave, q * SC_RP + i, xch + (size_t)(q & 1) * SC_SLOT_BYTES + (size_t)(wave * SC_RP + i) * SC_TASK_BYTES, lane, H); }
                SC_SYNC();
            }
        } else {
            ScanPre pf; scan_prefetch(F.ws, b, h, pdir, pci, lane, conv, kkpp, kapp, pf);
#pragma unroll 1
            for (int q = -1; q < SC_ROUNDS; ++q) {
                if (q + 1 < SC_ROUNDS) { scan_produce(F.ws, b, h, pdir, (q + 1) * SC_RP + pci, pl, xch + (size_t)((q + 1) & 1) * SC_SLOT_BYTES + (size_t)(pdir * SC_RP + pci) * SC_TASK_BYTES, lane, conv, kkpp, kapp, pf);
                    asm volatile("s_waitcnt vmcnt(%0) lgkmcnt(0)" :: "n"(SC_PRE_LOADS) : "memory"); __builtin_amdgcn_s_barrier(); asm volatile("" ::: "memory"); }
                else SC_SYNC();
            }
        }
#undef SC_SYNC
    }
}
#undef MF

__device__ __forceinline__ void p5_rwkv_out(Frame& F) {
    const int gw = blockIdx.x * NWAVES + F.wave, NGW = F.G * NWAVES, lane = F.lane, c0 = 8 * lane;
    const bf16* ZK = (const bf16*)(F.ws + WS_ZK); const bf16* ZV = (const bf16*)(F.ws + WS_ZV); const bf16* ZR = (const bf16*)(F.ws + WS_ZR);
    const bf16* AS0 = (const bf16*)(F.ws + WS_AS); const bf16* AS1 = AS0 + (size_t)NTOK * 512;
    const bf16* YF = (const bf16*)(F.ws + WS_YF); const bf16* YB = (const bf16*)(F.ws + WS_YB); const bf16* G = (const bf16*)(F.ws + WS_G);
    bf16* ORW = (bf16*)(F.ws + WS_ORW);
    LAS float* PL = (LAS float*)F.lds;
    { const float* convg = karg_in(I_CONV); const float* kag = karg_in(I_KA); const float* rkg = karg_in(I_RK); const float* lnwg = karg_in(I_LNW); const float* lnbg = karg_in(I_LNB);
      for (int i = F.tid; i < 15 * 512; i += 512) { const int row = i >> 9, c = i & 511; float v;
          if (row < 9) v = convg[(row % 3) * 1536 + (row / 3) * 512 + c]; else if (row < 11) v = kag[(row - 9) * 512 + c]; else if (row < 13) v = rkg[(row - 11) * 512 + c]; else if (row == 13) v = lnwg[c]; else v = lnbg[c];
          PL[i] = v; }
      __syncthreads(); }
    const LAS float* conv = PL; const LAS float* ka = PL + 9 * 512; const LAS float* rk = PL + 11 * 512; const LAS float* lnw = PL + 13 * 512; const LAS float* lnb = PL + 14 * 512;
    for (int m0 = gw; m0 < NLAT; m0 += 2 * NGW) {
        v4u raw[2][14];
        const v4u z4 = (v4u){0u, 0u, 0u, 0u};
#pragma unroll
        for (int rr = 0; rr < 2; ++rr) { const int m = min(m0 + rr * NGW, NLAT - 1);
            const int t = m & 2047; const bool first = t == 0, last = t == SEQ - 1; const size_t o = (size_t)m * 512 + c0;
            const size_t om = first ? o : o - 512, op = last ? o : o + 512;
#pragma unroll
            for (int which = 0; which < 3; ++which) { const bf16* Z = which == 0 ? ZR : (which == 1 ? ZK : ZV);
                const v4u ra = *(const GAS v4u*)(Z + om), rc_ = *(const GAS v4u*)(Z + op);
                raw[rr][3 * which] = first ? z4 : ra; raw[rr][3 * which + 1] = *(const GAS v4u*)(Z + o); raw[rr][3 * which + 2] = last ? z4 : rc_; }
            raw[rr][9] = *(const GAS v4u*)(AS0 + o); raw[rr][10] = *(const GAS v4u*)(AS1 + o); raw[rr][11] = *(const GAS v4u*)(YF + o); raw[rr][12] = *(const GAS v4u*)(YB + o); raw[rr][13] = *(const GAS v4u*)(G + o); }
#pragma unroll
        for (int rr = 0; rr < 2; ++rr) { const int m = m0 + rr * NGW; if (m >= NLAT) continue;
            const size_t o = (size_t)m * 512 + c0;
            float r[8], k[8], v[8], tmp[8];
            asm volatile("" ::: "memory");
#pragma unroll
            for (int which = 0; which < 3; ++which) { float (&dst)[8] = which == 0 ? r : (which == 1 ? k : v);
                asm volatile("" ::: "memory");
                float fa[8], fb[8], fc[8]; unpack8(raw[rr][3 * which], fa); unpack8(raw[rr][3 * which + 1], fb); unpack8(raw[rr][3 * which + 2], fc);
                const LAS float* cwp = conv + (3 * which) * 512 + c0;
#pragma unroll
                for (int j = 0; j < 8; ++j) dst[j] = cwp[j] * fa[j] + cwp[512 + j] * fb[j] + cwp[1024 + j] * fc[j]; }
            asm volatile("" ::: "memory");
            float a0[8], a1[8]; unpack8(raw[rr][9], a0); unpack8(raw[rr][10], a1);
            float s = 0.f;
#pragma unroll
            for (int j = 0; j < 8; ++j) { const float km0 = k[j] * (1.0f + (a0[j] - 1.0f) * ka[c0 + j]), km1 = k[j] * (1.0f + (a1[j] - 1.0f) * ka[512 + c0 + j]);
                s += r[j] * (km0 * rk[c0 + j] + km1 * rk[512 + c0 + j]); }
            s += __shfl_xor(s, 1); s += __shfl_xor(s, 2); s += __shfl_xor(s, 4);
            asm volatile("" ::: "memory");
            float y[8], yb[8]; unpack8(raw[rr][11], y); unpack8(raw[rr][12], yb);
            float sm = 0.f;
#pragma unroll
            for (int j = 0; j < 8; ++j) { y[j] += yb[j]; sm += y[j]; }
            sm += __shfl_xor(sm, 1); sm += __shfl_xor(sm, 2); sm += __shfl_xor(sm, 4);
            const float mean = sm * (1.f / 64.f); float sq = 0.f;
#pragma unroll
            for (int j = 0; j < 8; ++j) { y[j] -= mean; sq += y[j] * y[j]; }
            sq += __shfl_xor(sq, 1); sq += __shfl_xor(sq, 2); sq += __shfl_xor(sq, 4);
            const float rstd = __builtin_amdgcn_rsqf(sq * (1.f / 64.f) + 64e-5f);
            float gg[8]; unpack8(raw[rr][13], gg);
#pragma unroll
            for (int j = 0; j < 8; ++j) tmp[j] = (y[j] * rstd * lnw[c0 + j] + lnb[c0 + j] + s * v[j]) * gg[j];
            *(GAS v4u*)(ORW + o) = pack8(tmp); }
    }
}

struct EpiMerge {
    static constexpr bool PERM = true, AFTER_DRAIN = false;
    bf16* merged; const bf16* gates; int goff; int first;
    __device__ __forceinline__ void operator()(const f32x4 (&acc)[2][2][4][2], const Unit& u, int wr, int wc, int fr, int fq) const {
        const int row0 = u.pm * 256 + wr * 64 + fr, col0 = u.pn * 256 + wc * 32 + 8 * fq;
#pragma unroll
        for (int ai = 0; ai < 2; ++ai)
#pragma unroll
            for (int m = 0; m < 4; ++m) { const size_t row = (size_t)(row0 + ai * 128 + m * 16);
#pragma unroll
                for (int bj = 0; bj < 2; ++bj) { const int col = col0 + bj * 128;
                    float gt[8]; unpack8(*(const GAS v4u*)(gates + row * 2048 + goff + col), gt);
                    const f32x4 v0 = acc[ai][bj][m][0], v1 = acc[ai][bj][m][1];
                    float o[8] = {v0.x * gt[0], v0.y * gt[1], v0.z * gt[2], v0.w * gt[3], v1.x * gt[4], v1.y * gt[5], v1.z * gt[6], v1.w * gt[7]};
                    GAS v4u* p = (GAS v4u*)(merged + row * 1024 + col);
                    if (!first) { float pv[8]; unpack8(*p, pv);
#pragma unroll
                        for (int j = 0; j < 8; ++j) o[j] += pv[j]; }
                    *p = pack8(o); } }
    }
};
struct EpiMerge2 {
    static constexpr bool PERM = true, AFTER_DRAIN = false;
    bf16* merged; const bf16* gates;
    __device__ __forceinline__ void mid(f32x4 (&acc)[2][2][4][2], const Unit& u, int wr, int wc, int fr, int fq) const {
        const int row0 = u.pm * 256 + wr * 64 + fr, col0 = u.pn * 256 + wc * 32 + 8 * fq;
#pragma unroll
        for (int ai = 0; ai < 2; ++ai)
#pragma unroll
            for (int m = 0; m < 4; ++m) { const size_t row = (size_t)(row0 + ai * 128 + m * 16);
#pragma unroll
                for (int bj = 0; bj < 2; ++bj) { const int col = col0 + bj * 128;
                    float gr[8], ga[8]; unpack8(*(const GAS v4u*)(gates + row * 2048 + col), gr); unpack8(*(const GAS v4u*)(gates + row * 2048 + 1024 + col), ga);
                    float q[8];
#pragma unroll
                    for (int j = 0; j < 8; ++j) q[j] = gr[j] * __builtin_amdgcn_rcpf(fmaxf(ga[j], 1e-30f));
                    acc[ai][bj][m][0] *= (f32x4){q[0], q[1], q[2], q[3]}; acc[ai][bj][m][1] *= (f32x4){q[4], q[5], q[6], q[7]}; } }
    }
    __device__ __forceinline__ void operator()(const f32x4 (&acc)[2][2][4][2], const Unit& u, int wr, int wc, int fr, int fq) const {
        const int row0 = u.pm * 256 + wr * 64 + fr, col0 = u.pn * 256 + wc * 32 + 8 * fq;
#pragma unroll
        for (int ai = 0; ai < 2; ++ai)
#pragma unroll
            for (int m = 0; m < 4; ++m) { const size_t row = (size_t)(row0 + ai * 128 + m * 16);
#pragma unroll
                for (int bj = 0; bj < 2; ++bj) { const int col = col0 + bj * 128;
                    float ga[8]; unpack8(*(const GAS v4u*)(gates + row * 2048 + 1024 + col), ga);
                    const f32x4 v0 = acc[ai][bj][m][0], v1 = acc[ai][bj][m][1];
                    float o[8] = {v0.x * fmaxf(ga[0], 1e-30f), v0.y * fmaxf(ga[1], 1e-30f), v0.z * fmaxf(ga[2], 1e-30f), v0.w * fmaxf(ga[3], 1e-30f),
                                  v1.x * fmaxf(ga[4], 1e-30f), v1.y * fmaxf(ga[5], 1e-30f), v1.z * fmaxf(ga[6], 1e-30f), v1.w * fmaxf(ga[7], 1e-30f)};
                    *(GAS v4u*)(merged + row * 1024 + col) = pack8(o); } }
    }
};
struct EpiOutproj {
    static constexpr bool PERM = true, AFTER_DRAIN = false;
    bf16* delta; const float* mod;
    __device__ __forceinline__ void operator()(const f32x4 (&acc)[2][2][4][2], const Unit& u, int wr, int wc, int fr, int fq) const {
        const int row0 = u.pm * 256 + wr * 64 + fr, col0 = u.pn * 256 + wc * 32 + 8 * fq; const int b = u.pm >> 3;
        f32x4 gv[2][2];
#pragma unroll
        for (int bj = 0; bj < 2; ++bj)
#pragma unroll
            for (int n = 0; n < 2; ++n) gv[bj][n] = *(const f32x4*)(mod + (size_t)b * 6144 + 2048 + col0 + bj * 128 + 4 * n);
#pragma unroll
        for (int ai = 0; ai < 2; ++ai)
#pragma unroll
            for (int m = 0; m < 4; ++m) { const size_t off = (size_t)(row0 + ai * 128 + m * 16) * 1024 + col0;
#pragma unroll
                for (int bj = 0; bj < 2; ++bj) { const f32x4 v0 = gv[bj][0] * acc[ai][bj][m][0], v1 = gv[bj][1] * acc[ai][bj][m][1];
                    v4u w; w.x = pkbf(v0.x, v0.y); w.y = pkbf(v0.z, v0.w); w.z = pkbf(v1.x, v1.y); w.w = pkbf(v1.z, v1.w);
                    *(GAS v4u*)(delta + off + bj * 128) = w; } }
    }
};

constexpr int RW_PITCH = 2064;
__device__ __forceinline__ void p8_norm2_router(Frame& F) {
    LAS unsigned char* rhi = F.lds; LAS unsigned char* rlo = F.lds + 32 * RW_PITCH;
    const float* rw = karg_in(I_ROUTER);
    for (int i = F.tid; i < 16384; i += 512) { const int e = i & 15, k = i >> 4; const float w = rw[i]; const unsigned h = pkbf(w, 0.f) & 0xffffu; const float wl = w - __uint_as_float(h << 16);
        *(LAS bf16*)(rhi + e * RW_PITCH + 2 * k) = (bf16)h; *(LAS bf16*)(rlo + e * RW_PITCH + 2 * k) = (bf16)(pkbf(wl, 0.f) & 0xffffu); }
    for (int i = F.tid; i < 16 * 1024 / 2; i += 512) { const int e = 16 + i / 512, k2 = i % 512; *(LAS unsigned*)(rhi + e * RW_PITCH + 4 * k2) = 0u; *(LAS unsigned*)(rlo + e * RW_PITCH + 4 * k2) = 0u; }
    __syncthreads();
    const int gw = blockIdx.x * NWAVES + F.wave, NGW = F.G * NWAVES, lane = F.lane, l32 = lane & 31, hi = lane >> 5;
    const float* mod = (const float*)(F.ws + WS_MOD); bf16* H2 = (bf16*)(F.ws + WS_H2); float* AFF = (float*)(F.ws + WS_AFF); unsigned char* H2Q = F.ws + WS_H2Q;
    const float* g2 = karg_in(I_N2G); const float* Xp = karg_in(I_X); const bf16* DELTA = (const bf16*)(F.ws + WS_DELTA);
    f32x4 gv[4];
#pragma unroll
    for (int j = 0; j < 4; ++j) gv[j] = *(const f32x4*)(g2 + 4 * lane + 256 * j);
    for (int tile = gw; tile < NLAT / 32; tile += NGW) {
        const int mbase = tile * 32, b = mbase >> 11; const float* sh = mod + (size_t)b * 6144 + 3072; const float* sc = sh + 1024;
        f32x4 av[4], bv[4];
#pragma unroll
        for (int j = 0; j < 4; ++j) { av[j] = *(const f32x4*)(sc + 4 * lane + 256 * j) + 1.0f; bv[j] = *(const f32x4*)(sh + 4 * lane + 256 * j); }
#pragma unroll 1
        for (int r0 = 0; r0 < 32; r0 += 4) {
            f32x4 v[4][4];
#pragma unroll
            for (int r = 0; r < 4; ++r) { const float* xr = Xp + (size_t)(mbase + r0 + r) * DM; const bf16* dr = DELTA + (size_t)(mbase + r0 + r) * DM;
#pragma unroll
                for (int j = 0; j < 4; ++j) { const v2u d = *(const GAS v2u*)(dr + 4 * lane + 256 * j);
                    v[r][j] = *(const GAS f32x4*)(xr + 4 * lane + 256 * j) + (f32x4){bflo(d.x), bfhi(d.x), bflo(d.y), bfhi(d.y)}; } }
#pragma unroll
            for (int r = 0; r < 4; ++r) { float s = 0.f;
#pragma unroll
                for (int j = 0; j < 4; ++j) s += (v[r][j].x * v[r][j].x + v[r][j].y * v[r][j].y) + (v[r][j].z * v[r][j].z + v[r][j].w * v[r][j].w);
                const float rstd = __builtin_amdgcn_rsqf(wave_sum(s) * (1.f / DM) + 1e-6f);
#pragma unroll
                for (int j = 0; j < 4; ++j) { const f32x4 y = v[r][j] * rstd * gv[j] * av[j] + bv[j];
                    v2u o; o.x = pkbf(y.x, y.y); o.y = pkbf(y.z, y.w);
                    *(GAS v2u*)(H2 + (size_t)(mbase + r0 + r) * DM + 4 * lane + 256 * j) = o;
                    *(GAS unsigned*)(H2Q + (size_t)(mbase + r0 + r) * DM + 4 * lane + 256 * j) = pk4f8(y.x, y.y, y.z, y.w); } }
        }
        asm volatile("s_waitcnt vmcnt(0)" ::: "memory");
        f32x16 acc;
#pragma unroll
        for (int r = 0; r < 16; ++r) acc[r] = 0.f;
        const bf16* hrow = H2 + (size_t)(mbase + l32) * DM + 8 * hi;
        const LAS unsigned char* ah = rhi + l32 * RW_PITCH + 16 * hi; const LAS unsigned char* al = rlo + l32 * RW_PITCH + 16 * hi;
#pragma unroll 8
        for (int ks = 0; ks < 64; ++ks) { const bf16x8 bf = *(const GAS bf16x8*)(hrow + 16 * ks);
            const bf16x8 fh = *(const LAS bf16x8*)(ah + 32 * ks), fl = *(const LAS bf16x8*)(al + 32 * ks);
            acc = __builtin_amdgcn_mfma_f32_32x32x16_bf16(fh, bf, acc, 0, 0, 0); acc = __builtin_amdgcn_mfma_f32_32x32x16_bf16(fl, bf, acc, 0, 0, 0); }
        float mx = acc[0];
#pragma unroll
        for (int r = 1; r < 8; ++r) mx = fmaxf(mx, acc[r]);
        mx = fmaxf(mx, __shfl_xor(mx, 32));
        float pe[8], den = 0.f;
#pragma unroll
        for (int r = 0; r < 8; ++r) { pe[r] = __expf(acc[r] - mx); den += pe[r]; }
        den += __shfl_xor(den, 32);
        const float inv = 1.0f / den; const int t = (mbase & 2047) + l32;
#pragma unroll
        for (int r = 0; r < 8; ++r) { const int e = (r & 3) + 8 * (r >> 2) + 4 * hi; AFF[((size_t)b * 16 + e) * SEQ + t] = pe[r] * inv; }
    }
}

__device__ __forceinline__ int block_count(Frame& F, LAS int* wc, int slot, bool p0, bool p1, bool p2, bool p3) {
    const int c = __builtin_popcountll(__ballot(p0)) + __builtin_popcountll(__ballot(p1)) + __builtin_popcountll(__ballot(p2)) + __builtin_popcountll(__ballot(p3));
    if (F.lane == 0) wc[slot * 8 + F.wave] = c;
    __syncthreads();
    int s = 0;
#pragma unroll
    for (int w = 0; w < 8; ++w) s += wc[slot * 8 + w];
    return s;
}
__device__ __forceinline__ void p9_topk_gather(Frame& F) {
    LAS int* wc = (LAS int*)F.lds;
    LAS int* sel = (LAS int*)(F.lds + 1024);
    const float* AFF = (const float*)(F.ws + WS_AFF); int* IDX = (int*)(F.ws + WS_IDX); float* VAL = (float*)(F.ws + WS_VAL);
    const bf16* H2 = (const bf16*)(F.ws + WS_H2); bf16* XE = (bf16*)(F.ws + WS_XE); int* INV = (int*)(F.ws + WS_INV);
    const int tid = F.tid, lane = F.lane, wave = F.wave;
    for (int p = blockIdx.x; p < NB * NE; p += F.G) {
        const int b = p >> 4, e = p & 15;
        const f32x4 av = *(const GAS f32x4*)(AFF + (size_t)p * SEQ + 4 * tid);
        const unsigned u0 = __float_as_uint(av.x), u1 = __float_as_uint(av.y), u2 = __float_as_uint(av.z), u3 = __float_as_uint(av.w);
        unsigned tau = 0u; int it = 0;
        for (int bit = 30; bit >= 0; --bit, ++it) { const unsigned cand = tau | (1u << bit);
            const int cnt = block_count(F, wc, it & 1, u0 >= cand, u1 >= cand, u2 >= cand, u3 >= cand);
            if (cnt >= CAP) tau = cand; }
        const int cgt = block_count(F, wc, it & 1, u0 > tau, u1 > tau, u2 > tau, u3 > tau); ++it;
        const int need_eq = CAP - cgt;
        const int ngt = (u0 > tau) + (u1 > tau) + (u2 > tau) + (u3 > tau), neq = (u0 == tau) + (u1 == tau) + (u2 == tau) + (u3 == tau);
        int pk = ngt | (neq << 16), inc = pk;
#pragma unroll
        for (int o = 1; o < 64; o <<= 1) { const int nb = __shfl_up(inc, o); if (lane >= o) inc += nb; }
        if (lane == 63) wc[16 + wave] = inc;
        __syncthreads();
        int base = 0;
#pragma unroll
        for (int w = 0; w < 8; ++w) base += (w < wave) ? wc[16 + w] : 0;
        int ex = base + inc - pk; int gpos = ex & 0xffff, epos = ex >> 16;
        const unsigned uu[4] = {u0, u1, u2, u3}; const float ff[4] = {av.x, av.y, av.z, av.w};
#pragma unroll
        for (int j = 0; j < 4; ++j) { int slot = -1;
            if (uu[j] > tau) { slot = gpos; ++gpos; } else if (uu[j] == tau) { if (epos < need_eq) slot = cgt + epos; ++epos; }
            if (slot >= 0) { IDX[(size_t)(e * NB + b) * CAP + slot] = 4 * tid + j; VAL[(size_t)(e * NB + b) * CAP + slot] = ff[j]; sel[slot] = 4 * tid + j; }
            INV[((size_t)b * SEQ + 4 * tid + j) * 16 + e] = slot; }
        __syncthreads();
        __syncthreads();
    }
}

struct ExpertOrder {
    int G, c, upe, npn;
    __device__ void init(int G_, int c_, int npn_) { G = G_; c = c_; npn = npn_; upe = 32 * npn_; }
    __device__ bool next(int i, Unit& u) const { const unsigned L = (unsigned)i * (unsigned)G + (unsigned)c; if (L >= (unsigned)(NE * upe)) return false;
        const unsigned e = L / (unsigned)upe, rem = L - e * (unsigned)upe; u.pm = (int)(e * 32u + (rem & 31u)); u.pn = (int)(e * (unsigned)npn + (rem >> 5)); return true; }
    __device__ __forceinline__ void a_ready(const Unit&) const {}
    __device__ __forceinline__ void done(const Unit&) const {}
};
struct EpiSwiglu {
    static constexpr bool PERM = true, AFTER_DRAIN = false;
    unsigned char* act;
    __device__ __forceinline__ void operator()(const f32x4 (&acc)[2][2][4][2], const Unit& u, int wr, int wc, int fr, int fq) const {
        const int e = u.pm >> 5, pnl = u.pn - 12 * e; const int row0 = u.pm * 256 + wr * 64 + fr, col = 128 * pnl + wc * 32 + 8 * fq;
        constexpr float WI = 1.0f / W_SCALE, OS = ACT_SCALE / W_SCALE;
#pragma unroll
        for (int ai = 0; ai < 2; ++ai)
#pragma unroll
            for (int m = 0; m < 4; ++m) { const f32x4 g0 = acc[ai][0][m][0] * WI, g1 = acc[ai][0][m][1] * WI, u0 = acc[ai][1][m][0] * OS, u1 = acc[ai][1][m][1] * OS;
                v2u o; o.x = pk4f8(g0.x * sigmoidf_(g0.x) * u0.x, g0.y * sigmoidf_(g0.y) * u0.y, g0.z * sigmoidf_(g0.z) * u0.z, g0.w * sigmoidf_(g0.w) * u0.w);
                o.y = pk4f8(g1.x * sigmoidf_(g1.x) * u1.x, g1.y * sigmoidf_(g1.y) * u1.y, g1.z * sigmoidf_(g1.z) * u1.z, g1.w * sigmoidf_(g1.w) * u1.w);
                *(GAS v2u*)(act + (size_t)(row0 + ai * 128 + m * 16) * DFF + col) = o; }
    }
};
struct EpiDown {
    static constexpr bool PERM = true, AFTER_DRAIN = false;
    bf16* y2; const float* val;
    __device__ __forceinline__ void operator()(const f32x4 (&acc)[2][2][4][2], const Unit& u, int wr, int wc, int fr, int fq) const {
        const int e = u.pm >> 5, pnl = u.pn - 4 * e; const int srow0 = u.pm * 256 + wr * 64 + fr, col0 = pnl * 256 + wc * 32 + 8 * fq;
#pragma unroll
        for (int ai = 0; ai < 2; ++ai)
#pragma unroll
            for (int m = 0; m < 4; ++m) { const int srow = srow0 + ai * 128 + m * 16; const float vl = val[srow] * (1.0f / (W_SCALE * ACT_SCALE));
#pragma unroll
                for (int bj = 0; bj < 2; ++bj) { const f32x4 v0 = acc[ai][bj][m][0] * vl, v1 = acc[ai][bj][m][1] * vl;
                    v4u w; w.x = pkbf(v0.x, v0.y); w.y = pkbf(v0.z, v0.w); w.z = pkbf(v1.x, v1.y); w.w = pkbf(v1.z, v1.w);
                    *(GAS v4u*)(y2 + (size_t)srow * DM + col0 + bj * 128) = w; } }
    }
};
__device__ __forceinline__ void p12_combine(Frame& F, bool dostore = true) {
    const int gw = blockIdx.x * NWAVES + F.wave, NGW = F.G * NWAVES, lane = F.lane;
    const int* INV = (const int*)(F.ws + WS_INV); const bf16* Y2 = (const bf16*)(F.ws + WS_Y2); const float* mod = (const float*)(F.ws + WS_MOD);
    const float* Xp = karg_in(I_X); const bf16* DELTA = (const bf16*)(F.ws + WS_DELTA);
    for (int m0 = gw; m0 < NLAT; m0 += 2 * NGW) {
        int inv[2]; f32x4 xv[2][4];
#pragma unroll
        for (int r = 0; r < 2; ++r) { const int m = min(m0 + r * NGW, NLAT - 1);
            { const int iv = INV[(size_t)m * 16 + (lane & 15)]; inv[r] = lane < 16 ? iv : -1; const float* orow = Xp + (size_t)m * DM; const bf16* dr = DELTA + (size_t)m * DM;
                const v4u d0 = *(const GAS v4u*)(dr + 8 * lane), d1 = *(const GAS v4u*)(dr + 512 + 8 * lane);
                xv[r][0] = *(const GAS f32x4*)(orow + 8 * lane) + (f32x4){bflo(d0.x), bfhi(d0.x), bflo(d0.y), bfhi(d0.y)}; xv[r][1] = *(const GAS f32x4*)(orow + 8 * lane + 4) + (f32x4){bflo(d0.z), bfhi(d0.z), bflo(d0.w), bfhi(d0.w)};
                xv[r][2] = *(const GAS f32x4*)(orow + 512 + 8 * lane) + (f32x4){bflo(d1.x), bfhi(d1.x), bflo(d1.y), bfhi(d1.y)}; xv[r][3] = *(const GAS f32x4*)(orow + 512 + 8 * lane + 4) + (f32x4){bflo(d1.z), bfhi(d1.z), bflo(d1.w), bfhi(d1.w)}; } }
#pragma unroll
        for (int r = 0; r < 2; ++r) { const int m = m0 + r * NGW; if (m >= NLAT) continue;
            const int b = m >> 11; unsigned long long mk = __ballot(inv[r] >= 0);
            float a0[8] = {0.f, 0.f, 0.f, 0.f, 0.f, 0.f, 0.f, 0.f}, a1[8] = {0.f, 0.f, 0.f, 0.f, 0.f, 0.f, 0.f, 0.f};
            while (mk) {
                const int e = __builtin_ctzll(mk); mk &= mk - 1; const int slot = __builtin_amdgcn_readlane(inv[r], e);
                const bool two = mk != 0; int e2 = e, slot2 = slot; if (two) { e2 = __builtin_ctzll(mk); mk &= mk - 1; slot2 = __builtin_amdgcn_readlane(inv[r], e2); }
                const bf16* yr = Y2 + ((size_t)(e * NB + b) * CAP + slot) * DM; const bf16* yr2 = Y2 + ((size_t)(e2 * NB + b) * CAP + slot2) * DM;
                const v4u q0 = *(const GAS v4u*)(yr + 8 * lane), q1 = *(const GAS v4u*)(yr + 512 + 8 * lane), q2 = *(const GAS v4u*)(yr2 + 8 * lane), q3 = *(const GAS v4u*)(yr2 + 512 + 8 * lane);
                float f0[8], f1[8], f2[8], f3[8]; unpack8(q0, f0); unpack8(q1, f1); unpack8(q2, f2); unpack8(q3, f3);
                const float w2 = two ? 1.0f : 0.0f;
#pragma unroll
                for (int j = 0; j < 8; ++j) { a0[j] += f0[j] + w2 * f2[j]; a1[j] += f1[j] + w2 * f3[j]; }
            }
            float* orow = F.out + (size_t)m * DM; const float* g = mod + (size_t)b * 6144 + 5120;
            const f32x4 g0 = *(const f32x4*)(g + 8 * lane), g1 = *(const f32x4*)(g + 8 * lane + 4), g2 = *(const f32x4*)(g + 512 + 8 * lane), g3 = *(const f32x4*)(g + 512 + 8 * lane + 4);
            if (dostore) {
            *(GAS f32x4*)(orow + 8 * lane) = xv[r][0] + g0 * (f32x4){a0[0], a0[1], a0[2], a0[3]}; *(GAS f32x4*)(orow + 8 * lane + 4) = xv[r][1] + g1 * (f32x4){a0[4], a0[5], a0[6], a0[7]};
            *(GAS f32x4*)(orow + 512 + 8 * lane) = xv[r][2] + g2 * (f32x4){a1[0], a1[1], a1[2], a1[3]}; *(GAS f32x4*)(orow + 512 + 8 * lane + 4) = xv[r][3] + g3 * (f32x4){a1[4], a1[5], a1[6], a1[7]}; }
        }
    }
}

struct Args { const float* in[30]; float* out; unsigned char* ws; int ph_lo, ph_hi; };
__global__ void __launch_bounds__(NWAVES * 64, 2) mk_fwd(Args args) {
    extern __shared__ __attribute__((aligned(16))) unsigned char lds[];
    Frame F;
    F.lds = (LAS unsigned char*)lds; F.MISC = (volatile LAS unsigned*)(F.lds + MISC_OFF);
    F.tid = threadIdx.x; F.lane = F.tid & 63; F.wave = __builtin_amdgcn_readfirstlane(F.tid >> 6); F.G = gridDim.x;
    F.out = args.out; F.ws = args.ws; F.ctl = (gu32*)(args.ws + WS_CTL);
    for (int u = F.tid; u < (LDS_BYTES - LDSCTL_OFF) / 4; u += NWAVES * 64) ((LAS unsigned*)(F.lds + LDSCTL_OFF))[u] = 0u;
    __syncthreads();
    XcdBarrier bar; bar.bar = (unsigned*)(F.ctl + CW_BAR); bar.x = 0; bar.st = nullptr;
    if (N_LAUNCHES == 1) bar = xcd_barrier_post((unsigned*)(F.ctl + CW_BAR), F.MISC + 8);
#define GRID_BAR() do { if (N_LAUNCHES == 1) xcd_barrier(bar); } while (0)
    const int lo = args.ph_lo, hi = args.ph_hi;
#ifndef PH_MASK
#define PH_MASK 0x1FFF
#endif
#define IN(k) (((PH_MASK >> (k)) & 1) && lo <= (k) && (k) < hi)
#define SEAM(k) do { if (IN(k) && IN((k) + 1)) GRID_BAR(); } while (0)
    unsigned char* ws = args.ws;

    if (IN(0)) { p0_prologue(F); } SEAM(0);
    if (IN(1)) { p1_norm1(F); } SEAM(1);
    if (IN(2)) {
        pg8::Gemm g{(const bf16*)(ws + WS_H1), (const bf16*)(ws + WS_WIN), NTOK, WIN_ROWS, DM}; InprojOrder S; S.init(F.G, (int)blockIdx.x);
        EpiInproj E{(bf16*)(ws + WS_ZK), (bf16*)(ws + WS_ZV), (bf16*)(ws + WS_ZR), (bf16*)(ws + WS_Q), (bf16*)(ws + WS_KQ), (bf16*)(ws + WS_VQ), (bf16*)(ws + WS_LA), (bf16*)args.out};
        pg8::gemm_phase<EpiInproj, InprojOrder, true, true>(F.lds, g, S, E);
    } SEAM(2);
    if (IN(3)) {
        p3a_lora(F);
        p3b_attn_prep(F);
    } SEAM(3);
    if (IN(4)) { p4a_attention(F); __syncthreads(); p4b_scan(F); } SEAM(4);
    if (IN(5)) { p5_rwkv_out(F); } SEAM(5);
    if (IN(6)) {
        pg8::Gemm g{(const bf16*)(ws + WS_ORW), (const bf16*)(ws + WS_WBRR), NLAT, DM, DM, (const bf16*)(ws + WS_Q), 512}; pg8::StaticOrder S; S.init(NLAT, DM, F.G, (int)blockIdx.x);
        EpiMerge2 E{(bf16*)(ws + WS_MERGED), (const bf16*)args.out};
        pg8::gemm_phase<EpiMerge2, pg8::StaticOrder, true, true, true>(F.lds, g, S, E);
    } SEAM(6);
    if (IN(7)) {
        pg8::Gemm g{(const bf16*)(ws + WS_MERGED), (const bf16*)(ws + WS_WOUT), NLAT, DM, DM}; pg8::StaticOrder S; S.init(NLAT, DM, F.G, (int)blockIdx.x);
        EpiOutproj E{(bf16*)(ws + WS_DELTA), (const float*)(ws + WS_MOD)};
        pg8::gemm_phase<EpiOutproj, pg8::StaticOrder, true, true>(F.lds, g, S, E);
    } SEAM(7);
    if (IN(8)) { p8_norm2_router(F); } SEAM(8);
    if (IN(9)) { p9_topk_gather(F); } SEAM(9);
    if (IN(10)) {
        pg8::Gemm g{(const bf16*)(ws + WS_H2Q), (const bf16*)(ws + WS_WGU), NSLOT, NE * 3072, DM / 2, nullptr, 0, (const int*)(ws + WS_IDX), (LAS int*)(F.lds + RING_BYTES)}; ExpertOrder S; S.init(F.G, (int)blockIdx.x, 12);
        EpiSwiglu E{ws + WS_ACT};
        pg8::gemm_phase<EpiSwiglu, ExpertOrder, true, true, false, true, true>(F.lds, g, S, E);
    } SEAM(10);
    if (IN(11)) {
        pg8::Gemm g{(const bf16*)(ws + WS_ACT), (const bf16*)(ws + WS_WD), NSLOT, NE * 1024, DFF / 2}; ExpertOrder S; S.init(F.G, (int)blockIdx.x, 4);
        EpiDown E{(bf16*)(ws + WS_Y2), (const float*)(ws + WS_VAL)};
        pg8::gemm_phase<EpiDown, ExpertOrder, true, true, false, false, true>(F.lds, g, S, E);
    } SEAM(11);
    if (IN(12)) { p12_combine(F); }
#undef IN
#undef SEAM
#undef GRID_BAR
}

extern "C" void kernel_launch(void* const* d_in, const int* in_sizes, int n_in, void* d_out, int out_size, void* d_ws, size_t ws_size, hipStream_t stream) {
    static int grid = 0;
    if (grid == 0) {
        if (n_in != 30 || out_size != NLAT * DM || ws_size < WS_END) { fprintf(stderr, "kernel_launch: unexpected problem (n_in %d out %d ws %zu)\n", n_in, out_size, ws_size); grid = -1; return; }
        int dev = 0, cus = 0, per_cu = 0;
        if (hipGetDevice(&dev) != hipSuccess || hipDeviceGetAttribute(&cus, hipDeviceAttributeMultiprocessorCount, dev) != hipSuccess) { grid = -1; return; }
        if (hipFuncSetAttribute((const void*)mk_fwd, hipFuncAttributeMaxDynamicSharedMemorySize, LDS_BYTES) != hipSuccess) { fprintf(stderr, "kernel_launch: hipFuncSetAttribute failed\n"); grid = -1; return; }
        if (hipOccupancyMaxActiveBlocksPerMultiprocessor(&per_cu, (const void*)mk_fwd, NWAVES * 64, LDS_BYTES) != hipSuccess || per_cu < 1) fprintf(stderr, "kernel_launch: occupancy query says %d\n", per_cu);
        (void)hipGetLastError();
        grid = cus;
    }
    if (grid < 0) return;
    if (hipMemsetAsync((char*)d_ws + WS_CTL, 0, CTL_ZERO_BYTES, stream) != hipSuccess) return;
    Args a{};
    for (int i = 0; i < 30; ++i) a.in[i] = (const float*)d_in[i];
    a.out = (float*)d_out; a.ws = (unsigned char*)d_ws;
    if (N_LAUNCHES == 1) { a.ph_lo = 0; a.ph_hi = N_PHASES; hipLaunchKernelGGL(mk_fwd, dim3(grid), dim3(NWAVES * 64), LDS_BYTES, stream, a); }
    else for (int li = 0; li < N_PHASES; ++li) { a.ph_lo = li; a.ph_hi = li + 1; hipLaunchKernelGGL(mk_fwd, dim3(grid), dim3(NWAVES * 64), LDS_BYTES, stream, a); }
}
```

```cpp
#include <hip/hip_runtime.h>
#include <cstdio>
#include <cstdint>
#define MK_N_LAUNCHES 1
namespace pg8 {
#define PG8_LAS __attribute__((address_space(3)))
typedef unsigned short bf16_t;
typedef short bf16x8 __attribute__((ext_vector_type(8)));
typedef float f32x4 __attribute__((ext_vector_type(4)));
typedef unsigned u32x4 __attribute__((ext_vector_type(4)));
typedef int i32x4 __attribute__((ext_vector_type(4)));
typedef int i32x8 __attribute__((ext_vector_type(8)));
constexpr int BM = 256, BK = 64, HALF = 128, HTB = HALF * BK * 2  , STAGE_BYTES = 8 * HTB, NXCD = 8, WGM = 8;

__host__ __device__ __forceinline__ int lds_byte(int r, int c) { const int st = (r >> 4) * 2 + (c >> 5), rr = r & 15, cc = c & 31, ob = rr * 64 + cc * 2; return st * 1024 + (ob ^ (((ob >> 9) & 1) << 5)); }
__host__ __device__ __forceinline__ void stage_rc(int b, int& R, int& C) { const int st = b / 1024, sb = b % 1024, swz = sb ^ (((sb >> 9) & 1) << 5); R = (st >> 1) * 16 + swz / 64; C = (st & 1) * 32 + (swz % 64) / 2; }
__host__ __device__ __forceinline__ int perm32(int rho) { const int n = rho >> 4, i = rho & 15; return 8 * (i >> 2) + 4 * n + (i & 3); }

struct Unit { int pm, pn; };
struct Gemm { const bf16_t* A; const bf16_t* Bt; int M, N, K; const bf16_t* A2 = nullptr; int lda = 0; const int* gidx = nullptr; PG8_LAS int* glds = nullptr; };

struct StaticOrder {
    int nM, nN, nwg, G, c;
    __host__ __device__ void init(int M, int N, int G_, int c_) { nM = M / BM; nN = N / BM; nwg = nM * nN; G = G_; c = c_; }
    __host__ __device__ bool next(int i, Unit& u) const {
        const long L = (long)i * G + c; if (L >= nwg) return false;
        int wgid = (int)L; { const int q = nwg / NXCD, r = nwg % NXCD, xcd = wgid % NXCD, off = wgid / NXCD; wgid = (xcd < r ? xcd * (q + 1) : r * (q + 1) + (xcd - r) * q) + off; }
        const int nig = WGM * nN, gid = wgid / nig, fm = gid * WGM, gsz = (nM - fm) < WGM ? (nM - fm) : WGM;
        u.pm = fm + ((wgid % nig) % gsz); u.pn = (wgid % nig) / gsz; return true;
    }
    __device__ __forceinline__ void a_ready(const Unit&) const {}
    __device__ __forceinline__ void done(const Unit&) const {}
};

template <class Epi, class Sched, bool ALIGN_EPI = false, bool SP2 = false, bool SPLITA = false, bool GATHERA = false, bool FP8 = false>
__device__ __forceinline__ void gemm_phase(PG8_LAS unsigned char* lds, const Gemm g, const Sched& S, const Epi& E, const int wid, const int lane) {
    const int tid = wid * 64 + lane, wr = wid >> 2, wc = wid & 3, fr = lane & 15, fq = lane >> 4;
    const int K = g.K, nt = K / BK, lda = g.lda ? g.lda : g.K, nh = nt / 2;
    unsigned voffA[2], voffB[2];
#pragma unroll
    for (int i = 0; i < 2; ++i) { int R, C; stage_rc(tid * 16 + i * 8192, R, C); const int Rb = Epi::PERM ? ((R & ~31) + perm32(R & 31)) : R;
        voffA[i] = (unsigned)(R * lda + C) * 2u; voffB[i] = (unsigned)(Rb * K + C) * 2u; }
    const size_t kstep = (size_t)(BK * 2);
    const size_t hstep = (size_t)HALF * K * 2;
    const size_t tstep = 2 * hstep;
    const size_t hstepA = (size_t)HALF * lda * 2, tstepA = 2 * hstepA;
    const unsigned ldsw = (unsigned)wid * 1024u;
    const int aoff = lds_byte(wr * 64 + fr, fq * 8), boff = lds_byte(wc * 32 + fr, fq * 8);
#define PG8_SA(b, h) (((b) * 2 + (h)) * HTB)
#define PG8_SB(b, h) ((4 + (b) * 2 + (h)) * HTB)
#define PG8_STAGE(bufoff, gbase, voff) do { _Pragma("unroll") for (int _i = 0; _i < 2; ++_i) \
        __builtin_amdgcn_global_load_lds((const unsigned*)((const char*)(gbase) + (voff)[_i]), (PG8_LAS unsigned*)(lds + (bufoff) + ldsw + _i * 8192), 16, 0, 0); } while (0)
#define PG8_LD32(off) __builtin_shufflevector(*(const PG8_LAS i32x4*)(lds + (off)), *(const PG8_LAS i32x4*)(lds + (off) + 1024), 0, 1, 2, 3, 4, 5, 6, 7)
#define PG8_LDA(dst, b, h) do { if constexpr (FP8) { _Pragma("unroll") for (int m = 0; m < 4; ++m) dst##8[m] = PG8_LD32(PG8_SA(b, h) + aoff + m * 2048); } else { \
        _Pragma("unroll") for (int m = 0; m < 4; ++m) _Pragma("unroll") for (int k = 0; k < 2; ++k) dst[m][k] = *(const PG8_LAS bf16x8*)(lds + PG8_SA(b, h) + aoff + m * 2048 + k * 1024); } } while (0)
#define PG8_LDB(dst, b, h) do { if constexpr (FP8) { _Pragma("unroll") for (int n = 0; n < 2; ++n) dst##8[n] = PG8_LD32(PG8_SB(b, h) + boff + n * 2048); } else { \
        _Pragma("unroll") for (int n = 0; n < 2; ++n) _Pragma("unroll") for (int k = 0; k < 2; ++k) dst[n][k] = *(const PG8_LAS bf16x8*)(lds + PG8_SB(b, h) + boff + n * 2048 + k * 1024); } } while (0)
#define PG8_MMA(ai, bj, At, Bt) do { __builtin_amdgcn_s_setprio(1); if constexpr (FP8) { _Pragma("unroll") for (int m = 0; m < 4; ++m) _Pragma("unroll") for (int n = 0; n < 2; ++n) \
        asm volatile("v_mfma_f32_16x16x128_f8f6f4 %0, %1, %2, %0" : "+v"(acc[ai][bj][m][n]) : "v"(Bt##8[n]), "v"(At##8[m])); } else { \
        _Pragma("unroll") for (int m = 0; m < 4; ++m) _Pragma("unroll") for (int n = 0; n < 2; ++n) _Pragma("unroll") for (int k = 0; k < 2; ++k) \
        acc[ai][bj][m][n] = __builtin_amdgcn_mfma_f32_16x16x32_bf16(Bt[n][k], At[m][k], acc[ai][bj][m][n], 0, 0, 0); } __builtin_amdgcn_s_setprio(0); } while (0)
#define PG8_WAIT_V(n) asm volatile("s_waitcnt vmcnt(" #n ")" ::: "memory")
#define PG8_WAIT_L(n) asm volatile("s_waitcnt lgkmcnt(" #n ")" ::: "memory")
#define PG8_BAR __builtin_amdgcn_s_barrier()
#define PG8_SCHED __builtin_amdgcn_sched_barrier(0)
    Unit cur, nxt; int ui = 0;
    if (!S.next(0, cur)) return;
    f32x4 acc[2][2][4][2];
#pragma unroll
    for (int a = 0; a < 2; ++a)
#pragma unroll
        for (int b = 0; b < 2; ++b)
#pragma unroll
            for (int m = 0; m < 4; ++m)
#pragma unroll
                for (int n = 0; n < 2; ++n) acc[a][b][m][n] = (f32x4){0.f, 0.f, 0.f, 0.f};
    bf16x8 At[4][2], B0[2][2], B1[2][2]; i32x8 At8[4], B08[2], B18[2];
    const char* cA = (const char*)g.A + (size_t)cur.pm * tstepA; const char* cB = (const char*)g.Bt + (size_t)cur.pn * tstep;
    const char* cA2 = SPLITA ? (const char*)g.A2 + (size_t)cur.pm * tstepA : cA;
#define PG8_AADDR(tt) (SPLITA ? (((tt) < nh) ? cA + (size_t)(tt) * kstep : cA2 + (size_t)((tt) - nh) * kstep) : cA + (size_t)(tt) * kstep)
    unsigned gofc[2][2] = {{0u, 0u}, {0u, 0u}}, gofn[2][2] = {{0u, 0u}, {0u, 0u}}; int gR[2] = {0, 0}, gC[2] = {0, 0};
    if constexpr (GATHERA) {
#pragma unroll
        for (int i = 0; i < 2; ++i) { int R, C; stage_rc(tid * 16 + i * 8192, R, C); gR[i] = R; gC[i] = C; }
        if (tid < 256) g.glds[tid] = g.gidx[cur.pm * 256 + tid];
        asm volatile("s_waitcnt vmcnt(0) lgkmcnt(0)" ::: "memory"); __builtin_amdgcn_s_barrier(); asm volatile("" ::: "memory");
#pragma unroll
        for (int hh = 0; hh < 2; ++hh)
#pragma unroll
            for (int i = 0; i < 2; ++i) gofc[hh][i] = (unsigned)(((cur.pm & 31) * 2048 + g.glds[hh * 128 + gR[i]]) * lda + gC[i]) * 2u;
        cA = (const char*)g.A; cA2 = cA;
    }
#define PG8_GA(hh) (GATHERA ? gofc[hh] : voffA)
#define PG8_GN(hh) (GATHERA ? (last ? gofn[hh] : gofc[hh]) : voffA)
#define PG8_HA(x) (GATHERA ? (x) : (x) + hstepA)
    S.a_ready(cur);
    if constexpr (SP2) {
        PG8_STAGE(PG8_SB(0, 0), cB, voffB); PG8_STAGE(PG8_SB(0, 1), cB + hstep, voffB); PG8_STAGE(PG8_SA(0, 0), cA, PG8_GA(0)); PG8_STAGE(PG8_SA(0, 1), PG8_HA(cA), PG8_GA(1));
        if (wr == 1) PG8_BAR;
        PG8_WAIT_V(2); PG8_BAR;
        PG8_STAGE(PG8_SB(1, 0), cB + kstep, voffB); PG8_STAGE(PG8_SA(1, 0), cA + kstep, PG8_GA(0)); PG8_STAGE(PG8_SB(1, 1), cB + hstep + kstep, voffB);
        PG8_WAIT_V(6); PG8_BAR;
    } else {
        PG8_STAGE(PG8_SB(0, 0), cB, voffB); PG8_STAGE(PG8_SA(0, 0), cA, voffA); PG8_STAGE(PG8_SB(0, 1), cB + hstep, voffB); PG8_STAGE(PG8_SA(0, 1), cA + hstepA, voffA);
        if (wr == 1) PG8_BAR;
        PG8_WAIT_V(4); PG8_BAR;
        PG8_STAGE(PG8_SB(1, 0), cB + kstep, voffB); PG8_STAGE(PG8_SA(1, 0), cA + kstep, PG8_GA(0)); PG8_STAGE(PG8_SB(1, 1), cB + hstep + kstep, voffB);
        PG8_WAIT_V(6); PG8_BAR;
    }
    for (;;) {
        const bool has_next = S.next(ui + 1, nxt);
        const char* nA = has_next ? (const char*)g.A + (size_t)nxt.pm * tstepA : cA; const char* nB = has_next ? (const char*)g.Bt + (size_t)nxt.pn * tstep : cB;
        const char* nA2 = (SPLITA && has_next) ? (const char*)g.A2 + (size_t)nxt.pm * tstepA : cA2;
        if constexpr (GATHERA) { nA = cA;
            if (has_next) __builtin_amdgcn_global_load_lds((const unsigned*)(g.gidx + nxt.pm * 256 + (wid & 3) * 64 + lane), (PG8_LAS unsigned*)(g.glds + ((ui + 1) & 1) * 256 + (wid & 3) * 64), 4, 0, 0); }
        for (int t = 0; t < nt; t += 2) {
            const bool last = (t == nt - 2);
            const char* a1 = PG8_AADDR(t + 1);
            const char* a2 = last ? nA : PG8_AADDR(t + 2); const char* b2 = last ? nB : cB + (size_t)(t + 2) * kstep;
            const char* a3 = a2 + kstep; const char* b3 = b2 + kstep;
            if (last && has_next) S.a_ready(nxt);
            if constexpr (GATHERA) { if (last && has_next) {
#pragma unroll
                for (int hh = 0; hh < 2; ++hh)
#pragma unroll
                    for (int i = 0; i < 2; ++i) gofn[hh][i] = (unsigned)(((nxt.pm & 31) * 2048 + g.glds[((ui + 1) & 1) * 256 + hh * 128 + gR[i]]) * lda + gC[i]) * 2u; } }
            if constexpr (SPLITA) { if (t == nh) E.mid(acc, cur, wr, wc, fr, fq); }
            if constexpr (SP2) {
            PG8_LDB(B0, 0, 0); PG8_LDB(B1, 0, 1); PG8_SCHED; PG8_LDA(At, 0, 0); PG8_STAGE(PG8_SA(1, 1), PG8_HA(a1), PG8_GA(1));
            PG8_WAIT_V(8); PG8_WAIT_L(0); PG8_BAR; PG8_MMA(0, 0, At, B0); PG8_MMA(0, 1, At, B1); PG8_BAR; PG8_SCHED;
            PG8_LDA(At, 0, 1); PG8_STAGE(PG8_SB(0, 0), b2, voffB); PG8_STAGE(PG8_SB(0, 1), b2 + hstep, voffB); PG8_STAGE(PG8_SA(0, 0), a2, PG8_GN(0));
            PG8_WAIT_V(8); PG8_WAIT_L(0); PG8_BAR; PG8_MMA(1, 0, At, B0); PG8_MMA(1, 1, At, B1); PG8_BAR; PG8_SCHED;
            PG8_LDB(B0, 1, 0); PG8_LDB(B1, 1, 1); PG8_SCHED; PG8_LDA(At, 1, 0); PG8_STAGE(PG8_SA(0, 1), PG8_HA(a2), PG8_GN(1));
            PG8_WAIT_V(8); PG8_WAIT_L(0); PG8_BAR; PG8_MMA(0, 0, At, B0); PG8_MMA(0, 1, At, B1); PG8_BAR; PG8_SCHED;
            PG8_LDA(At, 1, 1); PG8_STAGE(PG8_SB(1, 0), b3, voffB); PG8_STAGE(PG8_SB(1, 1), b3 + hstep, voffB); PG8_STAGE(PG8_SA(1, 0), a3, PG8_GN(0));
            PG8_WAIT_V(8); PG8_WAIT_L(0); PG8_BAR; PG8_MMA(1, 0, At, B0); PG8_MMA(1, 1, At, B1); PG8_BAR; PG8_SCHED;
            } else {
            PG8_LDB(B0, 0, 0); PG8_SCHED; PG8_LDA(At, 0, 0); PG8_STAGE(PG8_SA(1, 1), a1 + hstepA, voffA);
            PG8_WAIT_L(8); PG8_BAR; PG8_WAIT_L(0); PG8_MMA(0, 0, At, B0); PG8_BAR; PG8_SCHED;
            PG8_LDB(B1, 0, 1); PG8_STAGE(PG8_SB(0, 0), b2, voffB);
            PG8_BAR; PG8_WAIT_L(0); PG8_MMA(0, 1, At, B1); PG8_BAR;
            PG8_LDA(At, 0, 1); PG8_STAGE(PG8_SA(0, 0), a2, voffA);
            PG8_BAR; PG8_WAIT_L(0); PG8_MMA(1, 0, At, B0); PG8_BAR; PG8_SCHED;
            PG8_STAGE(PG8_SB(0, 1), b2 + hstep, voffB);
            PG8_WAIT_V(6); PG8_BAR; PG8_MMA(1, 1, At, B1); PG8_BAR;
            PG8_LDB(B0, 1, 0); PG8_SCHED; PG8_LDA(At, 1, 0); PG8_STAGE(PG8_SA(0, 1), a2 + hstepA, voffA);
            PG8_WAIT_L(8); PG8_BAR; PG8_WAIT_L(0); PG8_MMA(0, 0, At, B0); PG8_BAR; PG8_SCHED;
            PG8_LDB(B1, 1, 1); PG8_STAGE(PG8_SB(1, 0), b3, voffB);
            PG8_BAR; PG8_WAIT_L(0); PG8_MMA(0, 1, At, B1); PG8_BAR;
            PG8_LDA(At, 1, 1); PG8_STAGE(PG8_SA(1, 0), a3, voffA);
            PG8_BAR; PG8_WAIT_L(0); PG8_MMA(1, 0, At, B0); PG8_BAR; PG8_SCHED;
            PG8_STAGE(PG8_SB(1, 1), b3 + hstep, voffB);
            PG8_WAIT_V(6); PG8_BAR; PG8_MMA(1, 1, At, B1); PG8_BAR;
            }
        }
        if constexpr (FP8) asm volatile("s_nop 15\n\ts_nop 15" ::: "memory");
        if constexpr (ALIGN_EPI) { if (wr == 0) PG8_BAR; }
        if constexpr (!Epi::AFTER_DRAIN) { E(acc, cur, wr, wc, fr, fq); S.done(cur); }
        if (!has_next) break;
#pragma unroll
        for (int a = 0; a < 2; ++a)
#pragma unroll
            for (int b = 0; b < 2; ++b)
#pragma unroll
                for (int m = 0; m < 4; ++m)
#pragma unroll
                    for (int n = 0; n < 2; ++n) acc[a][b][m][n] = (f32x4){0.f, 0.f, 0.f, 0.f};
        cur = nxt; cA = nA; cA2 = nA2; cB = nB; ++ui;
        if constexpr (GATHERA) {
#pragma unroll
            for (int hh = 0; hh < 2; ++hh) { gofc[hh][0] = gofn[hh][0]; gofc[hh][1] = gofn[hh][1]; } }
        if constexpr (ALIGN_EPI) { if (wr == 1) PG8_BAR; }
    }
    PG8_WAIT_V(0);
    if constexpr (!ALIGN_EPI) { if (wr == 0) PG8_BAR; }
    PG8_BAR;
    if constexpr (Epi::AFTER_DRAIN) { E.fused(acc, cur, wr, wc, fr, fq, lds, wid, lane); S.done(cur); }
#undef PG8_AADDR
#undef PG8_GA
#undef PG8_GN
#undef PG8_HA
#undef PG8_SA
#undef PG8_SB
#undef PG8_STAGE
#undef PG8_LDA
#undef PG8_LDB
#undef PG8_MMA
#undef PG8_LD32
#undef PG8_WAIT_V
#undef PG8_WAIT_L
#undef PG8_BAR
#undef PG8_SCHED
}
}
#define GAS __attribute__((address_space(1)))
#define LAS __attribute__((address_space(3)))
typedef unsigned short bf16;
typedef unsigned v4u __attribute__((ext_vector_type(4)));
typedef float f32x4 __attribute__((ext_vector_type(4)));
typedef short bf16x8 __attribute__((ext_vector_type(8)));
typedef GAS unsigned gu32;
typedef GAS unsigned long long gu64;
#define RLX_AGENT __ATOMIC_RELAXED, __HIP_MEMORY_SCOPE_AGENT
#define LDS_WAIT() asm volatile("s_waitcnt lgkmcnt(0)" ::: "memory")
#define VM_WAIT() asm volatile("s_waitcnt vmcnt(0)" ::: "memory")
__device__ __forceinline__ unsigned long long rt() { return __builtin_amdgcn_s_memrealtime(); }
__device__ __forceinline__ unsigned f2bf(float f) { unsigned u = __builtin_bit_cast(unsigned, f); return (u + 0x7fffu + ((u >> 16) & 1u)) >> 16; }
__device__ __forceinline__ unsigned pk2(float lo, float hi) { return f2bf(lo) | (f2bf(hi) << 16); }

#define XB_TMO      128
#define XB_XCNT(j)  (256  + 64 * (j))
#define XB_XSUB(j)  (1280 + 64 * (j))
#define XB_XGEN(j)  (2304 + 64 * (j))
#define XB_TOP      3328
#define XB_TOPGEN   3392
#define XCD_BAR_WORDS 3456
#define XB_SPIN_CAP (1u << 18)

__device__ __forceinline__ unsigned xb_ld(unsigned* p)              { return __hip_atomic_load(p, __ATOMIC_RELAXED, __HIP_MEMORY_SCOPE_AGENT); }
__device__ __forceinline__ unsigned xb_add(unsigned* p, unsigned v) { return __hip_atomic_fetch_add(p, v, __ATOMIC_RELAXED, __HIP_MEMORY_SCOPE_AGENT); }
__device__ __forceinline__ unsigned xb_xcc_id() { return (unsigned)__builtin_amdgcn_s_getreg((3 << 11) | 20) & 0xFu; }
#define XB_SPIN(cond, bar) do { unsigned _sp = 0; while (cond) { __builtin_amdgcn_s_sleep(1); \
    if ((++_sp & 255u) == 0u) { if (xb_ld(&(bar)[XB_TMO])) break; if (_sp > XB_SPIN_CAP) { atomicAdd(&(bar)[XB_TMO], 1u); break; } } } } while (0)

__device__ __forceinline__ int mk_lane() { int l; asm volatile("v_mbcnt_lo_u32_b32 %0, -1, 0\n\tv_mbcnt_hi_u32_b32 %0, -1, %0" : "=v"(l)); return l; }
struct XcdBarrier {
    int w;
    unsigned* bar; unsigned x;
    volatile LAS unsigned* st;
};

__device__ __forceinline__ XcdBarrier xcd_barrier_post(unsigned* bar, volatile LAS unsigned* st) {
    XcdBarrier b; b.bar = bar; b.x = xb_xcc_id(); b.st = st; b.w = __builtin_amdgcn_readfirstlane((int)threadIdx.x >> 6);
    if (threadIdx.x == 0) (void)xb_add(&bar[XB_XCNT(b.x)], 1u);
    return b;
}
__device__ __forceinline__ void xcd_barrier_complete(unsigned* bar, unsigned x, unsigned& nloc, unsigned& nx) {
    const unsigned G = gridDim.x * gridDim.y * gridDim.z;
    unsigned sum, cnt, mine, sp = 0u;
    for (;;) {
        sum = 0u; cnt = 0u; mine = 0u;
#pragma unroll
        for (unsigned j = 0; j < 16; ++j) { const unsigned c = xb_ld(&bar[XB_XCNT(j)]); sum += c; cnt += (c > 0u) ? 1u : 0u; mine = (j == x) ? c : mine; }
        if (sum == G) break;
        __builtin_amdgcn_s_sleep(1);
        if ((++sp & 255u) == 0u) { if (xb_ld(&bar[XB_TMO])) break; if (sp > XB_SPIN_CAP) { atomicAdd(&bar[XB_TMO], 1u); break; } }
    }
    nloc = mine > 0u ? mine : 1u; nx = cnt > 0u ? cnt : 1u;
}

__device__ __forceinline__ void xcd_barrier(const XcdBarrier& b) {
    asm volatile("s_waitcnt vmcnt(0)" ::: "memory");
    __syncthreads();
    if (b.w == 0 && mk_lane() == 0) {
        unsigned* bar = b.bar;
        __builtin_amdgcn_s_waitcnt(0);
        unsigned nloc = b.st[0], nx = b.st[1];
        if (nloc == 0u) { xcd_barrier_complete(bar, b.x, nloc, nx); b.st[0] = nloc; b.st[1] = nx; }
        const unsigned old = xb_add(&bar[XB_XSUB(b.x)], 1u);
        const unsigned gen = old / nloc;
        if (old + 1u == (gen + 1u) * nloc) {
            __builtin_amdgcn_fence(__ATOMIC_RELEASE, "agent");
            asm volatile("s_waitcnt vmcnt(0)" ::: "memory");
            const unsigned og = xb_add(&bar[XB_TOP], 1u);
            const unsigned tg = og / nx;
            if (og + 1u == (tg + 1u) * nx) xb_add(&bar[XB_TOPGEN], 1u);
            else XB_SPIN(xb_ld(&bar[XB_TOPGEN]) == tg, bar);
            __builtin_amdgcn_fence(__ATOMIC_ACQUIRE, "agent");
            xb_add(&bar[XB_XGEN(b.x)], 1u);
            asm volatile("s_waitcnt vmcnt(0)" ::: "memory");
        } else {
            XB_SPIN(xb_ld(&bar[XB_XGEN(b.x)]) == gen, bar);
            __builtin_amdgcn_fence(__ATOMIC_ACQUIRE, "agent");
            asm volatile("s_waitcnt vmcnt(0)" ::: "memory");
        }
    }
    __syncthreads();
}

typedef float f32x2 __attribute__((ext_vector_type(2)));
typedef float f32x16 __attribute__((ext_vector_type(16)));
typedef unsigned v2u __attribute__((ext_vector_type(2)));
typedef __bf16 bf16x2_t __attribute__((ext_vector_type(2)));
using pg8::Unit;

constexpr int NWAVES = 8;
#ifndef MK_N_LAUNCHES
#define MK_N_LAUNCHES 1
#endif
constexpr int N_PHASES = 13;
constexpr int N_LAUNCHES = MK_N_LAUNCHES;

constexpr int NB = 32, SEQ = 2048, LC = 256, DM = 1024, NLAT = NB * SEQ, NCTX = NB * LC, NTOK = NLAT + NCTX;
constexpr int NE = 16, CAP = 256, DFF = 1536, NSLOT = NE * NB * CAP;
constexpr int WIN_ROWS = 2816, LORA_N = 2560, LORA_K = 384;
constexpr int KEYS = SEQ + LC;

constexpr size_t MiB = 1u << 20, KiB = 1u << 10;
constexpr size_t WS_CTL = 0, CTL_ZERO_BYTES = 1 * MiB;
constexpr size_t WS_MOD = 1 * MiB;
constexpr size_t WS_WIN = 2 * MiB;
constexpr size_t WS_WG8 = 8 * MiB;
constexpr size_t WS_H1Q = 700 * MiB;
constexpr size_t WS_WLORA = 11 * MiB + 512 * KiB;
constexpr size_t WS_WBRR = 13 * MiB + 512 * KiB;
constexpr size_t WS_WBRA = 14 * MiB + 512 * KiB;
constexpr size_t WS_WOUT = 15 * MiB + 512 * KiB;
constexpr size_t WS_WGU = 17 * MiB + 512 * KiB;
constexpr size_t WS_WD = 113 * MiB + 512 * KiB;
constexpr size_t WS_IDX = 161 * MiB + 512 * KiB;
constexpr size_t WS_VAL = 162 * MiB;
constexpr size_t WS_ZK = 163 * MiB;
constexpr size_t WS_ZV = 235 * MiB;
constexpr size_t WS_ZR = 307 * MiB;
constexpr size_t WS_Q = 371 * MiB;
constexpr size_t WS_KQ = 435 * MiB;
constexpr size_t WS_VQ = 453 * MiB;
constexpr size_t WS_XCH = 453 * MiB;
constexpr size_t WS_YB = 959 * MiB;
constexpr size_t WS_LA = 471 * MiB;
constexpr size_t WS_H1 = 525 * MiB;
constexpr size_t WS_EW = 525 * MiB;
constexpr size_t WS_ORW = 525 * MiB;
constexpr size_t WS_AS = 669 * MiB;
constexpr size_t WS_G = 813 * MiB;
constexpr size_t WS_VT = 877 * MiB;
constexpr size_t WS_YF = 895 * MiB;
constexpr size_t WS_MERGED = 163 * MiB;
constexpr size_t WS_INV = 163 * MiB;
constexpr size_t WS_XE = 167 * MiB;
constexpr size_t WS_Y2 = 167 * MiB;
constexpr size_t WS_H2 = 167 * MiB;
constexpr size_t WS_AFF = 551 * MiB;
constexpr size_t WS_ACT = 423 * MiB;
constexpr size_t WS_H2Q = 700 * MiB;
constexpr float Y2_SCALE = 32.0f;
constexpr float W_SCALE = 32.0f, ACT_SCALE = 8.0f;
constexpr size_t WS_DELTA = 807 * MiB;
constexpr size_t WS_END = 1023 * MiB;
constexpr int CW_BAR = 4096;

constexpr int RING_BYTES = 131072;
constexpr int LDSCTL_OFF = 147456 - 1024, MISC_OFF = LDSCTL_OFF + 320;
static_assert(33 * 1024 * 4 <= LDSCTL_OFF, "P0's silu(c) image must stay below the LDS control words");
constexpr int LDS_BYTES = 147456;

__device__ __forceinline__ unsigned pkbf(float lo, float hi) { f32x2 v = {lo, hi}; return __builtin_bit_cast(unsigned, __builtin_convertvector(v, bf16x2_t)); }
__device__ __forceinline__ unsigned pk4f8(float a, float b, float c, float d) {
    a = __builtin_amdgcn_fmed3f(a, -448.f, 448.f); b = __builtin_amdgcn_fmed3f(b, -448.f, 448.f); c = __builtin_amdgcn_fmed3f(c, -448.f, 448.f); d = __builtin_amdgcn_fmed3f(d, -448.f, 448.f);
    int r = __builtin_amdgcn_cvt_pk_fp8_f32(a, b, 0, false); r = __builtin_amdgcn_cvt_pk_fp8_f32(c, d, r, true); return (unsigned)r; }
__device__ __forceinline__ float bflo(unsigned u) { return __uint_as_float(u << 16); }
__device__ __forceinline__ float bfhi(unsigned u) { return __uint_as_float(u & 0xffff0000u); }
__device__ __forceinline__ float bf1(bf16 h) { return __uint_as_float(((unsigned)h) << 16); }
__device__ __forceinline__ float sigmoidf_(float x) { return __builtin_amdgcn_rcpf(1.0f + __builtin_amdgcn_exp2f(-1.4426950408889634f * x)); }
__device__ __forceinline__ float tanhf_(float x) { return 1.0f - 2.0f * __builtin_amdgcn_rcpf(__builtin_amdgcn_exp2f(2.8853900817779268f * x) + 1.0f); }
__device__ __forceinline__ float wave_sum(float v) {
    int x = __float_as_int(v);
#define WS_DPP(ctrl, rmask) x = __float_as_int(__int_as_float(x) + __int_as_float(__builtin_amdgcn_update_dpp(0, x, ctrl, rmask, 0xf, false)))
    WS_DPP(0x111, 0xf); WS_DPP(0x112, 0xf); WS_DPP(0x114, 0xf); WS_DPP(0x118, 0xf); WS_DPP(0x142, 0xa); WS_DPP(0x143, 0xc);
#undef WS_DPP
    return __int_as_float(__builtin_amdgcn_readlane(x, 63));
}
__device__ __forceinline__ void unpack8(const v4u w, float (&f)[8]) {
    f[0] = bflo(w.x); f[1] = bfhi(w.x); f[2] = bflo(w.y); f[3] = bfhi(w.y); f[4] = bflo(w.z); f[5] = bfhi(w.z); f[6] = bflo(w.w); f[7] = bfhi(w.w);
}
__device__ __forceinline__ void unpack8f8(const v2u w, float (&f)[8]) {
    const f32x2 a = __builtin_amdgcn_cvt_pk_f32_fp8((int)w.x, false), b = __builtin_amdgcn_cvt_pk_f32_fp8((int)w.x, true), c = __builtin_amdgcn_cvt_pk_f32_fp8((int)w.y, false), d = __builtin_amdgcn_cvt_pk_f32_fp8((int)w.y, true);
    f[0] = a.x; f[1] = a.y; f[2] = b.x; f[3] = b.y; f[4] = c.x; f[5] = c.y; f[6] = d.x; f[7] = d.y; }
__device__ __forceinline__ v4u pack8(const float (&f)[8]) { v4u w; w.x = pkbf(f[0], f[1]); w.y = pkbf(f[2], f[3]); w.z = pkbf(f[4], f[5]); w.w = pkbf(f[6], f[7]); return w; }

struct Frame {
    LAS unsigned char* lds;
    volatile LAS unsigned* MISC;
    gu32* ctl;
    int tid, lane, wave, G;
    float* out; unsigned char* ws;
};
enum { I_X = 0, I_C, I_CTX, I_CCTX, I_ADAW, I_ADAB, I_N1G, I_N2G, I_WIN, I_CONV, I_W0, I_W2, I_A0, I_A2, I_KK, I_KA, I_RK, I_G2, I_LNW, I_LNB, I_QG, I_KG, I_SINK,
       I_WBRR, I_WBRA, I_WOUT, I_ROUTER, I_EG, I_EU, I_ED };
typedef const __attribute__((address_space(4))) unsigned char* kptr_t;
__device__ __forceinline__ const float* karg_in(int i) { kptr_t kp = (kptr_t)__builtin_amdgcn_kernarg_segment_ptr(); asm volatile("" : "+s"(kp)); return *(const float* const __attribute__((address_space(4)))*)(kp + 8 * i); }

__device__ __forceinline__ void transpose_item(const float* W, int N, int k0, int n0, bf16* WT, int Kd, int drow0, LAS float* scr, int lane) {
#pragma unroll 8
    for (int i = 0; i < 32; ++i) { const int kk = 2 * i + (lane >> 5); scr[kk * 33 + (lane & 31)] = W[(size_t)(k0 + kk) * N + n0 + (lane & 31)]; }
    LDS_WAIT(); asm volatile("" ::: "memory");
    const int c = lane & 7;
#pragma unroll
    for (int j = 0; j < 4; ++j) { const int n = (lane >> 3) + 8 * j; const LAS float* s = scr + (8 * c) * 33 + n;
        v4u o; o.x = pkbf(s[0 * 33], s[1 * 33]); o.y = pkbf(s[2 * 33], s[3 * 33]); o.z = pkbf(s[4 * 33], s[5 * 33]); o.w = pkbf(s[6 * 33], s[7 * 33]);
        *(GAS v4u*)(WT + (size_t)(drow0 + n) * Kd + k0 + 8 * c) = o; }
    LDS_WAIT(); asm volatile("" ::: "memory");
}
__device__ __forceinline__ void transpose_item_f8(const float* W, int N, int k0, int n0, unsigned char* WT, int Kd, int drow0, LAS float* scr, int lane, float scale) {
#pragma unroll 8
    for (int i = 0; i < 32; ++i) { const int kk = 2 * i + (lane >> 5); scr[kk * 33 + (lane & 31)] = W[(size_t)(k0 + kk) * N + n0 + (lane & 31)]; }
    LDS_WAIT(); asm volatile("" ::: "memory");
    const int c = lane & 7;
#pragma unroll
    for (int j = 0; j < 4; ++j) { const int n = (lane >> 3) + 8 * j; const LAS float* s = scr + (8 * c) * 33 + n;
        v2u o; o.x = pk4f8(s[0 * 33] * scale, s[1 * 33] * scale, s[2 * 33] * scale, s[3 * 33] * scale); o.y = pk4f8(s[4 * 33] * scale, s[5 * 33] * scale, s[6 * 33] * scale, s[7 * 33] * scale);
        *(GAS v2u*)(WT + (size_t)(drow0 + n) * Kd + k0 + 8 * c) = o; }
    LDS_WAIT(); asm volatile("" ::: "memory");
}
__device__ __forceinline__ int win_dest_block(int sb) {
    if (sb < 4) return 13 + sb;
    if (sb < 8) return sb - 4;
    if (sb < 12) return sb - 4;
    if (sb == 12) return 8;
    if (sb == 13) return 9;
    if (sb == 14) return 10;
    if (sb < 19) return sb + 2;
    if (sb == 19) return 11;
    if (sb == 20) return 12;
    return sb;
}
struct TrItem { const float* W; unsigned char* WT; int N, k0, n0, Kd, drow0, f8; };
__device__ __forceinline__ void tr_load(const TrItem& t, float (&v)[32], int lane) {
#pragma unroll
    for (int i = 0; i < 32; ++i) v[i] = t.W[(size_t)(t.k0 + 2 * i + (lane >> 5)) * t.N + t.n0 + (lane & 31)];
}
__device__ __forceinline__ void tr_store(const TrItem& t, const float (&v)[32], LAS float* scr, int lane) {
#pragma unroll
    for (int i = 0; i < 32; ++i) scr[(2 * i + (lane >> 5)) * 33 + (lane & 31)] = v[i];
    LDS_WAIT(); asm volatile("" ::: "memory");
    const int c = lane & 7;
#pragma unroll
    for (int j = 0; j < 4; ++j) { const int n = (lane >> 3) + 8 * j; const LAS float* s = scr + (8 * c) * 33 + n;
        if (t.f8) { v2u o; o.x = pk4f8(s[0 * 33] * W_SCALE, s[1 * 33] * W_SCALE, s[2 * 33] * W_SCALE, s[3 * 33] * W_SCALE); o.y = pk4f8(s[4 * 33] * W_SCALE, s[5 * 33] * W_SCALE, s[6 * 33] * W_SCALE, s[7 * 33] * W_SCALE);
            *(GAS v2u*)(t.WT + (size_t)(t.drow0 + n) * t.Kd + t.k0 + 8 * c) = o; }
        else { v4u o; o.x = pkbf(s[0 * 33], s[1 * 33]); o.y = pkbf(s[2 * 33], s[3 * 33]); o.z = pkbf(s[4 * 33], s[5 * 33]); o.w = pkbf(s[6 * 33], s[7 * 33]);
            *(GAS v4u*)((bf16*)t.WT + (size_t)(t.drow0 + n) * t.Kd + t.k0 + 8 * c) = o; } }
    LDS_WAIT(); asm volatile("" ::: "memory");
}
__device__ __forceinline__ void weight_copies(Frame& F, const int part, const int gw, const int NGW, LAS float* scr) {
    constexpr int IT_WIN = 16 * 148, IT_G = 16 * 768, IT_BR = 256, IT_OUT = 512;
    constexpr int NITEMS = IT_WIN + 3 * IT_G + 2 * IT_BR + IT_OUT;
    bf16* WIN = (bf16*)(F.ws + WS_WIN); unsigned char* WGU = F.ws + WS_WGU; unsigned char* WD = F.ws + WS_WD;
    auto decode = [&](int it) -> TrItem {
        TrItem t; int r = it;
        if (r < IT_WIN) { const int kb = r / 148, nb = r % 148, n0 = 32 * nb; const int db = win_dest_block(n0 >> 7);
            if ((n0 >> 7) >= 21) { t = TrItem{karg_in(I_WIN), F.ws + WS_WG8, 4736, 64 * kb, n0, 1024, n0 - 21 * 128, 1}; return t; }
            t = TrItem{karg_in(I_WIN), (unsigned char*)WIN, 4736, 64 * kb, n0, 1024, db * 128 + (n0 & 127), 0}; return t; }
        r -= IT_WIN;
        if (r < IT_G) { const int e = r / 768, q = r % 768, kb = q / 48, nb = q % 48, n0 = 32 * nb;
            t = TrItem{karg_in(I_EG) + (size_t)e * 1024 * 1536, WGU, 1536, 64 * kb, n0, 1024, e * 3072 + 256 * (n0 >> 7) + (n0 & 127), 1}; return t; }
        r -= IT_G;
        if (r < IT_G) { const int e = r / 768, q = r % 768, kb = q / 48, nb = q % 48, n0 = 32 * nb;
            t = TrItem{karg_in(I_EU) + (size_t)e * 1024 * 1536, WGU, 1536, 64 * kb, n0, 1024, e * 3072 + 256 * (n0 >> 7) + 128 + (n0 & 127), 1}; return t; }
        r -= IT_G;
        if (r < IT_G) { const int e = r / 768, q = r % 768, kb = q / 32, nb = q % 32, n0 = 32 * nb;
            t = TrItem{karg_in(I_ED) + (size_t)e * 1536 * 1024, WD, 1024, 64 * kb, n0, 1536, e * 1024 + n0, 1}; return t; }
        r -= IT_G;
        if (r < IT_BR) { const int kb = r / 32, nb = r % 32; t = TrItem{karg_in(I_WBRR), F.ws + WS_WBRR, 1024, 64 * kb, 32 * nb, 1024, 32 * nb, 0}; return t; }
        r -= IT_BR;
        if (r < IT_BR) { const int kb = r / 32, nb = r % 32; t = TrItem{karg_in(I_WBRA), F.ws + WS_WBRR + 1024, 1024, 64 * kb, 32 * nb, 1024, 32 * nb, 0}; return t; }
        r -= IT_BR;
        { const int kb = r / 32, nb = r % 32; t = TrItem{karg_in(I_WOUT), F.ws + WS_WOUT, 1024, 64 * kb, 32 * nb, 1024, 32 * nb, 0}; return t; }
    };
    const int cnt = part ? 3 * IT_G : NITEMS - 3 * IT_G;
    auto remap = [&](int i) -> int { return part ? i + IT_WIN : (i < IT_WIN ? i : i + 3 * IT_G); };
    for (int i = gw; i < cnt; i += 2 * NGW) {
        const bool two = i + NGW < cnt;
        const TrItem ta = decode(remap(i)), tb = decode(remap(two ? i + NGW : i));
        float va[32], vb[32];
        tr_load(ta, va, F.lane); tr_load(tb, vb, F.lane);
        tr_store(ta, va, scr, F.lane);
        if (two) tr_store(tb, vb, scr, F.lane);
    }
}
__device__ __forceinline__ void p0_prologue(Frame& F) {
    for (int cg = blockIdx.x; cg < 256; cg += F.G) {
        LAS float* cs = (LAS float*)F.lds;
        const float* c = karg_in(I_C); const float* cc = karg_in(I_CCTX);
        { f32x4 cv[17];
#pragma unroll
            for (int j = 0; j < 16; ++j) cv[j] = *(const GAS f32x4*)(c + 4 * (F.tid + 512 * j));
            cv[16] = *(const GAS f32x4*)(cc + 4 * (F.tid & 255));
#pragma unroll
            for (int j = 0; j < 17; ++j) { const f32x4 v = cv[j]; const f32x4 o = {v.x * sigmoidf_(v.x), v.y * sigmoidf_(v.y), v.z * sigmoidf_(v.z), v.w * sigmoidf_(v.w)};
                if (j < 16) *(LAS f32x4*)(cs + 4 * (F.tid + 512 * j)) = o; else if (F.tid < 256) *(LAS f32x4*)(cs + 32 * 1024 + 4 * F.tid) = o; } }
        __syncthreads();
        const int sub = F.lane < 24 ? 0 : 1, cl = F.lane < 24 ? F.lane : (F.lane < 48 ? F.lane - 24 : F.lane - 48);
        const float* awu = karg_in(I_ADAW) + (size_t)(F.wave * 128) * 6144 + cg * 24;
        const int loff = sub * 64 * 6144 + cl;
        const LAS float* csl = cs + F.wave * 128 + sub * 64;
        float acc[33];
#pragma unroll
        for (int b = 0; b < 33; ++b) acc[b] = 0.f;
        float w[16], wn[16];
#pragma unroll
        for (int j = 0; j < 16; ++j) w[j] = (awu + (size_t)j * 6144)[loff];
#pragma unroll
        for (int kc = 0; kc < 64; kc += 16) {
            if (kc + 16 < 64) {
#pragma unroll
                for (int j = 0; j < 16; ++j) wn[j] = (awu + (size_t)(kc + 16 + j) * 6144)[loff]; }
            asm volatile("" ::: "memory");
#pragma unroll
            for (int q = 0; q < 4; ++q) {
#pragma unroll
                for (int bg = 0; bg < 3; ++bg) {
#pragma unroll
                    for (int b = 11 * bg; b < 11 * bg + 11; ++b) { const f32x4 cv = *(const LAS f32x4*)(csl + b * 1024 + kc + 4 * q);
                        acc[b] = __builtin_fmaf(cv.x, w[4 * q], __builtin_fmaf(cv.y, w[4 * q + 1], __builtin_fmaf(cv.z, w[4 * q + 2], __builtin_fmaf(cv.w, w[4 * q + 3], acc[b])))); asm volatile("" : "+v"(acc[b])); }
                    asm volatile("" ::: "memory"); } }
#pragma unroll
            for (int j = 0; j < 16; ++j) w[j] = wn[j];
        }
        __syncthreads();
        LAS float* red = (LAS float*)F.lds;
        if (F.lane < 48) {
#pragma unroll
            for (int b = 0; b < 33; ++b) red[((F.wave * 2 + sub) * 33 + b) * 24 + cl] = acc[b]; }
        __syncthreads();
        float* mod = (float*)(F.ws + WS_MOD); const float* ab = karg_in(I_ADAB);
        for (int i = F.tid; i < 33 * 24; i += 512) { const int b = i / 24, l = i - b * 24; float sm = 0.f;
#pragma unroll
            for (int pz = 0; pz < 16; ++pz) sm += red[(pz * 33 + b) * 24 + l];
            mod[(size_t)b * 6144 + cg * 24 + l] = sm + ab[cg * 24 + l]; }
        __syncthreads();
    }
    weight_copies(F, 0, blockIdx.x * NWAVES + F.wave, F.G * NWAVES, (LAS float*)(F.lds + F.wave * 16384));
    bf16* WIN = (bf16*)(F.ws + WS_WIN);
    const int gt = blockIdx.x * 512 + F.tid, NGT = F.G * 512;
    for (int i = gt; i < 128 * 1024 / 8; i += NGT) *(GAS v4u*)(WIN + (size_t)2688 * 1024 + (size_t)i * 8) = (v4u){0u, 0u, 0u, 0u};
    { bf16* WL = (bf16*)(F.ws + WS_WLORA); const float* w2 = karg_in(I_W2); const float* a2 = karg_in(I_A2); const float* g2 = karg_in(I_G2);
      for (int i = gt; i < LORA_N * (LORA_K / 8); i += NGT) { const int n = i / (LORA_K / 8), k8 = (i % (LORA_K / 8)) * 8; const int rg = n >> 9, col = n & 511; float f[8];
          const float* base = rg < 2 ? w2 + (size_t)(rg * 64) * 512 : (rg < 4 ? a2 + (size_t)((rg - 2) * 64) * 512 : g2); const int lo = rg < 4 ? 64 * rg : 256, len = rg < 4 ? 64 : 128;
          const bool valid = k8 >= lo && k8 < lo + len; const int kb = valid ? k8 - lo : 0;
#pragma unroll
          for (int j = 0; j < 8; ++j) f[j] = base[(size_t)(kb + j) * 512 + col];
#pragma unroll
          for (int j = 0; j < 8; ++j) f[j] = valid ? f[j] : 0.f;
          *(GAS v4u*)(WL + (size_t)n * LORA_K + k8) = pack8(f); } }
}

__device__ __forceinline__ void p1_norm1(Frame& F) {
    const int gw = blockIdx.x * NWAVES + F.wave, NGW = F.G * NWAVES;
    const float* mod = (const float*)(F.ws + WS_MOD); bf16* H1 = (bf16*)(F.ws + WS_H1); unsigned char* H1Q = F.ws + WS_H1Q;
    const float* g1 = karg_in(I_N1G); const float* Xp = karg_in(I_X); const float* CTXp = karg_in(I_CTX);
    f32x4 gv[4];
#pragma unroll
    for (int j = 0; j < 4; ++j) gv[j] = *(const f32x4*)(g1 + 4 * F.lane + 256 * j);
    for (int m0 = gw; m0 < NTOK; m0 += 4 * NGW) {
        f32x4 v[4][4]; float s[4];
#pragma unroll
        for (int r = 0; r < 4; ++r) { const int m = min(m0 + r * NGW, NTOK - 1); s[r] = 0.f;
            const float* xr = m < NLAT ? Xp + (size_t)m * DM : CTXp + (size_t)(m - NLAT) * DM;
#pragma unroll
            for (int j = 0; j < 4; ++j) v[r][j] = *(const GAS f32x4*)(xr + 4 * F.lane + 256 * j); }
#pragma unroll
        for (int r = 0; r < 4; ++r) { const int m = m0 + r * NGW;
            if (m < NTOK) {
#pragma unroll
                for (int j = 0; j < 4; ++j) s[r] += (v[r][j].x * v[r][j].x + v[r][j].y * v[r][j].y) + (v[r][j].z * v[r][j].z + v[r][j].w * v[r][j].w);
                const float rstd = __builtin_amdgcn_rsqf(wave_sum(s[r]) * (1.f / DM) + 1e-6f);
                const int mb = m < NLAT ? (m >> 11) : 32; const float* sh = mod + (size_t)mb * 6144; const float* sc = sh + 1024;
#pragma unroll
                for (int j = 0; j < 4; ++j) { const f32x4 a = *(const f32x4*)(sc + 4 * F.lane + 256 * j), bsh = *(const f32x4*)(sh + 4 * F.lane + 256 * j);
                    const f32x4 y = v[r][j] * rstd * gv[j] * (a + 1.0f) + bsh;
                    v2u o; o.x = pkbf(y.x, y.y); o.y = pkbf(y.z, y.w);
                    *(GAS v2u*)(H1 + (size_t)m * DM + 4 * F.lane + 256 * j) = o;
                    if (m < NLAT) *(GAS unsigned*)(H1Q + (size_t)m * DM + 4 * F.lane + 256 * j) = pk4f8(y.x, y.y, y.z, y.w); } } }
    }
}

struct InprojOrder {
    pg8::StaticOrder so; int G, c;
    __device__ void init(int G_, int c_) { so.init(NLAT, WIN_ROWS, G_, c_); G = G_; c = c_; }
    __device__ bool next(int i, Unit& u) const {
        long L = (long)i * G + c; if (L < 2816) return so.next(i, u);
        L -= 2816; if (L >= 224) return false; u.pm = 256 + (int)(L % 32); u.pn = (int)(L / 32); return true; }
    __device__ __forceinline__ void a_ready(const Unit&) const {}
    __device__ __forceinline__ void done(const Unit&) const {}
};
struct EpiInproj {
    static constexpr bool PERM = true, AFTER_DRAIN = false;
    bf16 *zk, *zv, *zr, *q, *kq, *vq, *la;
    __device__ __forceinline__ void operator()(const f32x4 (&acc)[2][2][4][2], const Unit& u, int wr, int wc, int fr, int fq) const {
        const int row0 = u.pm * 256 + wr * 64 + fr; const bool isctx = u.pm >= 256;
#pragma unroll
        for (int bj = 0; bj < 2; ++bj) {
            const int c128 = 2 * u.pn + bj; bf16* base = nullptr; int pitch = 0, act = 0; bool ok = true;
            if (c128 < 4) { base = zk + c128 * 128; pitch = 512; }
            else if (c128 < 8) { base = zv + (c128 - 4) * 128; pitch = 512; }
            else if (c128 < 11) { base = la + (c128 - 8) * 128; pitch = 384; act = (c128 == 8) ? 1 : ((c128 == 10) ? 2 : 0); }
            else if (c128 == 11) { base = kq; pitch = 128; }
            else if (c128 == 12) { base = vq; pitch = 128; }
            else if (c128 < 17) { base = zr + (c128 - 13) * 128; pitch = 512; ok = !isctx; }
            else if (c128 < 21) { base = q + (c128 - 17) * 128; pitch = 512; ok = !isctx; }
            else ok = false;
            if (ok) {
#pragma unroll
                for (int ai = 0; ai < 2; ++ai)
#pragma unroll
                    for (int m = 0; m < 4; ++m) {
                        f32x4 v0 = acc[ai][bj][m][0], v1 = acc[ai][bj][m][1];
                        if (act == 1) { v0.x = tanhf_(v0.x); v0.y = tanhf_(v0.y); v0.z = tanhf_(v0.z); v0.w = tanhf_(v0.w); v1.x = tanhf_(v1.x); v1.y = tanhf_(v1.y); v1.z = tanhf_(v1.z); v1.w = tanhf_(v1.w); }
                        else if (act == 2) { v0.x = sigmoidf_(v0.x); v0.y = sigmoidf_(v0.y); v0.z = sigmoidf_(v0.z); v0.w = sigmoidf_(v0.w); v1.x = sigmoidf_(v1.x); v1.y = sigmoidf_(v1.y); v1.z = sigmoidf_(v1.z); v1.w = sigmoidf_(v1.w); }
                        v4u w; w.x = pkbf(v0.x, v0.y); w.y = pkbf(v0.z, v0.w); w.z = pkbf(v1.x, v1.y); w.w = pkbf(v1.z, v1.w);
                        *(GAS v4u*)(base + (size_t)(row0 + ai * 128 + m * 16) * pitch + wc * 32 + 8 * fq) = w;
                    }
            }
        }
    }
};

struct EpiGates {
    static constexpr bool PERM = true, AFTER_DRAIN = false;
    bf16* gates;
    __device__ __forceinline__ void operator()(const f32x4 (&acc)[2][2][4][2], const Unit& u, int wr, int wc, int fr, int fq) const {
        const int row0 = u.pm * 256 + wr * 64 + fr; constexpr float WI = 1.0f / W_SCALE;
#pragma unroll
        for (int bj = 0; bj < 2; ++bj)
#pragma unroll
            for (int ai = 0; ai < 2; ++ai)
#pragma unroll
                for (int m = 0; m < 4; ++m) {
                    const f32x4 v0 = acc[ai][bj][m][0] * WI, v1 = acc[ai][bj][m][1] * WI;
                    v4u w; w.x = pkbf(sigmoidf_(v0.x), sigmoidf_(v0.y)); w.y = pkbf(sigmoidf_(v0.z), sigmoidf_(v0.w)); w.z = pkbf(sigmoidf_(v1.x), sigmoidf_(v1.y)); w.w = pkbf(sigmoidf_(v1.z), sigmoidf_(v1.w));
                    *(GAS v4u*)(gates + (size_t)(row0 + ai * 128 + m * 16) * 2048 + u.pn * 256 + bj * 128 + wc * 32 + 8 * fq) = w;
                }
    }
};

constexpr int LORA_LP = 144;
template <int NKS> __device__ __forceinline__ void lora_item(const bf16* LA, const bf16* WL, bf16* outp, const float* bias, float scale, int act, int tile, int rg, int kbase, int lane, LAS unsigned char* st) {
    const int l32 = lane & 31, hi = lane >> 5;
    bf16x8 xf[2][NKS];
#pragma unroll
    for (int s2 = 0; s2 < 2; ++s2)
#pragma unroll
        for (int ks = 0; ks < NKS; ++ks) xf[s2][ks] = *(const GAS bf16x8*)(LA + (size_t)(tile * 64 + s2 * 32 + l32) * LORA_K + kbase + 16 * ks + 8 * hi);
    bf16x8 wf[NKS], wn[NKS];
    { const bf16* wp = WL + (size_t)(rg * 512 + l32) * LORA_K + kbase + 8 * hi;
#pragma unroll
      for (int ks = 0; ks < NKS; ++ks) wf[ks] = *(const GAS bf16x8*)(wp + 16 * ks); }
#pragma unroll 1
    for (int np = 0; np < 8; ++np) {
#pragma unroll
        for (int nh = 0; nh < 2; ++nh) { const int nt = 2 * np + nh;
            f32x16 acc0, acc1;
#pragma unroll
            for (int r = 0; r < 16; ++r) { acc0[r] = 0.f; acc1[r] = 0.f; }
            { const int ntn = nt < 15 ? nt + 1 : 15; const bf16* wp = WL + (size_t)(rg * 512 + ntn * 32 + l32) * LORA_K + kbase + 8 * hi;
#pragma unroll
              for (int ks = 0; ks < NKS; ++ks) wn[ks] = *(const GAS bf16x8*)(wp + 16 * ks); }
#pragma unroll
            for (int ks = 0; ks < NKS; ++ks) { acc0 = __builtin_amdgcn_mfma_f32_32x32x16_bf16(wf[ks], xf[0][ks], acc0, 0, 0, 0); acc1 = __builtin_amdgcn_mfma_f32_32x32x16_bf16(wf[ks], xf[1][ks], acc1, 0, 0, 0); }
#pragma unroll
            for (int ks = 0; ks < NKS; ++ks) wf[ks] = wn[ks];
#pragma unroll
            for (int r4 = 0; r4 < 4; ++r4) { const int col = nt * 32 + 8 * r4 + 4 * hi;
                f32x4 bv = (f32x4){0.f, 0.f, 0.f, 0.f}; if (act) bv = *(const f32x4*)(bias + col);
                f32x4 v0 = (f32x4){acc0[4 * r4], acc0[4 * r4 + 1], acc0[4 * r4 + 2], acc0[4 * r4 + 3]} + bv, v1 = (f32x4){acc1[4 * r4], acc1[4 * r4 + 1], acc1[4 * r4 + 2], acc1[4 * r4 + 3]} + bv;
                if (act) { v0.x = scale * sigmoidf_(v0.x); v0.y = scale * sigmoidf_(v0.y); v0.z = scale * sigmoidf_(v0.z); v0.w = scale * sigmoidf_(v0.w);
                           v1.x = scale * sigmoidf_(v1.x); v1.y = scale * sigmoidf_(v1.y); v1.z = scale * sigmoidf_(v1.z); v1.w = scale * sigmoidf_(v1.w); }
                v2u o0, o1; o0.x = pkbf(v0.x, v0.y); o0.y = pkbf(v0.z, v0.w); o1.x = pkbf(v1.x, v1.y); o1.y = pkbf(v1.z, v1.w);
                const int lc = (32 * nh + 8 * r4 + 4 * hi) * 2;
                *(LAS v2u*)(st + l32 * LORA_LP + lc) = o0; *(LAS v2u*)(st + 32 * LORA_LP + l32 * LORA_LP + lc) = o1; }
        }
#pragma unroll
        for (int i = 0; i < 8; ++i) { const int row = 8 * i + (lane >> 3);
            const v4u w = *(const LAS v4u*)(st + row * LORA_LP + (lane & 7) * 16);
            *(GAS v4u*)(outp + (size_t)(tile * 64 + row) * 512 + np * 64 + (lane & 7) * 8) = w; }
    }
}
__device__ __forceinline__ void p3a_lora(Frame& F) {
    const bf16* LA = (const bf16*)(F.ws + WS_LA); const bf16* WL = (const bf16*)(F.ws + WS_WLORA);
    bf16* EW = (bf16*)(F.ws + WS_EW); bf16* AS = (bf16*)(F.ws + WS_AS); bf16* G = (bf16*)(F.ws + WS_G);
    const float* w0 = karg_in(I_W0); const float* a0 = karg_in(I_A0);
    const int gw = blockIdx.x * NWAVES + F.wave, NGW = F.G * NWAVES;
    LAS unsigned char* st = F.lds + 16384 + F.wave * (64 * LORA_LP);
    if (NGW == 2048) {
#pragma unroll 1
        for (int k = 0; k < 3; ++k) {
            if ((gw & 3) == 0) { if (k < 2) lora_item<8>(LA, WL, G, nullptr, 1.0f, 0, 2 * (gw >> 2) + k, 4, 256, F.lane, st); }
            else { const int j = (gw - (gw >> 2) - 1) * 3 + k, tile = j >> 2, rg = j & 3;
                if (rg < 2) lora_item<4>(LA, WL, EW + (size_t)rg * NTOK * 512, w0 + rg * 512, 0.60653066f, 1, tile, rg, 64 * rg, F.lane, st);
                else lora_item<4>(LA, WL, AS + (size_t)(rg - 2) * NTOK * 512, a0 + (rg - 2) * 512, 1.0f, 1, tile, rg, 64 * rg, F.lane, st); }
        }
    } else
    for (int item = gw; item < (NTOK / 64) * 5; item += NGW) {
        const int rg = item % 5, tile = item / 5;
        if (rg == 4) { if (tile < NLAT / 64) lora_item<8>(LA, WL, G, nullptr, 1.0f, 0, tile, 4, 256, F.lane, st); }
        else if (rg < 2) lora_item<4>(LA, WL, EW + (size_t)rg * NTOK * 512, w0 + rg * 512, 0.60653066f, 1, tile, rg, 64 * rg, F.lane, st);
        else lora_item<4>(LA, WL, AS + (size_t)(rg - 2) * NTOK * 512, a0 + (rg - 2) * 512, 1.0f, 1, tile, rg, 64 * rg, F.lane, st);
    }
}

__device__ __forceinline__ void p3b_attn_prep(Frame& F) {
    LAS float* tab = (LAS float*)F.lds;
    for (int i = F.tid; i < 1024; i += 512) { const int pos = i >> 4, fi = i & 15;
        const float invf = exp2f(-(float)fi * (13.287712379549449f / 16.0f));
        const float ang = (float)pos * invf; tab[2 * i] = cosf(ang); tab[2 * i + 1] = sinf(ang); }
    __syncthreads();
    const int gw = blockIdx.x * NWAVES + F.wave, NGW = F.G * NWAVES, lane = F.lane;
    {
        bf16* KQ = (bf16*)(F.ws + WS_KQ); const float* kg = karg_in(I_KG);
        const int l32 = lane & 31; const float g0 = kg[2 * l32], g1 = kg[2 * l32 + 1];
        for (int m0 = gw; m0 < NTOK; m0 += 12 * NGW) {
            unsigned raw[12];
#pragma unroll
            for (int r = 0; r < 12; ++r) { const int m = min(m0 + r * NGW, NTOK - 1); raw[r] = *(const GAS unsigned*)(KQ + (size_t)m * 128 + 2 * lane); }
#pragma unroll
            for (int r = 0; r < 12; ++r) { const int m = m0 + r * NGW; if (m >= NTOK) continue;
                GAS unsigned* p = (GAS unsigned*)(KQ + (size_t)m * 128 + 2 * lane); const unsigned w = raw[r];
                float y0 = bflo(w), y1 = bfhi(w); float ss = y0 * y0 + y1 * y1;
                ss += __shfl_xor(ss, 1); ss += __shfl_xor(ss, 2); ss += __shfl_xor(ss, 4); ss += __shfl_xor(ss, 8); ss += __shfl_xor(ss, 16);
                const float rstd = __builtin_amdgcn_rsqf(ss * (1.f / 64.f) + 1e-6f);
                y0 = y0 * rstd * g0; y1 = y1 * rstd * g1;
                const float p0 = __shfl_xor(y0, 8), p1 = __shfl_xor(y1, 8);
                if (m < NLAT) { const int t = m & 2047; const int pos = (l32 < 16) ? (t >> 6) : (t & 63); const bool second = (l32 & 8) != 0; const int fi0 = (2 * l32) & 15;
                    const float c0 = tab[(pos * 16 + fi0) * 2], s0 = tab[(pos * 16 + fi0) * 2 + 1], c1 = tab[(pos * 16 + fi0 + 1) * 2], s1 = tab[(pos * 16 + fi0 + 1) * 2 + 1];
                    const float o0 = second ? (p0 * s0 + y0 * c0) : (y0 * c0 - p0 * s0), o1 = second ? (p1 * s1 + y1 * c1) : (y1 * c1 - p1 * s1);
                    y0 = o0; y1 = o1; }
                *p = pkbf(y0, y1); }
        }
    }
    {
        const bf16* VQ = (const bf16*)(F.ws + WS_VQ); bf16* VT = (bf16*)(F.ws + WS_VT);
        const int gt = blockIdx.x * 512 + F.tid, NGT = F.G * 512;
        constexpr int VTN = NB * 2 * (KEYS / 8) * 64;
        for (int i0 = gt; i0 < VTN; i0 += 3 * NGT) {
            float f[3][8];
#pragma unroll
            for (int u = 0; u < 3; ++u) { const int i = min(i0 + u * NGT, VTN - 1); const int d = i & 63, kg8 = (i >> 6) % (KEYS / 8), bh = (i >> 6) / (KEYS / 8), b = bh >> 1, hk = bh & 1;
#pragma unroll
                for (int j = 0; j < 8; ++j) { const int key = kg8 * 8 + j; const size_t row = key < SEQ ? (size_t)b * SEQ + key : (size_t)NLAT + b * LC + (key - SEQ); f[u][j] = bf1(VQ[row * 128 + hk * 64 + d]); } }
#pragma unroll
            for (int u = 0; u < 3; ++u) { const int i = i0 + u * NGT; if (i >= VTN) continue; const int d = i & 63, kg8 = (i >> 6) % (KEYS / 8), bh = (i >> 6) / (KEYS / 8);
                *(GAS v4u*)(VT + ((size_t)bh * 64 + d) * KEYS + kg8 * 8) = pack8(f[u]); }
        }
    }
}

__device__ __forceinline__ int key_perm(int i) { const int r = 4 * (i >> 3) + (i & 3), hi = (i >> 2) & 1; return 8 * hi + r + (r >= 8 ? 8 : 0); }
__device__ __forceinline__ void attn_tile(const bf16x8 (&kf)[4], const bf16x8 (&vf)[4], const bf16x8 (&qf)[4], f32x16& o0, f32x16& o1, float& mrun, float& lrun, int mask, int l32, int hi) {
    f32x16 s;
#pragma unroll
    for (int r = 0; r < 16; ++r) s[r] = 0.f;
#pragma unroll
    for (int ks = 0; ks < 4; ++ks) s = __builtin_amdgcn_mfma_f32_32x32x16_bf16(kf[ks], qf[ks], s, 0, 0, 0);
    if (mask) {
#pragma unroll
        for (int r = 0; r < 16; ++r) { const int kk = 8 * hi + r + (r >= 8 ? 8 : 0); const bool ok = (mask == 1) ? (kk >= l32) : (kk <= l32); s[r] = ok ? s[r] : -1e30f; }
    }
    float ps = 0.f; float p[16];
#pragma unroll
    for (int r = 0; r < 16; ++r) { p[r] = __builtin_amdgcn_exp2f(s[r] - mrun); ps += p[r]; }
    if (__builtin_amdgcn_ballot_w64(!(ps <= 1024.0f)) != 0ull) {
        float mx = s[0];
#pragma unroll
        for (int r = 1; r < 16; ++r) mx = fmaxf(mx, s[r]);
        mx = fmaxf(mx, __shfl_xor(mx, 32));
        const float mnew = fmaxf(mrun, mx), alpha = __builtin_amdgcn_exp2f(mrun - mnew); lrun *= alpha; mrun = mnew;
        ps = 0.f;
#pragma unroll
        for (int r = 0; r < 16; ++r) { o0[r] *= alpha; o1[r] *= alpha; p[r] = __builtin_amdgcn_exp2f(s[r] - mnew); ps += p[r]; }
    }
    lrun += ps;
    v4u pa, pb; pa.x = pkbf(p[0], p[1]); pa.y = pkbf(p[2], p[3]); pa.z = pkbf(p[4], p[5]); pa.w = pkbf(p[6], p[7]);
    pb.x = pkbf(p[8], p[9]); pb.y = pkbf(p[10], p[11]); pb.z = pkbf(p[12], p[13]); pb.w = pkbf(p[14], p[15]);
    const bf16x8 pa8 = __builtin_bit_cast(bf16x8, pa), pb8 = __builtin_bit_cast(bf16x8, pb);
    o0 = __builtin_amdgcn_mfma_f32_32x32x16_bf16(vf[0], pa8, o0, 0, 0, 0);
    o0 = __builtin_amdgcn_mfma_f32_32x32x16_bf16(vf[1], pb8, o0, 0, 0, 0);
    o1 = __builtin_amdgcn_mfma_f32_32x32x16_bf16(vf[2], pa8, o1, 0, 0, 0);
    o1 = __builtin_amdgcn_mfma_f32_32x32x16_bf16(vf[3], pb8, o1, 0, 0, 0);
}
constexpr int AT_KP = 144, AT_VP = 80, AT_KB = 32 * AT_KP, AT_VB = 64 * AT_VP, AT_BUF = AT_KB + AT_VB;
__device__ __forceinline__ void p4a_attention(Frame& F, bool dostore = true) {
    bf16* Q = (bf16*)(F.ws + WS_Q); const bf16* KQ = (const bf16*)(F.ws + WS_KQ); const bf16* VT = (const bf16*)(F.ws + WS_VT);
    const float* sink = karg_in(I_SINK);
    const int tid = F.tid, lane = F.lane, l32 = lane & 31, hi = lane >> 5;
    const int kperm = key_perm(l32);
    LAS unsigned char* lb = F.lds;
    LAS float* tab = (LAS float*)(F.lds + 32768);
    for (int i = F.tid; i < 1024; i += 512) { const int pos = i >> 4, fi = i & 15;
        const float invf = exp2f(-(float)fi * (13.287712379549449f / 16.0f));
        const float ang = (float)pos * invf; tab[2 * i] = cosf(ang); tab[2 * i + 1] = sinf(ang); }
    __syncthreads();
    float gq[4][8];
    { const float* qg = karg_in(I_QG);
#pragma unroll
      for (int ks = 0; ks < 4; ++ks)
#pragma unroll
          for (int j = 0; j < 8; ++j) gq[ks][j] = qg[16 * ks + 8 * hi + j]; }
    const bool kpart = tid < 256; const int tt = tid & 255;
    const int skey = tt >> 3, skc = tt & 7, sd = tt >> 2, svc = tt & 3;
    const int sdst = kpart ? (skey * AT_KP + skc * 16) : (AT_KB + sd * AT_VP + svc * 16);
    for (int unit = blockIdx.x; unit < NB * 2 * 16; unit += F.G) {
        const int b = unit >> 5, hk = (unit >> 4) & 1, qb = unit & 15;
        const int g = F.wave >> 1, half = F.wave & 1, h = hk * 4 + g;
        const float sink2 = sink[h] * 1.4426950408889634f;
        const int tq0 = qb * 128 + half * 64;
        const size_t qrow = (size_t)b * SEQ + tq0 + l32;
        bf16x8 qf0[4], qf1[4];
#pragma unroll
        for (int ks = 0; ks < 4; ++ks) { qf0[ks] = *(const GAS bf16x8*)(Q + qrow * 512 + h * 64 + 16 * ks + 8 * hi); qf1[ks] = *(const GAS bf16x8*)(Q + (qrow + 32) * 512 + h * 64 + 16 * ks + 8 * hi); }
#pragma unroll
        for (int qi = 0; qi < 2; ++qi) { bf16x8 (&qf)[4] = qi ? qf1 : qf0; const int t = tq0 + l32 + 32 * qi;
            float y[4][8]; float ss = 0.f;
#pragma unroll
            for (int ks = 0; ks < 4; ++ks) { unpack8(__builtin_bit_cast(v4u, qf[ks]), y[ks]);
#pragma unroll
                for (int j = 0; j < 8; ++j) ss += y[ks][j] * y[ks][j]; }
            ss += __shfl_xor(ss, 32);
            const float rstd = __builtin_amdgcn_rsqf(ss * (1.f / 64.f) + 1e-6f), qs = 0.125f * 1.4426950408889634f;
            const LAS float* tr = tab + ((t >> 6) * 16 + 8 * hi) * 2; const LAS float* tc = tab + ((t & 63) * 16 + 8 * hi) * 2;
#pragma unroll
            for (int j = 0; j < 8; ++j) { const f32x2 cr = *(const LAS f32x2*)(tr + 2 * j), cc = *(const LAS f32x2*)(tc + 2 * j);
                const float a0 = y[0][j] * rstd * gq[0][j], a1 = y[1][j] * rstd * gq[1][j], b0 = y[2][j] * rstd * gq[2][j], b1 = y[3][j] * rstd * gq[3][j];
                y[0][j] = (a0 * cr.x - a1 * cr.y) * qs; y[1][j] = (a0 * cr.y + a1 * cr.x) * qs; y[2][j] = (b0 * cc.x - b1 * cc.y) * qs; y[3][j] = (b0 * cc.y + b1 * cc.x) * qs; }
#pragma unroll
            for (int ks = 0; ks < 4; ++ks) qf[ks] = __builtin_bit_cast(bf16x8, pack8(y[ks])); }
        float m0 = sink2, m1 = sink2, l0 = hi == 0 ? 1.0f : 0.0f, l1 = l0;
        f32x16 oa0, oa1, ob0, ob1;
#pragma unroll
        for (int r = 0; r < 16; ++r) { oa0[r] = 0.f; oa1[r] = 0.f; ob0[r] = 0.f; ob1[r] = 0.f; }
        const bf16* vsrc0 = VT + ((size_t)(b * 2 + hk) * 64 + sd) * KEYS + 8 * svc;
        const bf16* ksrc0 = KQ + (size_t)skey * 128 + hk * 64 + 8 * skc;
#define AT_SRC(s_, ptr_) do { int key0_; size_t krow_; if ((s_) < 8) { key0_ = SEQ + 32 * (s_); krow_ = (size_t)NLAT + b * LC + 32 * (s_); } \
            else { int kp_ = qb * 128 - 128 + 32 * ((s_) - 8); kp_ = (kp_ >= 0 && kp_ < SEQ) ? kp_ : 0; key0_ = kp_; krow_ = (size_t)b * SEQ + kp_; } \
            ptr_ = kpart ? (ksrc0 + krow_ * 128) : (vsrc0 + key0_); } while (0)
        v4u stg;
        { const bf16* sp; AT_SRC(0, sp); stg = *(const GAS v4u*)sp; }
        __syncthreads();
        *(LAS v4u*)(lb + sdst) = stg;
        __syncthreads();
#pragma unroll 1
        for (int s = 0; s < 20; ++s) {
            if (s + 1 < 20) { const bf16* sp; AT_SRC(s + 1, sp); stg = *(const GAS v4u*)sp; }
            const LAS unsigned char* kb_ = lb + (s & 1) * AT_BUF; const LAS unsigned char* vb_ = kb_ + AT_KB;
            bool use0, use1; int mk0 = 0, mk1 = 0;
            if (s < 8) { use0 = true; use1 = true; }
            else { const int j = s - 8, kp0 = qb * 128 - 128 + 32 * j, bi = j - 2 * half; const bool inr = kp0 >= 0 && kp0 < SEQ;
                use0 = inr && bi >= 0 && bi <= 8; use1 = inr && bi >= 1 && bi <= 9; mk0 = bi == 0 ? 1 : (bi == 8 ? 2 : 0); mk1 = bi == 1 ? 1 : (bi == 9 ? 2 : 0); }
            if (use0 || use1) {
                bf16x8 kf[4], vf[4];
#pragma unroll
                for (int ks = 0; ks < 4; ++ks) kf[ks] = *(const LAS bf16x8*)(kb_ + kperm * AT_KP + 32 * ks + 16 * hi);
                vf[0] = *(const LAS bf16x8*)(vb_ + l32 * AT_VP + 16 * hi); vf[1] = *(const LAS bf16x8*)(vb_ + l32 * AT_VP + 32 + 16 * hi);
                vf[2] = *(const LAS bf16x8*)(vb_ + (32 + l32) * AT_VP + 16 * hi); vf[3] = *(const LAS bf16x8*)(vb_ + (32 + l32) * AT_VP + 32 + 16 * hi);
                if (use0) attn_tile(kf, vf, qf0, oa0, oa1, m0, l0, mk0, l32, hi);
                if (use1) attn_tile(kf, vf, qf1, ob0, ob1, m1, l1, mk1, l32, hi);
            }
            if (s + 1 < 20) *(LAS v4u*)(lb + ((s + 1) & 1) * AT_BUF + sdst) = stg;
            __syncthreads();
        }
#undef AT_SRC
#pragma unroll
        for (int qi = 0; qi < 2; ++qi) {
            const float lr = qi ? l1 : l0; const float ltot = lr + __shfl_xor(lr, 32), inv = 1.0f / ltot;
            const f32x16& o0 = qi ? ob0 : oa0; const f32x16& o1 = qi ? ob1 : oa1;
            bf16* op = Q + (qrow + 32 * qi) * 512 + h * 64 + 4 * hi;
#pragma unroll
            for (int r4 = 0; r4 < 4; ++r4) {
                v2u w0; w0.x = pkbf(o0[4 * r4] * inv, o0[4 * r4 + 1] * inv); w0.y = pkbf(o0[4 * r4 + 2] * inv, o0[4 * r4 + 3] * inv);
                v2u w1; w1.x = pkbf(o1[4 * r4] * inv, o1[4 * r4 + 1] * inv); w1.y = pkbf(o1[4 * r4 + 2] * inv, o1[4 * r4 + 3] * inv);
                if (dostore) { *(GAS v2u*)(op + 8 * r4) = w0; *(GAS v2u*)(op + 32 + 8 * r4) = w1; }
            }
        }
    }
}

constexpr int SC_C = 32, SC_NCH = (LC + SEQ) / SC_C;
constexpr int SC_RP = 3;
constexpr int SC_ROUNDS = SC_NCH / SC_RP;
constexpr int SC_TASK_BYTES = 24576;
constexpr int SC_SLOT_BYTES = 2 * SC_RP * SC_TASK_BYTES;
constexpr int SC_PITCH = 144;
constexpr int SC_PLDS = 4 * 32 * SC_PITCH + 256;
__device__ __forceinline__ int launder(int v) { asm volatile("" : "+v"(v)); return v; }
__device__ __forceinline__ int crow_(int r, int hi) { return (r & 3) + 8 * (r >> 2) + 4 * hi; }
__device__ __forceinline__ bf16x8 packacc(const f32x16& x, int s) {
    v4u p; p.x = pkbf(x[8 * s], x[8 * s + 1]); p.y = pkbf(x[8 * s + 2], x[8 * s + 3]); p.z = pkbf(x[8 * s + 4], x[8 * s + 5]); p.w = pkbf(x[8 * s + 6], x[8 * s + 7]);
    return __builtin_bit_cast(bf16x8, p); }
#define MF(a, b, c) __builtin_amdgcn_mfma_f32_32x32x16_bf16((a), (b), (c), 0, 0, 0)
__device__ __forceinline__ f32x16 zero16() { f32x16 z;
#pragma unroll
    for (int r = 0; r < 16; ++r) z[r] = 0.f;
    return z; }
__device__ __forceinline__ void st_acc_bf16(unsigned char* p, const f32x16& x) {
    v4u a, b; a.x = pkbf(x[0], x[1]); a.y = pkbf(x[2], x[3]); a.z = pkbf(x[4], x[5]); a.w = pkbf(x[6], x[7]); b.x = pkbf(x[8], x[9]); b.y = pkbf(x[10], x[11]); b.z = pkbf(x[12], x[13]); b.w = pkbf(x[14], x[15]);
    *(GAS v4u*)p = a; *(GAS v4u*)(p + 16) = b; }
__device__ __forceinline__ f32x16 ld_acc_bf16(const unsigned char* p) {
    const v4u a = *(const GAS v4u*)p, b = *(const GAS v4u*)(p + 16); f32x16 x;
    x[0] = bflo(a.x); x[1] = bfhi(a.x); x[2] = bflo(a.y); x[3] = bfhi(a.y); x[4] = bflo(a.z); x[5] = bfhi(a.z); x[6] = bflo(a.w); x[7] = bfhi(a.w);
    x[8] = bflo(b.x); x[9] = bfhi(b.x); x[10] = bflo(b.y); x[11] = bfhi(b.y); x[12] = bflo(b.z); x[13] = bfhi(b.z); x[14] = bflo(b.w); x[15] = bfhi(b.w); return x; }

__device__ __forceinline__ void chan_to_frags(const unsigned (&pp)[16], int, bf16x8 (&fr)[2][2]) {
    unsigned t0[8], t1[8];
#pragma unroll
    for (int q = 0; q < 8; ++q) { const int plo = (q >> 1) * 4 + (q & 1), phi = plo + 2;
        const auto r = __builtin_amdgcn_permlane32_swap(pp[plo], pp[phi], false, false); t0[q] = r[0]; t1[q] = r[1]; }
#pragma unroll
    for (int s2 = 0; s2 < 2; ++s2) { v4u a, b2; a.x = t0[4 * s2]; a.y = t0[4 * s2 + 1]; a.z = t0[4 * s2 + 2]; a.w = t0[4 * s2 + 3]; b2.x = t1[4 * s2]; b2.y = t1[4 * s2 + 1]; b2.z = t1[4 * s2 + 2]; b2.w = t1[4 * s2 + 3];
        fr[0][s2] = __builtin_bit_cast(bf16x8, a); fr[1][s2] = __builtin_bit_cast(bf16x8, b2); }
}
struct ScanPre { float cw[9], kkp, kap; bf16 km, kc, vm, vc, rm, rc; bf16 gk[8], gv[8], gr[8], ge[8], ga[8]; };
constexpr int SC_PRE_LOADS = 11 + 6 + 40;
__device__ __forceinline__ void scan_prefetch(unsigned char* ws, int b, int h, int dir, int chunk, int lane, const float* conv, const float* kkpp, const float* kapp, ScanPre& pf) {
    const bool lat = chunk >= LC / SC_C; const int len = lat ? SEQ : LC, n0 = lat ? chunk * SC_C - LC : chunk * SC_C;
    const int rowbase = lat ? b * SEQ : NLAT + b * LC, col = h * 64 + lane;
    const int tk0 = dir ? (len - 1 - n0) : n0, tstep = dir ? -1 : 1;
    const unsigned ob0 = ((unsigned)(rowbase + tk0) * 512u + (unsigned)col) * 2u; const long ostepb = (long)tstep * 1024;
    const bool vm1 = n0 > 0;
    const char* ZKc = (const char*)(ws + WS_ZK); const char* ZVc = (const char*)(ws + WS_ZV); const char* ZRc = lat ? (const char*)(ws + WS_ZR) : ZKc;
    const char* EWc = (const char*)(ws + WS_EW) + (size_t)dir * NTOK * 1024; const char* ASc = (const char*)(ws + WS_AS) + (size_t)dir * NTOK * 1024;
#pragma unroll
    for (int j = 0; j < 3; ++j) { pf.cw[j] = conv[j * 1536 + col]; pf.cw[3 + j] = conv[j * 1536 + 512 + col]; pf.cw[6 + j] = conv[j * 1536 + 1024 + col]; }
    pf.kkp = kkpp[dir * 512 + col]; pf.kap = kapp[dir * 512 + col];
#define SC_LD(base, j) (*(const GAS bf16*)((base) + (long)(j) * ostepb + ob0))
    const long jm1 = vm1 ? -1 : 0;
    pf.km = SC_LD(ZKc, jm1); pf.kc = SC_LD(ZKc, 0); pf.vm = SC_LD(ZVc, jm1); pf.vc = SC_LD(ZVc, 0); pf.rm = SC_LD(ZRc, jm1); pf.rc = SC_LD(ZRc, 0);
#pragma unroll
    for (int jj = 0; jj < 8; ++jj) { pf.gk[jj] = SC_LD(ZKc, jj + 1); pf.gv[jj] = SC_LD(ZVc, jj + 1); pf.gr[jj] = SC_LD(ZRc, jj + 1); pf.ge[jj] = SC_LD(EWc, jj); pf.ga[jj] = SC_LD(ASc, jj); }
#undef SC_LD
}
__device__ __forceinline__ void scan_produce(unsigned char* ws, int b, int h, int dir, int chunk, LAS unsigned char* pl, unsigned char* xo, int lane_in, const float* conv, const float* kkpp, const float* kapp, ScanPre& pf) {
    int lane = launder(lane_in);
    float cw[9]; float kkp = pf.kkp, kap = pf.kap;
#pragma unroll
    for (int j = 0; j < 9; ++j) cw[j] = pf.cw[j];
    const bf16* ZK = (const bf16*)(ws + WS_ZK); const bf16* ZV = (const bf16*)(ws + WS_ZV); const bf16* ZR = (const bf16*)(ws + WS_ZR);
    const bf16* EW = (const bf16*)(ws + WS_EW) + (size_t)dir * NTOK * 512; const bf16* AS = (const bf16*)(ws + WS_AS) + (size_t)dir * NTOK * 512;
    int l32 = lane & 31, hi = lane >> 5; const int col = h * 64 + lane;
    const bool lat = chunk >= LC / SC_C; const int len = lat ? SEQ : LC, n0 = lat ? chunk * SC_C - LC : chunk * SC_C;
    const int rowbase = lat ? b * SEQ : NLAT + b * LC;
    LAS unsigned char* mA = pl; LAS unsigned char* mB = pl + 32 * SC_PITCH; LAS unsigned char* mK = pl + 64 * SC_PITCH; LAS unsigned char* mR = pl + 96 * SC_PITCH;
    LAS float* pcs = (LAS float*)(pl + 128 * SC_PITCH);
    unsigned pa[16], pb[16], pk[16], pv[16]; float P = 1.0f;
    const float latf = lat ? 1.0f : 0.0f;
    const float cwr_m = latf * (dir ? cw[2] : cw[0]), cwr_c = latf * cw[1], cwr_p = latf * (dir ? cw[0] : cw[2]), cwk_m = dir ? cw[5] : cw[3], cwk_p = dir ? cw[3] : cw[5], cwv_m = dir ? cw[8] : cw[6], cwv_p = dir ? cw[6] : cw[8];
    const int tk0 = dir ? (len - 1 - n0) : n0, tstep = dir ? -1 : 1;
    const unsigned ob0 = ((unsigned)(rowbase + tk0) * 512u + (unsigned)col) * 2u;
    const long ostepb = (long)tstep * 1024;
    const bool vm1 = n0 > 0, vp32 = n0 + SC_C < len;
    const char* ZKc = (const char*)ZK; const char* ZVc = (const char*)ZV; const char* ZRc = lat ? (const char*)ZR : (const char*)ZK;
    const char* EWc = (const char*)EW; const char* ASc = (const char*)AS;
#define SC_LD(base, j) (*(const GAS bf16*)((base) + (long)(j) * ostepb + ob0))
    float km = bf1(pf.km), kc = bf1(pf.kc), vm = bf1(pf.vm), vc = bf1(pf.vc), rm = bf1(pf.rm), rc = bf1(pf.rc);
    km = vm1 ? km : 0.f; vm = vm1 ? vm : 0.f; rm = vm1 ? rm : 0.f;
    bf16 rk[16], rv[16], rr[16], re[16], ra[16];
#define SC_LOADSTEP(j, sl) do { const bool vn = ((j) + 1 < SC_C) || vp32; const long jn = vn ? ((j) + 1) : (j); const bf16 tk_ = SC_LD(ZKc, jn), tv_ = SC_LD(ZVc, jn), tr_ = SC_LD(ZRc, jn); \
        rk[sl] = vn ? tk_ : (bf16)0; rv[sl] = vn ? tv_ : (bf16)0; rr[sl] = vn ? tr_ : (bf16)0; re[sl] = SC_LD(EWc, (j)); ra[sl] = SC_LD(ASc, (j)); } while (0)
#pragma unroll
    for (int jj = 0; jj < 8; ++jj) { rk[jj] = pf.gk[jj]; rv[jj] = pf.gv[jj]; rr[jj] = pf.gr[jj]; re[jj] = pf.ge[jj]; ra[jj] = pf.ga[jj]; }
#pragma unroll
    for (int jj = 8; jj < 16; ++jj) SC_LOADSTEP(jj, jj);
    asm volatile("" ::: "memory");
#pragma unroll
    for (int p = 0; p < 16; ++p) {
        bf16 ck[2], cv[2], cr[2], ce[2], ca[2];
#pragma unroll
        for (int u = 0; u < 2; ++u) { const int sl = (2 * p + u) & 15; ck[u] = rk[sl]; cv[u] = rv[sl]; cr[u] = rr[sl]; ce[u] = re[sl]; ca[u] = ra[sl]; }
        if (2 * p + 16 < SC_C) { SC_LOADSTEP(2 * p + 16, (2 * p) & 15); SC_LOADSTEP(2 * p + 17, (2 * p + 1) & 15); }
        float va[2], vb[2], vk[2], vv[2], vr[2];
#pragma unroll
        for (int u = 0; u < 2; ++u) {
            const float kp = bf1(ck[u]), vp = bf1(cv[u]), rp = bf1(cr[u]);
            const float k = cwk_m * km + cw[4] * kc + cwk_p * kp, v = cwv_m * vm + cw[7] * vc + cwv_p * vp, r = cwr_m * rm + cwr_c * rc + cwr_p * rp;
            km = kc; kc = kp; vm = vc; vc = vp; rm = rc; rc = rp;
            const float a = bf1(ca[u]), ew = bf1(ce[u]), w = __expf(-ew);
            const float kkv = k * kkp, ss = wave_sum(kkv * kkv), kk = kkv * __builtin_amdgcn_rsqf(fmaxf(ss, 1e-24f));
            const float kmod = k * (1.0f + (a - 1.0f) * kap);
            const float Pprev = P; P *= w; const float invP = __builtin_amdgcn_rcpf(P);
            const float at = -kk * Pprev, bt = kk * a * invP, kt = kmod * invP, rt = r * P;
            va[u] = at; vb[u] = bt; vk[u] = kt; vv[u] = v; vr[u] = rt;
        }
        pa[p] = pkbf(va[0], va[1]); pb[p] = pkbf(vb[0], vb[1]); pk[p] = pkbf(vk[0], vk[1]); pv[p] = pkbf(vv[0], vv[1]); const unsigned prt = pkbf(vr[0], vr[1]);
        { const int i0 = 2 * p;
          *(LAS bf16*)(mA + i0 * SC_PITCH + 2 * lane) = (bf16)(pa[p] & 0xffffu); *(LAS bf16*)(mA + (i0 + 1) * SC_PITCH + 2 * lane) = (bf16)(pa[p] >> 16);
          *(LAS bf16*)(mB + i0 * SC_PITCH + 2 * lane) = (bf16)(pb[p] & 0xffffu); *(LAS bf16*)(mB + (i0 + 1) * SC_PITCH + 2 * lane) = (bf16)(pb[p] >> 16);
          *(LAS bf16*)(mK + i0 * SC_PITCH + 2 * lane) = (bf16)(pk[p] & 0xffffu); *(LAS bf16*)(mK + (i0 + 1) * SC_PITCH + 2 * lane) = (bf16)(pk[p] >> 16);
          *(LAS bf16*)(mR + i0 * SC_PITCH + 2 * lane) = (bf16)(prt & 0xffffu); *(LAS bf16*)(mR + (i0 + 1) * SC_PITCH + 2 * lane) = (bf16)(prt >> 16); }
        if ((p & 3) == 3) asm volatile("" ::: "memory");
    }
#undef SC_LOADSTEP
#undef SC_LD
    pcs[lane] = P;
    const float pc_o = __shfl_xor(P, 32); const float pcn0 = hi ? pc_o : P, pcn1 = hi ? P : pc_o;
    bf16x8 fA[2][2], fB[2][2], fK[2][2], fV[2][2];
    chan_to_frags(pa, hi, fA); chan_to_frags(pb, hi, fB); chan_to_frags(pk, hi, fK); chan_to_frags(pv, hi, fV);
    LDS_WAIT(); asm volatile("" ::: "memory");
    __builtin_amdgcn_sched_barrier(0);
    lane = launder(lane_in); l32 = lane & 31; hi = lane >> 5;
    f32x16 X = zero16(), XT = zero16(), LakT = zero16(), MrbT = zero16(), MrkT = zero16();
    const int roff = l32 * SC_PITCH + 16 * hi;
#pragma unroll
    for (int ks = 0; ks < 4; ++ks) {
        const bf16x8 ga = *(const LAS bf16x8*)(mA + roff + 32 * ks), gb = *(const LAS bf16x8*)(mB + roff + 32 * ks), gk = *(const LAS bf16x8*)(mK + roff + 32 * ks), gr = *(const LAS bf16x8*)(mR + roff + 32 * ks);
        X = MF(ga, gb, X); XT = MF(gb, ga, XT); LakT = MF(gk, ga, LakT); MrbT = MF(gb, gr, MrbT); MrkT = MF(gk, gr, MrkT);
    }
    f32x16 TmT;
#pragma unroll
    for (int r = 0; r < 16; ++r) { const int row = crow_(r, hi);
        X[r] = (l32 < row) ? X[r] : 0.f; XT[r] = (row < l32) ? XT[r] : 0.f; LakT[r] = (row < l32) ? LakT[r] : 0.f;
        MrbT[r] = (row <= l32) ? MrbT[r] : 0.f; MrkT[r] = (row <= l32) ? MrkT[r] : 0.f; TmT[r] = XT[r] + ((row == l32) ? 1.0f : 0.f); }
    const bf16x8 la0 = packacc(LakT, 0), la1 = packacc(LakT, 1), rb0 = packacc(MrbT, 0), rb1 = packacc(MrbT, 1), rk0 = packacc(MrkT, 0), rk1 = packacc(MrkT, 1);
    __builtin_amdgcn_sched_barrier(0);
#pragma unroll
    for (int it = 0; it < 4; ++it) {
        const bf16x8 x0 = packacc(X, 0), x1 = packacc(X, 1), y0 = packacc(XT, 0), y1 = packacc(XT, 1), t0 = packacc(TmT, 0), t1 = packacc(TmT, 1);
        f32x16 Xn = zero16(), XnT = zero16();
        Xn = MF(y0, x0, Xn); Xn = MF(y1, x1, Xn); XnT = MF(x0, y0, XnT); XnT = MF(x1, y1, XnT);
        const bf16x8 n0 = packacc(Xn, 0), n1 = packacc(Xn, 1);
        TmT = MF(n0, t0, TmT); TmT = MF(n1, t1, TmT);
        X = Xn; XT = XnT;
    }
    __builtin_amdgcn_sched_barrier(0);
    const bf16x8 tt0 = packacc(TmT, 0), tt1 = packacc(TmT, 1);
    f32x16 W[2], Ut[2];
#pragma unroll
    for (int ct = 0; ct < 2; ++ct) { f32x16 w = zero16(); w = MF(tt0, fA[ct][0], w); w = MF(tt1, fA[ct][1], w); W[ct] = w;
        f32x16 x1 = zero16(); x1 = MF(la0, fV[ct][0], x1); x1 = MF(la1, fV[ct][1], x1);
        f32x16 u = zero16(); u = MF(tt0, packacc(x1, 0), u); u = MF(tt1, packacc(x1, 1), u); Ut[ct] = u; }
    bf16x8 fW[2][2], fU[2][2];
#pragma unroll
    for (int ct = 0; ct < 2; ++ct) { fW[ct][0] = packacc(W[ct], 0); fW[ct][1] = packacc(W[ct], 1); fU[ct][0] = packacc(Ut[ct], 0); fU[ct][1] = packacc(Ut[ct], 1); }
    __builtin_amdgcn_sched_barrier(0);
    lane = launder(lane_in); l32 = lane & 31; hi = lane >> 5;
#pragma unroll
    for (int kt = 0; kt < 2; ++kt) { f32x16 acc;
#pragma unroll
        for (int r4 = 0; r4 < 4; ++r4) { const v2u rr = *(const LAS v2u*)(mR + l32 * SC_PITCH + 2 * (32 * kt + 8 * r4 + 4 * hi));
            acc[4 * r4] = bflo(rr.x); acc[4 * r4 + 1] = bfhi(rr.x); acc[4 * r4 + 2] = bflo(rr.y); acc[4 * r4 + 3] = bfhi(rr.y); }
        acc = MF(fW[kt][0], rb0, acc); acc = MF(fW[kt][1], rb1, acc);
        *(GAS bf16x8*)(xo + 16384 + (kt * 2 + 0) * 1024 + lane * 16) = packacc(acc, 0); *(GAS bf16x8*)(xo + 16384 + (kt * 2 + 1) * 1024 + lane * 16) = packacc(acc, 1); }
#pragma unroll
    for (int vt = 0; vt < 2; ++vt) { f32x16 acc = zero16();
        acc = MF(rb0, fU[vt][0], acc); acc = MF(rb1, fU[vt][1], acc); acc = MF(rk0, fV[vt][0], acc); acc = MF(rk1, fV[vt][1], acc);
        st_acc_bf16(xo + 20480 + vt * 2048 + lane * 32, acc); }
    __builtin_amdgcn_sched_barrier(0);
    lane = launder(lane_in); l32 = lane & 31; hi = lane >> 5;
#pragma unroll
    for (int kt = 0; kt < 2; ++kt)
#pragma unroll
        for (int nt = 0; nt < 2; ++nt) { f32x16 acc = zero16(); acc = MF(fW[kt][0], fB[nt][0], acc); acc = MF(fW[kt][1], fB[nt][1], acc);
            const float pc = nt ? pcn1 : pcn0;
#pragma unroll
            for (int r = 0; r < 16; ++r) acc[r] = (acc[r] + ((kt == nt && crow_(r, hi) == l32) ? 1.0f : 0.f)) * pc;
            *(GAS bf16x8*)(xo + ((kt * 2 + nt) * 2 + 0) * 1024 + lane * 16) = packacc(acc, 0); *(GAS bf16x8*)(xo + ((kt * 2 + nt) * 2 + 1) * 1024 + lane * 16) = packacc(acc, 1); }
    __builtin_amdgcn_sched_barrier(0);
    lane = launder(lane_in); l32 = lane & 31; hi = lane >> 5;
#pragma unroll
    for (int kt = 0; kt < 2; ++kt)
#pragma unroll
        for (int vt = 0; vt < 2; ++vt) { f32x16 acc = zero16();
            acc = MF(fB[kt][0], fU[vt][0], acc); acc = MF(fB[kt][1], fU[vt][1], acc); acc = MF(fK[kt][0], fV[vt][0], acc); acc = MF(fK[kt][1], fV[vt][1], acc);
#pragma unroll
            for (int r4 = 0; r4 < 4; ++r4) { const f32x4 pr = *(const LAS f32x4*)(pcs + 32 * kt + 8 * r4 + 4 * hi);
                acc[4 * r4] *= pr.x; acc[4 * r4 + 1] *= pr.y; acc[4 * r4 + 2] *= pr.z; acc[4 * r4 + 3] *= pr.w; }
            st_acc_bf16(xo + 8192 + (kt * 2 + vt) * 2048 + lane * 32, acc); }
    LDS_WAIT();
    __builtin_amdgcn_sched_barrier(0); asm volatile("" ::: "memory");
    scan_prefetch(ws, b, h, dir, (chunk + SC_RP < SC_NCH) ? chunk + SC_RP : chunk, launder(lane_in), conv, kkpp, kapp, pf);
    __builtin_amdgcn_sched_barrier(0); asm volatile("" ::: "memory");
}
__device__ __forceinline__ void scan_consume(unsigned char* ws, int b, int h, int dir, int chunk, const unsigned char* xi, int lane, f32x16 (&H)[2][2]) {
    const int l32 = lane & 31, hi = lane >> 5;
    bf16x8 hb[2][2][2];
#pragma unroll
    for (int kt = 0; kt < 2; ++kt)
#pragma unroll
        for (int vt = 0; vt < 2; ++vt) { hb[kt][vt][0] = packacc(H[kt][vt], 0); hb[kt][vt][1] = packacc(H[kt][vt], 1); }
    if (chunk >= LC / SC_C) {
        bf16x8 rf[2][2];
#pragma unroll
        for (int kt = 0; kt < 2; ++kt)
#pragma unroll
            for (int s2 = 0; s2 < 2; ++s2) rf[kt][s2] = *(const GAS bf16x8*)(xi + 16384 + (kt * 2 + s2) * 1024 + lane * 16);
        bf16* Y = (bf16*)(ws + (dir ? WS_YB : WS_YF)); const int n0 = chunk * SC_C - LC;
#pragma unroll
        for (int vt = 0; vt < 2; ++vt) { f32x16 acc = ld_acc_bf16(xi + 20480 + vt * 2048 + lane * 32);
#pragma unroll
            for (int kt = 0; kt < 2; ++kt) { acc = MF(rf[kt][0], hb[kt][vt][0], acc); acc = MF(rf[kt][1], hb[kt][vt][1], acc); }
#pragma unroll
            for (int r = 0; r < 16; ++r) { const int i = crow_(r, hi), tk = dir ? (SEQ - 1 - (n0 + i)) : (n0 + i);
                Y[((size_t)b * SEQ + tk) * 512 + h * 64 + 32 * vt + l32] = (bf16)(pkbf(acc[r], 0.f) & 0xffffu); } }
    }
    f32x16 Hn[2][2];
#pragma unroll
    for (int nt = 0; nt < 2; ++nt)
#pragma unroll
        for (int vt = 0; vt < 2; ++vt) Hn[nt][vt] = ld_acc_bf16(xi + 8192 + (nt * 2 + vt) * 2048 + lane * 32);
#pragma unroll
    for (int kt = 0; kt < 2; ++kt)
#pragma unroll
        for (int nt = 0; nt < 2; ++nt) { const bf16x8 g0 = *(const GAS bf16x8*)(xi + ((kt * 2 + nt) * 2 + 0) * 1024 + lane * 16), g1 = *(const GAS bf16x8*)(xi + ((kt * 2 + nt) * 2 + 1) * 1024 + lane * 16);
#pragma unroll
            for (int vt = 0; vt < 2; ++vt) { Hn[nt][vt] = MF(g0, hb[kt][vt][0], Hn[nt][vt]); Hn[nt][vt] = MF(g1, hb[kt][vt][1], Hn[nt][vt]); } }
#pragma unroll
    for (int nt = 0; nt < 2; ++nt)
#pragma unroll
        for (int vt = 0; vt < 2; ++vt) H[nt][vt] = Hn[nt][vt];
}
__device__ __forceinline__ void p4b_scan(Frame& F) {
    const int wave = F.wave, lane = F.lane;
    const bool is_cons = wave < 2; const int pw = wave - 2;
    unsigned char* xch = F.ws + WS_XCH + (size_t)blockIdx.x * (2 * SC_SLOT_BYTES);
    LAS unsigned char* pl = F.lds + (is_cons ? 0 : pw) * SC_PLDS;
    for (int task = blockIdx.x; task < NB * 8; task += F.G) {
        const int b = task >> 3, h = task & 7; const int pdir = is_cons ? wave : pw / SC_RP, pci = is_cons ? 0 : pw % SC_RP;
        const float* conv = karg_in(I_CONV); const float* kkpp = karg_in(I_KK); const float* kapp = karg_in(I_KA);
#define SC_SYNC() do { asm volatile("s_waitcnt vmcnt(0) lgkmcnt(0)" ::: "memory"); __builtin_amdgcn_s_barrier(); asm volatile("" ::: "memory"); } while (0)
        if (is_cons) {
            f32x16 H[2][2];
#pragma unroll
            for (int i = 0; i < 2; ++i)
#pragma unroll
                for (int j = 0; j < 2; ++j) H[i][j] = zero16();
#pragma unroll 1
            for (int q = -1; q < SC_ROUNDS; ++q) {
                if (q >= 0) { __builtin_amdgcn_fence(__ATOMIC_ACQUIRE, "agent");
#pragma unroll 1
                    for (int i = 0; i < SC_RP; ++i) scan_consume(F.ws, b, h, wave, q * SC_RP + i, xch + (size_t)(q & 1) * SC_SLOT_BYTES + (size_t)(wave * SC_RP + i) * SC_TASK_BYTES, lane, H); }
                SC_SYNC();
            }
        } else {
            ScanPre pf; scan_prefetch(F.ws, b, h, pdir, pci, lane, conv, kkpp, kapp, pf);
#pragma unroll 1
            for (int q = -1; q < SC_ROUNDS; ++q) {
                if (q + 1 < SC_ROUNDS) { scan_produce(F.ws, b, h, pdir, (q + 1) * SC_RP + pci, pl, xch + (size_t)((q + 1) & 1) * SC_SLOT_BYTES + (size_t)(pdir * SC_RP + pci) * SC_TASK_BYTES, lane, conv, kkpp, kapp, pf);
                    asm volatile("s_waitcnt vmcnt(%0) lgkmcnt(0)" :: "n"(SC_PRE_LOADS) : "memory"); __builtin_amdgcn_s_barrier(); asm volatile("" ::: "memory"); }
                else SC_SYNC();
            }
        }
#undef SC_SYNC
    }
}
#undef MF

__device__ __forceinline__ void p5_rwkv_out(Frame& F) {
    const int gw = blockIdx.x * NWAVES + F.wave, NGW = F.G * NWAVES, lane = F.lane, c0 = 8 * lane;
    const bf16* ZK = (const bf16*)(F.ws + WS_ZK); const bf16* ZV = (const bf16*)(F.ws + WS_ZV); const bf16* ZR = (const bf16*)(F.ws + WS_ZR);
    const bf16* AS0 = (const bf16*)(F.ws + WS_AS); const bf16* AS1 = AS0 + (size_t)NTOK * 512;
    const bf16* YF = (const bf16*)(F.ws + WS_YF); const bf16* YB = (const bf16*)(F.ws + WS_YB); const bf16* G = (const bf16*)(F.ws + WS_G);
    bf16* ORW = (bf16*)(F.ws + WS_ORW);
    LAS float* PL = (LAS float*)F.lds;
    { const float* convg = karg_in(I_CONV); const float* kag = karg_in(I_KA); const float* rkg = karg_in(I_RK); const float* lnwg = karg_in(I_LNW); const float* lnbg = karg_in(I_LNB);
      const int c = F.tid; float pv[15];
#pragma unroll
      for (int row = 0; row < 9; ++row) pv[row] = convg[(row % 3) * 1536 + (row / 3) * 512 + c];
      pv[9] = kag[c]; pv[10] = kag[512 + c]; pv[11] = rkg[c]; pv[12] = rkg[512 + c]; pv[13] = lnwg[c]; pv[14] = lnbg[c];
#pragma unroll
      for (int row = 0; row < 15; ++row) PL[row * 512 + c] = pv[row];
      __syncthreads(); }
    const LAS float* conv = PL; const LAS float* ka = PL + 9 * 512; const LAS float* rk = PL + 11 * 512; const LAS float* lnw = PL + 13 * 512; const LAS float* lnb = PL + 14 * 512;
    for (int m0 = gw; m0 < NLAT; m0 += 2 * NGW) {
        v4u raw[2][14];
        const v4u z4 = (v4u){0u, 0u, 0u, 0u};
#pragma unroll
        for (int rr = 0; rr < 2; ++rr) { const int m = min(m0 + rr * NGW, NLAT - 1);
            const int t = m & 2047; const bool first = t == 0, last = t == SEQ - 1; const size_t o = (size_t)m * 512 + c0;
            const size_t om = first ? o : o - 512, op = last ? o : o + 512;
#pragma unroll
            for (int which = 0; which < 3; ++which) { const bf16* Z = which == 0 ? ZR : (which == 1 ? ZK : ZV);
                const v4u ra = *(const GAS v4u*)(Z + om), rc_ = *(const GAS v4u*)(Z + op);
                raw[rr][3 * which] = first ? z4 : ra; raw[rr][3 * which + 1] = *(const GAS v4u*)(Z + o); raw[rr][3 * which + 2] = last ? z4 : rc_; }
            raw[rr][9] = *(const GAS v4u*)(AS0 + o); raw[rr][10] = *(const GAS v4u*)(AS1 + o); raw[rr][11] = *(const GAS v4u*)(YF + o); raw[rr][12] = *(const GAS v4u*)(YB + o); raw[rr][13] = *(const GAS v4u*)(G + o); }
#pragma unroll
        for (int rr = 0; rr < 2; ++rr) { const int m = m0 + rr * NGW; if (m >= NLAT) continue;
            const size_t o = (size_t)m * 512 + c0;
            float r[8], k[8], v[8], tmp[8];
            asm volatile("" ::: "memory");
#pragma unroll
            for (int which = 0; which < 3; ++which) { float (&dst)[8] = which == 0 ? r : (which == 1 ? k : v);
                asm volatile("" ::: "memory");
                float fa[8], fb[8], fc[8]; unpack8(raw[rr][3 * which], fa); unpack8(raw[rr][3 * which + 1], fb); unpack8(raw[rr][3 * which + 2], fc);
                const LAS float* cwp = conv + (3 * which) * 512 + c0;
#pragma unroll
                for (int j = 0; j < 8; ++j) dst[j] = cwp[j] * fa[j] + cwp[512 + j] * fb[j] + cwp[1024 + j] * fc[j]; }
            asm volatile("" ::: "memory");
            float a0[8], a1[8]; unpack8(raw[rr][9], a0); unpack8(raw[rr][10], a1);
            float s = 0.f;
#pragma unroll
            for (int j = 0; j < 8; ++j) { const float km0 = k[j] * (1.0f + (a0[j] - 1.0f) * ka[c0 + j]), km1 = k[j] * (1.0f + (a1[j] - 1.0f) * ka[512 + c0 + j]);
                s += r[j] * (km0 * rk[c0 + j] + km1 * rk[512 + c0 + j]); }
            s += __shfl_xor(s, 1); s += __shfl_xor(s, 2); s += __shfl_xor(s, 4);
            asm volatile("" ::: "memory");
            float y[8], yb[8]; unpack8(raw[rr][11], y); unpack8(raw[rr][12], yb);
            float sm = 0.f;
#pragma unroll
            for (int j = 0; j < 8; ++j) { y[j] += yb[j]; sm += y[j]; }
            sm += __shfl_xor(sm, 1); sm += __shfl_xor(sm, 2); sm += __shfl_xor(sm, 4);
            const float mean = sm * (1.f / 64.f); float sq = 0.f;
#pragma unroll
            for (int j = 0; j < 8; ++j) { y[j] -= mean; sq += y[j] * y[j]; }
            sq += __shfl_xor(sq, 1); sq += __shfl_xor(sq, 2); sq += __shfl_xor(sq, 4);
            const float rstd = __builtin_amdgcn_rsqf(sq * (1.f / 64.f) + 64e-5f);
            float gg[8]; unpack8(raw[rr][13], gg);
#pragma unroll
            for (int j = 0; j < 8; ++j) tmp[j] = (y[j] * rstd * lnw[c0 + j] + lnb[c0 + j] + s * v[j]) * gg[j];
            *(GAS v4u*)(ORW + o) = pack8(tmp); }
    }
}

struct EpiMerge {
    static constexpr bool PERM = true, AFTER_DRAIN = false;
    bf16* merged; const bf16* gates; int goff; int first;
    __device__ __forceinline__ void operator()(const f32x4 (&acc)[2][2][4][2], const Unit& u, int wr, int wc, int fr, int fq) const {
        const int row0 = u.pm * 256 + wr * 64 + fr, col0 = u.pn * 256 + wc * 32 + 8 * fq;
#pragma unroll
        for (int ai = 0; ai < 2; ++ai)
#pragma unroll
            for (int m = 0; m < 4; ++m) { const size_t row = (size_t)(row0 + ai * 128 + m * 16);
#pragma unroll
                for (int bj = 0; bj < 2; ++bj) { const int col = col0 + bj * 128;
                    float gt[8]; unpack8(*(const GAS v4u*)(gates + row * 2048 + goff + col), gt);
                    const f32x4 v0 = acc[ai][bj][m][0], v1 = acc[ai][bj][m][1];
                    float o[8] = {v0.x * gt[0], v0.y * gt[1], v0.z * gt[2], v0.w * gt[3], v1.x * gt[4], v1.y * gt[5], v1.z * gt[6], v1.w * gt[7]};
                    GAS v4u* p = (GAS v4u*)(merged + row * 1024 + col);
                    if (!first) { float pv[8]; unpack8(*p, pv);
#pragma unroll
                        for (int j = 0; j < 8; ++j) o[j] += pv[j]; }
                    *p = pack8(o); } }
    }
};
struct EpiMerge2 {
    static constexpr bool PERM = true, AFTER_DRAIN = false;
    bf16* merged; const bf16* gates;
    __device__ __forceinline__ void mid(f32x4 (&acc)[2][2][4][2], const Unit& u, int wr, int wc, int fr, int fq) const {
        const int row0 = u.pm * 256 + wr * 64 + fr, col0 = u.pn * 256 + wc * 32 + 8 * fq;
#pragma unroll
        for (int ai = 0; ai < 2; ++ai)
#pragma unroll
          for (int mh = 0; mh < 2; ++mh) {
            v4u g[8];
#pragma unroll
            for (int m2 = 0; m2 < 2; ++m2)
#pragma unroll
                for (int bj = 0; bj < 2; ++bj) { const bf16* gp = gates + (size_t)(row0 + ai * 128 + (2 * mh + m2) * 16) * 2048 + col0 + bj * 128;
                    g[(m2 * 2 + bj) * 2] = *(const GAS v4u*)gp; g[(m2 * 2 + bj) * 2 + 1] = *(const GAS v4u*)(gp + 1024); }
            asm volatile("" : "+v"(g[0]), "+v"(g[1]), "+v"(g[2]), "+v"(g[3]), "+v"(g[4]), "+v"(g[5]), "+v"(g[6]), "+v"(g[7]));
#pragma unroll
            for (int m2 = 0; m2 < 2; ++m2)
#pragma unroll
                for (int bj = 0; bj < 2; ++bj) { const int m = 2 * mh + m2; float gr[8], ga[8]; unpack8(g[(m2 * 2 + bj) * 2], gr); unpack8(g[(m2 * 2 + bj) * 2 + 1], ga);
                    float q[8];
#pragma unroll
                    for (int j = 0; j < 8; ++j) q[j] = gr[j] * __builtin_amdgcn_rcpf(fmaxf(ga[j], 1e-30f));
                    acc[ai][bj][m][0] *= (f32x4){q[0], q[1], q[2], q[3]}; acc[ai][bj][m][1] *= (f32x4){q[4], q[5], q[6], q[7]}; }
          }
    }
    __device__ __forceinline__ void operator()(const f32x4 (&acc)[2][2][4][2], const Unit& u, int wr, int wc, int fr, int fq) const {
        const int row0 = u.pm * 256 + wr * 64 + fr, col0 = u.pn * 256 + wc * 32 + 8 * fq;
#pragma unroll
        for (int ai = 0; ai < 2; ++ai) {
            v4u g[8];
#pragma unroll
            for (int m = 0; m < 4; ++m)
#pragma unroll
                for (int bj = 0; bj < 2; ++bj) g[m * 2 + bj] = *(const GAS v4u*)(gates + (size_t)(row0 + ai * 128 + m * 16) * 2048 + 1024 + col0 + bj * 128);
            asm volatile("" : "+v"(g[0]), "+v"(g[1]), "+v"(g[2]), "+v"(g[3]), "+v"(g[4]), "+v"(g[5]), "+v"(g[6]), "+v"(g[7]));
#pragma unroll
            for (int m = 0; m < 4; ++m) { const size_t row = (size_t)(row0 + ai * 128 + m * 16);
#pragma unroll
                for (int bj = 0; bj < 2; ++bj) { const int col = col0 + bj * 128;
                    float ga[8]; unpack8(g[m * 2 + bj], ga);
                    const f32x4 v0 = acc[ai][bj][m][0], v1 = acc[ai][bj][m][1];
                    float o[8] = {v0.x * fmaxf(ga[0], 1e-30f), v0.y * fmaxf(ga[1], 1e-30f), v0.z * fmaxf(ga[2], 1e-30f), v0.w * fmaxf(ga[3], 1e-30f),
                                  v1.x * fmaxf(ga[4], 1e-30f), v1.y * fmaxf(ga[5], 1e-30f), v1.z * fmaxf(ga[6], 1e-30f), v1.w * fmaxf(ga[7], 1e-30f)};
                    *(GAS v4u*)(merged + row * 1024 + col) = pack8(o); } }
        }
    }
};
struct EpiOutproj {
    static constexpr bool PERM = true, AFTER_DRAIN = false;
    bf16* x1; const float* mod; const float* x;
    __device__ __forceinline__ void operator()(const f32x4 (&acc)[2][2][4][2], const Unit& u, int wr, int wc, int fr, int fq) const {
        const int row0 = u.pm * 256 + wr * 64 + fr, col0 = u.pn * 256 + wc * 32 + 8 * fq; const int b = u.pm >> 3;
        f32x4 gv[2][2];
#pragma unroll
        for (int bj = 0; bj < 2; ++bj)
#pragma unroll
            for (int n = 0; n < 2; ++n) gv[bj][n] = *(const f32x4*)(mod + (size_t)b * 6144 + 2048 + col0 + bj * 128 + 4 * n);
#pragma unroll
        for (int ai = 0; ai < 2; ++ai)
#pragma unroll
            for (int mp = 0; mp < 2; ++mp) {
                f32x4 xv[8];
#pragma unroll
                for (int m2 = 0; m2 < 2; ++m2)
#pragma unroll
                    for (int bj = 0; bj < 2; ++bj) { const float* xp = x + (size_t)(row0 + ai * 128 + (2 * mp + m2) * 16) * 1024 + col0 + bj * 128;
                        xv[(m2 * 2 + bj) * 2] = *(const GAS f32x4*)xp; xv[(m2 * 2 + bj) * 2 + 1] = *(const GAS f32x4*)(xp + 4); }
                asm volatile("" : "+v"(xv[0]), "+v"(xv[1]), "+v"(xv[2]), "+v"(xv[3]), "+v"(xv[4]), "+v"(xv[5]), "+v"(xv[6]), "+v"(xv[7]));
#pragma unroll
                for (int m2 = 0; m2 < 2; ++m2)
#pragma unroll
                    for (int bj = 0; bj < 2; ++bj) { const int m = 2 * mp + m2; const f32x4 v0 = xv[(m2 * 2 + bj) * 2] + gv[bj][0] * acc[ai][bj][m][0], v1 = xv[(m2 * 2 + bj) * 2 + 1] + gv[bj][1] * acc[ai][bj][m][1];
                        v4u w; w.x = pkbf(v0.x, v0.y); w.y = pkbf(v0.z, v0.w); w.z = pkbf(v1.x, v1.y); w.w = pkbf(v1.z, v1.w);
                        *(GAS v4u*)(x1 + (size_t)(row0 + ai * 128 + m * 16) * 1024 + col0 + bj * 128) = w; }
            }
    }
};

constexpr int RW_PITCH = 2064;
constexpr int P8_STG = 2 * 16 * RW_PITCH;
static_assert(P8_STG + 4 * 4 * RW_PITCH + 4 * 8448 <= LDSCTL_OFF, "P8 LDS image");
__device__ __forceinline__ void p8_norm2_router(Frame& F) {
    LAS unsigned char* rhi = F.lds; LAS unsigned char* rlo = F.lds + 16 * RW_PITCH;
    const float* rw = karg_in(I_ROUTER);
    { f32x4 w4[8];
#pragma unroll
      for (int j = 0; j < 8; ++j) w4[j] = *(const GAS f32x4*)(rw + 4 * (F.tid + 512 * j));
#pragma unroll
      for (int j = 0; j < 8; ++j)
#pragma unroll
          for (int cc = 0; cc < 4; ++cc) { const int i = 4 * (F.tid + 512 * j) + cc, e = i & 15, k = i >> 4; const float w = w4[j][cc]; const unsigned h = pkbf(w, 0.f) & 0xffffu; const float wl = w - __uint_as_float(h << 16);
              *(LAS bf16*)(rhi + e * RW_PITCH + 2 * k) = (bf16)h; *(LAS bf16*)(rlo + e * RW_PITCH + 2 * k) = (bf16)(pkbf(wl, 0.f) & 0xffffu); } }
    __syncthreads();
    if (F.wave >= 4) { weight_copies(F, 1, blockIdx.x * 4 + (F.wave - 4), F.G * 4, (LAS float*)(F.lds + P8_STG + 4 * 4 * RW_PITCH + (F.wave - 4) * 8448)); return; }
    const int gw = blockIdx.x * 4 + F.wave, NGW = F.G * 4, lane = F.lane, n16 = lane & 15, kg = lane >> 4;
    LAS unsigned char* stg = F.lds + P8_STG + F.wave * (4 * RW_PITCH);
    const float* mod = (const float*)(F.ws + WS_MOD); float* AFF = (float*)(F.ws + WS_AFF); unsigned char* H2Q = F.ws + WS_H2Q;
    const float* g2 = karg_in(I_N2G); const float* Xp = karg_in(I_X); const bf16* DELTA = (const bf16*)(F.ws + WS_DELTA);
    f32x4 gv[4];
#pragma unroll
    for (int j = 0; j < 4; ++j) gv[j] = *(const f32x4*)(g2 + 4 * lane + 256 * j);
    const LAS unsigned char* ah = rhi + n16 * RW_PITCH + 16 * kg; const LAS unsigned char* al = rlo + n16 * RW_PITCH + 16 * kg;
    const LAS unsigned char* bs = stg + (n16 & 3) * RW_PITCH + 16 * kg;
    for (int tile = gw; tile < NLAT / 32; tile += NGW) {
        const int mbase = tile * 32, b = mbase >> 11; const float* sh = mod + (size_t)b * 6144 + 3072; const float* sc = sh + 1024;
        f32x4 av[4], bv[4];
#pragma unroll
        for (int j = 0; j < 4; ++j) { av[j] = *(const f32x4*)(sc + 4 * lane + 256 * j) + 1.0f; bv[j] = *(const f32x4*)(sh + 4 * lane + 256 * j); }
        v2u dn[4][4];
#pragma unroll
        for (int r = 0; r < 4; ++r)
#pragma unroll
            for (int j = 0; j < 4; ++j) dn[r][j] = *(const GAS v2u*)(DELTA + (size_t)(mbase + r) * DM + 4 * lane + 256 * j);
#pragma unroll 1
        for (int r0 = 0; r0 < 32; r0 += 4) {
            f32x4 v[4][4];
#pragma unroll
            for (int r = 0; r < 4; ++r)
#pragma unroll
                for (int j = 0; j < 4; ++j) { const v2u d = dn[r][j]; v[r][j] = (f32x4){bflo(d.x), bfhi(d.x), bflo(d.y), bfhi(d.y)}; }
            { const int rn = r0 + 4 < 32 ? r0 + 4 : r0;
#pragma unroll
              for (int r = 0; r < 4; ++r)
#pragma unroll
                  for (int j = 0; j < 4; ++j) dn[r][j] = *(const GAS v2u*)(DELTA + (size_t)(mbase + rn + r) * DM + 4 * lane + 256 * j); }
#pragma unroll
            for (int r = 0; r < 4; ++r) { float s = 0.f;
#pragma unroll
                for (int j = 0; j < 4; ++j) s += (v[r][j].x * v[r][j].x + v[r][j].y * v[r][j].y) + (v[r][j].z * v[r][j].z + v[r][j].w * v[r][j].w);
                const float rstd = __builtin_amdgcn_rsqf(wave_sum(s) * (1.f / DM) + 1e-6f);
#pragma unroll
                for (int j = 0; j < 4; ++j) { const f32x4 y = v[r][j] * rstd * gv[j] * av[j] + bv[j];
                    v2u o; o.x = pkbf(y.x, y.y); o.y = pkbf(y.z, y.w);
                    *(LAS v2u*)(stg + r * RW_PITCH + 8 * lane + 512 * j) = o;
                    *(GAS unsigned*)(H2Q + (size_t)(mbase + r0 + r) * DM + 4 * lane + 256 * j) = pk4f8(y.x, y.y, y.z, y.w); } }
            LDS_WAIT(); asm volatile("" ::: "memory");
            f32x4 acc = {0.f, 0.f, 0.f, 0.f};
#pragma unroll 8
            for (int ks = 0; ks < 32; ++ks) { const bf16x8 bf = *(const LAS bf16x8*)(bs + 64 * ks);
                const bf16x8 fh = *(const LAS bf16x8*)(ah + 64 * ks), fl = *(const LAS bf16x8*)(al + 64 * ks);
                acc = __builtin_amdgcn_mfma_f32_16x16x32_bf16(fh, bf, acc, 0, 0, 0); acc = __builtin_amdgcn_mfma_f32_16x16x32_bf16(fl, bf, acc, 0, 0, 0); }
            asm volatile("" ::: "memory");
            float mx = fmaxf(fmaxf(acc.x, acc.y), fmaxf(acc.z, acc.w));
            mx = fmaxf(mx, __shfl_xor(mx, 16)); mx = fmaxf(mx, __shfl_xor(mx, 32));
            const float p0 = __expf(acc.x - mx), p1 = __expf(acc.y - mx), p2 = __expf(acc.z - mx), p3 = __expf(acc.w - mx);
            float den = (p0 + p1) + (p2 + p3); den += __shfl_xor(den, 16); den += __shfl_xor(den, 32);
            const float inv = 1.0f / den; const int t = (mbase & 2047) + r0 + n16;
            if (n16 < 4) { float* ap = AFF + ((size_t)b * 16 + 4 * kg) * SEQ + t; ap[0] = p0 * inv; ap[SEQ] = p1 * inv; ap[2 * SEQ] = p2 * inv; ap[3 * SEQ] = p3 * inv; }
        }
    }
}

__device__ __forceinline__ int block_count(Frame& F, LAS int* wc, int slot, bool p0, bool p1, bool p2, bool p3) {
    const int c = __builtin_popcountll(__ballot(p0)) + __builtin_popcountll(__ballot(p1)) + __builtin_popcountll(__ballot(p2)) + __builtin_popcountll(__ballot(p3));
    if (F.lane == 0) wc[slot * 8 + F.wave] = c;
    __syncthreads();
    int s = 0;
#pragma unroll
    for (int w = 0; w < 8; ++w) s += wc[slot * 8 + w];
    return s;
}
__device__ __forceinline__ void p9_topk_gather(Frame& F) {
    LAS int* wc = (LAS int*)F.lds;
    LAS int* sel = (LAS int*)(F.lds + 1024);
    const float* AFF = (const float*)(F.ws + WS_AFF); int* IDX = (int*)(F.ws + WS_IDX); float* VAL = (float*)(F.ws + WS_VAL);
    const bf16* H2 = (const bf16*)(F.ws + WS_H2); bf16* XE = (bf16*)(F.ws + WS_XE); int* INV = (int*)(F.ws + WS_INV);
    const int tid = F.tid, lane = F.lane, wave = F.wave;
    for (int p = blockIdx.x; p < NB * NE; p += F.G) {
        const int b = p >> 4, e = p & 15;
        const f32x4 av = *(const GAS f32x4*)(AFF + (size_t)p * SEQ + 4 * tid);
        const unsigned u0 = __float_as_uint(av.x), u1 = __float_as_uint(av.y), u2 = __float_as_uint(av.z), u3 = __float_as_uint(av.w);
        unsigned tau = 0u; int it = 0;
        for (int bit = 30; bit >= 0; --bit, ++it) { const unsigned cand = tau | (1u << bit);
            const int cnt = block_count(F, wc, it & 1, u0 >= cand, u1 >= cand, u2 >= cand, u3 >= cand);
            if (cnt >= CAP) tau = cand; }
        const int cgt = block_count(F, wc, it & 1, u0 > tau, u1 > tau, u2 > tau, u3 > tau); ++it;
        const int need_eq = CAP - cgt;
        const int ngt = (u0 > tau) + (u1 > tau) + (u2 > tau) + (u3 > tau), neq = (u0 == tau) + (u1 == tau) + (u2 == tau) + (u3 == tau);
        int pk = ngt | (neq << 16), inc = pk;
#pragma unroll
        for (int o = 1; o < 64; o <<= 1) { const int nb = __shfl_up(inc, o); if (lane >= o) inc += nb; }
        if (lane == 63) wc[16 + wave] = inc;
        __syncthreads();
        int base = 0;
#pragma unroll
        for (int w = 0; w < 8; ++w) base += (w < wave) ? wc[16 + w] : 0;
        int ex = base + inc - pk; int gpos = ex & 0xffff, epos = ex >> 16;
        const unsigned uu[4] = {u0, u1, u2, u3}; const float ff[4] = {av.x, av.y, av.z, av.w};
#pragma unroll
        for (int j = 0; j < 4; ++j) { int slot = -1;
            if (uu[j] > tau) { slot = gpos; ++gpos; } else if (uu[j] == tau) { if (epos < need_eq) slot = cgt + epos; ++epos; }
            if (slot >= 0) { IDX[(size_t)(e * NB + b) * CAP + slot] = 4 * tid + j; VAL[(size_t)(e * NB + b) * CAP + slot] = ff[j]; sel[slot] = 4 * tid + j; }
            INV[((size_t)b * SEQ + 4 * tid + j) * 16 + e] = slot; }
        __syncthreads();
        __syncthreads();
    }
}

struct ExpertOrder {
    int G, c, upe, npn; int rev = 0;
    __device__ void init(int G_, int c_, int npn_) { G = G_; c = c_; npn = npn_; upe = 32 * npn_; }
    __device__ bool next(int i, Unit& u) const {
        if (G == 256) {
            const unsigned rp = (unsigned)npn >> 2, pi = (unsigned)i / rp, r3 = (unsigned)i - pi * rp; if (pi >= (unsigned)(NE / 2)) return false;
            const unsigned xcd = (unsigned)c & 7u, slot = (unsigned)c >> 3, e0 = 2u * pi + (xcd >> 2), e = rev ? (unsigned)(NE - 1) - e0 : e0;
            u.pm = (int)(e * 32u + (xcd & 3u) + 4u * (slot & 7u)); u.pn = (int)(e * (unsigned)npn + 4u * r3 + (slot >> 3)); return true; }
        const unsigned L = (unsigned)i * (unsigned)G + (unsigned)c; if (L >= (unsigned)(NE * upe)) return false;
        const unsigned e0 = L / (unsigned)upe, rem = L - e0 * (unsigned)upe, e = rev ? (unsigned)(NE - 1) - e0 : e0; u.pm = (int)(e * 32u + (rem & 31u)); u.pn = (int)(e * (unsigned)npn + (rem >> 5)); return true; }
    __device__ __forceinline__ void a_ready(const Unit&) const {}
    __device__ __forceinline__ void done(const Unit&) const {}
};
struct EpiSwiglu {
    static constexpr bool PERM = true, AFTER_DRAIN = false;
    unsigned char* act;
    __device__ __forceinline__ void operator()(const f32x4 (&acc)[2][2][4][2], const Unit& u, int wr, int wc, int fr, int fq) const {
        const int e = u.pm >> 5, pnl = u.pn - 12 * e; const int row0 = u.pm * 256 + wr * 64 + fr, col = 128 * pnl + wc * 32 + 8 * fq;
        constexpr float WI = 1.0f / W_SCALE, OS = ACT_SCALE / W_SCALE;
#pragma unroll
        for (int ai = 0; ai < 2; ++ai)
#pragma unroll
            for (int m = 0; m < 4; ++m) { v2u o;
#pragma unroll
                for (int n = 0; n < 2; ++n) { const f32x4 G = acc[ai][0][m][n], U = acc[ai][1][m][n]; const f32x4 arg = G * (-1.4426950408889634f * WI);
                    f32x4 d = {__builtin_amdgcn_exp2f(arg.x), __builtin_amdgcn_exp2f(arg.y), __builtin_amdgcn_exp2f(arg.z), __builtin_amdgcn_exp2f(arg.w)}; d = d + 1.0f;
                    const f32x4 r = {__builtin_amdgcn_rcpf(d.x), __builtin_amdgcn_rcpf(d.y), __builtin_amdgcn_rcpf(d.z), __builtin_amdgcn_rcpf(d.w)};
                    const f32x4 v = (G * U) * (r * (WI * OS));
                    const unsigned pk = pk4f8(v.x, v.y, v.z, v.w); if (n == 0) o.x = pk; else o.y = pk; }
                *(GAS v2u*)(act + (size_t)(row0 + ai * 128 + m * 16) * DFF + col) = o; }
    }
};
struct EpiDown {
    static constexpr bool PERM = true, AFTER_DRAIN = false;
    unsigned char* y2; const float* val;
    __device__ __forceinline__ void operator()(const f32x4 (&acc)[2][2][4][2], const Unit& u, int wr, int wc, int fr, int fq) const {
        const int e = u.pm >> 5, pnl = u.pn - 4 * e; const int srow0 = u.pm * 256 + wr * 64 + fr, col0 = pnl * 256 + wc * 32 + 8 * fq;
#pragma unroll
        for (int ai = 0; ai < 2; ++ai)
#pragma unroll
            for (int m = 0; m < 4; ++m) { const int srow = srow0 + ai * 128 + m * 16; constexpr float vl = Y2_SCALE / (W_SCALE * ACT_SCALE);
#pragma unroll
                for (int bj = 0; bj < 2; ++bj) { const f32x4 v0 = acc[ai][bj][m][0] * vl, v1 = acc[ai][bj][m][1] * vl;
                    v2u w; w.x = pk4f8(v0.x, v0.y, v0.z, v0.w); w.y = pk4f8(v1.x, v1.y, v1.z, v1.w);
                    *(GAS v2u*)(y2 + (size_t)srow * DM + col0 + bj * 128) = w; } }
    }
};
constexpr int P12R = 4;
__device__ __forceinline__ void p12_combine(Frame& F, bool dostore = true) {
    const int gw = blockIdx.x * NWAVES + F.wave, NGW = F.G * NWAVES, lane = F.lane;
    const int* INV = (const int*)(F.ws + WS_INV); const unsigned char* Y2 = F.ws + WS_Y2; const float* VAL = (const float*)(F.ws + WS_VAL); const float* mod = (const float*)(F.ws + WS_MOD);
    const float* Xp = karg_in(I_X); const bf16* DELTA = (const bf16*)(F.ws + WS_DELTA);
    for (int m0 = gw; m0 < NLAT; m0 += P12R * NGW) {
        int inv[P12R]; f32x4 xv[P12R][4];
#pragma unroll
        for (int r = 0; r < P12R; ++r) { const int m = min(m0 + r * NGW, NLAT - 1);
            { const int iv = INV[(size_t)m * 16 + (lane & 15)]; inv[r] = lane < 16 ? iv : -1; const bf16* dr = DELTA + (size_t)m * DM;
                const v4u d0 = *(const GAS v4u*)(dr + 8 * lane), d1 = *(const GAS v4u*)(dr + 512 + 8 * lane);
                xv[r][0] = (f32x4){bflo(d0.x), bfhi(d0.x), bflo(d0.y), bfhi(d0.y)}; xv[r][1] = (f32x4){bflo(d0.z), bfhi(d0.z), bflo(d0.w), bfhi(d0.w)};
                xv[r][2] = (f32x4){bflo(d1.x), bfhi(d1.x), bflo(d1.y), bfhi(d1.y)}; xv[r][3] = (f32x4){bflo(d1.z), bfhi(d1.z), bflo(d1.w), bfhi(d1.w)}; } }
#pragma unroll
        for (int r = 0; r < P12R; ++r) { const int m = m0 + r * NGW; if (m >= NLAT) continue;
            const int b = m >> 11; unsigned long long mk = __ballot(inv[r] >= 0);
            float a0[8] = {0.f, 0.f, 0.f, 0.f, 0.f, 0.f, 0.f, 0.f}, a1[8] = {0.f, 0.f, 0.f, 0.f, 0.f, 0.f, 0.f, 0.f};
            while (mk) {
                const int e = __builtin_ctzll(mk); mk &= mk - 1; const int slot = __builtin_amdgcn_readlane(inv[r], e);
                const bool two = mk != 0; int e2 = e, slot2 = slot; if (two) { e2 = __builtin_ctzll(mk); mk &= mk - 1; slot2 = __builtin_amdgcn_readlane(inv[r], e2); }
                const unsigned char* yr = Y2 + ((size_t)(e * NB + b) * CAP + slot) * DM; const unsigned char* yr2 = Y2 + ((size_t)(e2 * NB + b) * CAP + slot2) * DM;
                const v2u q0 = *(const GAS v2u*)(yr + 8 * lane), q1 = *(const GAS v2u*)(yr + 512 + 8 * lane), q2 = *(const GAS v2u*)(yr2 + 8 * lane), q3 = *(const GAS v2u*)(yr2 + 512 + 8 * lane);
                float f0[8], f1[8], f2[8], f3[8]; unpack8f8(q0, f0); unpack8f8(q1, f1); unpack8f8(q2, f2); unpack8f8(q3, f3);
                const float w1 = VAL[(size_t)(e * NB + b) * CAP + slot], w2v = VAL[(size_t)(e2 * NB + b) * CAP + slot2]; const float w2 = two ? w2v : 0.0f;
#pragma unroll
                for (int j = 0; j < 8; ++j) { a0[j] += w1 * f0[j] + w2 * f2[j]; a1[j] += w1 * f1[j] + w2 * f3[j]; }
            }
            float* orow = F.out + (size_t)m * DM; const float* g = mod + (size_t)b * 6144 + 5120; constexpr float YI = 1.0f / Y2_SCALE;
            const f32x4 g0 = *(const f32x4*)(g + 8 * lane) * YI, g1 = *(const f32x4*)(g + 8 * lane + 4) * YI, g2 = *(const f32x4*)(g + 512 + 8 * lane) * YI, g3 = *(const f32x4*)(g + 512 + 8 * lane + 4) * YI;
            if (dostore) {
            *(GAS f32x4*)(orow + 8 * lane) = xv[r][0] + g0 * (f32x4){a0[0], a0[1], a0[2], a0[3]}; *(GAS f32x4*)(orow + 8 * lane + 4) = xv[r][1] + g1 * (f32x4){a0[4], a0[5], a0[6], a0[7]};
            *(GAS f32x4*)(orow + 512 + 8 * lane) = xv[r][2] + g2 * (f32x4){a1[0], a1[1], a1[2], a1[3]}; *(GAS f32x4*)(orow + 512 + 8 * lane + 4) = xv[r][3] + g3 * (f32x4){a1[4], a1[5], a1[6], a1[7]}; }
        }
    }
}

struct Args { const float* in[30]; float* out; unsigned char* ws; int ph_lo, ph_hi; };
__global__ void __launch_bounds__(NWAVES * 64, 2) mk_fwd(Args args) {
    extern __shared__ __attribute__((aligned(16))) unsigned char lds[];
    Frame F;
    F.lds = (LAS unsigned char*)lds; F.MISC = (volatile LAS unsigned*)(F.lds + MISC_OFF);
    F.wave = __builtin_amdgcn_readfirstlane((int)threadIdx.x >> 6); F.tid = F.wave * 64 + mk_lane(); F.lane = F.tid & 63; F.G = gridDim.x;
    F.out = args.out; F.ws = args.ws; F.ctl = (gu32*)(args.ws + WS_CTL);
    for (int u = F.tid; u < (LDS_BYTES - LDSCTL_OFF) / 4; u += NWAVES * 64) ((LAS unsigned*)(F.lds + LDSCTL_OFF))[u] = 0u;
    __syncthreads();
    XcdBarrier bar; bar.bar = (unsigned*)(F.ctl + CW_BAR); bar.x = 0; bar.st = nullptr; bar.w = F.wave;
    if (N_LAUNCHES == 1) bar = xcd_barrier_post((unsigned*)(F.ctl + CW_BAR), F.MISC + 8);
#define GRID_BAR() do { if (N_LAUNCHES == 1) xcd_barrier(bar); } while (0)
    const int lo = args.ph_lo, hi = args.ph_hi;
#ifndef PH_MASK
#define PH_MASK 0x1FFF
#endif
#define IN(k) (((PH_MASK >> (k)) & 1) && lo <= (k) && (k) < hi && ((F.tid = F.wave * 64 + mk_lane()), (F.lane = F.tid & 63), true))
#define SEAM(k) do { if (IN(k) && IN((k) + 1)) GRID_BAR(); } while (0)
    unsigned char* ws = args.ws;

    if (IN(0)) { p0_prologue(F); } SEAM(0);
    if (IN(1)) { p1_norm1(F); } SEAM(1);
    if (IN(2)) {
        pg8::Gemm g{(const bf16*)(ws + WS_H1), (const bf16*)(ws + WS_WIN), NTOK, WIN_ROWS, DM}; InprojOrder S; S.init(F.G, (int)blockIdx.x);
        EpiInproj E{(bf16*)(ws + WS_ZK), (bf16*)(ws + WS_ZV), (bf16*)(ws + WS_ZR), (bf16*)(ws + WS_Q), (bf16*)(ws + WS_KQ), (bf16*)(ws + WS_VQ), (bf16*)(ws + WS_LA)};
        pg8::gemm_phase<EpiInproj, InprojOrder, true, true>(F.lds, g, S, E, F.wave, F.lane);
        __syncthreads();
        pg8::Gemm g8{(const bf16*)(ws + WS_H1Q), (const bf16*)(ws + WS_WG8), NLAT, 2048, DM / 2}; pg8::StaticOrder S8; S8.init(NLAT, 2048, F.G, (int)blockIdx.x);
        EpiGates E8{(bf16*)args.out};
        pg8::gemm_phase<EpiGates, pg8::StaticOrder, true, true, false, false, true>(F.lds, g8, S8, E8, F.wave, F.lane);
    } SEAM(2);
    if (IN(3)) {
        p3a_lora(F);
        p3b_attn_prep(F);
    } SEAM(3);
    if (IN(4)) { p4a_attention(F); __syncthreads(); p4b_scan(F); } SEAM(4);
    if (IN(5)) { p5_rwkv_out(F); } SEAM(5);
    if (IN(6)) {
        pg8::Gemm g{(const bf16*)(ws + WS_ORW), (const bf16*)(ws + WS_WBRR), NLAT, DM, DM, (const bf16*)(ws + WS_Q), 512}; pg8::StaticOrder S; S.init(NLAT, DM, F.G, (int)blockIdx.x);
        EpiMerge2 E{(bf16*)(ws + WS_MERGED), (const bf16*)args.out};
        pg8::gemm_phase<EpiMerge2, pg8::StaticOrder, true, true, true>(F.lds, g, S, E, F.wave, F.lane);
    } SEAM(6);
    if (IN(7)) {
        pg8::Gemm g{(const bf16*)(ws + WS_MERGED), (const bf16*)(ws + WS_WOUT), NLAT, DM, DM}; pg8::StaticOrder S; S.init(NLAT, DM, F.G, (int)blockIdx.x);
        EpiOutproj E{(bf16*)(ws + WS_DELTA), (const float*)(ws + WS_MOD), karg_in(I_X)};
        pg8::gemm_phase<EpiOutproj, pg8::StaticOrder, true, true>(F.lds, g, S, E, F.wave, F.lane);
    } SEAM(7);
    if (IN(8)) { p8_norm2_router(F); } SEAM(8);
    if (IN(9)) { p9_topk_gather(F); } SEAM(9);
    if (IN(10)) {
        pg8::Gemm g{(const bf16*)(ws + WS_H2Q), (const bf16*)(ws + WS_WGU), NSLOT, NE * 3072, DM / 2, nullptr, 0, (const int*)(ws + WS_IDX), (LAS int*)(F.lds + RING_BYTES)}; ExpertOrder S; S.init(F.G, (int)blockIdx.x, 12);
        EpiSwiglu E{ws + WS_ACT};
        pg8::gemm_phase<EpiSwiglu, ExpertOrder, true, true, false, true, true>(F.lds, g, S, E, F.wave, F.lane);
    } SEAM(10);
    if (IN(11)) {
        pg8::Gemm g{(const bf16*)(ws + WS_ACT), (const bf16*)(ws + WS_WD), NSLOT, NE * 1024, DFF / 2}; ExpertOrder S; S.init(F.G, (int)blockIdx.x, 4); S.rev = 1;
        EpiDown E{ws + WS_Y2, (const float*)(ws + WS_VAL)};
        pg8::gemm_phase<EpiDown, ExpertOrder, true, true, false, false, true>(F.lds, g, S, E, F.wave, F.lane);
    } SEAM(11);
    if (IN(12)) { p12_combine(F); }
#undef IN
#undef SEAM
#undef GRID_BAR
}

extern "C" void kernel_launch(void* const* d_in, const int* in_sizes, int n_in, void* d_out, int out_size, void* d_ws, size_t ws_size, hipStream_t stream) {
    static int grid = 0;
    if (grid == 0) {
        if (n_in != 30 || out_size != NLAT * DM || ws_size < WS_END) { fprintf(stderr, "kernel_launch: unexpected problem (n_in %d out %d ws %zu)\n", n_in, out_size, ws_size); grid = -1; return; }
        int dev = 0, cus = 0, per_cu = 0;
        if (hipGetDevice(&dev) != hipSuccess || hipDeviceGetAttribute(&cus, hipDeviceAttributeMultiprocessorCount, dev) != hipSuccess) { grid = -1; return; }
        if (hipFuncSetAttribute((const void*)mk_fwd, hipFuncAttributeMaxDynamicSharedMemorySize, LDS_BYTES) != hipSuccess) { fprintf(stderr, "kernel_launch: hipFuncSetAttribute failed\n"); grid = -1; return; }
        if (hipOccupancyMaxActiveBlocksPerMultiprocessor(&per_cu, (const void*)mk_fwd, NWAVES * 64, LDS_BYTES) != hipSuccess || per_cu < 1) fprintf(stderr, "kernel_launch: occupancy query says %d\n", per_cu);
        (void)hipGetLastError();
        grid = cus;
    }
    if (grid < 0) return;
    if (hipMemsetAsync((char*)d_ws + WS_CTL, 0, CTL_ZERO_BYTES, stream) != hipSuccess) return;
    Args a{};
    for (int i = 0; i < 30; ++i) a.in[i] = (const float*)d_in[i];
    a.out = (float*)d_out; a.ws = (unsigned char*)d_ws;
    if (N_LAUNCHES == 1) { a.ph_lo = 0; a.ph_hi = N_PHASES; hipLaunchKernelGGL(mk_fwd, dim3(grid), dim3(NWAVES * 64), LDS_BYTES, stream, a); }
    else for (int li = 0; li < N_PHASES; ++li) { a.ph_lo = li; a.ph_hi = li + 1; hipLaunchKernelGGL(mk_fwd, dim3(grid), dim3(NWAVES * 64), LDS_BYTES, stream, a); }
}
```
